# Optimizing an MI355X kernel written in HIP

```python
import math
import jax
import jax.numpy as jnp
from jax import lax
import numpy as np

D_MODEL = 1024
BATCH = 16
SEQ = 2048
DEPTH = 2

N_BRANCH = 4
BRANCH = 512
ROPE_THETA = 500000.0
EPS = 1e-6
Q_BLOCK = 128

DA_HEADS = 4
DA_DHALF = 64
DA_DV = 2 * DA_DHALF
DA_ROT = DA_DHALF // 4

MB_HEADDIM = 64
MB_HEADS = BRANCH // MB_HEADDIM
MB_GROUPS = 2
MB_PER_GROUP = MB_HEADS // MB_GROUPS
MB_STATE = 128
MB_CONV = 4
MB_CHUNK = 128
MB_CONV_DIM = BRANCH + 2 * MB_GROUPS * MB_STATE

S5_GROUP = 16
S5_GROUPS = BRANCH // S5_GROUP
S5_STATE = 64

MLA_HEADS = 4
MLA_Q_RANK = 256
MLA_KV_RANK = 128
MLA_NOPE = 128
MLA_ROPE = 64
MLA_V = BRANCH // MLA_HEADS
MLA_QK = MLA_NOPE + MLA_ROPE

IN_LAYOUT = (
    ('da_q', DA_HEADS * 2 * DA_DHALF),
    ('da_k', DA_HEADS * 2 * DA_DHALF),
    ('da_v', DA_HEADS * DA_DV),
    ('da_gate', BRANCH),
    ('mb_z', BRANCH),
    ('mb_xbc', MB_CONV_DIM),
    ('mb_dt', MB_HEADS),
    ('s5_u', BRANCH),
    ('s5_gate', BRANCH),
    ('mla_cq', MLA_Q_RANK),
    ('mla_ckv', MLA_KV_RANK),
    ('mla_krope', MLA_ROPE),
    ('mla_gate', BRANCH),
    ('gate_a', D_MODEL),
    ('gate_b', D_MODEL),
    ('gate_c', D_MODEL),
    ('gate_d', D_MODEL),
)
D_IN = sum(n for _, n in IN_LAYOUT)

kernel_name = 'hybrid_gated_diffattn_ssd_s5_mla'


def in_proj(h, w, name):
    start = 0
    for nm, n in IN_LAYOUT:
        if nm == name:
            return h @ w[:, start:start + n]
        start += n
    raise KeyError(name)


def rmsnorm(x, g):
    xf = x.astype(jnp.float32)
    y = xf * lax.rsqrt(jnp.mean(xf * xf, axis=-1, keepdims=True) + EPS)
    return (y * g.astype(jnp.float32)).astype(x.dtype)


def rope_tables(positions, rot_dim, dtype):
    inv_freq = 1.0 / (ROPE_THETA ** (jnp.arange(0, rot_dim, 2, dtype=jnp.float32) / rot_dim))
    ang = positions.astype(jnp.float32)[..., None] * inv_freq
    return jnp.cos(ang).astype(dtype), jnp.sin(ang).astype(dtype)


def rotate(x, cos, sin):
    half = x.shape[-1] // 2
    x1, x2 = x[..., :half], x[..., half:]
    return jnp.concatenate([x1 * cos - x2 * sin, x2 * cos + x1 * sin], axis=-1)


def causal_block_attention(q, k, v, scale):
    bsz, s = q.shape[0], q.shape[1]
    nb = s // Q_BLOCK
    qb = q.reshape((bsz, nb, Q_BLOCK) + q.shape[2:]).swapaxes(0, 1)
    kpos = jnp.arange(s)

    def one_block(args):
        qi, i = args
        sc = jnp.einsum('bqhmd,bkhmd->bhmqk', qi, k).astype(jnp.float32) * scale
        qpos = i * Q_BLOCK + jnp.arange(Q_BLOCK)
        sc = jnp.where(kpos[None, :] <= qpos[:, None], sc, -jnp.inf)
        p = jax.nn.softmax(sc, axis=-1).astype(v.dtype)
        return jnp.einsum('bhmqk,bkhe->bqhme', p, v)

    out = lax.map(one_block, (qb, jnp.arange(nb)))
    return out.swapaxes(0, 1).reshape((bsz, s) + out.shape[3:])


def diff_attention(q, k, v, gate, positions, q_g, k_g, lq1, lk1, lq2, lk2, subln_g, lambda_init):
    bsz, s = q.shape[0], q.shape[1]
    f32 = jnp.float32
    q = rmsnorm(q.reshape(bsz, s, DA_HEADS, 2, DA_DHALF), q_g)
    k = rmsnorm(k.reshape(bsz, s, DA_HEADS, 2, DA_DHALF), k_g)
    cos, sin = rope_tables(positions, DA_ROT, q.dtype)
    cos, sin = cos[:, :, None, None, :], sin[:, :, None, None, :]
    q = jnp.concatenate([rotate(q[..., :DA_ROT], cos, sin), q[..., DA_ROT:]], axis=-1)
    k = jnp.concatenate([rotate(k[..., :DA_ROT], cos, sin), k[..., DA_ROT:]], axis=-1)
    v = v.reshape(bsz, s, DA_HEADS, DA_DV)
    o = causal_block_attention(q, k, v, DA_DHALF ** -0.5)
    lam = (jnp.exp(jnp.sum(lq1.astype(f32) * lk1.astype(f32)))
           - jnp.exp(jnp.sum(lq2.astype(f32) * lk2.astype(f32))) + lambda_init)
    o = o[..., 0, :] - lam.astype(o.dtype) * o[..., 1, :]
    o = rmsnorm(o, subln_g) * (1.0 - lambda_init)
    return o.reshape(bsz, s, BRANCH) * jax.nn.silu(gate)


def causal_depthwise_conv(x, w, b):
    c = x.shape[-1]
    y = lax.conv_general_dilated(x, w[:, None, :].astype(x.dtype), window_strides=(1,),
                                 padding=[(MB_CONV - 1, 0)],
                                 dimension_numbers=('NWC', 'WIO', 'NWC'),
                                 feature_group_count=c)
    return y + b


def segsum(a):
    t = a.shape[-1]
    cs = jnp.cumsum(a, axis=-1)
    diff = cs[..., :, None] - cs[..., None, :]
    return jnp.where(jnp.tril(jnp.ones((t, t), dtype=bool)), diff, -jnp.inf)


def ssd_chunked(X, A, Bm, Cm):
    bsz, s, g, r, p = X.shape
    n = Bm.shape[-1]
    c, l = s // MB_CHUNK, MB_CHUNK
    Xc = X.reshape(bsz, c, l, g, r, p)
    Bc = Bm.reshape(bsz, c, l, g, n)
    Cc = Cm.reshape(bsz, c, l, g, n)
    Ac = A.reshape(bsz, c, l, g, r).transpose(0, 1, 3, 4, 2)
    Acum = jnp.cumsum(Ac, axis=-1)
    Lmat = jnp.exp(segsum(Ac))
    CB = jnp.einsum('bclgn,bcsgn->bcgls', Cc, Bc)
    y_diag = jnp.einsum('bcgrls,bcsgrp->bclgrp', CB[:, :, :, None] * Lmat, Xc)
    decay_states = jnp.exp(Acum[..., -1:] - Acum)
    states = jnp.einsum('bclgn,bcgrl,bclgrp->bcgrpn', Bc, decay_states, Xc)
    states = jnp.concatenate([jnp.zeros_like(states[:, :1]), states], axis=1)
    a_last = jnp.pad(Acum[..., -1], ((0, 0), (1, 0), (0, 0), (0, 0)))
    decay_chunk = jnp.exp(segsum(a_last.transpose(0, 2, 3, 1)))
    new_states = jnp.einsum('bgrzc,bcgrpn->bzgrpn', decay_chunk, states)
    states_in = new_states[:, :-1]
    y_off = jnp.einsum('bclgn,bcgrpn,bcgrl->bclgrp', Cc, states_in, jnp.exp(Acum))
    return (y_diag + y_off).reshape(bsz, s, g, r, p)


def mamba2_branch(z, xbc, dt, conv_w, conv_b, dt_bias, a_log, d_skip, norm_g):
    bsz, s = z.shape[0], z.shape[1]
    f32 = jnp.float32
    xbc = jax.nn.silu(causal_depthwise_conv(xbc, conv_w, conv_b))
    xs = xbc[..., :BRANCH]
    Bm = xbc[..., BRANCH:BRANCH + MB_GROUPS * MB_STATE]
    Cm = xbc[..., BRANCH + MB_GROUPS * MB_STATE:]
    dt = jax.nn.softplus(dt.astype(f32) + dt_bias.astype(f32))
    A = -jnp.exp(a_log.astype(f32)).reshape(MB_GROUPS, MB_PER_GROUP)
    dtg = dt.reshape(bsz, s, MB_GROUPS, MB_PER_GROUP)
    X = xs.astype(f32).reshape(bsz, s, MB_GROUPS, MB_PER_GROUP, MB_HEADDIM)
    y = ssd_chunked(X * dtg[..., None], dtg * A,
                    Bm.astype(f32).reshape(bsz, s, MB_GROUPS, MB_STATE),
                    Cm.astype(f32).reshape(bsz, s, MB_GROUPS, MB_STATE))
    y = y + d_skip.astype(f32).reshape(MB_GROUPS, MB_PER_GROUP)[:, :, None] * X
    y = y.reshape(bsz, s, BRANCH).astype(z.dtype) * jax.nn.silu(z)
    y = rmsnorm(y.reshape(bsz, s, MB_GROUPS, BRANCH // MB_GROUPS),
                norm_g.reshape(MB_GROUPS, BRANCH // MB_GROUPS))
    return y.reshape(bsz, s, BRANCH)


def complex_linear_combine(e1, e2):
    a1r, a1i, b1r, b1i = e1
    a2r, a2i, b2r, b2i = e2
    return (a2r * a1r - a2i * a1i, a2r * a1i + a2i * a1r,
            a2r * b1r - a2i * b1i + b2r, a2r * b1i + a2i * b1r + b2i)


def s5_branch(u, gate, lam_re, lam_im, log_step, b_re, b_im, c_re, c_im, d_skip, w_glu, b_glu):
    bsz, s = u.shape[0], u.shape[1]
    f32 = jnp.float32
    uf = u.astype(f32)
    ug = uf.reshape(bsz, s, S5_GROUPS, S5_GROUP)
    lr, li = lam_re.astype(f32), lam_im.astype(f32)
    step = jnp.exp(log_step.astype(f32))[:, None]
    mag = jnp.exp(lr * step)
    ab_re, ab_im = mag * jnp.cos(li * step), mag * jnp.sin(li * step)
    den = lr * lr + li * li
    f_re = ((ab_re - 1.0) * lr + ab_im * li) / den
    f_im = (ab_im * lr - (ab_re - 1.0) * li) / den
    br, bi = b_re.astype(f32), b_im.astype(f32)
    bb_re = f_re[..., None] * br - f_im[..., None] * bi
    bb_im = f_re[..., None] * bi + f_im[..., None] * br
    bu_re = jnp.einsum('bsgc,gpc->sbgp', ug, bb_re)
    bu_im = jnp.einsum('bsgc,gpc->sbgp', ug, bb_im)
    a_re = jnp.broadcast_to(ab_re, (s, 1) + ab_re.shape)
    a_im = jnp.broadcast_to(ab_im, (s, 1) + ab_im.shape)
    _, _, h_re, h_im = lax.associative_scan(complex_linear_combine, (a_re, a_im, bu_re, bu_im), axis=0)
    y = (jnp.einsum('sbgp,gcp->bsgc', h_re, c_re.astype(f32))
         - jnp.einsum('sbgp,gcp->bsgc', h_im, c_im.astype(f32)))
    y = y.reshape(bsz, s, BRANCH) + d_skip.astype(f32) * uf
    y = jax.nn.gelu(y)
    y = y * jax.nn.sigmoid(y @ w_glu.astype(f32) + b_glu.astype(f32))
    return y.astype(u.dtype) * jax.nn.silu(gate)


def mla_branch(c_q, c_kv, k_rope, gate, positions, q_a_norm, w_uq, kv_a_norm, w_ukv, q_norm, k_norm):
    bsz, s = c_q.shape[0], c_q.shape[1]
    q = (rmsnorm(c_q, q_a_norm) @ w_uq).reshape(bsz, s, MLA_HEADS, MLA_QK)
    kv = (rmsnorm(c_kv, kv_a_norm) @ w_ukv).reshape(bsz, s, MLA_HEADS, MLA_NOPE + MLA_V)
    k_nope, v = kv[..., :MLA_NOPE], kv[..., MLA_NOPE:]
    k = jnp.concatenate([k_nope, jnp.broadcast_to(k_rope[:, :, None, :], (bsz, s, MLA_HEADS, MLA_ROPE))], axis=-1)
    q = rmsnorm(q, q_norm)
    k = rmsnorm(k, k_norm)
    cos, sin = rope_tables(positions, MLA_ROPE, q.dtype)
    cos, sin = cos[:, :, None, :], sin[:, :, None, :]
    q = jnp.concatenate([q[..., :MLA_NOPE], rotate(q[..., MLA_NOPE:], cos, sin)], axis=-1)
    k = jnp.concatenate([k[..., :MLA_NOPE], rotate(k[..., MLA_NOPE:], cos, sin)], axis=-1)
    o = causal_block_attention(q[:, :, :, None], k[:, :, :, None], v, MLA_QK ** -0.5)
    return o.reshape(bsz, s, BRANCH) * jax.nn.silu(gate)


def setup_inputs(seed: int = 0) -> dict:
    key = jax.random.key(seed)
    ks = list(jax.random.split(key, 64))
    f32 = jnp.float32
    L = DEPTH

    def normal(shape, scale):
        return scale * jax.random.normal(ks.pop(), shape, f32)

    def gain(shape):
        return 1.0 + 0.02 * jax.random.normal(ks.pop(), shape, f32)

    def log_uniform(shape, lo, hi):
        return jax.random.uniform(ks.pop(), shape, f32, math.log(lo), math.log(hi))

    x = normal((BATCH, SEQ, D_MODEL), 1.0)
    positions = (jnp.arange(SEQ, dtype=jnp.int32)[None, :]
                 + jax.random.randint(ks.pop(), (BATCH, 1), 0, SEQ, dtype=jnp.int32))
    dt0 = jnp.exp(log_uniform((L, MB_HEADS), 1e-3, 1e-1))
    mb_dt_bias = dt0 + jnp.log(-jnp.expm1(-dt0))
    mb_a_log = jnp.log(jax.random.uniform(ks.pop(), (L, MB_HEADS), f32, 1.0, 16.0))
    s5_lam_re = -0.5 + normal((L, S5_GROUPS, S5_STATE), 0.01)
    s5_lam_im = (jnp.pi * jnp.arange(S5_STATE, dtype=f32))[None, None, :] + normal((L, S5_GROUPS, S5_STATE), 0.01)
    return {
        'x': x,
        'positions': positions,
        'norm_g': gain((L, D_MODEL)),
        'w_in': normal((L, D_MODEL, D_IN), D_MODEL ** -0.5),
        'da_q_norm': gain((L, DA_DHALF)),
        'da_k_norm': gain((L, DA_DHALF)),
        'da_lambda_q1': normal((L, DA_DHALF), 0.1),
        'da_lambda_k1': normal((L, DA_DHALF), 0.1),
        'da_lambda_q2': normal((L, DA_DHALF), 0.1),
        'da_lambda_k2': normal((L, DA_DHALF), 0.1),
        'da_subln': gain((L, DA_DV)),
        'mb_conv_w': normal((L, MB_CONV, MB_CONV_DIM), MB_CONV ** -0.5),
        'mb_conv_b': normal((L, MB_CONV_DIM), 0.02),
        'mb_dt_bias': mb_dt_bias,
        'mb_a_log': mb_a_log,
        'mb_d': gain((L, MB_HEADS)),
        'mb_norm': gain((L, BRANCH)),
        's5_lam_re': s5_lam_re,
        's5_lam_im': s5_lam_im,
        's5_log_step': log_uniform((L, S5_GROUPS), 1e-3, 1e-1),
        's5_b_re': normal((L, S5_GROUPS, S5_STATE, S5_GROUP), (2 * S5_GROUP) ** -0.5),
        's5_b_im': normal((L, S5_GROUPS, S5_STATE, S5_GROUP), (2 * S5_GROUP) ** -0.5),
        's5_c_re': normal((L, S5_GROUPS, S5_GROUP, S5_STATE), S5_STATE ** -0.5),
        's5_c_im': normal((L, S5_GROUPS, S5_GROUP, S5_STATE), S5_STATE ** -0.5),
        's5_d': gain((L, BRANCH)),
        's5_w_glu': normal((L, BRANCH, BRANCH), BRANCH ** -0.5),
        's5_b_glu': normal((L, BRANCH), 0.02),
        'mla_q_a_norm': gain((L, MLA_Q_RANK)),
        'mla_w_uq': normal((L, MLA_Q_RANK, MLA_HEADS * MLA_QK), MLA_Q_RANK ** -0.5),
        'mla_kv_a_norm': gain((L, MLA_KV_RANK)),
        'mla_w_ukv': normal((L, MLA_KV_RANK, MLA_HEADS * (MLA_NOPE + MLA_V)), MLA_KV_RANK ** -0.5),
        'mla_q_norm': gain((L, MLA_QK)),
        'mla_k_norm': gain((L, MLA_QK)),
        'w_br': normal((L, N_BRANCH, BRANCH, D_MODEL), BRANCH ** -0.5),
        'w_out': normal((L, D_MODEL, D_MODEL), D_MODEL ** -0.5),
    }


def reference(x, positions, norm_g, w_in, da_q_norm, da_k_norm, da_lambda_q1, da_lambda_k1,
              da_lambda_q2, da_lambda_k2, da_subln, mb_conv_w, mb_conv_b, mb_dt_bias, mb_a_log,
              mb_d, mb_norm, s5_lam_re, s5_lam_im, s5_log_step, s5_b_re, s5_b_im, s5_c_re,
              s5_c_im, s5_d, s5_w_glu, s5_b_glu, mla_q_a_norm, mla_w_uq, mla_kv_a_norm,
              mla_w_ukv, mla_q_norm, mla_k_norm, w_br, w_out):
    gate_names = ('gate_a', 'gate_b', 'gate_c', 'gate_d')
    for l in range(DEPTH):
        h = rmsnorm(x, norm_g[l])
        w = w_in[l]
        lambda_init = 0.8 - 0.6 * math.exp(-0.3 * l)
        y_a = diff_attention(in_proj(h, w, 'da_q'), in_proj(h, w, 'da_k'), in_proj(h, w, 'da_v'),
                             in_proj(h, w, 'da_gate'), positions, da_q_norm[l], da_k_norm[l],
                             da_lambda_q1[l], da_lambda_k1[l], da_lambda_q2[l], da_lambda_k2[l],
                             da_subln[l], lambda_init)
        y_b = mamba2_branch(in_proj(h, w, 'mb_z'), in_proj(h, w, 'mb_xbc'), in_proj(h, w, 'mb_dt'),
                            mb_conv_w[l], mb_conv_b[l], mb_dt_bias[l], mb_a_log[l], mb_d[l], mb_norm[l])
        y_c = s5_branch(in_proj(h, w, 's5_u'), in_proj(h, w, 's5_gate'), s5_lam_re[l], s5_lam_im[l],
                        s5_log_step[l], s5_b_re[l], s5_b_im[l], s5_c_re[l], s5_c_im[l], s5_d[l],
                        s5_w_glu[l], s5_b_glu[l])
        y_d = mla_branch(in_proj(h, w, 'mla_cq'), in_proj(h, w, 'mla_ckv'), in_proj(h, w, 'mla_krope'),
                         in_proj(h, w, 'mla_gate'), positions, mla_q_a_norm[l], mla_w_uq[l],
                         mla_kv_a_norm[l], mla_w_ukv[l], mla_q_norm[l], mla_k_norm[l])
        branches = (y_a, y_b, y_c, y_d)
        merged = jax.nn.sigmoid(in_proj(h, w, gate_names[0])) * (branches[0] @ w_br[l, 0])
        for n in range(1, N_BRANCH):
            merged = merged + jax.nn.sigmoid(in_proj(h, w, gate_names[n])) * (branches[n] @ w_br[l, n])
        x = x + merged @ w_out[l]
    return x
```

```cpp
#include <hip/hip_runtime.h>
#include <hip/hip_cooperative_groups.h>
#include <cstdio>
#include <cstdint>
namespace cg = cooperative_groups;

typedef unsigned short bf16_t;
typedef short bf16x8 __attribute__((ext_vector_type(8)));
typedef float f32x4 __attribute__((ext_vector_type(4)));
typedef unsigned u32x4 __attribute__((ext_vector_type(4)));
typedef unsigned u32x2 __attribute__((ext_vector_type(2)));

constexpr int SEQ = 2048, BATCH = 16;
constexpr int D_IN = 9672, D_INP = 9728;
constexpr int RB = 4;
constexpr int TR = RB * SEQ;
constexpr int NROUND = BATCH / RB;
constexpr int NRT = TR / 128;
constexpr int NBC = TR / 8;
constexpr int MAXBLK = 512;
constexpr float EPS = 1e-6f;
constexpr float LOG2E = 1.4426950408889634f;
constexpr int C_DAQ = 0, C_DAK = 512, C_DAV = 1024, C_DAG = 1536, C_MBZ = 2048, C_XBC = 2560, C_DT = 3584,
              C_S5U = 3592, C_S5G = 4104, C_CQ = 4616, C_CKV = 4872, C_KR = 5000, C_MLG = 5064, C_GATE = 5576;
constexpr long LDP = D_INP;

constexpr size_t al256(size_t x) { return (x + 255) & ~size_t(255); }
constexpr size_t OFF_WINT = 0;
constexpr size_t OFF_WBRT = OFF_WINT + al256((size_t)2 * D_INP * 1024 * 2);
constexpr size_t OFF_WOUTT = OFF_WBRT + al256((size_t)2 * 4 * 1024 * 512 * 2);
constexpr size_t OFF_WGLUT = OFF_WOUTT + al256((size_t)2 * 1024 * 1024 * 2);
constexpr size_t OFF_WUQT = OFF_WGLUT + al256((size_t)2 * 512 * 512 * 2);
constexpr size_t OFF_WUKVT = OFF_WUQT + al256((size_t)2 * 768 * 256 * 2);
constexpr size_t OFF_KMAT = OFF_WUKVT + al256((size_t)2 * 1024 * 128 * 2);
constexpr size_t OFF_EMAT = OFF_KMAT + al256((size_t)2 * 32 * 128 * 128 * 2);
constexpr size_t OFF_FMAT = OFF_EMAT + al256((size_t)2 * 32 * 128 * 128 * 2);
constexpr size_t OFF_A8 = OFF_FMAT + al256((size_t)2 * 32 * 128 * 128 * 2);
constexpr size_t OFF_LAM = OFF_A8 + al256((size_t)2 * 32 * 64 * 2 * 4);
constexpr size_t OFF_H = OFF_LAM + 256;
constexpr size_t OFF_PROJ = OFF_H + al256((size_t)TR * 1024 * 2);
constexpr size_t OFF_XC = OFF_PROJ + al256((size_t)TR * D_INP * 2);
constexpr size_t OFF_DT = OFF_XC + al256((size_t)TR * 1024 * 2);
constexpr size_t OFF_ACUM = OFF_DT + al256((size_t)TR * 8 * 4);
constexpr size_t OFF_VTA = OFF_ACUM + al256((size_t)TR * 8 * 4);
constexpr size_t OFF_VTD = OFF_VTA + al256((size_t)RB * 4 * 128 * 2048 * 2);
constexpr size_t OFF_QM = OFF_VTD + al256((size_t)RB * 4 * 128 * 2048 * 2);
constexpr size_t OFF_KM = OFF_QM + al256((size_t)TR * 768 * 2);
constexpr size_t OFF_KN = OFF_KM + al256((size_t)TR * 768 * 2);
constexpr size_t OFF_ST = OFF_KN + al256((size_t)TR * 512 * 2);
constexpr size_t OFF_SIN = OFF_ST + al256((size_t)RB * 16 * 8 * 8192 * 4);
constexpr size_t OFF_MS = OFF_SIN + al256((size_t)RB * 16 * 8 * 8192 * 2);
constexpr size_t OFF_XS = OFF_MS + al256((size_t)MAXBLK * 128 * 128 * 2);
constexpr size_t OFF_E = OFF_XS + al256((size_t)MAXBLK * 128 * 64 * 2);
constexpr size_t OFF_HIN = OFF_E + al256((size_t)32 * 128 * NBC * 4);
constexpr size_t OFF_YG = OFF_HIN + al256((size_t)32 * 128 * NBC * 2);
constexpr size_t OFF_MERGED = OFF_YG + al256((size_t)TR * 512 * 2);
constexpr size_t OFF_BAR = OFF_MERGED + al256((size_t)TR * 1024 * 2);
constexpr size_t WS_TOTAL = OFF_BAR + 8192;

constexpr int SMEM_BYTES = 55296 + 4096;

struct Params {
  const float* in[35];
  float* out;
  unsigned char* ws;
};

#define MEMBAR() do { asm volatile("" ::: "memory"); __builtin_amdgcn_sched_barrier(0); } while (0)
__device__ __forceinline__ int otid() { int t = threadIdx.x; asm volatile("" : "+v"(t)); return t; }
__device__ __forceinline__ bf16_t f2bf(float f) {
  unsigned u = __float_as_uint(f);
  u += 0x7fffu + ((u >> 16) & 1u);
  return (bf16_t)(u >> 16);
}
__device__ __forceinline__ float bf2f(bf16_t b) { return __uint_as_float(((unsigned)b) << 16); }
__device__ __forceinline__ unsigned pack2(float a, float b) { return (unsigned)f2bf(a) | ((unsigned)f2bf(b) << 16); }
__device__ __forceinline__ float sigmoidf_(float x) { return 1.0f / (1.0f + __expf(-x)); }
__device__ __forceinline__ float siluf_(float x) { return x / (1.0f + __expf(-x)); }
__device__ __forceinline__ float gelu_tanh(float x) {
  float u = 0.7978845608028654f * (x + 0.044715f * x * x * x);
  float t = 1.0f - 2.0f / (__expf(2.0f * u) + 1.0f);
  return 0.5f * x * (1.0f + t);
}
__device__ __forceinline__ float wave_sum(float v) {
#pragma unroll
  for (int d = 32; d >= 1; d >>= 1) v += __shfl_xor(v, d, 64);
  return v;
}

__device__ __forceinline__ void block_global_handoff() {
  asm volatile("s_waitcnt vmcnt(0)" ::: "memory");
  __syncthreads();
  if (otid() < 64) {
    __builtin_amdgcn_fence(__ATOMIC_ACQUIRE, "agent");
    asm volatile("s_waitcnt vmcnt(0)" ::: "memory");
  }
  __syncthreads();
}
template <int R, bool T, bool SEG, int N>
__device__ __forceinline__ void g_load(u32x4 (&rg)[N], const bf16_t* __restrict__ P, long ld, int k0, long segs, int tid) {
#pragma unroll
  for (int i = 0; i < N; ++i) {
    const int ch = tid + i * 256;
    if (!T) {
      const int row = ch >> 3, kc = k0 + (ch & 7) * 8;
      const long ko = SEG ? ((long)(kc >> 4) * segs + (kc & 15)) : (long)kc;
      rg[i] = *(const u32x4*)(P + (long)row * ld + ko);
    } else {
      constexpr int CPR = R / 8;
      const int kk = ch / CPR, m0 = (ch % CPR) * 8;
      rg[i] = *(const u32x4*)(P + (long)(k0 + kk) * ld + m0);
    }
  }
}
template <int R, bool T, int N>
__device__ __forceinline__ void s_store(const u32x4 (&rg)[N], bf16_t* sm, int tid) {
  constexpr int LS = 72;
#pragma unroll
  for (int i = 0; i < N; ++i) {
    const int ch = tid + i * 256;
    if (!T) {
      const int row = ch >> 3, kc = (ch & 7) * 8;
      *(u32x4*)(sm + row * LS + kc) = rg[i];
    } else {
      constexpr int CPR = R / 8;
      const int kk = ch / CPR, m0 = (ch % CPR) * 8;
      bf16_t* d = sm + m0 * LS + kk;
      d[0 * LS] = (bf16_t)(rg[i].x & 0xffffu); d[1 * LS] = (bf16_t)(rg[i].x >> 16);
      d[2 * LS] = (bf16_t)(rg[i].y & 0xffffu); d[3 * LS] = (bf16_t)(rg[i].y >> 16);
      d[4 * LS] = (bf16_t)(rg[i].z & 0xffffu); d[5 * LS] = (bf16_t)(rg[i].z >> 16);
      d[6 * LS] = (bf16_t)(rg[i].w & 0xffffu); d[7 * LS] = (bf16_t)(rg[i].w >> 16);
    }
  }
}
template <int BN, bool TA, bool TB, bool SEGA>
__device__ __forceinline__ void gemm_tile(f32x4 (&acc)[4][BN / 32], const bf16_t* __restrict__ A, long lda,
                                          const bf16_t* __restrict__ B, long ldb, int K, bf16_t* smem, long segs = 0) {
  constexpr int LS = 72;
  bf16_t* sA = smem;
  bf16_t* sB = smem + 128 * LS;
  const int tid = otid(), w = tid >> 6, l = tid & 63, g = l >> 4, c = l & 15;
  const int wr = w >> 1, wc = w & 1;
  constexpr int NA = 4, NB = BN / 32;
  u32x4 ra[NA], rb[NB];
  const int nk = K / 64;
  g_load<128, TA, SEGA, NA>(ra, A, lda, 0, segs, tid);
  g_load<BN, TB, false, NB>(rb, B, ldb, 0, 0, tid);
  const bf16_t* pa = sA + (wr * 64 + c) * LS + g * 8;
  const bf16_t* pb = sB + (wc * (BN / 2) + c) * LS + g * 8;
  for (int kt = 0; kt < nk; ++kt) {
    __syncthreads();
    s_store<128, TA, NA>(ra, sA, tid);
    s_store<BN, TB, NB>(rb, sB, tid);
    __syncthreads();
    if (kt + 1 < nk) {
      g_load<128, TA, SEGA, NA>(ra, A, lda, (kt + 1) * 64, segs, tid);
      g_load<BN, TB, false, NB>(rb, B, ldb, (kt + 1) * 64, 0, tid);
    }
#pragma unroll
    for (int ks = 0; ks < 2; ++ks) {
      bf16x8 af[4], bfr[BN / 32];
#pragma unroll
      for (int i = 0; i < 4; ++i) af[i] = *(const bf16x8*)(pa + i * 16 * LS + ks * 32);
#pragma unroll
      for (int j = 0; j < BN / 32; ++j) bfr[j] = *(const bf16x8*)(pb + j * 16 * LS + ks * 32);
#pragma unroll
      for (int i = 0; i < 4; ++i)
#pragma unroll
        for (int j = 0; j < BN / 32; ++j) acc[i][j] = __builtin_amdgcn_mfma_f32_16x16x32_bf16(af[i], bfr[j], acc[i][j], 0, 0, 0);
    }
  }
}

template <int NJ>
__device__ __forceinline__ void zero_acc(f32x4 (&acc)[4][NJ]) {
#pragma unroll
  for (int i = 0; i < 4; ++i)
#pragma unroll
    for (int j = 0; j < NJ; ++j) acc[i][j] = (f32x4){0.f, 0.f, 0.f, 0.f};
}

__device__ __forceinline__ void tconv_tile(const float* __restrict__ src, bf16_t* __restrict__ dst, int K, int N, int tk, int tn, float* sm) {
  const int tid = otid();
  const int k0 = tk * 64, n0 = tn * 64;
  __syncthreads();
#pragma unroll 4
  for (int i = 0; i < 16; ++i) {
    const int kk = i * 4 + (tid >> 6), nn = tid & 63;
    float v = 0.f;
    if (n0 + nn < N) v = src[(long)(k0 + kk) * N + n0 + nn];
    sm[kk * 65 + nn] = v;
  }
  __syncthreads();
#pragma unroll 4
  for (int i = 0; i < 16; ++i) {
    const int nn = i * 4 + (tid >> 6), kk = tid & 63;
    dst[(long)(n0 + nn) * K + k0 + kk] = f2bf(sm[kk * 65 + nn]);
  }
}

__device__ __forceinline__ void tconv_job(const float* src, bf16_t* dst, int K, int N, int Npad, float* sm) {
  const int tkn = K / 64, tnn = Npad / 64;
  for (int t = blockIdx.x; t < tkn * tnn; t += gridDim.x) tconv_tile(src, dst, K, N, t % tkn, t / tkn, sm);
}

__device__ __forceinline__ void s5_prep(const Params& p, int layer, int grp, float* sm) {
  float* pwr = sm;
  float* pwi = pwr + 9 * 64;
  float* bbr = pwi + 9 * 64;
  float* bbi = bbr + 1024;
  float* cr = bbi + 1024;
  float* ci = cr + 1024;
  float* kt = ci + 1024;
  const int tid = otid();
  const int lg = layer * 32 + grp;
  __syncthreads();
  if (tid < 64) {
    const int pp = tid;
    const double step = exp((double)p.in[19][lg]);
    const double lr = (double)p.in[17][lg * 64 + pp], li = (double)p.in[18][lg * 64 + pp];
    const double mag = exp(lr * step);
    const double abr = mag * cos(li * step), abi = mag * sin(li * step);
    const double den = lr * lr + li * li;
    const double fr = ((abr - 1.0) * lr + abi * li) / den;
    const double fi = (abi * lr - (abr - 1.0) * li) / den;
    double qr = 1.0, qi = 0.0;
    for (int t = 0; t < 9; ++t) {
      pwr[t * 64 + pp] = (float)qr;
      pwi[t * 64 + pp] = (float)qi;
      const double nr = qr * abr - qi * abi, ni = qr * abi + qi * abr;
      qr = nr; qi = ni;
    }
    float* a8 = (float*)(p.ws + OFF_A8) + (size_t)(lg * 64 + pp) * 2;
    a8[0] = pwr[8 * 64 + pp];
    a8[1] = pwi[8 * 64 + pp];
    for (int cc = 0; cc < 16; ++cc) {
      const double br = (double)p.in[20][(lg * 64 + pp) * 16 + cc], bi = (double)p.in[21][(lg * 64 + pp) * 16 + cc];
      bbr[pp * 16 + cc] = (float)(fr * br - fi * bi);
      bbi[pp * 16 + cc] = (float)(fr * bi + fi * br);
    }
  }
  for (int e = tid; e < 1024; e += 256) {
    cr[e] = p.in[22][lg * 1024 + e];
    ci[e] = p.in[23][lg * 1024 + e];
  }
  __syncthreads();
  for (int e = tid; e < 2048; e += 256) {
    const int tau = e >> 8, co = (e >> 4) & 15, cin = e & 15;
    float s = 0.f;
    for (int pp = 0; pp < 64; ++pp) {
      const float pr = pwr[tau * 64 + pp], pi = pwi[tau * 64 + pp];
      const float zr = pr * bbr[pp * 16 + cin] - pi * bbi[pp * 16 + cin];
      const float zi = pr * bbi[pp * 16 + cin] + pi * bbr[pp * 16 + cin];
      s += cr[co * 64 + pp] * zr - ci[co * 64 + pp] * zi;
    }
    kt[e] = s;
  }
  __syncthreads();
  bf16_t* Km = (bf16_t*)(p.ws + OFF_KMAT) + (size_t)lg * 16384;
  bf16_t* Em = (bf16_t*)(p.ws + OFF_EMAT) + (size_t)lg * 16384;
  bf16_t* Fm = (bf16_t*)(p.ws + OFF_FMAT) + (size_t)lg * 16384;
  for (int e = tid; e < 16384; e += 256) {
    const int n = e >> 7, k = e & 127;
    {
      const int tq = n >> 4, co = n & 15, sq = k >> 4, cin = k & 15;
      Km[e] = f2bf(tq >= sq ? kt[((tq - sq) * 16 + co) * 16 + cin] : 0.f);
    }
    {
      const int pp = n >> 1, ri = n & 1, sq = k >> 4, cin = k & 15;
      const float pr = pwr[(7 - sq) * 64 + pp], pi = pwi[(7 - sq) * 64 + pp];
      const float zr = pr * bbr[pp * 16 + cin] - pi * bbi[pp * 16 + cin];
      const float zi = pr * bbi[pp * 16 + cin] + pi * bbr[pp * 16 + cin];
      Em[e] = f2bf(ri ? zi : zr);
    }
    {
      const int tq = n >> 4, co = n & 15, pp = k >> 1, ri = k & 1;
      const float pr = pwr[(tq + 1) * 64 + pp], pi = pwi[(tq + 1) * 64 + pp];
      const float gr = cr[co * 64 + pp] * pr - ci[co * 64 + pp] * pi;
      const float gi = cr[co * 64 + pp] * pi + ci[co * 64 + pp] * pr;
      Fm[e] = f2bf(ri ? -gi : gr);
    }
  }
}

__device__ __forceinline__ void phase_prep(const Params& p, float* smf) {
  for (int L = 0; L < 2; ++L) {
    tconv_job(p.in[3] + (size_t)L * 1024 * D_IN, (bf16_t*)(p.ws + OFF_WINT) + (size_t)L * D_INP * 1024, 1024, D_IN, D_INP, smf);
    for (int n = 0; n < 4; ++n)
      tconv_job(p.in[33] + (size_t)(L * 4 + n) * 512 * 1024, (bf16_t*)(p.ws + OFF_WBRT) + (size_t)(L * 4 + n) * 1024 * 512, 512, 1024, 1024, smf);
    tconv_job(p.in[34] + (size_t)L * 1024 * 1024, (bf16_t*)(p.ws + OFF_WOUTT) + (size_t)L * 1024 * 1024, 1024, 1024, 1024, smf);
    tconv_job(p.in[25] + (size_t)L * 512 * 512, (bf16_t*)(p.ws + OFF_WGLUT) + (size_t)L * 512 * 512, 512, 512, 512, smf);
    tconv_job(p.in[28] + (size_t)L * 256 * 768, (bf16_t*)(p.ws + OFF_WUQT) + (size_t)L * 768 * 256, 256, 768, 768, smf);
    tconv_job(p.in[30] + (size_t)L * 128 * 1024, (bf16_t*)(p.ws + OFF_WUKVT) + (size_t)L * 1024 * 128, 128, 1024, 1024, smf);
  }
  for (int it = blockIdx.x; it < 64; it += gridDim.x) s5_prep(p, it >> 5, it & 31, smf);
  if (blockIdx.x == gridDim.x - 1 && otid() < 2) {
    const int L = otid();
    float s1 = 0.f, s2 = 0.f;
    for (int i = 0; i < 64; ++i) {
      s1 += p.in[6][L * 64 + i] * p.in[7][L * 64 + i];
      s2 += p.in[8][L * 64 + i] * p.in[9][L * 64 + i];
    }
    const float li = 0.8f - 0.6f * expf(-0.3f * (float)L);
    ((float*)(p.ws + OFF_LAM))[L] = expf(s1) - expf(s2) + li;
  }
}

__device__ __forceinline__ void phase_hnorm(const float* __restrict__ x, const float* __restrict__ gn, bf16_t* __restrict__ H) {
  const int w = otid() >> 6, l = otid() & 63;
  for (int row = blockIdx.x * 4 + w; row < TR; row += gridDim.x * 4) {
    const float4* xr = (const float4*)(x + (size_t)row * 1024);
    float4 v[4];
    float ss = 0.f;
#pragma unroll
    for (int i = 0; i < 4; ++i) {
      v[i] = xr[i * 64 + l];
      ss += v[i].x * v[i].x + v[i].y * v[i].y + v[i].z * v[i].z + v[i].w * v[i].w;
    }
    ss = wave_sum(ss);
    const float rs = rsqrtf(ss * (1.0f / 1024.0f) + EPS);
#pragma unroll
    for (int i = 0; i < 4; ++i) {
      const float4 gg = ((const float4*)gn)[i * 64 + l];
      u32x2 o;
      o.x = pack2(v[i].x * rs * gg.x, v[i].y * rs * gg.y);
      o.y = pack2(v[i].z * rs * gg.z, v[i].w * rs * gg.w);
      *(u32x2*)(H + (size_t)row * 1024 + (i * 64 + l) * 4) = o;
    }
  }
}

__device__ __forceinline__ void inproj_tile(const Params& p, int layer, int rt, int ct, bf16_t* smem) {
  const bf16_t* H = (const bf16_t*)(p.ws + OFF_H);
  const bf16_t* W = (const bf16_t*)(p.ws + OFF_WINT) + (size_t)layer * D_INP * 1024;
  bf16_t* PROJ = (bf16_t*)(p.ws + OFF_PROJ);
  bf16_t* VTA = (bf16_t*)(p.ws + OFF_VTA);
  f32x4 acc[4][4];
  zero_acc<4>(acc);
  gemm_tile<128, false, false, false>(acc, H + (size_t)rt * 128 * 1024, 1024, W + (size_t)ct * 128 * 1024, 1024, 1024, smem);
  const int tid = otid(), w = tid >> 6, l = tid & 63, g = l >> 4, c = l & 15, wr = w >> 1, wc = w & 1;
  const int c0 = ct * 128;
  if (c0 >= C_DAV && c0 < C_DAG) {
    const int h = (c0 - C_DAV) >> 7;
#pragma unroll
    for (int i = 0; i < 4; ++i)
#pragma unroll
      for (int j = 0; j < 4; ++j) {
        const int row = rt * 128 + wr * 64 + i * 16 + g * 4;
        const int dv = wc * 64 + j * 16 + c;
        const int b = row >> 11, s = row & 2047;
        u32x2 o;
        o.x = pack2(acc[i][j][0], acc[i][j][1]);
        o.y = pack2(acc[i][j][2], acc[i][j][3]);
        *(u32x2*)(VTA + ((size_t)((b * 4 + h) * 128 + dv)) * 2048 + s) = o;
      }
  } else {
#pragma unroll
    for (int i = 0; i < 4; ++i) {
#pragma unroll
      for (int r = 0; r < 4; ++r) {
        const int row = rt * 128 + wr * 64 + i * 16 + g * 4 + r;
        bf16_t* rp = PROJ + (size_t)row * LDP + c0 + wc * 64 + c;
#pragma unroll
        for (int j = 0; j < 4; ++j) {
          float v = acc[i][j][r];
          if (c0 + wc * 64 + j * 16 + c >= C_GATE) v = sigmoidf_(v);
          rp[j * 16] = f2bf(v);
        }
      }
      MEMBAR();
    }
  }
}

__device__ __forceinline__ void tokpost_item(const Params& p, int layer, int round, int item) {
  bf16_t* PROJ = (bf16_t*)(p.ws + OFF_PROJ);
  const int* pos = (const int*)p.in[1];
  const int w = otid() >> 6, l = otid() & 63;
  for (int tt = 0; tt < 4; ++tt) {
    const int row = item * 16 + w * 4 + tt;
    const float fpos = (float)pos[round * TR + row];
    bf16_t* pr = PROJ + (size_t)row * LDP;
    {
      const int which = l >> 5, idx = (l & 31) * 16, off = (l & 3) * 16;
      bf16_t* ptr = pr + which * 512 + idx;
      u32x4 u0 = *(const u32x4*)ptr, u1 = *(const u32x4*)(ptr + 8);
      const unsigned uu[8] = {u0.x, u0.y, u0.z, u0.w, u1.x, u1.y, u1.z, u1.w};
      float v[16];
      float ss = 0.f;
#pragma unroll
      for (int e = 0; e < 8; ++e) {
        v[2 * e] = __uint_as_float(uu[e] << 16);
        v[2 * e + 1] = __uint_as_float(uu[e] & 0xffff0000u);
        ss += v[2 * e] * v[2 * e] + v[2 * e + 1] * v[2 * e + 1];
      }
      ss += __shfl_xor(ss, 1, 64);
      ss += __shfl_xor(ss, 2, 64);
      const float rs = rsqrtf(ss * (1.0f / 64.0f) + EPS);
      const float* gn = (which ? p.in[5] : p.in[4]) + layer * 64 + off;
#pragma unroll
      for (int e = 0; e < 16; ++e) v[e] = v[e] * rs * gn[e];
      if ((l & 3) == 0) {
#pragma unroll
        for (int i = 0; i < 8; ++i) {
          const float invf = expf(-13.122363377404328f * (float)i * 0.125f);
          const float ang = fpos * invf;
          const float cs = cosf(ang), sn = sinf(ang);
          const float x1 = v[i], x2 = v[i + 8];
          v[i] = x1 * cs - x2 * sn;
          v[i + 8] = x2 * cs + x1 * sn;
        }
      }
      if (which == 0) {
#pragma unroll
        for (int e = 0; e < 16; ++e) v[e] *= 0.125f * LOG2E;
      }
      u32x4 o0, o1;
      o0.x = pack2(v[0], v[1]); o0.y = pack2(v[2], v[3]); o0.z = pack2(v[4], v[5]); o0.w = pack2(v[6], v[7]);
      o1.x = pack2(v[8], v[9]); o1.y = pack2(v[10], v[11]); o1.z = pack2(v[12], v[13]); o1.w = pack2(v[14], v[15]);
      *(u32x4*)ptr = o0;
      *(u32x4*)(ptr + 8) = o1;
    }
    {
      bf16_t* ptr = pr + C_CQ + l * 4;
      u32x2 u = *(const u32x2*)ptr;
      float v0 = __uint_as_float(u.x << 16), v1 = __uint_as_float(u.x & 0xffff0000u);
      float v2 = __uint_as_float(u.y << 16), v3 = __uint_as_float(u.y & 0xffff0000u);
      float ss = wave_sum(v0 * v0 + v1 * v1 + v2 * v2 + v3 * v3);
      const float rs = rsqrtf(ss * (1.0f / 256.0f) + EPS);
      const float* gn = p.in[27] + layer * 256 + l * 4;
      u32x2 o;
      o.x = pack2(v0 * rs * gn[0], v1 * rs * gn[1]);
      o.y = pack2(v2 * rs * gn[2], v3 * rs * gn[3]);
      *(u32x2*)ptr = o;
    }
    {
      bf16_t* ptr = pr + C_CKV + l * 2;
      unsigned u = *(const unsigned*)ptr;
      float v0 = __uint_as_float(u << 16), v1 = __uint_as_float(u & 0xffff0000u);
      float ss = wave_sum(v0 * v0 + v1 * v1);
      const float rs = rsqrtf(ss * (1.0f / 128.0f) + EPS);
      const float* gn = p.in[29] + layer * 128 + l * 2;
      *(unsigned*)ptr = pack2(v0 * rs * gn[0], v1 * rs * gn[1]);
    }
  }
}

__device__ __forceinline__ void conv_item(const Params& p, int layer, int item) {
  const bf16_t* PROJ = (const bf16_t*)(p.ws + OFF_PROJ);
  bf16_t* XC = (bf16_t*)(p.ws + OFF_XC);
  const int chtile = item & 15, tt = (item >> 4) & 31, b = item >> 9;
  const int ch = chtile * 64 + (otid() & 63);
  const int tr0 = otid() >> 6;
  const float* cw = p.in[11] + (size_t)layer * 4 * 1024;
  const float w0 = cw[ch], w1 = cw[1024 + ch], w2 = cw[2048 + ch], w3 = cw[3072 + ch];
  const float bias = p.in[12][layer * 1024 + ch];
#pragma unroll 4
  for (int i = 0; i < 16; ++i) {
    const int t = tt * 64 + i * 4 + tr0;
    const bf16_t* base = PROJ + (size_t)(b * 2048 + t) * LDP + C_XBC + ch;
    float y = bias + w3 * bf2f(base[0]);
    if (t >= 1) y += w2 * bf2f(*(base - LDP));
    if (t >= 2) y += w1 * bf2f(*(base - 2 * LDP));
    if (t >= 3) y += w0 * bf2f(*(base - 3 * LDP));
    XC[(size_t)(b * 2048 + t) * 1024 + ch] = f2bf(siluf_(y));
  }
}

__device__ __forceinline__ void dtacum_item(const Params& p, int layer, int item) {
  const bf16_t* PROJ = (const bf16_t*)(p.ws + OFF_PROJ);
  float* DT = (float*)(p.ws + OFF_DT);
  float* AC = (float*)(p.ws + OFF_ACUM);
  const int w = otid() >> 6, l = otid() & 63;
  const int id = item * 4 + w;
  const int h = id & 7, bc = id >> 3;
  const int row0 = bc * 128 + 2 * l;
  const float bias = p.in[13][layer * 8 + h];
  const float A = -expf(p.in[14][layer * 8 + h]);
  float x0 = bf2f(PROJ[(size_t)row0 * LDP + C_DT + h]) + bias;
  float x1 = bf2f(PROJ[(size_t)(row0 + 1) * LDP + C_DT + h]) + bias;
  const float d0 = x0 > 20.f ? x0 : log1pf(expf(x0));
  const float d1 = x1 > 20.f ? x1 : log1pf(expf(x1));
  const float a0 = d0 * A, a1 = d1 * A;
  float s = a0 + a1;
#pragma unroll
  for (int d = 1; d < 64; d <<= 1) {
    const float t = __shfl_up(s, d, 64);
    if (l >= d) s += t;
  }
  DT[(size_t)row0 * 8 + h] = d0;
  DT[(size_t)(row0 + 1) * 8 + h] = d1;
  AC[(size_t)row0 * 8 + h] = s - a1;
  AC[(size_t)(row0 + 1) * 8 + h] = s;
}

__device__ __forceinline__ void s5_e_item(const Params& p, int layer, int item, bf16_t* smem) {
  const bf16_t* PROJ = (const bf16_t*)(p.ws + OFF_PROJ);
  const int grp = item >> 3, mt = item & 7;
  const bf16_t* Em = (const bf16_t*)(p.ws + OFF_EMAT) + (size_t)(layer * 32 + grp) * 16384;
  float* E = (float*)(p.ws + OFF_E);
  f32x4 acc[4][4];
  zero_acc<4>(acc);
  gemm_tile<128, false, false, true>(acc, PROJ + (size_t)mt * 128 * 8 * LDP + C_S5U + grp * 16, 8 * LDP, Em, 128, 128, smem, LDP);
  const int tid = otid(), w = tid >> 6, l = tid & 63, g = l >> 4, c = l & 15, wr = w >> 1, wc = w & 1;
#pragma unroll
  for (int i = 0; i < 4; ++i)
#pragma unroll
    for (int j = 0; j < 4; ++j) {
      const int m = mt * 128 + wr * 64 + i * 16 + g * 4;
      const int n = wc * 64 + j * 16 + c;
      *(f32x4*)(E + ((size_t)(grp * 128 + n)) * NBC + m) = acc[i][j];
    }
}

__device__ __forceinline__ void mla_up_q_tile(const Params& p, int layer, int rt, int ct, bf16_t* smem) {
  const bf16_t* PROJ = (const bf16_t*)(p.ws + OFF_PROJ);
  const bf16_t* W = (const bf16_t*)(p.ws + OFF_WUQT) + (size_t)layer * 768 * 256;
  bf16_t* QM = (bf16_t*)(p.ws + OFF_QM);
  f32x4 acc[4][4];
  zero_acc<4>(acc);
  gemm_tile<128, false, false, false>(acc, PROJ + (size_t)rt * 128 * LDP + C_CQ, LDP, W + (size_t)ct * 128 * 256, 256, 256, smem);
  const int tid = otid(), w = tid >> 6, l = tid & 63, g = l >> 4, c = l & 15, wr = w >> 1, wc = w & 1;
#pragma unroll
  for (int i = 0; i < 4; ++i)
#pragma unroll
    for (int j = 0; j < 4; ++j)
#pragma unroll
      for (int r = 0; r < 4; ++r) {
        const int row = rt * 128 + wr * 64 + i * 16 + g * 4 + r, col = ct * 128 + wc * 64 + j * 16 + c;
        QM[(size_t)row * 768 + col] = f2bf(acc[i][j][r]);
      }
}
__device__ __forceinline__ void mla_up_kv_tile(const Params& p, int layer, int rt, int ct, bf16_t* smem) {
  const bf16_t* PROJ = (const bf16_t*)(p.ws + OFF_PROJ);
  const bf16_t* W = (const bf16_t*)(p.ws + OFF_WUKVT) + (size_t)layer * 1024 * 128;
  bf16_t* KN = (bf16_t*)(p.ws + OFF_KN);
  bf16_t* VTD = (bf16_t*)(p.ws + OFF_VTD);
  f32x4 acc[4][4];
  zero_acc<4>(acc);
  gemm_tile<128, false, false, false>(acc, PROJ + (size_t)rt * 128 * LDP + C_CKV, LDP, W + (size_t)ct * 128 * 128, 128, 128, smem);
  const int tid = otid(), w = tid >> 6, l = tid & 63, g = l >> 4, c = l & 15, wr = w >> 1, wc = w & 1;
  const int h = ct >> 1;
  if ((ct & 1) == 0) {
#pragma unroll
    for (int i = 0; i < 4; ++i)
#pragma unroll
      for (int j = 0; j < 4; ++j)
#pragma unroll
        for (int r = 0; r < 4; ++r) {
          const int row = rt * 128 + wr * 64 + i * 16 + g * 4 + r, cc = wc * 64 + j * 16 + c;
          KN[(size_t)row * 512 + h * 128 + cc] = f2bf(acc[i][j][r]);
        }
  } else {
#pragma unroll
    for (int i = 0; i < 4; ++i)
#pragma unroll
      for (int j = 0; j < 4; ++j) {
        const int row = rt * 128 + wr * 64 + i * 16 + g * 4, dv = wc * 64 + j * 16 + c;
        const int b = row >> 11, s = row & 2047;
        u32x2 o;
        o.x = pack2(acc[i][j][0], acc[i][j][1]);
        o.y = pack2(acc[i][j][2], acc[i][j][3]);
        *(u32x2*)(VTD + ((size_t)((b * 4 + h) * 128 + dv)) * 2048 + s) = o;
      }
  }
}

__device__ __forceinline__ void mb_states_item(const Params& p, int item, bf16_t* smem) {
  const bf16_t* XC = (const bf16_t*)(p.ws + OFF_XC);
  const float* DT = (const float*)(p.ws + OFF_DT);
  const float* AC = (const float*)(p.ws + OFF_ACUM);
  bf16_t* XS = (bf16_t*)(p.ws + OFF_XS) + (size_t)blockIdx.x * 128 * 64;
  float* ST = (float*)(p.ws + OFF_ST);
  const int h = item & 7, bc = item >> 3;
  const int grp = h >> 2;
  const int row0 = bc * 128;
  const int tid = otid();
  __syncthreads();
  const float alast = AC[(size_t)(row0 + 127) * 8 + h];
  for (int e = tid; e < 8192; e += 256) {
    const int ll = e >> 6, pp = e & 63;
    const int row = row0 + ll;
    const float wgt = DT[(size_t)row * 8 + h] * __expf(alast - AC[(size_t)row * 8 + h]);
    XS[e] = f2bf(bf2f(XC[(size_t)row * 1024 + h * 64 + pp]) * wgt);
  }
  block_global_handoff();
  f32x4 acc[4][2];
  zero_acc<2>(acc);
  gemm_tile<64, true, true, false>(acc, XC + (size_t)row0 * 1024 + 512 + grp * 128, 1024, XS, 64, 128, smem);
  const int w = tid >> 6, l = tid & 63, g = l >> 4, c = l & 15, wr = w >> 1, wc = w & 1;
#pragma unroll
  for (int i = 0; i < 4; ++i)
#pragma unroll
    for (int j = 0; j < 2; ++j) {
      const int n = wr * 64 + i * 16 + g * 4;
      const int pp = wc * 32 + j * 16 + c;
      *(f32x4*)(ST + ((size_t)(bc * 8 + h) * 64 + pp) * 128 + n) = acc[i][j];
    }
}

__device__ __forceinline__ void s5_carry_item(const Params& p, int layer, int item) {
  const int idx = item * 256 + otid();
  const int b = idx >> 11, grp = (idx >> 6) & 31, pp = idx & 63;
  const float* a8 = (const float*)(p.ws + OFF_A8) + (size_t)((layer * 32 + grp) * 64 + pp) * 2;
  const float ar = a8[0], ai = a8[1];
  const float* er = (const float*)(p.ws + OFF_E) + ((size_t)(grp * 128 + 2 * pp)) * NBC + b * 256;
  const float* ei = er + NBC;
  bf16_t* hro = (bf16_t*)(p.ws + OFF_HIN) + ((size_t)(grp * 128 + 2 * pp)) * NBC + b * 256;
  bf16_t* hio = hro + NBC;
  float hr = 0.f, hi = 0.f;
  for (int c4 = 0; c4 < 64; ++c4) {
    const float4 vr = *(const float4*)(er + c4 * 4), vi = *(const float4*)(ei + c4 * 4);
    const float rr[4] = {vr.x, vr.y, vr.z, vr.w}, ii[4] = {vi.x, vi.y, vi.z, vi.w};
    float orr[4], oii[4];
#pragma unroll
    for (int k = 0; k < 4; ++k) {
      orr[k] = hr; oii[k] = hi;
      const float nr = ar * hr - ai * hi + rr[k];
      const float ni = ar * hi + ai * hr + ii[k];
      hr = nr; hi = ni;
    }
    u32x2 o0, o1;
    o0.x = pack2(orr[0], orr[1]); o0.y = pack2(orr[2], orr[3]);
    o1.x = pack2(oii[0], oii[1]); o1.y = pack2(oii[2], oii[3]);
    *(u32x2*)(hro + c4 * 4) = o0;
    *(u32x2*)(hio + c4 * 4) = o1;
  }
}

__device__ __forceinline__ void mlapost_item(const Params& p, int layer, int round, int item) {
  const bf16_t* PROJ = (const bf16_t*)(p.ws + OFF_PROJ);
  bf16_t* QM = (bf16_t*)(p.ws + OFF_QM);
  bf16_t* KM = (bf16_t*)(p.ws + OFF_KM);
  const bf16_t* KN = (const bf16_t*)(p.ws + OFF_KN);
  const int* pos = (const int*)p.in[1];
  const int w = otid() >> 6, l = otid() & 63;
  const float* qn = p.in[31] + layer * 192;
  const float* kn = p.in[32] + layer * 192;
  const float q0 = qn[l], q1 = qn[64 + l], q2 = qn[128 + l];
  const float k0 = kn[l], k1 = kn[64 + l], k2 = kn[128 + l];
  const float invf = expf(-13.122363377404328f * (float)(l & 31) * (1.0f / 32.0f));
  const float qscale = 0.07216878364870322f * LOG2E;
  for (int tt = 0; tt < 4; ++tt) {
    const int row = item * 16 + w * 4 + tt;
    const float ang = (float)pos[round * TR + row] * invf;
    const float cs = cosf(ang), sn = sinf(ang);
    const float kr = bf2f(PROJ[(size_t)row * LDP + C_KR + l]);
#pragma unroll
    for (int h = 0; h < 4; ++h) {
      {
        bf16_t* qp = QM + (size_t)row * 768 + h * 192;
        float e0 = bf2f(qp[l]), e1 = bf2f(qp[64 + l]), e2 = bf2f(qp[128 + l]);
        const float ss = wave_sum(e0 * e0 + e1 * e1 + e2 * e2);
        const float rs = rsqrtf(ss * (1.0f / 192.0f) + EPS);
        e0 *= rs * q0; e1 *= rs * q1; e2 *= rs * q2;
        const float ot = __shfl_xor(e2, 32, 64);
        e2 = (l < 32) ? (e2 * cs - ot * sn) : (e2 * cs + ot * sn);
        qp[l] = f2bf(e0 * qscale); qp[64 + l] = f2bf(e1 * qscale); qp[128 + l] = f2bf(e2 * qscale);
      }
      {
        const bf16_t* kp = KN + (size_t)row * 512 + h * 128;
        float e0 = bf2f(kp[l]), e1 = bf2f(kp[64 + l]), e2 = kr;
        const float ss = wave_sum(e0 * e0 + e1 * e1 + e2 * e2);
        const float rs = rsqrtf(ss * (1.0f / 192.0f) + EPS);
        e0 *= rs * k0; e1 *= rs * k1; e2 *= rs * k2;
        const float ot = __shfl_xor(e2, 32, 64);
        e2 = (l < 32) ? (e2 * cs - ot * sn) : (e2 * cs + ot * sn);
        bf16_t* ko = KM + (size_t)row * 768 + h * 192;
        ko[l] = f2bf(e0); ko[64 + l] = f2bf(e1); ko[128 + l] = f2bf(e2);
      }
    }
  }
}

__device__ __forceinline__ void mb_scan_item(const Params& p, int item) {
  const int idx = item * 256 + otid();
  const int b = idx >> 16, h = (idx >> 13) & 7, pn = idx & 8191;
  const float* ST = (const float*)(p.ws + OFF_ST);
  const float* AC = (const float*)(p.ws + OFF_ACUM);
  bf16_t* SIN = (bf16_t*)(p.ws + OFF_SIN);
  float cur = 0.f;
#pragma unroll 4
  for (int c = 0; c < 16; ++c) {
    const size_t o = ((size_t)((b * 16 + c) * 8 + h)) * 8192 + pn;
    SIN[o] = f2bf(cur);
    const float al = AC[(size_t)(b * 2048 + c * 128 + 127) * 8 + h];
    cur = __expf(al) * cur + ST[o];
  }
}

__device__ __forceinline__ void s5_y_item(const Params& p, int layer, int item, bf16_t* smem) {
  const bf16_t* PROJ = (const bf16_t*)(p.ws + OFF_PROJ);
  const int grp = item >> 3, mt = item & 7;
  const bf16_t* Km = (const bf16_t*)(p.ws + OFF_KMAT) + (size_t)(layer * 32 + grp) * 16384;
  const bf16_t* Fm = (const bf16_t*)(p.ws + OFF_FMAT) + (size_t)(layer * 32 + grp) * 16384;
  const bf16_t* HIN = (const bf16_t*)(p.ws + OFF_HIN) + (size_t)grp * 128 * NBC + mt * 128;
  bf16_t* YG = (bf16_t*)(p.ws + OFF_YG);
  f32x4 acc[4][4];
  zero_acc<4>(acc);
  gemm_tile<128, false, false, true>(acc, PROJ + (size_t)mt * 128 * 8 * LDP + C_S5U + grp * 16, 8 * LDP, Km, 128, 128, smem, LDP);
  gemm_tile<128, true, false, false>(acc, HIN, NBC, Fm, 128, 128, smem);
  const int tid = otid(), w = tid >> 6, l = tid & 63, g = l >> 4, c = l & 15, wr = w >> 1, wc = w & 1;
  const float* dsk = p.in[24] + layer * 512;
#pragma unroll
  for (int i = 0; i < 4; ++i)
#pragma unroll
    for (int j = 0; j < 4; ++j) {
      const int n = wc * 64 + j * 16 + c;
      const int tq = n >> 4, co = n & 15;
      const int ch = grp * 16 + co;
      const float dd = dsk[ch];
#pragma unroll
      for (int r = 0; r < 4; ++r) {
        const int m = mt * 128 + wr * 64 + i * 16 + g * 4 + r;
        const int row = m * 8 + tq;
        const float u = bf2f(PROJ[(size_t)row * LDP + C_S5U + ch]);
        const float y = acc[i][j][r] + dd * u;
        YG[(size_t)row * 512 + ch] = f2bf(gelu_tanh(y));
      }
    }
}

template <int DK, int NM>
__device__ __forceinline__ void attn_core(const bf16_t* __restrict__ Qb, long ldq, const bf16_t* __restrict__ Kb, long ldk,
                                          const bf16_t* __restrict__ Vt, int qb, bf16_t* smem, f32x4 (&O)[NM][8], float (&lsum)[NM][4]) {
  constexpr int KST = DK + 8;
  constexpr int KCH = NM * 64 * DK / 8 / 256;
  constexpr int CPM = 64 * DK / 8;
  constexpr int CPRK = DK / 8;
  bf16_t* sK = smem;
  bf16_t* sV = sK + NM * 64 * KST;
  bf16_t* sP = sV + 128 * 72;
  const int tid = otid(), w = tid >> 6, l = tid & 63, g = l >> 4, c = l & 15;
  bf16x8 qf[NM][DK / 32];
  {
    const long qrow = (long)qb * 64 + w * 16 + c;
#pragma unroll
    for (int m = 0; m < NM; ++m)
#pragma unroll
      for (int ks = 0; ks < DK / 32; ++ks) qf[m][ks] = *(const bf16x8*)(Qb + qrow * ldq + m * DK + ks * 32 + g * 8);
  }
  float mrow[NM][4];
#pragma unroll
  for (int m = 0; m < NM; ++m) {
#pragma unroll
    for (int r = 0; r < 4; ++r) { mrow[m][r] = -INFINITY; lsum[m][r] = 0.f; }
#pragma unroll
    for (int nt = 0; nt < 8; ++nt) O[m][nt] = (f32x4){0.f, 0.f, 0.f, 0.f};
  }
  u32x4 kr[KCH], vr[4];
  auto gloadK = [&](int kt) {
#pragma unroll
    for (int i = 0; i < KCH; ++i) {
      const int ch = tid + i * 256;
      const int m = ch / CPM, cc = ch % CPM;
      const int key = cc / CPRK, d0 = (cc % CPRK) * 8;
      kr[i] = *(const u32x4*)(Kb + (long)(kt * 64 + key) * ldk + m * DK + d0);
    }
  };
  auto gloadV = [&](int kt) {
#pragma unroll
    for (int i = 0; i < 4; ++i) {
      const int ch = tid + i * 256;
      const int dvr = ch >> 3, kc = (ch & 7) * 8;
      vr[i] = *(const u32x4*)(Vt + (long)dvr * 2048 + kt * 64 + kc);
    }
  };
  gloadK(0);
  gloadV(0);
  for (int kt = 0; kt <= qb; ++kt) {
    __syncthreads();
#pragma unroll
    for (int i = 0; i < KCH; ++i) {
      const int ch = tid + i * 256;
      const int m = ch / CPM, cc = ch % CPM;
      const int key = cc / CPRK, d0 = (cc % CPRK) * 8;
      *(u32x4*)(sK + (m * 64 + key) * KST + d0) = kr[i];
    }
#pragma unroll
    for (int i = 0; i < 4; ++i) {
      const int ch = tid + i * 256;
      const int dvr = ch >> 3, kc = (ch & 7) * 8;
      *(u32x4*)(sV + dvr * 72 + kc) = vr[i];
    }
    __syncthreads();
    if (kt < qb) gloadK(kt + 1);
#pragma unroll
    for (int m = 0; m < NM; ++m) {
      f32x4 S[4];
#pragma unroll
      for (int nt = 0; nt < 4; ++nt) {
        S[nt] = (f32x4){0.f, 0.f, 0.f, 0.f};
#pragma unroll
        for (int ks = 0; ks < DK / 32; ++ks) {
          const bf16x8 kf = *(const bf16x8*)(sK + (m * 64 + nt * 16 + c) * KST + ks * 32 + g * 8);
          S[nt] = __builtin_amdgcn_mfma_f32_16x16x32_bf16(qf[m][ks], kf, S[nt], 0, 0, 0);
        }
        MEMBAR();
      }
      if (kt == qb) {
#pragma unroll
        for (int nt = 0; nt < 4; ++nt)
#pragma unroll
          for (int r = 0; r < 4; ++r)
            if (nt * 16 + c > w * 16 + g * 4 + r) S[nt][r] = -INFINITY;
      }
      bf16_t* pw = sP + (size_t)((w * NM + m) * 16) * 72;
#pragma unroll
      for (int r = 0; r < 4; ++r) {
        float mx = fmaxf(fmaxf(S[0][r], S[1][r]), fmaxf(S[2][r], S[3][r]));
        mx = fmaxf(mx, __shfl_xor(mx, 1, 64));
        mx = fmaxf(mx, __shfl_xor(mx, 2, 64));
        mx = fmaxf(mx, __shfl_xor(mx, 4, 64));
        mx = fmaxf(mx, __shfl_xor(mx, 8, 64));
        const float mnew = fmaxf(mrow[m][r], mx);
        const float sc = __builtin_amdgcn_exp2f(mrow[m][r] - mnew);
        mrow[m][r] = mnew;
        float ps = 0.f;
#pragma unroll
        for (int nt = 0; nt < 4; ++nt) {
          const float pv = __builtin_amdgcn_exp2f(S[nt][r] - mnew);
          ps += pv;
          pw[(g * 4 + r) * 72 + nt * 16 + c] = f2bf(pv);
        }
        ps += __shfl_xor(ps, 1, 64);
        ps += __shfl_xor(ps, 2, 64);
        ps += __shfl_xor(ps, 4, 64);
        ps += __shfl_xor(ps, 8, 64);
        lsum[m][r] = lsum[m][r] * sc + ps;
#pragma unroll
        for (int nt = 0; nt < 8; ++nt) O[m][nt][r] *= sc;
      }
    }
    __syncthreads();
    if (kt < qb) gloadV(kt + 1);
#pragma unroll
    for (int m = 0; m < NM; ++m) {
      const bf16_t* pw = sP + (size_t)((w * NM + m) * 16) * 72;
#pragma unroll
      for (int ks = 0; ks < 2; ++ks) {
        const bf16x8 pf = *(const bf16x8*)(pw + c * 72 + ks * 32 + g * 8);
#pragma unroll
        for (int nt = 0; nt < 8; ++nt) {
          const bf16x8 vf = *(const bf16x8*)(sV + (nt * 16 + c) * 72 + ks * 32 + g * 8);
          O[m][nt] = __builtin_amdgcn_mfma_f32_16x16x32_bf16(pf, vf, O[m][nt], 0, 0, 0);
        }
        MEMBAR();
      }
    }
  }
}

__device__ __forceinline__ void da_attn_item(const Params& p, int layer, int bh, int qb, bf16_t* smem, bool dry = false) {
  bf16_t* PROJ = (bf16_t*)(p.ws + OFF_PROJ);
  const bf16_t* VTA = (const bf16_t*)(p.ws + OFF_VTA);
  const int b = bh >> 2, h = bh & 3;
  f32x4 O[2][8];
  float ls[2][4];
  {
    f32x4 O1[1][8];
    float l1[1][4];
#pragma unroll 1
    for (int m = 0; m < 2; ++m) {
      attn_core<64, 1>(PROJ + (size_t)b * 2048 * LDP + C_DAQ + h * 128 + m * 64, LDP, PROJ + (size_t)b * 2048 * LDP + C_DAK + h * 128 + m * 64, LDP,
                       VTA + (size_t)(b * 4 + h) * 128 * 2048, qb, smem, O1, l1);
      if (m == 0) {
#pragma unroll
        for (int nt = 0; nt < 8; ++nt) O[0][nt] = O1[0][nt];
#pragma unroll
        for (int r = 0; r < 4; ++r) ls[0][r] = l1[0][r];
      } else {
#pragma unroll
        for (int nt = 0; nt < 8; ++nt) O[1][nt] = O1[0][nt];
#pragma unroll
        for (int r = 0; r < 4; ++r) ls[1][r] = l1[0][r];
      }
    }
  }
  const int tid = otid(), w = tid >> 6, l = tid & 63, g = l >> 4, c = l & 15;
  const float lam = ((const float*)(p.ws + OFF_LAM))[layer];
  const float linit = 0.8f - 0.6f * expf(-0.3f * (float)layer);
  const float* sg = p.in[10] + layer * 128;
#pragma unroll
  for (int r = 0; r < 4; ++r) {
    const float i0 = 1.0f / ls[0][r], i1 = lam / ls[1][r];
    float o[8];
    float ss = 0.f;
#pragma unroll
    for (int nt = 0; nt < 8; ++nt) {
      o[nt] = O[0][nt][r] * i0 - O[1][nt][r] * i1;
      ss += o[nt] * o[nt];
    }
    ss += __shfl_xor(ss, 1, 64);
    ss += __shfl_xor(ss, 2, 64);
    ss += __shfl_xor(ss, 4, 64);
    ss += __shfl_xor(ss, 8, 64);
    const float rs = rsqrtf(ss * (1.0f / 128.0f) + EPS) * (1.0f - linit);
    const size_t row = (size_t)b * 2048 + qb * 64 + w * 16 + g * 4 + r;
#pragma unroll
    for (int nt = 0; nt < 8; ++nt) {
      const int dv = nt * 16 + c;
      bf16_t* gp = PROJ + row * LDP + C_DAG + h * 128 + dv;
      const float gt = bf2f(*gp);
      if (!dry) *gp = f2bf(o[nt] * rs * sg[dv] * siluf_(gt));
    }
  }
}

__device__ __forceinline__ void mla_attn_item(const Params& p, int bh, int qb, bf16_t* smem, bool dry = false) {
  bf16_t* PROJ = (bf16_t*)(p.ws + OFF_PROJ);
  const bf16_t* QM = (const bf16_t*)(p.ws + OFF_QM);
  const bf16_t* KM = (const bf16_t*)(p.ws + OFF_KM);
  const bf16_t* VTD = (const bf16_t*)(p.ws + OFF_VTD);
  const int b = bh >> 2, h = bh & 3;
  f32x4 O[1][8];
  float ls[1][4];
  attn_core<192, 1>(QM + (size_t)b * 2048 * 768 + h * 192, 768, KM + (size_t)b * 2048 * 768 + h * 192, 768,
                    VTD + (size_t)(b * 4 + h) * 128 * 2048, qb, smem, O, ls);
  const int tid = otid(), w = tid >> 6, l = tid & 63, g = l >> 4, c = l & 15;
#pragma unroll
  for (int r = 0; r < 4; ++r) {
    const float i0 = 1.0f / ls[0][r];
    const size_t row = (size_t)b * 2048 + qb * 64 + w * 16 + g * 4 + r;
#pragma unroll
    for (int nt = 0; nt < 8; ++nt) {
      const int dv = nt * 16 + c;
      bf16_t* gp = PROJ + row * LDP + C_MLG + h * 128 + dv;
      const float gt = bf2f(*gp);
      if (!dry) *gp = f2bf(O[0][nt][r] * i0 * siluf_(gt));
    }
  }
}

__device__ __forceinline__ void mb_out_item(const Params& p, int layer, int item, bf16_t* smem) {
  bf16_t* PROJ = (bf16_t*)(p.ws + OFF_PROJ);
  const bf16_t* XC = (const bf16_t*)(p.ws + OFF_XC);
  const float* DT = (const float*)(p.ws + OFF_DT);
  const float* AC = (const float*)(p.ws + OFF_ACUM);
  const bf16_t* SIN = (const bf16_t*)(p.ws + OFF_SIN);
  bf16_t* MS = (bf16_t*)(p.ws + OFF_MS) + (size_t)blockIdx.x * 128 * 128;
  float* rowss = (float*)((unsigned char*)smem + 55296);
  const int grp = item & 1, bc = item >> 1;
  const int row0 = bc * 128;
  __syncthreads();
  const bf16_t* Cp = XC + (size_t)row0 * 1024 + 768 + grp * 128;
  const bf16_t* Bp = XC + (size_t)row0 * 1024 + 512 + grp * 128;
#pragma unroll 1
  for (int r4 = 0; r4 < 4; ++r4) {
    const int h = grp * 4 + r4;
    const int tid = otid(), w = tid >> 6, l = tid & 63, g = l >> 4, c = l & 15, wr = w >> 1, wc = w & 1;
    {
      f32x4 cb[4][4];
      zero_acc<4>(cb);
      gemm_tile<128, false, false, false>(cb, Cp, 1024, Bp, 1024, 128, smem);
      float acs[4], dts[4];
#pragma unroll
      for (int j = 0; j < 4; ++j) {
        const int s = wc * 64 + j * 16 + c;
        acs[j] = AC[(size_t)(row0 + s) * 8 + h];
        dts[j] = DT[(size_t)(row0 + s) * 8 + h];
      }
#pragma unroll
      for (int i = 0; i < 4; ++i)
#pragma unroll
        for (int r = 0; r < 4; ++r) {
          const int lr = wr * 64 + i * 16 + g * 4 + r;
          const float acl = AC[(size_t)(row0 + lr) * 8 + h];
#pragma unroll
          for (int j = 0; j < 4; ++j) {
            const int s = wc * 64 + j * 16 + c;
            const float v = (s <= lr) ? cb[i][j][r] * __expf(acl - acs[j]) * dts[j] : 0.f;
            MS[lr * 128 + s] = f2bf(v);
          }
          MEMBAR();
        }
    }
    block_global_handoff();
    f32x4 ad[4][2], ao[4][2];
    zero_acc<2>(ad);
    zero_acc<2>(ao);
    gemm_tile<64, false, true, false>(ad, MS, 128, XC + (size_t)row0 * 1024 + h * 64, 1024, 128, smem);
    gemm_tile<64, false, false, false>(ao, Cp, 1024, SIN + ((size_t)(bc * 8 + h)) * 8192, 128, 128, smem);
    const float dsk = p.in[15][layer * 8 + h];
#pragma unroll
    for (int i = 0; i < 4; ++i)
#pragma unroll
      for (int r = 0; r < 4; ++r) {
        const int lr = wr * 64 + i * 16 + g * 4 + r;
        const size_t row = (size_t)row0 + lr;
        const float ea = __expf(AC[row * 8 + h]);
        float ssq = 0.f;
#pragma unroll
        for (int j = 0; j < 2; ++j) {
          const int ch = h * 64 + wc * 32 + j * 16 + c;
          const float xv = bf2f(XC[row * 1024 + ch]);
          bf16_t* zp = PROJ + row * LDP + C_MBZ + ch;
          const float z = bf2f(*zp);
          float y = ad[i][j][r] + ea * ao[i][j][r] + dsk * xv;
          y *= siluf_(z);
          ssq += y * y;
          *zp = f2bf(y);
        }
        ssq += __shfl_xor(ssq, 1, 64);
        ssq += __shfl_xor(ssq, 2, 64);
        ssq += __shfl_xor(ssq, 4, 64);
        ssq += __shfl_xor(ssq, 8, 64);
        if (c == 0) rowss[(r4 * 2 + wc) * 128 + lr] = ssq;
        MEMBAR();
      }
  }
  block_global_handoff();
  const float* ng = p.in[16] + layer * 512 + grp * 256;
  for (int e = otid(); e < 128 * 256; e += 256) {
    const int lr = e >> 8, cc = e & 255;
    bf16_t* zp = PROJ + (size_t)(row0 + lr) * LDP + C_MBZ + grp * 256 + cc;
    float tot = 0.f;
#pragma unroll
    for (int q = 0; q < 8; ++q) tot += rowss[q * 128 + lr];
    const float v = bf2f(*zp) * rsqrtf(tot * (1.0f / 256.0f) + EPS) * ng[cc];
    *zp = f2bf(v);
  }
}

__device__ __forceinline__ void s5_glu_tile(const Params& p, int layer, int rt, int ct, bf16_t* smem) {
  bf16_t* PROJ = (bf16_t*)(p.ws + OFF_PROJ);
  const bf16_t* YG = (const bf16_t*)(p.ws + OFF_YG);
  const bf16_t* W = (const bf16_t*)(p.ws + OFF_WGLUT) + (size_t)layer * 512 * 512;
  f32x4 acc[4][4];
  zero_acc<4>(acc);
  gemm_tile<128, false, false, false>(acc, YG + (size_t)rt * 128 * 512, 512, W + (size_t)ct * 128 * 512, 512, 512, smem);
  const int tid = otid(), w = tid >> 6, l = tid & 63, g = l >> 4, c = l & 15, wr = w >> 1, wc = w & 1;
  const float* bg = p.in[26] + layer * 512;
#pragma unroll
  for (int i = 0; i < 4; ++i)
#pragma unroll
    for (int j = 0; j < 4; ++j) {
      const int col = ct * 128 + wc * 64 + j * 16 + c;
      const float bb = bg[col];
#pragma unroll
      for (int r = 0; r < 4; ++r) {
        const size_t row = (size_t)rt * 128 + wr * 64 + i * 16 + g * 4 + r;
        const float yv = bf2f(YG[row * 512 + col]);
        bf16_t* gp = PROJ + row * LDP + C_S5G + col;
        const float gt = bf2f(*gp);
        *gp = f2bf(yv * sigmoidf_(acc[i][j][r] + bb) * siluf_(gt));
      }
    }
}

__device__ __forceinline__ void merge_tile(const Params& p, int layer, int rt, int ct, bf16_t* smem) {
  const bf16_t* PROJ = (const bf16_t*)(p.ws + OFF_PROJ);
  bf16_t* MG = (bf16_t*)(p.ws + OFF_MERGED);
  f32x4 macc[4][2];
  zero_acc<2>(macc);
  const int tid = otid(), w = tid >> 6, l = tid & 63, g = l >> 4, c = l & 15, wr = w >> 1, wc = w & 1;
  for (int n = 0; n < 4; ++n) {
    const int ycol = (n == 0) ? C_DAG : (n == 1) ? C_MBZ : (n == 2) ? C_S5G : C_MLG;
    const bf16_t* W = (const bf16_t*)(p.ws + OFF_WBRT) + (size_t)(layer * 4 + n) * 1024 * 512;
    f32x4 acc[4][2];
    zero_acc<2>(acc);
    gemm_tile<64, false, false, false>(acc, PROJ + (size_t)rt * 128 * LDP + ycol, LDP, W + (size_t)ct * 64 * 512, 512, 512, smem);
#pragma unroll
    for (int i = 0; i < 4; ++i) {
#pragma unroll
      for (int r = 0; r < 4; ++r) {
        const size_t row = (size_t)rt * 128 + wr * 64 + i * 16 + g * 4 + r;
        const bf16_t* gp = PROJ + row * LDP + C_GATE + n * 1024 + ct * 64 + wc * 32 + c;
#pragma unroll
        for (int j = 0; j < 2; ++j) macc[i][j][r] += bf2f(gp[j * 16]) * acc[i][j][r];
      }
      MEMBAR();
    }
  }
#pragma unroll
  for (int i = 0; i < 4; ++i) {
#pragma unroll
    for (int r = 0; r < 4; ++r) {
      const size_t row = (size_t)rt * 128 + wr * 64 + i * 16 + g * 4 + r;
      bf16_t* op = MG + row * 1024 + ct * 64 + wc * 32 + c;
#pragma unroll
      for (int j = 0; j < 2; ++j) op[j * 16] = f2bf(macc[i][j][r]);
    }
    MEMBAR();
  }
}

__device__ __forceinline__ void out_tile(const Params& p, int layer, const float* xo, float* xn, int rt, int ct, bf16_t* smem) {
  const bf16_t* MG = (const bf16_t*)(p.ws + OFF_MERGED);
  const bf16_t* W = (const bf16_t*)(p.ws + OFF_WOUTT) + (size_t)layer * 1024 * 1024;
  f32x4 acc[4][4];
  zero_acc<4>(acc);
  gemm_tile<128, false, false, false>(acc, MG + (size_t)rt * 128 * 1024, 1024, W + (size_t)ct * 128 * 1024, 1024, 1024, smem);
  const int tid = otid(), w = tid >> 6, l = tid & 63, g = l >> 4, c = l & 15, wr = w >> 1, wc = w & 1;
#pragma unroll
  for (int i = 0; i < 4; ++i)
#pragma unroll
    for (int j = 0; j < 4; ++j) {
      const int col = ct * 128 + wc * 64 + j * 16 + c;
#pragma unroll
      for (int r = 0; r < 4; ++r) {
        const size_t row = (size_t)rt * 128 + wr * 64 + i * 16 + g * 4 + r;
        xn[row * 1024 + col] = xo[row * 1024 + col] + acc[i][j][r];
      }
    }
}

__device__ __forceinline__ void gsync(cg::grid_group& grid, unsigned* bar, unsigned& epoch) {
  asm volatile("s_waitcnt vmcnt(0)" ::: "memory");
  __syncthreads();
  if (otid() == 0) {
    unsigned long long* w = (unsigned long long*)bar;
    __builtin_amdgcn_fence(__ATOMIC_RELEASE, "agent");
    asm volatile("s_waitcnt vmcnt(0)" ::: "memory");
    const unsigned long long old = __hip_atomic_fetch_add(w, 1ull, __ATOMIC_RELAXED, __HIP_MEMORY_SCOPE_AGENT);
    const unsigned G = gridDim.x;
    if ((unsigned)(old & 0xffffffffull) == G - 1) {
      __hip_atomic_fetch_add(w, (1ull << 32) - (unsigned long long)G, __ATOMIC_RELAXED, __HIP_MEMORY_SCOPE_AGENT);
    } else {
      const unsigned g0 = (unsigned)(old >> 32);
      while ((unsigned)(__hip_atomic_load(w, __ATOMIC_RELAXED, __HIP_MEMORY_SCOPE_AGENT) >> 32) == g0) __builtin_amdgcn_s_sleep(2);
    }
    __builtin_amdgcn_fence(__ATOMIC_ACQUIRE, "agent");
    asm volatile("s_waitcnt vmcnt(0)" ::: "memory");
  }
  __syncthreads();
}

#ifdef SELFCHECK
__device__ __forceinline__ void cksum(const void* ptr, size_t bytes, unsigned long long* slot) {
  const u32x4* q = (const u32x4*)ptr;
  const size_t n = bytes / 16;
  unsigned long long s = 0;
  for (size_t i = (size_t)blockIdx.x * 256 + otid(); i < n; i += (size_t)gridDim.x * 256) {
    const u32x4 v = q[i];
    s += (unsigned long long)v.x + 3ull * v.y + 5ull * v.z + 7ull * v.w;
  }
  unsigned lo = (unsigned)s, hi = (unsigned)(s >> 32);
  unsigned long long t = s;
#pragma unroll
  for (int d = 32; d >= 1; d >>= 1) {
    const unsigned l2 = __shfl_xor((unsigned)t, d, 64), h2 = __shfl_xor((unsigned)(t >> 32), d, 64);
    t += ((unsigned long long)h2 << 32) | l2;
  }
  (void)lo; (void)hi;
  if ((otid() & 63) == 0) atomicAdd(slot, t);
}
#define CK(ptr, bytes) cksum((ptr), (bytes), slots + slot)
#else
#define CK(ptr, bytes) do {} while (0)
#endif

__global__ void __launch_bounds__(256, 2) fwd_megakernel(Params p) {
  cg::grid_group grid = cg::this_grid();
  __shared__ __attribute__((aligned(16))) unsigned char smem_raw[SMEM_BYTES];
  bf16_t* smem = (bf16_t*)smem_raw;
  float* smf = (float*)smem_raw;
  const int G = gridDim.x, bid = blockIdx.x;
  unsigned* bar = (unsigned*)(p.ws + OFF_BAR);
  unsigned epoch = 0;
#ifdef START_DELAY_US
  {
    const unsigned long long t0 = __builtin_amdgcn_s_memrealtime();
    while (__builtin_amdgcn_s_memrealtime() - t0 < (unsigned long long)START_DELAY_US * 100ull) __builtin_amdgcn_s_sleep(20);
  }
#endif
  grid.sync();
#ifdef WCHECK
  unsigned wseen = 0;
  if (bid == 0 && otid() == 0) wseen = __hip_atomic_load(bar + 32, __ATOMIC_RELAXED, __HIP_MEMORY_SCOPE_AGENT);
#endif

#ifdef SELFCHECK
  unsigned long long* slots_base = (unsigned long long*)(p.ws + OFF_BAR + 256);
  if (bid == 0) for (int k = otid(); k < 768; k += 256) __hip_atomic_store(slots_base + k, 0ull, __ATOMIC_RELAXED, __HIP_MEMORY_SCOPE_AGENT);
  for (int run = 0; run < 3; ++run) {
  unsigned long long* slots = slots_base + run * 256;
  int slot = 0;
#endif
  phase_prep(p, smf);
  gsync(grid, bar, epoch);
  phase_prep(p, smf);
#ifdef SELF_POISON
  {
    u32x4* q = (u32x4*)(p.ws + OFF_H);
    const size_t n16 = (WS_TOTAL - OFF_H) / 16;
    const u32x4 pv = {SELF_POISON, SELF_POISON, SELF_POISON, SELF_POISON};
    for (size_t i = (size_t)bid * 256 + otid(); i < n16; i += (size_t)G * 256) q[i] = pv;
  }
#endif
  gsync(grid, bar, epoch);
#ifdef SELFCHECK
  CK(p.ws, OFF_H); slot++;
#endif

  for (int layer = 0; layer < 2; ++layer) {
    const float* xin = (layer == 0) ? p.in[0] : p.out;
    float* xout = p.out;
    for (int round = 0; round < NROUND; ++round) {
      const size_t tok0 = (size_t)round * TR;
      phase_hnorm(xin + tok0 * 1024, p.in[2] + layer * 1024, (bf16_t*)(p.ws + OFF_H));
      gsync(grid, bar, epoch);
#ifdef SELFCHECK
      CK(p.ws + OFF_H, (size_t)TR * 1024 * 2); slot++;
#endif
#ifndef REP_B
#define REP_B 1
#endif
      for (int rep = 0; rep < REP_B; ++rep) {
      for (int it = bid; it < NRT * 76; it += G) inproj_tile(p, layer, it % NRT, it / NRT, smem);
      gsync(grid, bar, epoch);
      }
#ifdef SELFCHECK
      CK(p.ws + OFF_PROJ, (size_t)TR * D_INP * 2); CK(p.ws + OFF_VTA, (size_t)RB * 4 * 128 * 2048 * 2); slot++;
#endif
      {
        constexpr int n1 = 256, n2 = TR / 16, n3 = RB * 32 * 16, n4 = RB * 16 * 8 / 4;
        for (int it = bid; it < n1 + n2 + n3 + n4; it += G) {
          if (it < n1) s5_e_item(p, layer, it, smem);
          else if (it < n1 + n2) tokpost_item(p, layer, round, it - n1);
          else if (it < n1 + n2 + n3) conv_item(p, layer, it - n1 - n2);
          else dtacum_item(p, layer, it - n1 - n2 - n3);
        }
      }
      gsync(grid, bar, epoch);
#ifdef SELFCHECK
      CK(p.ws + OFF_PROJ, (size_t)TR * D_INP * 2); CK(p.ws + OFF_E, (size_t)32 * 128 * NBC * 4); CK(p.ws + OFF_XC, (size_t)TR * 1024 * 2);
      CK(p.ws + OFF_DT, (size_t)TR * 8 * 4); CK(p.ws + OFF_ACUM, (size_t)TR * 8 * 4); slot++;
#endif
      {
        constexpr int n1 = NRT * 6, n2 = NRT * 8, n3 = RB * 16 * 8, n4 = RB * 32 * 64 / 256;
        for (int it = bid; it < n1 + n2 + n3 + n4; it += G) {
          if (it < n1) mla_up_q_tile(p, layer, it % NRT, it / NRT, smem);
          else if (it < n1 + n2) mla_up_kv_tile(p, layer, (it - n1) % NRT, (it - n1) / NRT, smem);
          else if (it < n1 + n2 + n3) mb_states_item(p, it - n1 - n2, smem);
          else s5_carry_item(p, layer, it - n1 - n2 - n3);
        }
      }
      gsync(grid, bar, epoch);
#ifdef SELFCHECK
      CK(p.ws + OFF_QM, (size_t)TR * 768 * 2); CK(p.ws + OFF_KN, (size_t)TR * 512 * 2); CK(p.ws + OFF_VTD, (size_t)RB * 4 * 128 * 2048 * 2);
      CK(p.ws + OFF_ST, (size_t)RB * 16 * 8 * 8192 * 4); CK(p.ws + OFF_HIN, (size_t)32 * 128 * NBC * 2); slot++;
#endif
      {
        constexpr int n1 = 256, n2 = TR / 16, n3 = RB * 8 * 8192 / 256;
        for (int it = bid; it < n1 + n2 + n3; it += G) {
          if (it < n1) s5_y_item(p, layer, it, smem);
          else if (it < n1 + n2) mlapost_item(p, layer, round, it - n1);
          else mb_scan_item(p, it - n1 - n2);
        }
      }
      gsync(grid, bar, epoch);
#ifdef SELFCHECK
      CK(p.ws + OFF_YG, (size_t)TR * 512 * 2); CK(p.ws + OFF_QM, (size_t)TR * 768 * 2); CK(p.ws + OFF_KM, (size_t)TR * 768 * 2);
      CK(p.ws + OFF_SIN, (size_t)RB * 16 * 8 * 8192 * 2); slot++;
#endif
#ifdef REP_ATT
      {
        constexpr int nat = RB * 4 * 32 * 2;
        for (int it = bid; it < nat; it += G) {
            const int half = nat / 2;
            const int qb = (it < half) ? (31 - it / 32) : ((it - half) / 32);
            const int sub = it & 31;
            if (sub < 16) da_attn_item(p, layer, sub, qb, smem, true);
            else mla_attn_item(p, sub - 16, qb, smem, true);
        }
        gsync(grid, bar, epoch);
      }
#endif
      {
        constexpr int nat = RB * 4 * 32 * 2;
        constexpr int n3 = RB * 16 * 2, n4 = NRT * 4;
        for (int it = bid; it < nat + n3 + n4; it += G) {
          if (it < nat) {
            const int half = nat / 2;
            const int qb = (it < half) ? (31 - it / 32) : ((it - half) / 32);
            const int sub = it & 31;
            if (sub < 16) da_attn_item(p, layer, sub, qb, smem);
            else mla_attn_item(p, sub - 16, qb, smem);
          } else if (it < nat + n3) mb_out_item(p, layer, it - nat, smem);
          else s5_glu_tile(p, layer, (it - nat - n3) % NRT, (it - nat - n3) / NRT, smem);
        }
      }
      gsync(grid, bar, epoch);
#ifdef SELFCHECK
      CK(p.ws + OFF_PROJ, (size_t)TR * D_INP * 2); slot++;
#endif
      for (int it = bid; it < NRT * 16; it += G) merge_tile(p, layer, it % NRT, it / NRT, smem);
      gsync(grid, bar, epoch);
#ifdef SELFCHECK
      CK(p.ws + OFF_MERGED, (size_t)TR * 1024 * 2); slot++;
#endif
      for (int it = bid; it < NRT * 8; it += G) out_tile(p, layer, xin + tok0 * 1024, xout + tok0 * 1024, it % NRT, it / NRT, smem);
      gsync(grid, bar, epoch);
#ifdef SELFCHECK
      CK(xout + tok0 * 1024, (size_t)TR * 1024 * 4); slot++;
#endif
    }
  }
#ifdef WCHECK
  if (bid == 0 && otid() == 0) {
    if (wseen != 0) p.out[0] = 1.0e6f;
    __hip_atomic_store(bar + 32, 1u, __ATOMIC_RELAXED, __HIP_MEMORY_SCOPE_AGENT);
  }
#endif
#ifdef SELFCHECK
  gsync(grid, bar, epoch);
  }
  gsync(grid, bar, epoch);
  if (bid == 0 && otid() == 0) {
    int bad = -1;
    for (int k = 0; k < 100; ++k) {
      const unsigned long long a = __hip_atomic_load(slots_base + k, __ATOMIC_RELAXED, __HIP_MEMORY_SCOPE_AGENT);
      const unsigned long long b = __hip_atomic_load(slots_base + 256 + k, __ATOMIC_RELAXED, __HIP_MEMORY_SCOPE_AGENT);
      const unsigned long long c = __hip_atomic_load(slots_base + 512 + k, __ATOMIC_RELAXED, __HIP_MEMORY_SCOPE_AGENT);
      if (a != b || a != c) { bad = k; break; }
    }
    if (bad >= 0) p.out[0] = 10000.0f * exp2f((float)bad);
  }
#endif
}

extern "C" void kernel_launch(void* const* d_in, const int* in_sizes, int n_in, void* d_out,
                              int out_size, void* d_ws, size_t ws_size, hipStream_t stream) {
  static int grid_blocks = 0;
  if (!grid_blocks) {
    int dev = 0, cus = 0, per_cu = 0;
    (void)hipGetDevice(&dev);
    (void)hipDeviceGetAttribute(&cus, hipDeviceAttributeMultiprocessorCount, dev);
    (void)hipOccupancyMaxActiveBlocksPerMultiprocessor(&per_cu, fwd_megakernel, 256, 0);
    if (per_cu > 2) per_cu = 2;
    if (per_cu < 1) per_cu = 1;
    grid_blocks = cus * per_cu;
    if (grid_blocks > MAXBLK) grid_blocks = MAXBLK;
  }
  if (ws_size < WS_TOTAL) fprintf(stderr, "workspace too small: %zu < %zu\n", ws_size, (size_t)WS_TOTAL);
  Params p{};
  for (int i = 0; i < 35; ++i) p.in[i] = (const float*)d_in[i];
  p.out = (float*)d_out;
  p.ws = (unsigned char*)d_ws;
  (void)hipMemsetAsync((unsigned char*)d_ws + OFF_BAR, 0, 64, stream);
  void* args[] = {&p};
  hipError_t e = hipLaunchCooperativeKernel((void*)fwd_megakernel, dim3(grid_blocks), dim3(256), args, 0, stream);
  if (e != hipSuccess) fprintf(stderr, "cooperative launch failed: %s (grid %d)\n", hipGetErrorString(e), grid_blocks);
}
```

```cpp
#include <hip/hip_runtime.h>
#include <hip/hip_cooperative_groups.h>
#include <cstdio>
#include <cstdint>
namespace cg = cooperative_groups;

typedef unsigned short bf16_t;
typedef short bf16x8 __attribute__((ext_vector_type(8)));
typedef float f32x4 __attribute__((ext_vector_type(4)));
typedef unsigned u32x4 __attribute__((ext_vector_type(4)));
typedef unsigned u32x2 __attribute__((ext_vector_type(2)));

constexpr int SEQ = 2048, BATCH = 16;
constexpr int D_IN = 9672, D_INP = 9728;
constexpr int RB = 4;
constexpr int TR = RB * SEQ;
constexpr int NROUND = BATCH / RB;
constexpr int NRT = TR / 128;
constexpr int NBC = TR / 8;
constexpr int MAXBLK = 512;
constexpr float EPS = 1e-6f;
constexpr float LOG2E = 1.4426950408889634f;
constexpr int C_DAQ = 0, C_DAK = 512, C_DAV = 1024, C_DAG = 1536, C_MBZ = 2048, C_XBC = 2560, C_DT = 3584,
              C_S5U = 3592, C_S5G = 4104, C_CQ = 4616, C_CKV = 4872, C_KR = 5000, C_MLG = 5064, C_GATE = 5576;
constexpr long LDP = D_INP;

constexpr size_t al256(size_t x) { return (x + 255) & ~size_t(255); }
constexpr size_t OFF_WINT = 0;
constexpr size_t OFF_WBRT = OFF_WINT + al256((size_t)2 * D_INP * 1024 * 2);
constexpr size_t OFF_WOUTT = OFF_WBRT + al256((size_t)2 * 4 * 1024 * 512 * 2);
constexpr size_t OFF_WGLUT = OFF_WOUTT + al256((size_t)2 * 1024 * 1024 * 2);
constexpr size_t OFF_WUQT = OFF_WGLUT + al256((size_t)2 * 512 * 512 * 2);
constexpr size_t OFF_WUKVT = OFF_WUQT + al256((size_t)2 * 768 * 256 * 2);
constexpr size_t OFF_KMAT = OFF_WUKVT + al256((size_t)2 * 1024 * 128 * 2);
constexpr size_t OFF_EMAT = OFF_KMAT + al256((size_t)2 * 32 * 128 * 128 * 2);
constexpr size_t OFF_FMAT = OFF_EMAT + al256((size_t)2 * 32 * 128 * 128 * 2);
constexpr size_t OFF_A8 = OFF_FMAT + al256((size_t)2 * 32 * 128 * 128 * 2);
constexpr size_t OFF_LAM = OFF_A8 + al256((size_t)2 * 32 * 64 * 2 * 4);
constexpr size_t OFF_H = OFF_LAM + 256;
constexpr size_t OFF_PROJ = OFF_H + al256((size_t)TR * 1024 * 2);
constexpr size_t OFF_XC = OFF_PROJ + al256((size_t)TR * D_INP * 2);
constexpr size_t OFF_DT = OFF_XC + al256((size_t)TR * 1024 * 2);
constexpr size_t OFF_ACUM = OFF_DT + al256((size_t)TR * 8 * 4);
constexpr size_t OFF_VTA = OFF_ACUM + al256((size_t)TR * 8 * 4);
constexpr size_t OFF_VTD = OFF_VTA + al256((size_t)RB * 4 * 128 * 2048 * 2);
constexpr size_t OFF_QM = OFF_VTD + al256((size_t)RB * 4 * 128 * 2048 * 2);
constexpr size_t OFF_KM = OFF_QM + al256((size_t)TR * 768 * 2);
constexpr size_t OFF_KN = OFF_KM + al256((size_t)TR * 768 * 2);
constexpr size_t OFF_ST = OFF_KN + al256((size_t)TR * 512 * 2);
constexpr size_t OFF_SIN = OFF_ST + al256((size_t)RB * 16 * 8 * 8192 * 4);
constexpr size_t OFF_MS = OFF_SIN + al256((size_t)RB * 16 * 8 * 8192 * 2);
constexpr size_t OFF_XS = OFF_MS + al256((size_t)MAXBLK * 128 * 128 * 2);
constexpr size_t OFF_E = OFF_XS + al256((size_t)MAXBLK * 128 * 64 * 2);
constexpr size_t OFF_HIN = OFF_E + al256((size_t)32 * 128 * NBC * 4);
constexpr size_t OFF_YG = OFF_HIN + al256((size_t)32 * 128 * NBC * 2);
constexpr size_t OFF_MERGED = OFF_YG + al256((size_t)TR * 512 * 2);
constexpr size_t OFF_BAR = OFF_MERGED + al256((size_t)TR * 1024 * 2);
constexpr size_t WS_TOTAL = OFF_BAR + 8192;

constexpr int SMEM_BYTES = 55296 + 4096;

struct Params {
  const float* in[35];
  float* out;
  unsigned char* ws;
};

#define MEMBAR() do { asm volatile("" ::: "memory"); __builtin_amdgcn_sched_barrier(0); } while (0)
__device__ __forceinline__ int otid() { int t = threadIdx.x; asm volatile("" : "+v"(t)); return t; }
__device__ __forceinline__ bf16_t f2bf(float f) {
  unsigned u = __float_as_uint(f);
  u += 0x7fffu + ((u >> 16) & 1u);
  return (bf16_t)(u >> 16);
}
__device__ __forceinline__ float bf2f(bf16_t b) { return __uint_as_float(((unsigned)b) << 16); }
__device__ __forceinline__ unsigned pack2(float a, float b) { return (unsigned)f2bf(a) | ((unsigned)f2bf(b) << 16); }
__device__ __forceinline__ float sigmoidf_(float x) { return 1.0f / (1.0f + __expf(-x)); }
__device__ __forceinline__ float siluf_(float x) { return x / (1.0f + __expf(-x)); }
__device__ __forceinline__ float gelu_tanh(float x) {
  float u = 0.7978845608028654f * (x + 0.044715f * x * x * x);
  float t = 1.0f - 2.0f / (__expf(2.0f * u) + 1.0f);
  return 0.5f * x * (1.0f + t);
}
__device__ __forceinline__ float wave_sum(float v) {
#pragma unroll
  for (int d = 32; d >= 1; d >>= 1) v += __shfl_xor(v, d, 64);
  return v;
}

__device__ __forceinline__ void block_global_handoff() {
  asm volatile("s_waitcnt vmcnt(0)" ::: "memory");
  __syncthreads();
  if (otid() < 64) {
    __builtin_amdgcn_fence(__ATOMIC_ACQUIRE, "agent");
    asm volatile("s_waitcnt vmcnt(0)" ::: "memory");
  }
  __syncthreads();
}
template <int R, bool T, bool SEG, int N>
__device__ __forceinline__ void g_load(u32x4 (&rg)[N], const bf16_t* __restrict__ P, long ld, int k0, long segs, int tid) {
#pragma unroll
  for (int i = 0; i < N; ++i) {
    const int ch = tid + i * 256;
    if (!T) {
      const int row = ch >> 3, kc = k0 + (ch & 7) * 8;
      const long ko = SEG ? ((long)(kc >> 4) * segs + (kc & 15)) : (long)kc;
      rg[i] = *(const u32x4*)(P + (long)row * ld + ko);
    } else {
      constexpr int CPR = R / 8;
      const int kk = ch / CPR, m0 = (ch % CPR) * 8;
      rg[i] = *(const u32x4*)(P + (long)(k0 + kk) * ld + m0);
    }
  }
}
template <int R, bool T, int N>
__device__ __forceinline__ void s_store(const u32x4 (&rg)[N], bf16_t* sm, int tid) {
  constexpr int LS = 72;
#pragma unroll
  for (int i = 0; i < N; ++i) {
    const int ch = tid + i * 256;
    if (!T) {
      const int row = ch >> 3, kc = (ch & 7) * 8;
      *(u32x4*)(sm + row * LS + kc) = rg[i];
    } else {
      constexpr int CPR = R / 8;
      const int kk = ch / CPR, m0 = (ch % CPR) * 8;
      bf16_t* d = sm + m0 * LS + kk;
      d[0 * LS] = (bf16_t)(rg[i].x & 0xffffu); d[1 * LS] = (bf16_t)(rg[i].x >> 16);
      d[2 * LS] = (bf16_t)(rg[i].y & 0xffffu); d[3 * LS] = (bf16_t)(rg[i].y >> 16);
      d[4 * LS] = (bf16_t)(rg[i].z & 0xffffu); d[5 * LS] = (bf16_t)(rg[i].z >> 16);
      d[6 * LS] = (bf16_t)(rg[i].w & 0xffffu); d[7 * LS] = (bf16_t)(rg[i].w >> 16);
    }
  }
}
template <int BN, bool TA, bool TB, bool SEGA>
__device__ __forceinline__ void gemm_tile(f32x4 (&acc)[4][BN / 32], const bf16_t* __restrict__ A, long lda,
                                          const bf16_t* __restrict__ B, long ldb, int K, bf16_t* smem, long segs = 0) {
  constexpr int LS = 72;
  bf16_t* sA = smem;
  bf16_t* sB = smem + 128 * LS;
  const int tid = otid(), w = tid >> 6, l = tid & 63, g = l >> 4, c = l & 15;
  const int wr = w >> 1, wc = w & 1;
  constexpr int NA = 4, NB = BN / 32;
  u32x4 ra[NA], rb[NB];
  const int nk = K / 64;
  g_load<128, TA, SEGA, NA>(ra, A, lda, 0, segs, tid);
  g_load<BN, TB, false, NB>(rb, B, ldb, 0, 0, tid);
  const bf16_t* pa = sA + (wr * 64 + c) * LS + g * 8;
  const bf16_t* pb = sB + (wc * (BN / 2) + c) * LS + g * 8;
  for (int kt = 0; kt < nk; ++kt) {
    __syncthreads();
    s_store<128, TA, NA>(ra, sA, tid);
    s_store<BN, TB, NB>(rb, sB, tid);
    __syncthreads();
    if (kt + 1 < nk) {
      g_load<128, TA, SEGA, NA>(ra, A, lda, (kt + 1) * 64, segs, tid);
      g_load<BN, TB, false, NB>(rb, B, ldb, (kt + 1) * 64, 0, tid);
    }
#pragma unroll
    for (int ks = 0; ks < 2; ++ks) {
      bf16x8 af[4], bfr[BN / 32];
#pragma unroll
      for (int i = 0; i < 4; ++i) af[i] = *(const bf16x8*)(pa + i * 16 * LS + ks * 32);
#pragma unroll
      for (int j = 0; j < BN / 32; ++j) bfr[j] = *(const bf16x8*)(pb + j * 16 * LS + ks * 32);
#pragma unroll
      for (int i = 0; i < 4; ++i)
#pragma unroll
        for (int j = 0; j < BN / 32; ++j) acc[i][j] = __builtin_amdgcn_mfma_f32_16x16x32_bf16(af[i], bfr[j], acc[i][j], 0, 0, 0);
    }
  }
}

template <int NJ>
__device__ __forceinline__ void zero_acc(f32x4 (&acc)[4][NJ]) {
#pragma unroll
  for (int i = 0; i < 4; ++i)
#pragma unroll
    for (int j = 0; j < NJ; ++j) acc[i][j] = (f32x4){0.f, 0.f, 0.f, 0.f};
}

__device__ __forceinline__ void tconv_tile(const float* __restrict__ src, bf16_t* __restrict__ dst, int K, int N, int tk, int tn, float* sm) {
  const int tid = otid();
  const int k0 = tk * 64, n0 = tn * 64;
  __syncthreads();
#pragma unroll 4
  for (int i = 0; i < 16; ++i) {
    const int kk = i * 4 + (tid >> 6), nn = tid & 63;
    float v = 0.f;
    if (n0 + nn < N) v = src[(long)(k0 + kk) * N + n0 + nn];
    sm[kk * 65 + nn] = v;
  }
  __syncthreads();
#pragma unroll 4
  for (int i = 0; i < 16; ++i) {
    const int nn = i * 4 + (tid >> 6), kk = tid & 63;
    dst[(long)(n0 + nn) * K + k0 + kk] = f2bf(sm[kk * 65 + nn]);
  }
}

__device__ __forceinline__ void tconv_job(const float* src, bf16_t* dst, int K, int N, int Npad, float* sm) {
  const int tkn = K / 64, tnn = Npad / 64;
  for (int t = blockIdx.x; t < tkn * tnn; t += gridDim.x) tconv_tile(src, dst, K, N, t % tkn, t / tkn, sm);
}

__device__ __forceinline__ void s5_prep(const Params& p, int layer, int grp, float* sm) {
  float* pwr = sm;
  float* pwi = pwr + 9 * 64;
  float* bbr = pwi + 9 * 64;
  float* bbi = bbr + 1024;
  float* cr = bbi + 1024;
  float* ci = cr + 1024;
  float* kt = ci + 1024;
  const int tid = otid();
  const int lg = layer * 32 + grp;
  __syncthreads();
  if (tid < 64) {
    const int pp = tid;
    const double step = exp((double)p.in[19][lg]);
    const double lr = (double)p.in[17][lg * 64 + pp], li = (double)p.in[18][lg * 64 + pp];
    const double mag = exp(lr * step);
    const double abr = mag * cos(li * step), abi = mag * sin(li * step);
    const double den = lr * lr + li * li;
    const double fr = ((abr - 1.0) * lr + abi * li) / den;
    const double fi = (abi * lr - (abr - 1.0) * li) / den;
    double qr = 1.0, qi = 0.0;
    for (int t = 0; t < 9; ++t) {
      pwr[t * 64 + pp] = (float)qr;
      pwi[t * 64 + pp] = (float)qi;
      const double nr = qr * abr - qi * abi, ni = qr * abi + qi * abr;
      qr = nr; qi = ni;
    }
    float* a8 = (float*)(p.ws + OFF_A8) + (size_t)(lg * 64 + pp) * 2;
    a8[0] = pwr[8 * 64 + pp];
    a8[1] = pwi[8 * 64 + pp];
    for (int cc = 0; cc < 16; ++cc) {
      const double br = (double)p.in[20][(lg * 64 + pp) * 16 + cc], bi = (double)p.in[21][(lg * 64 + pp) * 16 + cc];
      bbr[pp * 16 + cc] = (float)(fr * br - fi * bi);
      bbi[pp * 16 + cc] = (float)(fr * bi + fi * br);
    }
  }
  for (int e = tid; e < 1024; e += 256) {
    cr[e] = p.in[22][lg * 1024 + e];
    ci[e] = p.in[23][lg * 1024 + e];
  }
  __syncthreads();
  for (int e = tid; e < 2048; e += 256) {
    const int tau = e >> 8, co = (e >> 4) & 15, cin = e & 15;
    float s = 0.f;
    for (int pp = 0; pp < 64; ++pp) {
      const float pr = pwr[tau * 64 + pp], pi = pwi[tau * 64 + pp];
      const float zr = pr * bbr[pp * 16 + cin] - pi * bbi[pp * 16 + cin];
      const float zi = pr * bbi[pp * 16 + cin] + pi * bbr[pp * 16 + cin];
      s += cr[co * 64 + pp] * zr - ci[co * 64 + pp] * zi;
    }
    kt[e] = s;
  }
  __syncthreads();
  bf16_t* Km = (bf16_t*)(p.ws + OFF_KMAT) + (size_t)lg * 16384;
  bf16_t* Em = (bf16_t*)(p.ws + OFF_EMAT) + (size_t)lg * 16384;
  bf16_t* Fm = (bf16_t*)(p.ws + OFF_FMAT) + (size_t)lg * 16384;
  for (int e = tid; e < 16384; e += 256) {
    const int n = e >> 7, k = e & 127;
    {
      const int tq = n >> 4, co = n & 15, sq = k >> 4, cin = k & 15;
      Km[e] = f2bf(tq >= sq ? kt[((tq - sq) * 16 + co) * 16 + cin] : 0.f);
    }
    {
      const int pp = n >> 1, ri = n & 1, sq = k >> 4, cin = k & 15;
      const float pr = pwr[(7 - sq) * 64 + pp], pi = pwi[(7 - sq) * 64 + pp];
      const float zr = pr * bbr[pp * 16 + cin] - pi * bbi[pp * 16 + cin];
      const float zi = pr * bbi[pp * 16 + cin] + pi * bbr[pp * 16 + cin];
      Em[e] = f2bf(ri ? zi : zr);
    }
    {
      const int tq = n >> 4, co = n & 15, pp = k >> 1, ri = k & 1;
      const float pr = pwr[(tq + 1) * 64 + pp], pi = pwi[(tq + 1) * 64 + pp];
      const float gr = cr[co * 64 + pp] * pr - ci[co * 64 + pp] * pi;
      const float gi = cr[co * 64 + pp] * pi + ci[co * 64 + pp] * pr;
      Fm[e] = f2bf(ri ? -gi : gr);
    }
  }
}

__device__ __forceinline__ void phase_prep(const Params& p, float* smf) {
  for (int L = 0; L < 2; ++L) {
    tconv_job(p.in[3] + (size_t)L * 1024 * D_IN, (bf16_t*)(p.ws + OFF_WINT) + (size_t)L * D_INP * 1024, 1024, D_IN, D_INP, smf);
    for (int n = 0; n < 4; ++n)
      tconv_job(p.in[33] + (size_t)(L * 4 + n) * 512 * 1024, (bf16_t*)(p.ws + OFF_WBRT) + (size_t)(L * 4 + n) * 1024 * 512, 512, 1024, 1024, smf);
    tconv_job(p.in[34] + (size_t)L * 1024 * 1024, (bf16_t*)(p.ws + OFF_WOUTT) + (size_t)L * 1024 * 1024, 1024, 1024, 1024, smf);
    tconv_job(p.in[25] + (size_t)L * 512 * 512, (bf16_t*)(p.ws + OFF_WGLUT) + (size_t)L * 512 * 512, 512, 512, 512, smf);
    tconv_job(p.in[28] + (size_t)L * 256 * 768, (bf16_t*)(p.ws + OFF_WUQT) + (size_t)L * 768 * 256, 256, 768, 768, smf);
    tconv_job(p.in[30] + (size_t)L * 128 * 1024, (bf16_t*)(p.ws + OFF_WUKVT) + (size_t)L * 1024 * 128, 128, 1024, 1024, smf);
  }
  for (int it = blockIdx.x; it < 64; it += gridDim.x) s5_prep(p, it >> 5, it & 31, smf);
  if (blockIdx.x == gridDim.x - 1 && otid() < 2) {
    const int L = otid();
    float s1 = 0.f, s2 = 0.f;
    for (int i = 0; i < 64; ++i) {
      s1 += p.in[6][L * 64 + i] * p.in[7][L * 64 + i];
      s2 += p.in[8][L * 64 + i] * p.in[9][L * 64 + i];
    }
    const float li = 0.8f - 0.6f * expf(-0.3f * (float)L);
    ((float*)(p.ws + OFF_LAM))[L] = expf(s1) - expf(s2) + li;
  }
}

__device__ __forceinline__ void phase_hnorm(const float* __restrict__ x, const float* __restrict__ gn, bf16_t* __restrict__ H) {
  const int w = otid() >> 6, l = otid() & 63;
  for (int row = blockIdx.x * 4 + w; row < TR; row += gridDim.x * 4) {
    const float4* xr = (const float4*)(x + (size_t)row * 1024);
    float4 v[4];
    float ss = 0.f;
#pragma unroll
    for (int i = 0; i < 4; ++i) {
      v[i] = xr[i * 64 + l];
      ss += v[i].x * v[i].x + v[i].y * v[i].y + v[i].z * v[i].z + v[i].w * v[i].w;
    }
    ss = wave_sum(ss);
    const float rs = rsqrtf(ss * (1.0f / 1024.0f) + EPS);
#pragma unroll
    for (int i = 0; i < 4; ++i) {
      const float4 gg = ((const float4*)gn)[i * 64 + l];
      u32x2 o;
      o.x = pack2(v[i].x * rs * gg.x, v[i].y * rs * gg.y);
      o.y = pack2(v[i].z * rs * gg.z, v[i].w * rs * gg.w);
      *(u32x2*)(H + (size_t)row * 1024 + (i * 64 + l) * 4) = o;
    }
  }
}

__device__ __forceinline__ void inproj_tile(const Params& p, int layer, int rt, int ct, bf16_t* smem) {
  const bf16_t* H = (const bf16_t*)(p.ws + OFF_H);
  const bf16_t* W = (const bf16_t*)(p.ws + OFF_WINT) + (size_t)layer * D_INP * 1024;
  bf16_t* PROJ = (bf16_t*)(p.ws + OFF_PROJ);
  bf16_t* VTA = (bf16_t*)(p.ws + OFF_VTA);
  f32x4 acc[4][4];
  zero_acc<4>(acc);
  gemm_tile<128, false, false, false>(acc, H + (size_t)rt * 128 * 1024, 1024, W + (size_t)ct * 128 * 1024, 1024, 1024, smem);
  const int tid = otid(), w = tid >> 6, l = tid & 63, g = l >> 4, c = l & 15, wr = w >> 1, wc = w & 1;
  const int c0 = ct * 128;
  if (c0 >= C_DAV && c0 < C_DAG) {
    const int h = (c0 - C_DAV) >> 7;
#pragma unroll
    for (int i = 0; i < 4; ++i)
#pragma unroll
      for (int j = 0; j < 4; ++j) {
        const int row = rt * 128 + wr * 64 + i * 16 + g * 4;
        const int dv = wc * 64 + j * 16 + c;
        const int b = row >> 11, s = row & 2047;
        u32x2 o;
        o.x = pack2(acc[i][j][0], acc[i][j][1]);
        o.y = pack2(acc[i][j][2], acc[i][j][3]);
        *(u32x2*)(VTA + ((size_t)((b * 4 + h) * 128 + dv)) * 2048 + s) = o;
      }
  } else {
#pragma unroll
    for (int i = 0; i < 4; ++i) {
#pragma unroll
      for (int r = 0; r < 4; ++r) {
        const int row = rt * 128 + wr * 64 + i * 16 + g * 4 + r;
        bf16_t* rp = PROJ + (size_t)row * LDP + c0 + wc * 64 + c;
#pragma unroll
        for (int j = 0; j < 4; ++j) {
          float v = acc[i][j][r];
          if (c0 + wc * 64 + j * 16 + c >= C_GATE) v = sigmoidf_(v);
          rp[j * 16] = f2bf(v);
        }
      }
      MEMBAR();
    }
  }
}

__device__ __forceinline__ void tokpost_item(const Params& p, int layer, int round, int item) {
  bf16_t* PROJ = (bf16_t*)(p.ws + OFF_PROJ);
  const int* pos = (const int*)p.in[1];
  const int w = otid() >> 6, l = otid() & 63;
  for (int tt = 0; tt < 4; ++tt) {
    const int row = item * 16 + w * 4 + tt;
    const float fpos = (float)pos[round * TR + row];
    bf16_t* pr = PROJ + (size_t)row * LDP;
    {
      const int which = l >> 5, idx = (l & 31) * 16, off = (l & 3) * 16;
      bf16_t* ptr = pr + which * 512 + idx;
      u32x4 u0 = *(const u32x4*)ptr, u1 = *(const u32x4*)(ptr + 8);
      const unsigned uu[8] = {u0.x, u0.y, u0.z, u0.w, u1.x, u1.y, u1.z, u1.w};
      float v[16];
      float ss = 0.f;
#pragma unroll
      for (int e = 0; e < 8; ++e) {
        v[2 * e] = __uint_as_float(uu[e] << 16);
        v[2 * e + 1] = __uint_as_float(uu[e] & 0xffff0000u);
        ss += v[2 * e] * v[2 * e] + v[2 * e + 1] * v[2 * e + 1];
      }
      ss += __shfl_xor(ss, 1, 64);
      ss += __shfl_xor(ss, 2, 64);
      const float rs = rsqrtf(ss * (1.0f / 64.0f) + EPS);
      const float* gn = (which ? p.in[5] : p.in[4]) + layer * 64 + off;
#pragma unroll
      for (int e = 0; e < 16; ++e) v[e] = v[e] * rs * gn[e];
      if ((l & 3) == 0) {
#pragma unroll
        for (int i = 0; i < 8; ++i) {
          const float invf = expf(-13.122363377404328f * (float)i * 0.125f);
          const float ang = fpos * invf;
          const float cs = cosf(ang), sn = sinf(ang);
          const float x1 = v[i], x2 = v[i + 8];
          v[i] = x1 * cs - x2 * sn;
          v[i + 8] = x2 * cs + x1 * sn;
        }
      }
      if (which == 0) {
#pragma unroll
        for (int e = 0; e < 16; ++e) v[e] *= 0.125f * LOG2E;
      }
      u32x4 o0, o1;
      o0.x = pack2(v[0], v[1]); o0.y = pack2(v[2], v[3]); o0.z = pack2(v[4], v[5]); o0.w = pack2(v[6], v[7]);
      o1.x = pack2(v[8], v[9]); o1.y = pack2(v[10], v[11]); o1.z = pack2(v[12], v[13]); o1.w = pack2(v[14], v[15]);
      *(u32x4*)ptr = o0;
      *(u32x4*)(ptr + 8) = o1;
    }
    {
      bf16_t* ptr = pr + C_CQ + l * 4;
      u32x2 u = *(const u32x2*)ptr;
      float v0 = __uint_as_float(u.x << 16), v1 = __uint_as_float(u.x & 0xffff0000u);
      float v2 = __uint_as_float(u.y << 16), v3 = __uint_as_float(u.y & 0xffff0000u);
      float ss = wave_sum(v0 * v0 + v1 * v1 + v2 * v2 + v3 * v3);
      const float rs = rsqrtf(ss * (1.0f / 256.0f) + EPS);
      const float* gn = p.in[27] + layer * 256 + l * 4;
      u32x2 o;
      o.x = pack2(v0 * rs * gn[0], v1 * rs * gn[1]);
      o.y = pack2(v2 * rs * gn[2], v3 * rs * gn[3]);
      *(u32x2*)ptr = o;
    }
    {
      bf16_t* ptr = pr + C_CKV + l * 2;
      unsigned u = *(const unsigned*)ptr;
      float v0 = __uint_as_float(u << 16), v1 = __uint_as_float(u & 0xffff0000u);
      float ss = wave_sum(v0 * v0 + v1 * v1);
      const float rs = rsqrtf(ss * (1.0f / 128.0f) + EPS);
      const float* gn = p.in[29] + layer * 128 + l * 2;
      *(unsigned*)ptr = pack2(v0 * rs * gn[0], v1 * rs * gn[1]);
    }
  }
}

__device__ __forceinline__ void conv_item(const Params& p, int layer, int item) {
  const bf16_t* PROJ = (const bf16_t*)(p.ws + OFF_PROJ);
  bf16_t* XC = (bf16_t*)(p.ws + OFF_XC);
  const int chtile = item & 15, tt = (item >> 4) & 31, b = item >> 9;
  const int ch = chtile * 64 + (otid() & 63);
  const int tr0 = otid() >> 6;
  const float* cw = p.in[11] + (size_t)layer * 4 * 1024;
  const float w0 = cw[ch], w1 = cw[1024 + ch], w2 = cw[2048 + ch], w3 = cw[3072 + ch];
  const float bias = p.in[12][layer * 1024 + ch];
  for (int i0 = 0; i0 < 16; i0 += 8) {
    float x0[8], x1[8], x2[8], x3[8];
#pragma unroll
    for (int u = 0; u < 8; ++u) {
      const int t = tt * 64 + (i0 + u) * 4 + tr0;
      const bf16_t* base = PROJ + (size_t)(b * 2048 + t) * LDP + C_XBC + ch;
      x3[u] = bf2f(base[0]);
      x2[u] = (t >= 1) ? bf2f(*(base - LDP)) : 0.f;
      x1[u] = (t >= 2) ? bf2f(*(base - 2 * LDP)) : 0.f;
      x0[u] = (t >= 3) ? bf2f(*(base - 3 * LDP)) : 0.f;
    }
#pragma unroll
    for (int u = 0; u < 8; ++u) {
      const int t = tt * 64 + (i0 + u) * 4 + tr0;
      const float y = bias + w3 * x3[u] + w2 * x2[u] + w1 * x1[u] + w0 * x0[u];
      XC[(size_t)(b * 2048 + t) * 1024 + ch] = f2bf(siluf_(y));
    }
  }
}

__device__ __forceinline__ void dtacum_item(const Params& p, int layer, int item) {
  const bf16_t* PROJ = (const bf16_t*)(p.ws + OFF_PROJ);
  float* DT = (float*)(p.ws + OFF_DT);
  float* AC = (float*)(p.ws + OFF_ACUM);
  const int w = otid() >> 6, l = otid() & 63;
  const int id = item * 4 + w;
  const int h = id & 7, bc = id >> 3;
  const int row0 = bc * 128 + 2 * l;
  const float bias = p.in[13][layer * 8 + h];
  const float A = -expf(p.in[14][layer * 8 + h]);
  float x0 = bf2f(PROJ[(size_t)row0 * LDP + C_DT + h]) + bias;
  float x1 = bf2f(PROJ[(size_t)(row0 + 1) * LDP + C_DT + h]) + bias;
  const float d0 = x0 > 20.f ? x0 : log1pf(expf(x0));
  const float d1 = x1 > 20.f ? x1 : log1pf(expf(x1));
  const float a0 = d0 * A, a1 = d1 * A;
  float s = a0 + a1;
#pragma unroll
  for (int d = 1; d < 64; d <<= 1) {
    const float t = __shfl_up(s, d, 64);
    if (l >= d) s += t;
  }
  DT[(size_t)row0 * 8 + h] = d0;
  DT[(size_t)(row0 + 1) * 8 + h] = d1;
  AC[(size_t)row0 * 8 + h] = s - a1;
  AC[(size_t)(row0 + 1) * 8 + h] = s;
}

__device__ __forceinline__ void s5_e_item(const Params& p, int layer, int item, bf16_t* smem) {
  const bf16_t* PROJ = (const bf16_t*)(p.ws + OFF_PROJ);
  const int grp = item >> 3, mt = item & 7;
  const bf16_t* Em = (const bf16_t*)(p.ws + OFF_EMAT) + (size_t)(layer * 32 + grp) * 16384;
  float* E = (float*)(p.ws + OFF_E);
  f32x4 acc[4][4];
  zero_acc<4>(acc);
  gemm_tile<128, false, false, true>(acc, PROJ + (size_t)mt * 128 * 8 * LDP + C_S5U + grp * 16, 8 * LDP, Em, 128, 128, smem, LDP);
  const int tid = otid(), w = tid >> 6, l = tid & 63, g = l >> 4, c = l & 15, wr = w >> 1, wc = w & 1;
#pragma unroll
  for (int i = 0; i < 4; ++i)
#pragma unroll
    for (int j = 0; j < 4; ++j) {
      const int m = mt * 128 + wr * 64 + i * 16 + g * 4;
      const int n = wc * 64 + j * 16 + c;
      *(f32x4*)(E + ((size_t)(grp * 128 + n)) * NBC + m) = acc[i][j];
    }
}

__device__ __forceinline__ void mla_up_q_tile(const Params& p, int layer, int rt, int ct, bf16_t* smem) {
  const bf16_t* PROJ = (const bf16_t*)(p.ws + OFF_PROJ);
  const bf16_t* W = (const bf16_t*)(p.ws + OFF_WUQT) + (size_t)layer * 768 * 256;
  bf16_t* QM = (bf16_t*)(p.ws + OFF_QM);
  f32x4 acc[4][4];
  zero_acc<4>(acc);
  gemm_tile<128, false, false, false>(acc, PROJ + (size_t)rt * 128 * LDP + C_CQ, LDP, W + (size_t)ct * 128 * 256, 256, 256, smem);
  const int tid = otid(), w = tid >> 6, l = tid & 63, g = l >> 4, c = l & 15, wr = w >> 1, wc = w & 1;
#pragma unroll
  for (int i = 0; i < 4; ++i)
#pragma unroll
    for (int j = 0; j < 4; ++j)
#pragma unroll
      for (int r = 0; r < 4; ++r) {
        const int row = rt * 128 + wr * 64 + i * 16 + g * 4 + r, col = ct * 128 + wc * 64 + j * 16 + c;
        QM[(size_t)row * 768 + col] = f2bf(acc[i][j][r]);
      }
}
__device__ __forceinline__ void mla_up_kv_tile(const Params& p, int layer, int rt, int ct, bf16_t* smem) {
  const bf16_t* PROJ = (const bf16_t*)(p.ws + OFF_PROJ);
  const bf16_t* W = (const bf16_t*)(p.ws + OFF_WUKVT) + (size_t)layer * 1024 * 128;
  bf16_t* KN = (bf16_t*)(p.ws + OFF_KN);
  bf16_t* VTD = (bf16_t*)(p.ws + OFF_VTD);
  f32x4 acc[4][4];
  zero_acc<4>(acc);
  gemm_tile<128, false, false, false>(acc, PROJ + (size_t)rt * 128 * LDP + C_CKV, LDP, W + (size_t)ct * 128 * 128, 128, 128, smem);
  const int tid = otid(), w = tid >> 6, l = tid & 63, g = l >> 4, c = l & 15, wr = w >> 1, wc = w & 1;
  const int h = ct >> 1;
  if ((ct & 1) == 0) {
#pragma unroll
    for (int i = 0; i < 4; ++i)
#pragma unroll
      for (int j = 0; j < 4; ++j)
#pragma unroll
        for (int r = 0; r < 4; ++r) {
          const int row = rt * 128 + wr * 64 + i * 16 + g * 4 + r, cc = wc * 64 + j * 16 + c;
          KN[(size_t)row * 512 + h * 128 + cc] = f2bf(acc[i][j][r]);
        }
  } else {
#pragma unroll
    for (int i = 0; i < 4; ++i)
#pragma unroll
      for (int j = 0; j < 4; ++j) {
        const int row = rt * 128 + wr * 64 + i * 16 + g * 4, dv = wc * 64 + j * 16 + c;
        const int b = row >> 11, s = row & 2047;
        u32x2 o;
        o.x = pack2(acc[i][j][0], acc[i][j][1]);
        o.y = pack2(acc[i][j][2], acc[i][j][3]);
        *(u32x2*)(VTD + ((size_t)((b * 4 + h) * 128 + dv)) * 2048 + s) = o;
      }
  }
}

__device__ __forceinline__ void mb_states_item(const Params& p, int item, bf16_t* smem) {
  const bf16_t* XC = (const bf16_t*)(p.ws + OFF_XC);
  const float* DT = (const float*)(p.ws + OFF_DT);
  const float* AC = (const float*)(p.ws + OFF_ACUM);
  bf16_t* XS = (bf16_t*)(p.ws + OFF_XS) + (size_t)blockIdx.x * 128 * 64;
  float* ST = (float*)(p.ws + OFF_ST);
  const int h = item & 7, bc = item >> 3;
  const int grp = h >> 2;
  const int row0 = bc * 128;
  const int tid = otid();
  __syncthreads();
  const float alast = AC[(size_t)(row0 + 127) * 8 + h];
  for (int e0 = tid; e0 < 8192; e0 += 2048) {
    float dv[8], av[8];
    bf16_t xv[8];
#pragma unroll
    for (int u = 0; u < 8; ++u) {
      const int e = e0 + u * 256;
      const int row = row0 + (e >> 6);
      dv[u] = DT[(size_t)row * 8 + h];
      av[u] = AC[(size_t)row * 8 + h];
      xv[u] = XC[(size_t)row * 1024 + h * 64 + (e & 63)];
    }
#pragma unroll
    for (int u = 0; u < 8; ++u) XS[e0 + u * 256] = f2bf(bf2f(xv[u]) * dv[u] * __expf(alast - av[u]));
  }
  block_global_handoff();
  f32x4 acc[4][2];
  zero_acc<2>(acc);
  gemm_tile<64, true, true, false>(acc, XC + (size_t)row0 * 1024 + 512 + grp * 128, 1024, XS, 64, 128, smem);
  const int w = tid >> 6, l = tid & 63, g = l >> 4, c = l & 15, wr = w >> 1, wc = w & 1;
#pragma unroll
  for (int i = 0; i < 4; ++i)
#pragma unroll
    for (int j = 0; j < 2; ++j) {
      const int n = wr * 64 + i * 16 + g * 4;
      const int pp = wc * 32 + j * 16 + c;
      *(f32x4*)(ST + ((size_t)(bc * 8 + h) * 64 + pp) * 128 + n) = acc[i][j];
    }
}

__device__ __forceinline__ void s5_carry_item(const Params& p, int layer, int item) {
  const int idx = item * 256 + otid();
  const int b = idx >> 11, grp = (idx >> 6) & 31, pp = idx & 63;
  const float* a8 = (const float*)(p.ws + OFF_A8) + (size_t)((layer * 32 + grp) * 64 + pp) * 2;
  const float ar = a8[0], ai = a8[1];
  const float* er = (const float*)(p.ws + OFF_E) + ((size_t)(grp * 128 + 2 * pp)) * NBC + b * 256;
  const float* ei = er + NBC;
  bf16_t* hro = (bf16_t*)(p.ws + OFF_HIN) + ((size_t)(grp * 128 + 2 * pp)) * NBC + b * 256;
  bf16_t* hio = hro + NBC;
  float hr = 0.f, hi = 0.f;
  for (int c16 = 0; c16 < 16; ++c16) {
    f32x4 vr[4], vi[4];
#pragma unroll
    for (int u = 0; u < 4; ++u) {
      vr[u] = *(const f32x4*)(er + c16 * 16 + u * 4);
      vi[u] = *(const f32x4*)(ei + c16 * 16 + u * 4);
    }
#pragma unroll
    for (int u = 0; u < 4; ++u) {
      float orr[4], oii[4];
#pragma unroll
      for (int k = 0; k < 4; ++k) {
        orr[k] = hr; oii[k] = hi;
        const float nr = ar * hr - ai * hi + vr[u][k];
        const float ni = ar * hi + ai * hr + vi[u][k];
        hr = nr; hi = ni;
      }
      u32x2 o0, o1;
      o0.x = pack2(orr[0], orr[1]); o0.y = pack2(orr[2], orr[3]);
      o1.x = pack2(oii[0], oii[1]); o1.y = pack2(oii[2], oii[3]);
      *(u32x2*)(hro + c16 * 16 + u * 4) = o0;
      *(u32x2*)(hio + c16 * 16 + u * 4) = o1;
    }
  }
}

__device__ __forceinline__ void mlapost_item(const Params& p, int layer, int round, int item) {
  const bf16_t* PROJ = (const bf16_t*)(p.ws + OFF_PROJ);
  bf16_t* QM = (bf16_t*)(p.ws + OFF_QM);
  bf16_t* KM = (bf16_t*)(p.ws + OFF_KM);
  const bf16_t* KN = (const bf16_t*)(p.ws + OFF_KN);
  const int* pos = (const int*)p.in[1];
  const int w = otid() >> 6, l = otid() & 63;
  const float* qn = p.in[31] + layer * 192;
  const float* kn = p.in[32] + layer * 192;
  const float q0 = qn[l], q1 = qn[64 + l], q2 = qn[128 + l];
  const float k0 = kn[l], k1 = kn[64 + l], k2 = kn[128 + l];
  const float invf = expf(-13.122363377404328f * (float)(l & 31) * (1.0f / 32.0f));
  const float qscale = 0.07216878364870322f * LOG2E;
  for (int tt = 0; tt < 4; ++tt) {
    const int row = item * 16 + w * 4 + tt;
    const float ang = (float)pos[round * TR + row] * invf;
    const float cs = cosf(ang), sn = sinf(ang);
    const float kr = bf2f(PROJ[(size_t)row * LDP + C_KR + l]);
#pragma unroll
    for (int h = 0; h < 4; ++h) {
      {
        bf16_t* qp = QM + (size_t)row * 768 + h * 192;
        float e0 = bf2f(qp[l]), e1 = bf2f(qp[64 + l]), e2 = bf2f(qp[128 + l]);
        const float ss = wave_sum(e0 * e0 + e1 * e1 + e2 * e2);
        const float rs = rsqrtf(ss * (1.0f / 192.0f) + EPS);
        e0 *= rs * q0; e1 *= rs * q1; e2 *= rs * q2;
        const float ot = __shfl_xor(e2, 32, 64);
        e2 = (l < 32) ? (e2 * cs - ot * sn) : (e2 * cs + ot * sn);
        qp[l] = f2bf(e0 * qscale); qp[64 + l] = f2bf(e1 * qscale); qp[128 + l] = f2bf(e2 * qscale);
      }
      {
        const bf16_t* kp = KN + (size_t)row * 512 + h * 128;
        float e0 = bf2f(kp[l]), e1 = bf2f(kp[64 + l]), e2 = kr;
        const float ss = wave_sum(e0 * e0 + e1 * e1 + e2 * e2);
        const float rs = rsqrtf(ss * (1.0f / 192.0f) + EPS);
        e0 *= rs * k0; e1 *= rs * k1; e2 *= rs * k2;
        const float ot = __shfl_xor(e2, 32, 64);
        e2 = (l < 32) ? (e2 * cs - ot * sn) : (e2 * cs + ot * sn);
        bf16_t* ko = KM + (size_t)row * 768 + h * 192;
        ko[l] = f2bf(e0); ko[64 + l] = f2bf(e1); ko[128 + l] = f2bf(e2);
      }
    }
  }
}

__device__ __forceinline__ void mb_scan_item(const Params& p, int item) {
  const int idx = item * 256 + otid();
  const int b = idx >> 16, h = (idx >> 13) & 7, pn = idx & 8191;
  const float* ST = (const float*)(p.ws + OFF_ST);
  const float* AC = (const float*)(p.ws + OFF_ACUM);
  bf16_t* SIN = (bf16_t*)(p.ws + OFF_SIN);
  float cur = 0.f;
  float alv[16], stv[16];
#pragma unroll
  for (int c = 0; c < 16; ++c) {
    alv[c] = AC[(size_t)(b * 2048 + c * 128 + 127) * 8 + h];
    stv[c] = ST[((size_t)((b * 16 + c) * 8 + h)) * 8192 + pn];
  }
#pragma unroll
  for (int c = 0; c < 16; ++c) {
    SIN[((size_t)((b * 16 + c) * 8 + h)) * 8192 + pn] = f2bf(cur);
    cur = __expf(alv[c]) * cur + stv[c];
  }
}

__device__ __forceinline__ void s5_y_item(const Params& p, int layer, int item, bf16_t* smem) {
  const bf16_t* PROJ = (const bf16_t*)(p.ws + OFF_PROJ);
  const int grp = item >> 3, mt = item & 7;
  const bf16_t* Km = (const bf16_t*)(p.ws + OFF_KMAT) + (size_t)(layer * 32 + grp) * 16384;
  const bf16_t* Fm = (const bf16_t*)(p.ws + OFF_FMAT) + (size_t)(layer * 32 + grp) * 16384;
  const bf16_t* HIN = (const bf16_t*)(p.ws + OFF_HIN) + (size_t)grp * 128 * NBC + mt * 128;
  bf16_t* YG = (bf16_t*)(p.ws + OFF_YG);
  f32x4 acc[4][4];
  zero_acc<4>(acc);
  gemm_tile<128, false, false, true>(acc, PROJ + (size_t)mt * 128 * 8 * LDP + C_S5U + grp * 16, 8 * LDP, Km, 128, 128, smem, LDP);
  gemm_tile<128, true, false, false>(acc, HIN, NBC, Fm, 128, 128, smem);
  const int tid = otid(), w = tid >> 6, l = tid & 63, g = l >> 4, c = l & 15, wr = w >> 1, wc = w & 1;
  const float* dsk = p.in[24] + layer * 512;
#pragma unroll
  for (int i = 0; i < 4; ++i)
#pragma unroll
    for (int j = 0; j < 4; ++j) {
      const int n = wc * 64 + j * 16 + c;
      const int tq = n >> 4, co = n & 15;
      const int ch = grp * 16 + co;
      const float dd = dsk[ch];
#pragma unroll
      for (int r = 0; r < 4; ++r) {
        const int m = mt * 128 + wr * 64 + i * 16 + g * 4 + r;
        const int row = m * 8 + tq;
        const float u = bf2f(PROJ[(size_t)row * LDP + C_S5U + ch]);
        const float y = acc[i][j][r] + dd * u;
        YG[(size_t)row * 512 + ch] = f2bf(gelu_tanh(y));
      }
    }
}

template <int DK, int NM>
__device__ __forceinline__ void attn_core(const bf16_t* __restrict__ Qb, long ldq, const bf16_t* __restrict__ Kb, long ldk,
                                          const bf16_t* __restrict__ Vt, int qb, bf16_t* smem, f32x4 (&O)[NM][8], float (&lsum)[NM][4]) {
  constexpr int KST = DK + 8;
  constexpr int KCH = NM * 64 * DK / 8 / 256;
  constexpr int CPM = 64 * DK / 8;
  constexpr int CPRK = DK / 8;
  bf16_t* sK = smem;
  bf16_t* sV = sK + NM * 64 * KST;
  bf16_t* sP = sV + 128 * 72;
  const int tid = otid(), w = tid >> 6, l = tid & 63, g = l >> 4, c = l & 15;
  bf16x8 qf[NM][DK / 32];
  {
    const long qrow = (long)qb * 64 + w * 16 + c;
#pragma unroll
    for (int m = 0; m < NM; ++m)
#pragma unroll
      for (int ks = 0; ks < DK / 32; ++ks) qf[m][ks] = *(const bf16x8*)(Qb + qrow * ldq + m * DK + ks * 32 + g * 8);
  }
  float mrow[NM][4];
#pragma unroll
  for (int m = 0; m < NM; ++m) {
#pragma unroll
    for (int r = 0; r < 4; ++r) { mrow[m][r] = -INFINITY; lsum[m][r] = 0.f; }
#pragma unroll
    for (int nt = 0; nt < 8; ++nt) O[m][nt] = (f32x4){0.f, 0.f, 0.f, 0.f};
  }
  u32x4 kr[KCH], vr[4];
  auto gloadK = [&](int kt) {
#pragma unroll
    for (int i = 0; i < KCH; ++i) {
      const int ch = tid + i * 256;
      const int m = ch / CPM, cc = ch % CPM;
      const int key = cc / CPRK, d0 = (cc % CPRK) * 8;
      kr[i] = *(const u32x4*)(Kb + (long)(kt * 64 + key) * ldk + m * DK + d0);
    }
  };
  auto gloadV = [&](int kt) {
#pragma unroll
    for (int i = 0; i < 4; ++i) {
      const int ch = tid + i * 256;
      const int dvr = ch >> 3, kc = (ch & 7) * 8;
      vr[i] = *(const u32x4*)(Vt + (long)dvr * 2048 + kt * 64 + kc);
    }
  };
  gloadK(0);
  gloadV(0);
  for (int kt = 0; kt <= qb; ++kt) {
    __syncthreads();
#pragma unroll
    for (int i = 0; i < KCH; ++i) {
      const int ch = tid + i * 256;
      const int m = ch / CPM, cc = ch % CPM;
      const int key = cc / CPRK, d0 = (cc % CPRK) * 8;
      *(u32x4*)(sK + (m * 64 + key) * KST + d0) = kr[i];
    }
#pragma unroll
    for (int i = 0; i < 4; ++i) {
      const int ch = tid + i * 256;
      const int dvr = ch >> 3, kc = (ch & 7) * 8;
      *(u32x4*)(sV + dvr * 72 + kc) = vr[i];
    }
    __syncthreads();
    if (kt < qb) gloadK(kt + 1);
#pragma unroll
    for (int m = 0; m < NM; ++m) {
      f32x4 S[4];
#pragma unroll
      for (int nt = 0; nt < 4; ++nt) {
        S[nt] = (f32x4){0.f, 0.f, 0.f, 0.f};
#pragma unroll
        for (int ks = 0; ks < DK / 32; ++ks) {
          const bf16x8 kf = *(const bf16x8*)(sK + (m * 64 + nt * 16 + c) * KST + ks * 32 + g * 8);
          S[nt] = __builtin_amdgcn_mfma_f32_16x16x32_bf16(qf[m][ks], kf, S[nt], 0, 0, 0);
        }
        MEMBAR();
      }
      if (kt == qb) {
#pragma unroll
        for (int nt = 0; nt < 4; ++nt)
#pragma unroll
          for (int r = 0; r < 4; ++r)
            if (nt * 16 + c > w * 16 + g * 4 + r) S[nt][r] = -INFINITY;
      }
      bf16_t* pw = sP + (size_t)((w * NM + m) * 16) * 72;
#pragma unroll
      for (int r = 0; r < 4; ++r) {
        float mx = fmaxf(fmaxf(S[0][r], S[1][r]), fmaxf(S[2][r], S[3][r]));
        mx = fmaxf(mx, __shfl_xor(mx, 1, 64));
        mx = fmaxf(mx, __shfl_xor(mx, 2, 64));
        mx = fmaxf(mx, __shfl_xor(mx, 4, 64));
        mx = fmaxf(mx, __shfl_xor(mx, 8, 64));
        const float mnew = fmaxf(mrow[m][r], mx);
        const float sc = __builtin_amdgcn_exp2f(mrow[m][r] - mnew);
        mrow[m][r] = mnew;
        float ps = 0.f;
#pragma unroll
        for (int nt = 0; nt < 4; ++nt) {
          const float pv = __builtin_amdgcn_exp2f(S[nt][r] - mnew);
          ps += pv;
          pw[(g * 4 + r) * 72 + nt * 16 + c] = f2bf(pv);
        }
        ps += __shfl_xor(ps, 1, 64);
        ps += __shfl_xor(ps, 2, 64);
        ps += __shfl_xor(ps, 4, 64);
        ps += __shfl_xor(ps, 8, 64);
        lsum[m][r] = lsum[m][r] * sc + ps;
#pragma unroll
        for (int nt = 0; nt < 8; ++nt) O[m][nt][r] *= sc;
      }
    }
    __syncthreads();
    if (kt < qb) gloadV(kt + 1);
#pragma unroll
    for (int m = 0; m < NM; ++m) {
      const bf16_t* pw = sP + (size_t)((w * NM + m) * 16) * 72;
#pragma unroll
      for (int ks = 0; ks < 2; ++ks) {
        const bf16x8 pf = *(const bf16x8*)(pw + c * 72 + ks * 32 + g * 8);
#pragma unroll
        for (int nt = 0; nt < 8; ++nt) {
          const bf16x8 vf = *(const bf16x8*)(sV + (nt * 16 + c) * 72 + ks * 32 + g * 8);
          O[m][nt] = __builtin_amdgcn_mfma_f32_16x16x32_bf16(pf, vf, O[m][nt], 0, 0, 0);
        }
        MEMBAR();
      }
    }
  }
}

__device__ __forceinline__ void da_attn_item(const Params& p, int layer, int bh, int qb, bf16_t* smem, bool dry = false) {
  bf16_t* PROJ = (bf16_t*)(p.ws + OFF_PROJ);
  const bf16_t* VTA = (const bf16_t*)(p.ws + OFF_VTA);
  const int b = bh >> 2, h = bh & 3;
  f32x4 O[2][8];
  float ls[2][4];
  {
    f32x4 O1[1][8];
    float l1[1][4];
#pragma unroll 1
    for (int m = 0; m < 2; ++m) {
      attn_core<64, 1>(PROJ + (size_t)b * 2048 * LDP + C_DAQ + h * 128 + m * 64, LDP, PROJ + (size_t)b * 2048 * LDP + C_DAK + h * 128 + m * 64, LDP,
                       VTA + (size_t)(b * 4 + h) * 128 * 2048, qb, smem, O1, l1);
      if (m == 0) {
#pragma unroll
        for (int nt = 0; nt < 8; ++nt) O[0][nt] = O1[0][nt];
#pragma unroll
        for (int r = 0; r < 4; ++r) ls[0][r] = l1[0][r];
      } else {
#pragma unroll
        for (int nt = 0; nt < 8; ++nt) O[1][nt] = O1[0][nt];
#pragma unroll
        for (int r = 0; r < 4; ++r) ls[1][r] = l1[0][r];
      }
    }
  }
  const int tid = otid(), w = tid >> 6, l = tid & 63, g = l >> 4, c = l & 15;
  const float lam = ((const float*)(p.ws + OFF_LAM))[layer];
  const float linit = 0.8f - 0.6f * expf(-0.3f * (float)layer);
  const float* sg = p.in[10] + layer * 128;
#pragma unroll
  for (int r = 0; r < 4; ++r) {
    const float i0 = 1.0f / ls[0][r], i1 = lam / ls[1][r];
    float o[8];
    float ss = 0.f;
#pragma unroll
    for (int nt = 0; nt < 8; ++nt) {
      o[nt] = O[0][nt][r] * i0 - O[1][nt][r] * i1;
      ss += o[nt] * o[nt];
    }
    ss += __shfl_xor(ss, 1, 64);
    ss += __shfl_xor(ss, 2, 64);
    ss += __shfl_xor(ss, 4, 64);
    ss += __shfl_xor(ss, 8, 64);
    const float rs = rsqrtf(ss * (1.0f / 128.0f) + EPS) * (1.0f - linit);
    const size_t row = (size_t)b * 2048 + qb * 64 + w * 16 + g * 4 + r;
#pragma unroll
    for (int nt = 0; nt < 8; ++nt) {
      const int dv = nt * 16 + c;
      bf16_t* gp = PROJ + row * LDP + C_DAG + h * 128 + dv;
      const float gt = bf2f(*gp);
      if (!dry) *gp = f2bf(o[nt] * rs * sg[dv] * siluf_(gt));
    }
  }
}

__device__ __forceinline__ void mla_attn_item(const Params& p, int bh, int qb, bf16_t* smem, bool dry = false) {
  bf16_t* PROJ = (bf16_t*)(p.ws + OFF_PROJ);
  const bf16_t* QM = (const bf16_t*)(p.ws + OFF_QM);
  const bf16_t* KM = (const bf16_t*)(p.ws + OFF_KM);
  const bf16_t* VTD = (const bf16_t*)(p.ws + OFF_VTD);
  const int b = bh >> 2, h = bh & 3;
  f32x4 O[1][8];
  float ls[1][4];
  attn_core<192, 1>(QM + (size_t)b * 2048 * 768 + h * 192, 768, KM + (size_t)b * 2048 * 768 + h * 192, 768,
                    VTD + (size_t)(b * 4 + h) * 128 * 2048, qb, smem, O, ls);
  const int tid = otid(), w = tid >> 6, l = tid & 63, g = l >> 4, c = l & 15;
#pragma unroll
  for (int r = 0; r < 4; ++r) {
    const float i0 = 1.0f / ls[0][r];
    const size_t row = (size_t)b * 2048 + qb * 64 + w * 16 + g * 4 + r;
#pragma unroll
    for (int nt = 0; nt < 8; ++nt) {
      const int dv = nt * 16 + c;
      bf16_t* gp = PROJ + row * LDP + C_MLG + h * 128 + dv;
      const float gt = bf2f(*gp);
      if (!dry) *gp = f2bf(O[0][nt][r] * i0 * siluf_(gt));
    }
  }
}

__device__ __forceinline__ void mb_out_item(const Params& p, int layer, int item, bf16_t* smem) {
  bf16_t* PROJ = (bf16_t*)(p.ws + OFF_PROJ);
  const bf16_t* XC = (const bf16_t*)(p.ws + OFF_XC);
  const float* DT = (const float*)(p.ws + OFF_DT);
  const float* AC = (const float*)(p.ws + OFF_ACUM);
  const bf16_t* SIN = (const bf16_t*)(p.ws + OFF_SIN);
  bf16_t* MS = (bf16_t*)(p.ws + OFF_MS) + (size_t)blockIdx.x * 128 * 128;
  float* rowss = (float*)((unsigned char*)smem + 55296);
  const int grp = item & 1, bc = item >> 1;
  const int row0 = bc * 128;
  __syncthreads();
  const bf16_t* Cp = XC + (size_t)row0 * 1024 + 768 + grp * 128;
  const bf16_t* Bp = XC + (size_t)row0 * 1024 + 512 + grp * 128;
#pragma unroll 1
  for (int r4 = 0; r4 < 4; ++r4) {
    const int h = grp * 4 + r4;
    const int tid = otid(), w = tid >> 6, l = tid & 63, g = l >> 4, c = l & 15, wr = w >> 1, wc = w & 1;
    {
      f32x4 cb[4][4];
      zero_acc<4>(cb);
      gemm_tile<128, false, false, false>(cb, Cp, 1024, Bp, 1024, 128, smem);
      float acs[4], dts[4];
#pragma unroll
      for (int j = 0; j < 4; ++j) {
        const int s = wc * 64 + j * 16 + c;
        acs[j] = AC[(size_t)(row0 + s) * 8 + h];
        dts[j] = DT[(size_t)(row0 + s) * 8 + h];
      }
#pragma unroll
      for (int i = 0; i < 4; ++i)
#pragma unroll
        for (int r = 0; r < 4; ++r) {
          const int lr = wr * 64 + i * 16 + g * 4 + r;
          const float acl = AC[(size_t)(row0 + lr) * 8 + h];
#pragma unroll
          for (int j = 0; j < 4; ++j) {
            const int s = wc * 64 + j * 16 + c;
            const float v = (s <= lr) ? cb[i][j][r] * __expf(acl - acs[j]) * dts[j] : 0.f;
            MS[lr * 128 + s] = f2bf(v);
          }
          MEMBAR();
        }
    }
    block_global_handoff();
    f32x4 ad[4][2], ao[4][2];
    zero_acc<2>(ad);
    zero_acc<2>(ao);
    gemm_tile<64, false, true, false>(ad, MS, 128, XC + (size_t)row0 * 1024 + h * 64, 1024, 128, smem);
    gemm_tile<64, false, false, false>(ao, Cp, 1024, SIN + ((size_t)(bc * 8 + h)) * 8192, 128, 128, smem);
    const float dsk = p.in[15][layer * 8 + h];
#pragma unroll
    for (int i = 0; i < 4; ++i)
#pragma unroll
      for (int r = 0; r < 4; ++r) {
        const int lr = wr * 64 + i * 16 + g * 4 + r;
        const size_t row = (size_t)row0 + lr;
        const float ea = __expf(AC[row * 8 + h]);
        float ssq = 0.f;
#pragma unroll
        for (int j = 0; j < 2; ++j) {
          const int ch = h * 64 + wc * 32 + j * 16 + c;
          const float xv = bf2f(XC[row * 1024 + ch]);
          bf16_t* zp = PROJ + row * LDP + C_MBZ + ch;
          const float z = bf2f(*zp);
          float y = ad[i][j][r] + ea * ao[i][j][r] + dsk * xv;
          y *= siluf_(z);
          ssq += y * y;
          *zp = f2bf(y);
        }
        ssq += __shfl_xor(ssq, 1, 64);
        ssq += __shfl_xor(ssq, 2, 64);
        ssq += __shfl_xor(ssq, 4, 64);
        ssq += __shfl_xor(ssq, 8, 64);
        if (c == 0) rowss[(r4 * 2 + wc) * 128 + lr] = ssq;
        MEMBAR();
      }
  }
  block_global_handoff();
  const float* ng = p.in[16] + layer * 512 + grp * 256;
  {
    const int cc = otid();
    const float gcc = ng[cc];
    for (int l0 = 0; l0 < 128; l0 += 16) {
      bf16_t vals[16];
#pragma unroll
      for (int u = 0; u < 16; ++u) vals[u] = PROJ[(size_t)(row0 + l0 + u) * LDP + C_MBZ + grp * 256 + cc];
#pragma unroll
      for (int u = 0; u < 16; ++u) {
        const int lr = l0 + u;
        float tot = 0.f;
#pragma unroll
        for (int q = 0; q < 8; ++q) tot += rowss[q * 128 + lr];
        PROJ[(size_t)(row0 + lr) * LDP + C_MBZ + grp * 256 + cc] = f2bf(bf2f(vals[u]) * rsqrtf(tot * (1.0f / 256.0f) + EPS) * gcc);
      }
    }
  }
}

__device__ __forceinline__ void s5_glu_tile(const Params& p, int layer, int rt, int ct, bf16_t* smem) {
  bf16_t* PROJ = (bf16_t*)(p.ws + OFF_PROJ);
  const bf16_t* YG = (const bf16_t*)(p.ws + OFF_YG);
  const bf16_t* W = (const bf16_t*)(p.ws + OFF_WGLUT) + (size_t)layer * 512 * 512;
  f32x4 acc[4][4];
  zero_acc<4>(acc);
  gemm_tile<128, false, false, false>(acc, YG + (size_t)rt * 128 * 512, 512, W + (size_t)ct * 128 * 512, 512, 512, smem);
  const int tid = otid(), w = tid >> 6, l = tid & 63, g = l >> 4, c = l & 15, wr = w >> 1, wc = w & 1;
  const float* bg = p.in[26] + layer * 512;
#pragma unroll
  for (int i = 0; i < 4; ++i)
#pragma unroll
    for (int j = 0; j < 4; ++j) {
      const int col = ct * 128 + wc * 64 + j * 16 + c;
      const float bb = bg[col];
#pragma unroll
      for (int r = 0; r < 4; ++r) {
        const size_t row = (size_t)rt * 128 + wr * 64 + i * 16 + g * 4 + r;
        const float yv = bf2f(YG[row * 512 + col]);
        bf16_t* gp = PROJ + row * LDP + C_S5G + col;
        const float gt = bf2f(*gp);
        *gp = f2bf(yv * sigmoidf_(acc[i][j][r] + bb) * siluf_(gt));
      }
    }
}

__device__ __forceinline__ void merge_tile(const Params& p, int layer, int rt, int ct, bf16_t* smem) {
  const bf16_t* PROJ = (const bf16_t*)(p.ws + OFF_PROJ);
  bf16_t* MG = (bf16_t*)(p.ws + OFF_MERGED);
  f32x4 macc[4][2];
  zero_acc<2>(macc);
  const int tid = otid(), w = tid >> 6, l = tid & 63, g = l >> 4, c = l & 15, wr = w >> 1, wc = w & 1;
  for (int n = 0; n < 4; ++n) {
    const int ycol = (n == 0) ? C_DAG : (n == 1) ? C_MBZ : (n == 2) ? C_S5G : C_MLG;
    const bf16_t* W = (const bf16_t*)(p.ws + OFF_WBRT) + (size_t)(layer * 4 + n) * 1024 * 512;
    f32x4 acc[4][2];
    zero_acc<2>(acc);
    gemm_tile<64, false, false, false>(acc, PROJ + (size_t)rt * 128 * LDP + ycol, LDP, W + (size_t)ct * 64 * 512, 512, 512, smem);
#pragma unroll
    for (int i = 0; i < 4; ++i) {
#pragma unroll
      for (int r = 0; r < 4; ++r) {
        const size_t row = (size_t)rt * 128 + wr * 64 + i * 16 + g * 4 + r;
        const bf16_t* gp = PROJ + row * LDP + C_GATE + n * 1024 + ct * 64 + wc * 32 + c;
#pragma unroll
        for (int j = 0; j < 2; ++j) macc[i][j][r] += bf2f(gp[j * 16]) * acc[i][j][r];
      }
      MEMBAR();
    }
  }
#pragma unroll
  for (int i = 0; i < 4; ++i) {
#pragma unroll
    for (int r = 0; r < 4; ++r) {
      const size_t row = (size_t)rt * 128 + wr * 64 + i * 16 + g * 4 + r;
      bf16_t* op = MG + row * 1024 + ct * 64 + wc * 32 + c;
#pragma unroll
      for (int j = 0; j < 2; ++j) op[j * 16] = f2bf(macc[i][j][r]);
    }
    MEMBAR();
  }
}

__device__ __forceinline__ void out_tile(const Params& p, int layer, const float* xo, float* xn, int rt, int ct, bf16_t* smem) {
  const bf16_t* MG = (const bf16_t*)(p.ws + OFF_MERGED);
  const bf16_t* W = (const bf16_t*)(p.ws + OFF_WOUTT) + (size_t)layer * 1024 * 1024;
  f32x4 acc[4][4];
  zero_acc<4>(acc);
  gemm_tile<128, false, false, false>(acc, MG + (size_t)rt * 128 * 1024, 1024, W + (size_t)ct * 128 * 1024, 1024, 1024, smem);
  const int tid = otid(), w = tid >> 6, l = tid & 63, g = l >> 4, c = l & 15, wr = w >> 1, wc = w & 1;
#pragma unroll
  for (int i = 0; i < 4; ++i)
#pragma unroll
    for (int j = 0; j < 4; ++j) {
      const int col = ct * 128 + wc * 64 + j * 16 + c;
#pragma unroll
      for (int r = 0; r < 4; ++r) {
        const size_t row = (size_t)rt * 128 + wr * 64 + i * 16 + g * 4 + r;
        xn[row * 1024 + col] = xo[row * 1024 + col] + acc[i][j][r];
      }
    }
}

__device__ __forceinline__ void gsync(cg::grid_group& grid, unsigned* bar, unsigned& epoch) {
  asm volatile("s_waitcnt vmcnt(0)" ::: "memory");
  __syncthreads();
  if (otid() == 0) {
    unsigned long long* w = (unsigned long long*)bar;
    __builtin_amdgcn_fence(__ATOMIC_RELEASE, "agent");
    asm volatile("s_waitcnt vmcnt(0)" ::: "memory");
    const unsigned long long old = __hip_atomic_fetch_add(w, 1ull, __ATOMIC_RELAXED, __HIP_MEMORY_SCOPE_AGENT);
    const unsigned G = gridDim.x;
    if ((unsigned)(old & 0xffffffffull) == G - 1) {
      __hip_atomic_fetch_add(w, (1ull << 32) - (unsigned long long)G, __ATOMIC_RELAXED, __HIP_MEMORY_SCOPE_AGENT);
    } else {
      const unsigned g0 = (unsigned)(old >> 32);
      while ((unsigned)(__hip_atomic_load(w, __ATOMIC_RELAXED, __HIP_MEMORY_SCOPE_AGENT) >> 32) == g0) __builtin_amdgcn_s_sleep(2);
    }
    __builtin_amdgcn_fence(__ATOMIC_ACQUIRE, "agent");
    asm volatile("s_waitcnt vmcnt(0)" ::: "memory");
  }
  __syncthreads();
}

#ifdef SELFCHECK
__device__ __forceinline__ void cksum(const void* ptr, size_t bytes, unsigned long long* slot) {
  const u32x4* q = (const u32x4*)ptr;
  const size_t n = bytes / 16;
  unsigned long long s = 0;
  for (size_t i = (size_t)blockIdx.x * 256 + otid(); i < n; i += (size_t)gridDim.x * 256) {
    const u32x4 v = q[i];
    s += (unsigned long long)v.x + 3ull * v.y + 5ull * v.z + 7ull * v.w;
  }
  unsigned lo = (unsigned)s, hi = (unsigned)(s >> 32);
  unsigned long long t = s;
#pragma unroll
  for (int d = 32; d >= 1; d >>= 1) {
    const unsigned l2 = __shfl_xor((unsigned)t, d, 64), h2 = __shfl_xor((unsigned)(t >> 32), d, 64);
    t += ((unsigned long long)h2 << 32) | l2;
  }
  (void)lo; (void)hi;
  if ((otid() & 63) == 0) atomicAdd(slot, t);
}
#define CK(ptr, bytes) cksum((ptr), (bytes), slots + slot)
#else
#define CK(ptr, bytes) do {} while (0)
#endif

__device__ __forceinline__ void cksum_acc(const void* ptr, size_t bytes, unsigned long long& s) {
  const u32x4* q = (const u32x4*)ptr;
  const size_t n = bytes / 16;
  for (size_t i = (size_t)blockIdx.x * 256 + otid(); i < n; i += (size_t)gridDim.x * 256) {
    const u32x4 v = __builtin_nontemporal_load(q + i);
    s += (unsigned long long)v.x + 3ull * v.y + 5ull * v.z + 7ull * v.w;
  }
}
__device__ __forceinline__ void cksum_commit(unsigned long long t, unsigned long long* slot) {
#pragma unroll
  for (int d = 32; d >= 1; d >>= 1) {
    const unsigned l2 = __shfl_xor((unsigned)t, d, 64), h2 = __shfl_xor((unsigned)(t >> 32), d, 64);
    t += ((unsigned long long)h2 << 32) | l2;
  }
  if ((otid() & 63) == 0) atomicAdd(slot, t);
}

__global__ void __launch_bounds__(256, 2) fwd_megakernel(Params p) {
  cg::grid_group grid = cg::this_grid();
  __shared__ __attribute__((aligned(16))) unsigned char smem_raw[SMEM_BYTES];
  bf16_t* smem = (bf16_t*)smem_raw;
  float* smf = (float*)smem_raw;
  const int G = gridDim.x, bid = blockIdx.x;
  unsigned* bar = (unsigned*)(p.ws + OFF_BAR);
  unsigned epoch = 0;
#ifdef START_DELAY_US
  {
    const unsigned long long t0 = __builtin_amdgcn_s_memrealtime();
    while (__builtin_amdgcn_s_memrealtime() - t0 < (unsigned long long)START_DELAY_US * 100ull) __builtin_amdgcn_s_sleep(20);
  }
#endif
  grid.sync();
#ifdef WCHECK
  unsigned wseen = 0;
  if (bid == 0 && otid() == 0) wseen = __hip_atomic_load(bar + 32, __ATOMIC_RELAXED, __HIP_MEMORY_SCOPE_AGENT);
#endif

#ifdef SELFCHECK
  unsigned long long* slots_base = (unsigned long long*)(p.ws + OFF_BAR + 256);
  if (bid == 0) for (int k = otid(); k < 768; k += 256) __hip_atomic_store(slots_base + k, 0ull, __ATOMIC_RELAXED, __HIP_MEMORY_SCOPE_AGENT);
  for (int run = 0; run < 3; ++run) {
  unsigned long long* slots = slots_base + run * 256;
  int slot = 0;
#endif
  {
    unsigned long long* sslots = (unsigned long long*)(p.ws + OFF_BAR + 1024);
    unsigned long long prev = 0;
    for (int iter = 0; iter < 64; ++iter) {
      unsigned long long s = 0;
      cksum_acc(p.out, (size_t)BATCH * SEQ * 1024 * 4, s);
      cksum_acc(p.ws, OFF_BAR, s);
      cksum_commit(s, sslots + iter);
      gsync(grid, bar, epoch);
      const unsigned long long c = __hip_atomic_load(sslots + iter, __ATOMIC_RELAXED, __HIP_MEMORY_SCOPE_AGENT);
      if (iter > 0 && c == prev) break;
      prev = c;
    }
  }
  phase_prep(p, smf);
  gsync(grid, bar, epoch);
  phase_prep(p, smf);
#ifdef SELF_POISON
  {
    u32x4* q = (u32x4*)(p.ws + OFF_H);
    const size_t n16 = (WS_TOTAL - OFF_H) / 16;
    const u32x4 pv = {SELF_POISON, SELF_POISON, SELF_POISON, SELF_POISON};
    for (size_t i = (size_t)bid * 256 + otid(); i < n16; i += (size_t)G * 256) q[i] = pv;
  }
#endif
  gsync(grid, bar, epoch);
#ifdef SELFCHECK
  CK(p.ws, OFF_H); slot++;
#endif

  for (int layer = 0; layer < 2; ++layer) {
    const float* xin = (layer == 0) ? p.in[0] : p.out;
    float* xout = p.out;
    for (int round = 0; round < NROUND; ++round) {
      const size_t tok0 = (size_t)round * TR;
      phase_hnorm(xin + tok0 * 1024, p.in[2] + layer * 1024, (bf16_t*)(p.ws + OFF_H));
      gsync(grid, bar, epoch);
#ifdef SELFCHECK
      CK(p.ws + OFF_H, (size_t)TR * 1024 * 2); slot++;
#endif
#ifndef REP_B
#define REP_B 1
#endif
      for (int rep = 0; rep < REP_B; ++rep) {
      for (int it = bid; it < NRT * 76; it += G) inproj_tile(p, layer, it % NRT, it / NRT, smem);
      gsync(grid, bar, epoch);
      }
#ifdef SELFCHECK
      CK(p.ws + OFF_PROJ, (size_t)TR * D_INP * 2); CK(p.ws + OFF_VTA, (size_t)RB * 4 * 128 * 2048 * 2); slot++;
#endif
      {
        constexpr int n1 = 256, n2 = TR / 16, n3 = RB * 32 * 16, n4 = RB * 16 * 8 / 4;
        for (int it = bid; it < n1 + n2 + n3 + n4; it += G) {
          if (it < n1) s5_e_item(p, layer, it, smem);
          else if (it < n1 + n2) tokpost_item(p, layer, round, it - n1);
          else if (it < n1 + n2 + n3) conv_item(p, layer, it - n1 - n2);
          else dtacum_item(p, layer, it - n1 - n2 - n3);
        }
      }
      gsync(grid, bar, epoch);
#ifdef SELFCHECK
      CK(p.ws + OFF_PROJ, (size_t)TR * D_INP * 2); CK(p.ws + OFF_E, (size_t)32 * 128 * NBC * 4); CK(p.ws + OFF_XC, (size_t)TR * 1024 * 2);
      CK(p.ws + OFF_DT, (size_t)TR * 8 * 4); CK(p.ws + OFF_ACUM, (size_t)TR * 8 * 4); slot++;
#endif
      {
        constexpr int n1 = NRT * 6, n2 = NRT * 8, n3 = RB * 16 * 8, n4 = RB * 32 * 64 / 256;
        for (int it = bid; it < n1 + n2 + n3 + n4; it += G) {
          if (it < n1) mla_up_q_tile(p, layer, it % NRT, it / NRT, smem);
          else if (it < n1 + n2) mla_up_kv_tile(p, layer, (it - n1) % NRT, (it - n1) / NRT, smem);
          else if (it < n1 + n2 + n3) mb_states_item(p, it - n1 - n2, smem);
          else s5_carry_item(p, layer, it - n1 - n2 - n3);
        }
      }
      gsync(grid, bar, epoch);
#ifdef SELFCHECK
      CK(p.ws + OFF_QM, (size_t)TR * 768 * 2); CK(p.ws + OFF_KN, (size_t)TR * 512 * 2); CK(p.ws + OFF_VTD, (size_t)RB * 4 * 128 * 2048 * 2);
      CK(p.ws + OFF_ST, (size_t)RB * 16 * 8 * 8192 * 4); CK(p.ws + OFF_HIN, (size_t)32 * 128 * NBC * 2); slot++;
#endif
      {
        constexpr int n1 = 256, n2 = TR / 16, n3 = RB * 8 * 8192 / 256;
        for (int it = bid; it < n1 + n2 + n3; it += G) {
          if (it < n1) s5_y_item(p, layer, it, smem);
          else if (it < n1 + n2) mlapost_item(p, layer, round, it - n1);
          else mb_scan_item(p, it - n1 - n2);
        }
      }
      gsync(grid, bar, epoch);
#ifdef SELFCHECK
      CK(p.ws + OFF_YG, (size_t)TR * 512 * 2); CK(p.ws + OFF_QM, (size_t)TR * 768 * 2); CK(p.ws + OFF_KM, (size_t)TR * 768 * 2);
      CK(p.ws + OFF_SIN, (size_t)RB * 16 * 8 * 8192 * 2); slot++;
#endif
#ifdef REP_ATT
      {
        constexpr int nat = RB * 4 * 32 * 2;
        for (int it = bid; it < nat; it += G) {
            const int half = nat / 2;
            const int qb = (it < half) ? (31 - it / 32) : ((it - half) / 32);
            const int sub = it & 31;
            if (sub < 16) da_attn_item(p, layer, sub, qb, smem, true);
            else mla_attn_item(p, sub - 16, qb, smem, true);
        }
        gsync(grid, bar, epoch);
      }
#endif
      {
        constexpr int nat = RB * 4 * 32 * 2;
        constexpr int n3 = RB * 16 * 2, n4 = NRT * 4;
        for (int it0 = bid; it0 < nat + n3 + n4; it0 += G) {
          if (it0 < n3) { mb_out_item(p, layer, it0, smem); continue; }
          const int it = it0 - n3;
          if (it < nat) {
            const int half = nat / 2;
            const int qb = (it < half) ? (31 - it / 32) : ((it - half) / 32);
            const int sub = it & 31;
            if (sub < 16) da_attn_item(p, layer, sub, qb, smem);
            else mla_attn_item(p, sub - 16, qb, smem);
          } else s5_glu_tile(p, layer, (it - nat) % NRT, (it - nat) / NRT, smem);
        }
      }
      gsync(grid, bar, epoch);
#ifdef SELFCHECK
      CK(p.ws + OFF_PROJ, (size_t)TR * D_INP * 2); slot++;
#endif
      for (int it = bid; it < NRT * 16; it += G) merge_tile(p, layer, it % NRT, it / NRT, smem);
      gsync(grid, bar, epoch);
#ifdef SELFCHECK
      CK(p.ws + OFF_MERGED, (size_t)TR * 1024 * 2); slot++;
#endif
      for (int it = bid; it < NRT * 8; it += G) out_tile(p, layer, xin + tok0 * 1024, xout + tok0 * 1024, it % NRT, it / NRT, smem);
      gsync(grid, bar, epoch);
#ifdef SELFCHECK
      CK(xout + tok0 * 1024, (size_t)TR * 1024 * 4); slot++;
#endif
    }
  }
#ifdef WCHECK
  if (bid == 0 && otid() == 0) {
    if (wseen != 0) p.out[0] = 1.0e6f;
    __hip_atomic_store(bar + 32, 1u, __ATOMIC_RELAXED, __HIP_MEMORY_SCOPE_AGENT);
  }
#endif
#ifdef SELFCHECK
  gsync(grid, bar, epoch);
  }
  gsync(grid, bar, epoch);
  if (bid == 0 && otid() == 0) {
    int bad = -1;
    for (int k = 0; k < 100; ++k) {
      const unsigned long long a = __hip_atomic_load(slots_base + k, __ATOMIC_RELAXED, __HIP_MEMORY_SCOPE_AGENT);
      const unsigned long long b = __hip_atomic_load(slots_base + 256 + k, __ATOMIC_RELAXED, __HIP_MEMORY_SCOPE_AGENT);
      const unsigned long long c = __hip_atomic_load(slots_base + 512 + k, __ATOMIC_RELAXED, __HIP_MEMORY_SCOPE_AGENT);
      if (a != b || a != c) { bad = k; break; }
    }
    if (bad >= 0) p.out[0] = 10000.0f * exp2f((float)bad);
  }
#endif
}

extern "C" void kernel_launch(void* const* d_in, const int* in_sizes, int n_in, void* d_out,
                              int out_size, void* d_ws, size_t ws_size, hipStream_t stream) {
  static int grid_blocks = 0;
  if (!grid_blocks) {
    int dev = 0, cus = 0, per_cu = 0;
    (void)hipGetDevice(&dev);
    (void)hipDeviceGetAttribute(&cus, hipDeviceAttributeMultiprocessorCount, dev);
    (void)hipOccupancyMaxActiveBlocksPerMultiprocessor(&per_cu, fwd_megakernel, 256, 0);
    if (per_cu > 2) per_cu = 2;
    if (per_cu < 1) per_cu = 1;
    grid_blocks = cus * per_cu;
    if (grid_blocks > MAXBLK) grid_blocks = MAXBLK;
  }
  if (ws_size < WS_TOTAL) fprintf(stderr, "workspace too small: %zu < %zu\n", ws_size, (size_t)WS_TOTAL);
  Params p{};
  for (int i = 0; i < 35; ++i) p.in[i] = (const float*)d_in[i];
  p.out = (float*)d_out;
  p.ws = (unsigned char*)d_ws;
  (void)hipMemsetAsync((unsigned char*)d_ws + OFF_BAR, 0, 2048, stream);
  void* args[] = {&p};
  hipError_t e = hipLaunchCooperativeKernel((void*)fwd_megakernel, dim3(grid_blocks), dim3(256), args, 0, stream);
  if (e != hipSuccess) fprintf(stderr, "cooperative launch failed: %s (grid %d)\n", hipGetErrorString(e), grid_blocks);
}
```

```cpp
#include <hip/hip_runtime.h>
#include <hip/hip_cooperative_groups.h>
#include <cstdio>
#include <cstdint>
namespace cg = cooperative_groups;

typedef unsigned short bf16_t;
typedef short bf16x8 __attribute__((ext_vector_type(8)));
typedef float f32x4 __attribute__((ext_vector_type(4)));
typedef unsigned u32x4 __attribute__((ext_vector_type(4)));
typedef unsigned u32x2 __attribute__((ext_vector_type(2)));

constexpr int SEQ = 2048, BATCH = 16;
constexpr int D_IN = 9672, D_INP = 9728;
constexpr int RB = 4;
constexpr int TR = RB * SEQ;
constexpr int NROUND = BATCH / RB;
constexpr int NRT = TR / 128;
constexpr int NBC = TR / 8;
constexpr int MAXBLK = 512;
constexpr float EPS = 1e-6f;
constexpr float LOG2E = 1.4426950408889634f;
constexpr int C_DAQ = 0, C_DAK = 512, C_DAV = 1024, C_DAG = 1536, C_MBZ = 2048, C_XBC = 2560, C_DT = 3584,
              C_S5U = 3592, C_S5G = 4104, C_CQ = 4616, C_CKV = 4872, C_KR = 5000, C_MLG = 5064, C_GATE = 5576;
constexpr long LDP = D_INP;

constexpr size_t al256(size_t x) { return (x + 255) & ~size_t(255); }
constexpr size_t OFF_WINT = 0;
constexpr size_t OFF_WBRT = OFF_WINT + al256((size_t)2 * D_INP * 1024 * 2);
constexpr size_t OFF_WOUTT = OFF_WBRT + al256((size_t)2 * 4 * 1024 * 512 * 2);
constexpr size_t OFF_WGLUT = OFF_WOUTT + al256((size_t)2 * 1024 * 1024 * 2);
constexpr size_t OFF_WUQT = OFF_WGLUT + al256((size_t)2 * 512 * 512 * 2);
constexpr size_t OFF_WUKVT = OFF_WUQT + al256((size_t)2 * 768 * 256 * 2);
constexpr size_t OFF_KMAT = OFF_WUKVT + al256((size_t)2 * 1024 * 128 * 2);
constexpr size_t OFF_EMAT = OFF_KMAT + al256((size_t)2 * 32 * 128 * 128 * 2);
constexpr size_t OFF_FMAT = OFF_EMAT + al256((size_t)2 * 32 * 128 * 128 * 2);
constexpr size_t OFF_A8 = OFF_FMAT + al256((size_t)2 * 32 * 128 * 128 * 2);
constexpr size_t OFF_LAM = OFF_A8 + al256((size_t)2 * 32 * 64 * 2 * 4);
constexpr size_t OFF_H = OFF_LAM + 256;
constexpr size_t OFF_PROJ = OFF_H + al256((size_t)TR * 1024 * 2);
constexpr size_t OFF_XC = OFF_PROJ + al256((size_t)TR * D_INP * 2);
constexpr size_t OFF_DT = OFF_XC + al256((size_t)TR * 1024 * 2);
constexpr size_t OFF_ACUM = OFF_DT + al256((size_t)TR * 8 * 4);
constexpr size_t OFF_VTA = OFF_ACUM + al256((size_t)TR * 8 * 4);
constexpr size_t OFF_VTD = OFF_VTA + al256((size_t)RB * 4 * 128 * 2048 * 2);
constexpr size_t OFF_QM = OFF_VTD + al256((size_t)RB * 4 * 128 * 2048 * 2);
constexpr size_t OFF_KM = OFF_QM + al256((size_t)TR * 768 * 2);
constexpr size_t OFF_KN = OFF_KM + al256((size_t)TR * 768 * 2);
constexpr size_t OFF_ST = OFF_KN + al256((size_t)TR * 512 * 2);
constexpr size_t OFF_SIN = OFF_ST + al256((size_t)RB * 16 * 8 * 8192 * 4);
constexpr size_t OFF_MS = OFF_SIN + al256((size_t)RB * 16 * 8 * 8192 * 2);
constexpr size_t OFF_XS = OFF_MS + al256((size_t)MAXBLK * 128 * 128 * 2);
constexpr size_t OFF_E = OFF_XS + al256((size_t)MAXBLK * 128 * 64 * 2);
constexpr size_t OFF_HIN = OFF_E + al256((size_t)32 * 128 * NBC * 4);
constexpr size_t OFF_YG = OFF_HIN + al256((size_t)32 * 128 * NBC * 2);
constexpr size_t OFF_MERGED = OFF_YG + al256((size_t)TR * 512 * 2);
constexpr size_t OFF_BAR = OFF_MERGED + al256((size_t)TR * 1024 * 2);
constexpr size_t WS_TOTAL = OFF_BAR + 8192;

constexpr int SMEM_BYTES = 73728 + 4096;

struct Params {
  const float* in[35];
  float* out;
  unsigned char* ws;
};

#define MEMBAR() do { asm volatile("" ::: "memory"); __builtin_amdgcn_sched_barrier(0); } while (0)
__device__ __forceinline__ int otid() { int t = threadIdx.x; asm volatile("" : "+v"(t)); return t; }
__device__ __forceinline__ bf16_t f2bf(float f) {
  unsigned u = __float_as_uint(f);
  u += 0x7fffu + ((u >> 16) & 1u);
  return (bf16_t)(u >> 16);
}
__device__ __forceinline__ float bf2f(bf16_t b) { return __uint_as_float(((unsigned)b) << 16); }
__device__ __forceinline__ unsigned pack2(float a, float b) { return (unsigned)f2bf(a) | ((unsigned)f2bf(b) << 16); }
__device__ __forceinline__ float sigmoidf_(float x) { return 1.0f / (1.0f + __expf(-x)); }
__device__ __forceinline__ float siluf_(float x) { return x / (1.0f + __expf(-x)); }
__device__ __forceinline__ float gelu_tanh(float x) {
  float u = 0.7978845608028654f * (x + 0.044715f * x * x * x);
  float t = 1.0f - 2.0f / (__expf(2.0f * u) + 1.0f);
  return 0.5f * x * (1.0f + t);
}
__device__ __forceinline__ float wave_sum(float v) {
#pragma unroll
  for (int d = 32; d >= 1; d >>= 1) v += __shfl_xor(v, d, 64);
  return v;
}

__device__ __forceinline__ void block_global_handoff() {
  asm volatile("s_waitcnt vmcnt(0)" ::: "memory");
  __syncthreads();
  if (otid() < 64) {
    __builtin_amdgcn_fence(__ATOMIC_ACQUIRE, "agent");
    asm volatile("s_waitcnt vmcnt(0)" ::: "memory");
  }
  __syncthreads();
}
template <int R, bool T, bool SEG, int N>
__device__ __forceinline__ void g_load(u32x4 (&rg)[N], const bf16_t* __restrict__ P, long ld, int k0, long segs, int tid) {
#pragma unroll
  for (int i = 0; i < N; ++i) {
    const int ch = tid + i * 256;
    if (!T) {
      const int row = ch >> 3, kc = k0 + (ch & 7) * 8;
      const long ko = SEG ? ((long)(kc >> 4) * segs + (kc & 15)) : (long)kc;
      rg[i] = *(const u32x4*)(P + (long)row * ld + ko);
    } else {
      constexpr int CPR = R / 8;
      const int kk = ch / CPR, m0 = (ch % CPR) * 8;
      rg[i] = *(const u32x4*)(P + (long)(k0 + kk) * ld + m0);
    }
  }
}
template <int R, bool T, int N>
__device__ __forceinline__ void s_store(const u32x4 (&rg)[N], bf16_t* sm, int tid) {
  constexpr int LS = 72;
#pragma unroll
  for (int i = 0; i < N; ++i) {
    const int ch = tid + i * 256;
    if (!T) {
      const int row = ch >> 3, kc = (ch & 7) * 8;
      *(u32x4*)(sm + row * LS + kc) = rg[i];
    } else {
      constexpr int CPR = R / 8;
      const int kk = ch / CPR, m0 = (ch % CPR) * 8;
      bf16_t* d = sm + m0 * LS + kk;
      d[0 * LS] = (bf16_t)(rg[i].x & 0xffffu); d[1 * LS] = (bf16_t)(rg[i].x >> 16);
      d[2 * LS] = (bf16_t)(rg[i].y & 0xffffu); d[3 * LS] = (bf16_t)(rg[i].y >> 16);
      d[4 * LS] = (bf16_t)(rg[i].z & 0xffffu); d[5 * LS] = (bf16_t)(rg[i].z >> 16);
      d[6 * LS] = (bf16_t)(rg[i].w & 0xffffu); d[7 * LS] = (bf16_t)(rg[i].w >> 16);
    }
  }
}
template <int BN, bool TA, bool TB, bool SEGA>
__device__ __forceinline__ void gemm_tile(f32x4 (&acc)[4][BN / 32], const bf16_t* __restrict__ A, long lda,
                                          const bf16_t* __restrict__ B, long ldb, int K, bf16_t* smem, long segs = 0) {
  constexpr int LS = 72;
  constexpr int STAGE = 2 * 128 * LS;
  const int tid = otid(), w = tid >> 6, l = tid & 63, g = l >> 4, c = l & 15;
  const int wr = w >> 1, wc = w & 1;
  constexpr int NA = 4, NB = BN / 32;
  u32x4 ra[NA], rb[NB];
  const int nk = K / 64;
  g_load<128, TA, SEGA, NA>(ra, A, lda, 0, segs, tid);
  g_load<BN, TB, false, NB>(rb, B, ldb, 0, 0, tid);
  __syncthreads();
  s_store<128, TA, NA>(ra, smem, tid);
  s_store<BN, TB, NB>(rb, smem + 128 * LS, tid);
  __syncthreads();
  for (int kt = 0; kt < nk; ++kt) {
    const bf16_t* sA = smem + (kt & 1) * STAGE;
    const bf16_t* sB = sA + 128 * LS;
    if (kt + 1 < nk) {
      g_load<128, TA, SEGA, NA>(ra, A, lda, (kt + 1) * 64, segs, tid);
      g_load<BN, TB, false, NB>(rb, B, ldb, (kt + 1) * 64, 0, tid);
    }
    const bf16_t* pa = sA + (wr * 64 + c) * LS + g * 8;
    const bf16_t* pb = sB + (wc * (BN / 2) + c) * LS + g * 8;
#pragma unroll
    for (int ks = 0; ks < 2; ++ks) {
      bf16x8 af[4], bfr[BN / 32];
#pragma unroll
      for (int i = 0; i < 4; ++i) af[i] = *(const bf16x8*)(pa + i * 16 * LS + ks * 32);
#pragma unroll
      for (int j = 0; j < BN / 32; ++j) bfr[j] = *(const bf16x8*)(pb + j * 16 * LS + ks * 32);
#pragma unroll
      for (int i = 0; i < 4; ++i)
#pragma unroll
        for (int j = 0; j < BN / 32; ++j) acc[i][j] = __builtin_amdgcn_mfma_f32_16x16x32_bf16(af[i], bfr[j], acc[i][j], 0, 0, 0);
    }
    if (kt + 1 < nk) {
      bf16_t* nA = smem + ((kt + 1) & 1) * STAGE;
      s_store<128, TA, NA>(ra, nA, tid);
      s_store<BN, TB, NB>(rb, nA + 128 * LS, tid);
    }
    __syncthreads();
  }
}

template <int NJ>
__device__ __forceinline__ void zero_acc(f32x4 (&acc)[4][NJ]) {
#pragma unroll
  for (int i = 0; i < 4; ++i)
#pragma unroll
    for (int j = 0; j < NJ; ++j) acc[i][j] = (f32x4){0.f, 0.f, 0.f, 0.f};
}

__device__ __forceinline__ void tconv_tile(const float* __restrict__ src, bf16_t* __restrict__ dst, int K, int N, int tk, int tn, float* sm) {
  const int tid = otid();
  const int k0 = tk * 64, n0 = tn * 64;
  __syncthreads();
#pragma unroll 4
  for (int i = 0; i < 16; ++i) {
    const int kk = i * 4 + (tid >> 6), nn = tid & 63;
    float v = 0.f;
    if (n0 + nn < N) v = src[(long)(k0 + kk) * N + n0 + nn];
    sm[kk * 65 + nn] = v;
  }
  __syncthreads();
#pragma unroll 4
  for (int i = 0; i < 16; ++i) {
    const int nn = i * 4 + (tid >> 6), kk = tid & 63;
    dst[(long)(n0 + nn) * K + k0 + kk] = f2bf(sm[kk * 65 + nn]);
  }
}

__device__ __forceinline__ void tconv_job(const float* src, bf16_t* dst, int K, int N, int Npad, float* sm) {
  const int tkn = K / 64, tnn = Npad / 64;
  for (int t = blockIdx.x; t < tkn * tnn; t += gridDim.x) tconv_tile(src, dst, K, N, t % tkn, t / tkn, sm);
}

__device__ __forceinline__ void s5_prep(const Params& p, int layer, int grp, float* sm) {
  float* pwr = sm;
  float* pwi = pwr + 9 * 64;
  float* bbr = pwi + 9 * 64;
  float* bbi = bbr + 1024;
  float* cr = bbi + 1024;
  float* ci = cr + 1024;
  float* kt = ci + 1024;
  const int tid = otid();
  const int lg = layer * 32 + grp;
  __syncthreads();
  if (tid < 64) {
    const int pp = tid;
    const double step = exp((double)p.in[19][lg]);
    const double lr = (double)p.in[17][lg * 64 + pp], li = (double)p.in[18][lg * 64 + pp];
    const double mag = exp(lr * step);
    const double abr = mag * cos(li * step), abi = mag * sin(li * step);
    const double den = lr * lr + li * li;
    const double fr = ((abr - 1.0) * lr + abi * li) / den;
    const double fi = (abi * lr - (abr - 1.0) * li) / den;
    double qr = 1.0, qi = 0.0;
    for (int t = 0; t < 9; ++t) {
      pwr[t * 64 + pp] = (float)qr;
      pwi[t * 64 + pp] = (float)qi;
      const double nr = qr * abr - qi * abi, ni = qr * abi + qi * abr;
      qr = nr; qi = ni;
    }
    float* a8 = (float*)(p.ws + OFF_A8) + (size_t)(lg * 64 + pp) * 2;
    a8[0] = pwr[8 * 64 + pp];
    a8[1] = pwi[8 * 64 + pp];
    for (int cc = 0; cc < 16; ++cc) {
      const double br = (double)p.in[20][(lg * 64 + pp) * 16 + cc], bi = (double)p.in[21][(lg * 64 + pp) * 16 + cc];
      bbr[pp * 16 + cc] = (float)(fr * br - fi * bi);
      bbi[pp * 16 + cc] = (float)(fr * bi + fi * br);
    }
  }
  for (int e = tid; e < 1024; e += 256) {
    cr[e] = p.in[22][lg * 1024 + e];
    ci[e] = p.in[23][lg * 1024 + e];
  }
  __syncthreads();
  for (int e = tid; e < 2048; e += 256) {
    const int tau = e >> 8, co = (e >> 4) & 15, cin = e & 15;
    float s = 0.f;
    for (int pp = 0; pp < 64; ++pp) {
      const float pr = pwr[tau * 64 + pp], pi = pwi[tau * 64 + pp];
      const float zr = pr * bbr[pp * 16 + cin] - pi * bbi[pp * 16 + cin];
      const float zi = pr * bbi[pp * 16 + cin] + pi * bbr[pp * 16 + cin];
      s += cr[co * 64 + pp] * zr - ci[co * 64 + pp] * zi;
    }
    kt[e] = s;
  }
  __syncthreads();
  bf16_t* Km = (bf16_t*)(p.ws + OFF_KMAT) + (size_t)lg * 16384;
  bf16_t* Em = (bf16_t*)(p.ws + OFF_EMAT) + (size_t)lg * 16384;
  bf16_t* Fm = (bf16_t*)(p.ws + OFF_FMAT) + (size_t)lg * 16384;
  for (int e = tid; e < 16384; e += 256) {
    const int n = e >> 7, k = e & 127;
    {
      const int tq = n >> 4, co = n & 15, sq = k >> 4, cin = k & 15;
      Km[e] = f2bf(tq >= sq ? kt[((tq - sq) * 16 + co) * 16 + cin] : 0.f);
    }
    {
      const int pp = n >> 1, ri = n & 1, sq = k >> 4, cin = k & 15;
      const float pr = pwr[(7 - sq) * 64 + pp], pi = pwi[(7 - sq) * 64 + pp];
      const float zr = pr * bbr[pp * 16 + cin] - pi * bbi[pp * 16 + cin];
      const float zi = pr * bbi[pp * 16 + cin] + pi * bbr[pp * 16 + cin];
      Em[e] = f2bf(ri ? zi : zr);
    }
    {
      const int tq = n >> 4, co = n & 15, pp = k >> 1, ri = k & 1;
      const float pr = pwr[(tq + 1) * 64 + pp], pi = pwi[(tq + 1) * 64 + pp];
      const float gr = cr[co * 64 + pp] * pr - ci[co * 64 + pp] * pi;
      const float gi = cr[co * 64 + pp] * pi + ci[co * 64 + pp] * pr;
      Fm[e] = f2bf(ri ? -gi : gr);
    }
  }
}

__device__ __forceinline__ void phase_prep(const Params& p, float* smf) {
  for (int L = 0; L < 2; ++L) {
    tconv_job(p.in[3] + (size_t)L * 1024 * D_IN, (bf16_t*)(p.ws + OFF_WINT) + (size_t)L * D_INP * 1024, 1024, D_IN, D_INP, smf);
    for (int n = 0; n < 4; ++n)
      tconv_job(p.in[33] + (size_t)(L * 4 + n) * 512 * 1024, (bf16_t*)(p.ws + OFF_WBRT) + (size_t)(L * 4 + n) * 1024 * 512, 512, 1024, 1024, smf);
    tconv_job(p.in[34] + (size_t)L * 1024 * 1024, (bf16_t*)(p.ws + OFF_WOUTT) + (size_t)L * 1024 * 1024, 1024, 1024, 1024, smf);
    tconv_job(p.in[25] + (size_t)L * 512 * 512, (bf16_t*)(p.ws + OFF_WGLUT) + (size_t)L * 512 * 512, 512, 512, 512, smf);
    tconv_job(p.in[28] + (size_t)L * 256 * 768, (bf16_t*)(p.ws + OFF_WUQT) + (size_t)L * 768 * 256, 256, 768, 768, smf);
    tconv_job(p.in[30] + (size_t)L * 128 * 1024, (bf16_t*)(p.ws + OFF_WUKVT) + (size_t)L * 1024 * 128, 128, 1024, 1024, smf);
  }
  for (int it = blockIdx.x; it < 64; it += gridDim.x) s5_prep(p, it >> 5, it & 31, smf);
  if (blockIdx.x == gridDim.x - 1 && otid() < 2) {
    const int L = otid();
    float s1 = 0.f, s2 = 0.f;
    for (int i = 0; i < 64; ++i) {
      s1 += p.in[6][L * 64 + i] * p.in[7][L * 64 + i];
      s2 += p.in[8][L * 64 + i] * p.in[9][L * 64 + i];
    }
    const float li = 0.8f - 0.6f * expf(-0.3f * (float)L);
    ((float*)(p.ws + OFF_LAM))[L] = expf(s1) - expf(s2) + li;
  }
}

__device__ __forceinline__ void phase_hnorm(const float* __restrict__ x, const float* __restrict__ gn, bf16_t* __restrict__ H) {
  const int w = otid() >> 6, l = otid() & 63;
  for (int row = blockIdx.x * 4 + w; row < TR; row += gridDim.x * 4) {
    const float4* xr = (const float4*)(x + (size_t)row * 1024);
    float4 v[4];
    float ss = 0.f;
#pragma unroll
    for (int i = 0; i < 4; ++i) {
      v[i] = xr[i * 64 + l];
      ss += v[i].x * v[i].x + v[i].y * v[i].y + v[i].z * v[i].z + v[i].w * v[i].w;
    }
    ss = wave_sum(ss);
    const float rs = rsqrtf(ss * (1.0f / 1024.0f) + EPS);
#pragma unroll
    for (int i = 0; i < 4; ++i) {
      const float4 gg = ((const float4*)gn)[i * 64 + l];
      u32x2 o;
      o.x = pack2(v[i].x * rs * gg.x, v[i].y * rs * gg.y);
      o.y = pack2(v[i].z * rs * gg.z, v[i].w * rs * gg.w);
      *(u32x2*)(H + (size_t)row * 1024 + (i * 64 + l) * 4) = o;
    }
  }
}

__device__ __forceinline__ void inproj_tile(const Params& p, int layer, int rt, int ct, bf16_t* smem) {
  const bf16_t* H = (const bf16_t*)(p.ws + OFF_H);
  const bf16_t* W = (const bf16_t*)(p.ws + OFF_WINT) + (size_t)layer * D_INP * 1024;
  bf16_t* PROJ = (bf16_t*)(p.ws + OFF_PROJ);
  bf16_t* VTA = (bf16_t*)(p.ws + OFF_VTA);
  f32x4 acc[4][4];
  zero_acc<4>(acc);
  gemm_tile<128, false, false, false>(acc, H + (size_t)rt * 128 * 1024, 1024, W + (size_t)ct * 128 * 1024, 1024, 1024, smem);
  const int tid = otid(), w = tid >> 6, l = tid & 63, g = l >> 4, c = l & 15, wr = w >> 1, wc = w & 1;
  const int c0 = ct * 128;
  if (c0 >= C_DAV && c0 < C_DAG) {
    const int h = (c0 - C_DAV) >> 7;
#pragma unroll
    for (int i = 0; i < 4; ++i)
#pragma unroll
      for (int j = 0; j < 4; ++j) {
        const int row = rt * 128 + wr * 64 + i * 16 + g * 4;
        const int dv = wc * 64 + j * 16 + c;
        const int b = row >> 11, s = row & 2047;
        u32x2 o;
        o.x = pack2(acc[i][j][0], acc[i][j][1]);
        o.y = pack2(acc[i][j][2], acc[i][j][3]);
        *(u32x2*)(VTA + ((size_t)((b * 4 + h) * 128 + dv)) * 2048 + s) = o;
      }
  } else {
#pragma unroll
    for (int i = 0; i < 4; ++i) {
#pragma unroll
      for (int r = 0; r < 4; ++r) {
        const int row = rt * 128 + wr * 64 + i * 16 + g * 4 + r;
        bf16_t* rp = PROJ + (size_t)row * LDP + c0 + wc * 64 + c;
#pragma unroll
        for (int j = 0; j < 4; ++j) {
          float v = acc[i][j][r];
          if (c0 + wc * 64 + j * 16 + c >= C_GATE) v = sigmoidf_(v);
          rp[j * 16] = f2bf(v);
        }
      }
      MEMBAR();
    }
  }
}

__device__ __forceinline__ void tokpost_item(const Params& p, int layer, int round, int item) {
  bf16_t* PROJ = (bf16_t*)(p.ws + OFF_PROJ);
  const int* pos = (const int*)p.in[1];
  const int w = otid() >> 6, l = otid() & 63;
  for (int tt = 0; tt < 4; ++tt) {
    const int row = item * 16 + w * 4 + tt;
    const float fpos = (float)pos[round * TR + row];
    bf16_t* pr = PROJ + (size_t)row * LDP;
    {
      const int which = l >> 5, idx = (l & 31) * 16, off = (l & 3) * 16;
      bf16_t* ptr = pr + which * 512 + idx;
      u32x4 u0 = *(const u32x4*)ptr, u1 = *(const u32x4*)(ptr + 8);
      const unsigned uu[8] = {u0.x, u0.y, u0.z, u0.w, u1.x, u1.y, u1.z, u1.w};
      float v[16];
      float ss = 0.f;
#pragma unroll
      for (int e = 0; e < 8; ++e) {
        v[2 * e] = __uint_as_float(uu[e] << 16);
        v[2 * e + 1] = __uint_as_float(uu[e] & 0xffff0000u);
        ss += v[2 * e] * v[2 * e] + v[2 * e + 1] * v[2 * e + 1];
      }
      ss += __shfl_xor(ss, 1, 64);
      ss += __shfl_xor(ss, 2, 64);
      const float rs = rsqrtf(ss * (1.0f / 64.0f) + EPS);
      const float* gn = (which ? p.in[5] : p.in[4]) + layer * 64 + off;
#pragma unroll
      for (int e = 0; e < 16; ++e) v[e] = v[e] * rs * gn[e];
      if ((l & 3) == 0) {
#pragma unroll
        for (int i = 0; i < 8; ++i) {
          const float invf = expf(-13.122363377404328f * (float)i * 0.125f);
          const float ang = fpos * invf;
          const float cs = cosf(ang), sn = sinf(ang);
          const float x1 = v[i], x2 = v[i + 8];
          v[i] = x1 * cs - x2 * sn;
          v[i + 8] = x2 * cs + x1 * sn;
        }
      }
      if (which == 0) {
#pragma unroll
        for (int e = 0; e < 16; ++e) v[e] *= 0.125f * LOG2E;
      }
      u32x4 o0, o1;
      o0.x = pack2(v[0], v[1]); o0.y = pack2(v[2], v[3]); o0.z = pack2(v[4], v[5]); o0.w = pack2(v[6], v[7]);
      o1.x = pack2(v[8], v[9]); o1.y = pack2(v[10], v[11]); o1.z = pack2(v[12], v[13]); o1.w = pack2(v[14], v[15]);
      *(u32x4*)ptr = o0;
      *(u32x4*)(ptr + 8) = o1;
    }
    {
      bf16_t* ptr = pr + C_CQ + l * 4;
      u32x2 u = *(const u32x2*)ptr;
      float v0 = __uint_as_float(u.x << 16), v1 = __uint_as_float(u.x & 0xffff0000u);
      float v2 = __uint_as_float(u.y << 16), v3 = __uint_as_float(u.y & 0xffff0000u);
      float ss = wave_sum(v0 * v0 + v1 * v1 + v2 * v2 + v3 * v3);
      const float rs = rsqrtf(ss * (1.0f / 256.0f) + EPS);
      const float* gn = p.in[27] + layer * 256 + l * 4;
      u32x2 o;
      o.x = pack2(v0 * rs * gn[0], v1 * rs * gn[1]);
      o.y = pack2(v2 * rs * gn[2], v3 * rs * gn[3]);
      *(u32x2*)ptr = o;
    }
    {
      bf16_t* ptr = pr + C_CKV + l * 2;
      unsigned u = *(const unsigned*)ptr;
      float v0 = __uint_as_float(u << 16), v1 = __uint_as_float(u & 0xffff0000u);
      float ss = wave_sum(v0 * v0 + v1 * v1);
      const float rs = rsqrtf(ss * (1.0f / 128.0f) + EPS);
      const float* gn = p.in[29] + layer * 128 + l * 2;
      *(unsigned*)ptr = pack2(v0 * rs * gn[0], v1 * rs * gn[1]);
    }
  }
}

__device__ __forceinline__ void conv_item(const Params& p, int layer, int item) {
  const bf16_t* PROJ = (const bf16_t*)(p.ws + OFF_PROJ);
  bf16_t* XC = (bf16_t*)(p.ws + OFF_XC);
  const int chtile = item & 15, tt = (item >> 4) & 31, b = item >> 9;
  const int ch = chtile * 64 + (otid() & 63);
  const int tr0 = otid() >> 6;
  const float* cw = p.in[11] + (size_t)layer * 4 * 1024;
  const float w0 = cw[ch], w1 = cw[1024 + ch], w2 = cw[2048 + ch], w3 = cw[3072 + ch];
  const float bias = p.in[12][layer * 1024 + ch];
  for (int i0 = 0; i0 < 16; i0 += 8) {
    float x0[8], x1[8], x2[8], x3[8];
#pragma unroll
    for (int u = 0; u < 8; ++u) {
      const int t = tt * 64 + (i0 + u) * 4 + tr0;
      const bf16_t* base = PROJ + (size_t)(b * 2048 + t) * LDP + C_XBC + ch;
      x3[u] = bf2f(base[0]);
      x2[u] = (t >= 1) ? bf2f(*(base - LDP)) : 0.f;
      x1[u] = (t >= 2) ? bf2f(*(base - 2 * LDP)) : 0.f;
      x0[u] = (t >= 3) ? bf2f(*(base - 3 * LDP)) : 0.f;
    }
#pragma unroll
    for (int u = 0; u < 8; ++u) {
      const int t = tt * 64 + (i0 + u) * 4 + tr0;
      const float y = bias + w3 * x3[u] + w2 * x2[u] + w1 * x1[u] + w0 * x0[u];
      XC[(size_t)(b * 2048 + t) * 1024 + ch] = f2bf(siluf_(y));
    }
  }
}

__device__ __forceinline__ void dtacum_item(const Params& p, int layer, int item) {
  const bf16_t* PROJ = (const bf16_t*)(p.ws + OFF_PROJ);
  float* DT = (float*)(p.ws + OFF_DT);
  float* AC = (float*)(p.ws + OFF_ACUM);
  const int w = otid() >> 6, l = otid() & 63;
  const int id = item * 4 + w;
  const int h = id & 7, bc = id >> 3;
  const int row0 = bc * 128 + 2 * l;
  const float bias = p.in[13][layer * 8 + h];
  const float A = -expf(p.in[14][layer * 8 + h]);
  float x0 = bf2f(PROJ[(size_t)row0 * LDP + C_DT + h]) + bias;
  float x1 = bf2f(PROJ[(size_t)(row0 + 1) * LDP + C_DT + h]) + bias;
  const float d0 = x0 > 20.f ? x0 : log1pf(expf(x0));
  const float d1 = x1 > 20.f ? x1 : log1pf(expf(x1));
  const float a0 = d0 * A, a1 = d1 * A;
  float s = a0 + a1;
#pragma unroll
  for (int d = 1; d < 64; d <<= 1) {
    const float t = __shfl_up(s, d, 64);
    if (l >= d) s += t;
  }
  DT[(size_t)row0 * 8 + h] = d0;
  DT[(size_t)(row0 + 1) * 8 + h] = d1;
  AC[(size_t)row0 * 8 + h] = s - a1;
  AC[(size_t)(row0 + 1) * 8 + h] = s;
}

__device__ __forceinline__ void s5_e_item(const Params& p, int layer, int item, bf16_t* smem) {
  const bf16_t* PROJ = (const bf16_t*)(p.ws + OFF_PROJ);
  const int grp = item >> 3, mt = item & 7;
  const bf16_t* Em = (const bf16_t*)(p.ws + OFF_EMAT) + (size_t)(layer * 32 + grp) * 16384;
  float* E = (float*)(p.ws + OFF_E);
  f32x4 acc[4][4];
  zero_acc<4>(acc);
  gemm_tile<128, false, false, true>(acc, PROJ + (size_t)mt * 128 * 8 * LDP + C_S5U + grp * 16, 8 * LDP, Em, 128, 128, smem, LDP);
  const int tid = otid(), w = tid >> 6, l = tid & 63, g = l >> 4, c = l & 15, wr = w >> 1, wc = w & 1;
#pragma unroll
  for (int i = 0; i < 4; ++i)
#pragma unroll
    for (int j = 0; j < 4; ++j) {
      const int m = mt * 128 + wr * 64 + i * 16 + g * 4;
      const int n = wc * 64 + j * 16 + c;
      *(f32x4*)(E + ((size_t)(grp * 128 + n)) * NBC + m) = acc[i][j];
    }
}

__device__ __forceinline__ void mla_up_q_tile(const Params& p, int layer, int rt, int ct, bf16_t* smem) {
  const bf16_t* PROJ = (const bf16_t*)(p.ws + OFF_PROJ);
  const bf16_t* W = (const bf16_t*)(p.ws + OFF_WUQT) + (size_t)layer * 768 * 256;
  bf16_t* QM = (bf16_t*)(p.ws + OFF_QM);
  f32x4 acc[4][4];
  zero_acc<4>(acc);
  gemm_tile<128, false, false, false>(acc, PROJ + (size_t)rt * 128 * LDP + C_CQ, LDP, W + (size_t)ct * 128 * 256, 256, 256, smem);
  const int tid = otid(), w = tid >> 6, l = tid & 63, g = l >> 4, c = l & 15, wr = w >> 1, wc = w & 1;
#pragma unroll
  for (int i = 0; i < 4; ++i)
#pragma unroll
    for (int j = 0; j < 4; ++j)
#pragma unroll
      for (int r = 0; r < 4; ++r) {
        const int row = rt * 128 + wr * 64 + i * 16 + g * 4 + r, col = ct * 128 + wc * 64 + j * 16 + c;
        QM[(size_t)row * 768 + col] = f2bf(acc[i][j][r]);
      }
}
__device__ __forceinline__ void mla_up_kv_tile(const Params& p, int layer, int rt, int ct, bf16_t* smem) {
  const bf16_t* PROJ = (const bf16_t*)(p.ws + OFF_PROJ);
  const bf16_t* W = (const bf16_t*)(p.ws + OFF_WUKVT) + (size_t)layer * 1024 * 128;
  bf16_t* KN = (bf16_t*)(p.ws + OFF_KN);
  bf16_t* VTD = (bf16_t*)(p.ws + OFF_VTD);
  f32x4 acc[4][4];
  zero_acc<4>(acc);
  gemm_tile<128, false, false, false>(acc, PROJ + (size_t)rt * 128 * LDP + C_CKV, LDP, W + (size_t)ct * 128 * 128, 128, 128, smem);
  const int tid = otid(), w = tid >> 6, l = tid & 63, g = l >> 4, c = l & 15, wr = w >> 1, wc = w & 1;
  const int h = ct >> 1;
  if ((ct & 1) == 0) {
#pragma unroll
    for (int i = 0; i < 4; ++i)
#pragma unroll
      for (int j = 0; j < 4; ++j)
#pragma unroll
        for (int r = 0; r < 4; ++r) {
          const int row = rt * 128 + wr * 64 + i * 16 + g * 4 + r, cc = wc * 64 + j * 16 + c;
          KN[(size_t)row * 512 + h * 128 + cc] = f2bf(acc[i][j][r]);
        }
  } else {
#pragma unroll
    for (int i = 0; i < 4; ++i)
#pragma unroll
      for (int j = 0; j < 4; ++j) {
        const int row = rt * 128 + wr * 64 + i * 16 + g * 4, dv = wc * 64 + j * 16 + c;
        const int b = row >> 11, s = row & 2047;
        u32x2 o;
        o.x = pack2(acc[i][j][0], acc[i][j][1]);
        o.y = pack2(acc[i][j][2], acc[i][j][3]);
        *(u32x2*)(VTD + ((size_t)((b * 4 + h) * 128 + dv)) * 2048 + s) = o;
      }
  }
}

__device__ __forceinline__ void mb_states_item(const Params& p, int item, bf16_t* smem) {
  const bf16_t* XC = (const bf16_t*)(p.ws + OFF_XC);
  const float* DT = (const float*)(p.ws + OFF_DT);
  const float* AC = (const float*)(p.ws + OFF_ACUM);
  bf16_t* XS = (bf16_t*)(p.ws + OFF_XS) + (size_t)blockIdx.x * 128 * 64;
  float* ST = (float*)(p.ws + OFF_ST);
  const int h = item & 7, bc = item >> 3;
  const int grp = h >> 2;
  const int row0 = bc * 128;
  const int tid = otid();
  __syncthreads();
  const float alast = AC[(size_t)(row0 + 127) * 8 + h];
  for (int e0 = tid; e0 < 8192; e0 += 2048) {
    float dv[8], av[8];
    bf16_t xv[8];
#pragma unroll
    for (int u = 0; u < 8; ++u) {
      const int e = e0 + u * 256;
      const int row = row0 + (e >> 6);
      dv[u] = DT[(size_t)row * 8 + h];
      av[u] = AC[(size_t)row * 8 + h];
      xv[u] = XC[(size_t)row * 1024 + h * 64 + (e & 63)];
    }
#pragma unroll
    for (int u = 0; u < 8; ++u) XS[e0 + u * 256] = f2bf(bf2f(xv[u]) * dv[u] * __expf(alast - av[u]));
  }
  block_global_handoff();
  f32x4 acc[4][2];
  zero_acc<2>(acc);
  gemm_tile<64, true, true, false>(acc, XC + (size_t)row0 * 1024 + 512 + grp * 128, 1024, XS, 64, 128, smem);
  const int w = tid >> 6, l = tid & 63, g = l >> 4, c = l & 15, wr = w >> 1, wc = w & 1;
#pragma unroll
  for (int i = 0; i < 4; ++i)
#pragma unroll
    for (int j = 0; j < 2; ++j) {
      const int n = wr * 64 + i * 16 + g * 4;
      const int pp = wc * 32 + j * 16 + c;
      *(f32x4*)(ST + ((size_t)(bc * 8 + h) * 64 + pp) * 128 + n) = acc[i][j];
    }
}

__device__ __forceinline__ void s5_carry_item(const Params& p, int layer, int item) {
  const int idx = item * 256 + otid();
  const int b = idx >> 11, grp = (idx >> 6) & 31, pp = idx & 63;
  const float* a8 = (const float*)(p.ws + OFF_A8) + (size_t)((layer * 32 + grp) * 64 + pp) * 2;
  const float ar = a8[0], ai = a8[1];
  const float* er = (const float*)(p.ws + OFF_E) + ((size_t)(grp * 128 + 2 * pp)) * NBC + b * 256;
  const float* ei = er + NBC;
  bf16_t* hro = (bf16_t*)(p.ws + OFF_HIN) + ((size_t)(grp * 128 + 2 * pp)) * NBC + b * 256;
  bf16_t* hio = hro + NBC;
  float hr = 0.f, hi = 0.f;
  for (int c16 = 0; c16 < 16; ++c16) {
    f32x4 vr[4], vi[4];
#pragma unroll
    for (int u = 0; u < 4; ++u) {
      vr[u] = *(const f32x4*)(er + c16 * 16 + u * 4);
      vi[u] = *(const f32x4*)(ei + c16 * 16 + u * 4);
    }
#pragma unroll
    for (int u = 0; u < 4; ++u) {
      float orr[4], oii[4];
#pragma unroll
      for (int k = 0; k < 4; ++k) {
        orr[k] = hr; oii[k] = hi;
        const float nr = ar * hr - ai * hi + vr[u][k];
        const float ni = ar * hi + ai * hr + vi[u][k];
        hr = nr; hi = ni;
      }
      u32x2 o0, o1;
      o0.x = pack2(orr[0], orr[1]); o0.y = pack2(orr[2], orr[3]);
      o1.x = pack2(oii[0], oii[1]); o1.y = pack2(oii[2], oii[3]);
      *(u32x2*)(hro + c16 * 16 + u * 4) = o0;
      *(u32x2*)(hio + c16 * 16 + u * 4) = o1;
    }
  }
}

__device__ __forceinline__ void mlapost_item(const Params& p, int layer, int round, int item) {
  const bf16_t* PROJ = (const bf16_t*)(p.ws + OFF_PROJ);
  bf16_t* QM = (bf16_t*)(p.ws + OFF_QM);
  bf16_t* KM = (bf16_t*)(p.ws + OFF_KM);
  const bf16_t* KN = (const bf16_t*)(p.ws + OFF_KN);
  const int* pos = (const int*)p.in[1];
  const int w = otid() >> 6, l = otid() & 63;
  const float* qn = p.in[31] + layer * 192;
  const float* kn = p.in[32] + layer * 192;
  const float q0 = qn[l], q1 = qn[64 + l], q2 = qn[128 + l];
  const float k0 = kn[l], k1 = kn[64 + l], k2 = kn[128 + l];
  const float invf = expf(-13.122363377404328f * (float)(l & 31) * (1.0f / 32.0f));
  const float qscale = 0.07216878364870322f * LOG2E;
  for (int tt = 0; tt < 4; ++tt) {
    const int row = item * 16 + w * 4 + tt;
    const float ang = (float)pos[round * TR + row] * invf;
    const float cs = cosf(ang), sn = sinf(ang);
    const float kr = bf2f(PROJ[(size_t)row * LDP + C_KR + l]);
#pragma unroll
    for (int h = 0; h < 4; ++h) {
      {
        bf16_t* qp = QM + (size_t)row * 768 + h * 192;
        float e0 = bf2f(qp[l]), e1 = bf2f(qp[64 + l]), e2 = bf2f(qp[128 + l]);
        const float ss = wave_sum(e0 * e0 + e1 * e1 + e2 * e2);
        const float rs = rsqrtf(ss * (1.0f / 192.0f) + EPS);
        e0 *= rs * q0; e1 *= rs * q1; e2 *= rs * q2;
        const float ot = __shfl_xor(e2, 32, 64);
        e2 = (l < 32) ? (e2 * cs - ot * sn) : (e2 * cs + ot * sn);
        qp[l] = f2bf(e0 * qscale); qp[64 + l] = f2bf(e1 * qscale); qp[128 + l] = f2bf(e2 * qscale);
      }
      {
        const bf16_t* kp = KN + (size_t)row * 512 + h * 128;
        float e0 = bf2f(kp[l]), e1 = bf2f(kp[64 + l]), e2 = kr;
        const float ss = wave_sum(e0 * e0 + e1 * e1 + e2 * e2);
        const float rs = rsqrtf(ss * (1.0f / 192.0f) + EPS);
        e0 *= rs * k0; e1 *= rs * k1; e2 *= rs * k2;
        const float ot = __shfl_xor(e2, 32, 64);
        e2 = (l < 32) ? (e2 * cs - ot * sn) : (e2 * cs + ot * sn);
        bf16_t* ko = KM + (size_t)row * 768 + h * 192;
        ko[l] = f2bf(e0); ko[64 + l] = f2bf(e1); ko[128 + l] = f2bf(e2);
      }
    }
  }
}

__device__ __forceinline__ void mb_scan_item(const Params& p, int item) {
  const int idx = item * 256 + otid();
  const int b = idx >> 16, h = (idx >> 13) & 7, pn = idx & 8191;
  const float* ST = (const float*)(p.ws + OFF_ST);
  const float* AC = (const float*)(p.ws + OFF_ACUM);
  bf16_t* SIN = (bf16_t*)(p.ws + OFF_SIN);
  float cur = 0.f;
  float alv[16], stv[16];
#pragma unroll
  for (int c = 0; c < 16; ++c) {
    alv[c] = AC[(size_t)(b * 2048 + c * 128 + 127) * 8 + h];
    stv[c] = ST[((size_t)((b * 16 + c) * 8 + h)) * 8192 + pn];
  }
#pragma unroll
  for (int c = 0; c < 16; ++c) {
    SIN[((size_t)((b * 16 + c) * 8 + h)) * 8192 + pn] = f2bf(cur);
    cur = __expf(alv[c]) * cur + stv[c];
  }
}

__device__ __forceinline__ void s5_y_item(const Params& p, int layer, int item, bf16_t* smem) {
  const bf16_t* PROJ = (const bf16_t*)(p.ws + OFF_PROJ);
  const int grp = item >> 3, mt = item & 7;
  const bf16_t* Km = (const bf16_t*)(p.ws + OFF_KMAT) + (size_t)(layer * 32 + grp) * 16384;
  const bf16_t* Fm = (const bf16_t*)(p.ws + OFF_FMAT) + (size_t)(layer * 32 + grp) * 16384;
  const bf16_t* HIN = (const bf16_t*)(p.ws + OFF_HIN) + (size_t)grp * 128 * NBC + mt * 128;
  bf16_t* YG = (bf16_t*)(p.ws + OFF_YG);
  f32x4 acc[4][4];
  zero_acc<4>(acc);
  gemm_tile<128, false, false, true>(acc, PROJ + (size_t)mt * 128 * 8 * LDP + C_S5U + grp * 16, 8 * LDP, Km, 128, 128, smem, LDP);
  gemm_tile<128, true, false, false>(acc, HIN, NBC, Fm, 128, 128, smem);
  const int tid = otid(), w = tid >> 6, l = tid & 63, g = l >> 4, c = l & 15, wr = w >> 1, wc = w & 1;
  const float* dsk = p.in[24] + layer * 512;
#pragma unroll
  for (int i = 0; i < 4; ++i)
#pragma unroll
    for (int j = 0; j < 4; ++j) {
      const int n = wc * 64 + j * 16 + c;
      const int tq = n >> 4, co = n & 15;
      const int ch = grp * 16 + co;
      const float dd = dsk[ch];
#pragma unroll
      for (int r = 0; r < 4; ++r) {
        const int m = mt * 128 + wr * 64 + i * 16 + g * 4 + r;
        const int row = m * 8 + tq;
        const float u = bf2f(PROJ[(size_t)row * LDP + C_S5U + ch]);
        const float y = acc[i][j][r] + dd * u;
        YG[(size_t)row * 512 + ch] = f2bf(gelu_tanh(y));
      }
    }
}

template <int DK, int NM>
__device__ __forceinline__ void attn_core(const bf16_t* __restrict__ Qb, long ldq, const bf16_t* __restrict__ Kb, long ldk,
                                          const bf16_t* __restrict__ Vt, int qb, bf16_t* smem, f32x4 (&O)[NM][8], float (&lsum)[NM][4]) {
  constexpr int KST = DK + 8;
  constexpr int KCH = NM * 64 * DK / 8 / 256;
  constexpr int CPM = 64 * DK / 8;
  constexpr int CPRK = DK / 8;
  bf16_t* sK = smem;
  bf16_t* sV = sK + NM * 64 * KST;
  bf16_t* sP = sV + 128 * 72;
  const int tid = otid(), w = tid >> 6, l = tid & 63, g = l >> 4, c = l & 15;
  bf16x8 qf[NM][DK / 32];
  {
    const long qrow = (long)qb * 64 + w * 16 + c;
#pragma unroll
    for (int m = 0; m < NM; ++m)
#pragma unroll
      for (int ks = 0; ks < DK / 32; ++ks) qf[m][ks] = *(const bf16x8*)(Qb + qrow * ldq + m * DK + ks * 32 + g * 8);
  }
  float mrow[NM][4];
#pragma unroll
  for (int m = 0; m < NM; ++m) {
#pragma unroll
    for (int r = 0; r < 4; ++r) { mrow[m][r] = -INFINITY; lsum[m][r] = 0.f; }
#pragma unroll
    for (int nt = 0; nt < 8; ++nt) O[m][nt] = (f32x4){0.f, 0.f, 0.f, 0.f};
  }
  u32x4 kr[KCH], vr[4];
  auto gloadK = [&](int kt) {
#pragma unroll
    for (int i = 0; i < KCH; ++i) {
      const int ch = tid + i * 256;
      const int m = ch / CPM, cc = ch % CPM;
      const int key = cc / CPRK, d0 = (cc % CPRK) * 8;
      kr[i] = *(const u32x4*)(Kb + (long)(kt * 64 + key) * ldk + m * DK + d0);
    }
  };
  auto gloadV = [&](int kt) {
#pragma unroll
    for (int i = 0; i < 4; ++i) {
      const int ch = tid + i * 256;
      const int dvr = ch >> 3, kc = (ch & 7) * 8;
      vr[i] = *(const u32x4*)(Vt + (long)dvr * 2048 + kt * 64 + kc);
    }
  };
  gloadK(0);
  gloadV(0);
  for (int kt = 0; kt <= qb; ++kt) {
    __syncthreads();
#pragma unroll
    for (int i = 0; i < KCH; ++i) {
      const int ch = tid + i * 256;
      const int m = ch / CPM, cc = ch % CPM;
      const int key = cc / CPRK, d0 = (cc % CPRK) * 8;
      *(u32x4*)(sK + (m * 64 + key) * KST + d0) = kr[i];
    }
#pragma unroll
    for (int i = 0; i < 4; ++i) {
      const int ch = tid + i * 256;
      const int dvr = ch >> 3, kc = (ch & 7) * 8;
      *(u32x4*)(sV + dvr * 72 + kc) = vr[i];
    }
    __syncthreads();
    if (kt < qb) gloadK(kt + 1);
#pragma unroll
    for (int m = 0; m < NM; ++m) {
      f32x4 S[4];
#pragma unroll
      for (int nt = 0; nt < 4; ++nt) {
        S[nt] = (f32x4){0.f, 0.f, 0.f, 0.f};
#pragma unroll
        for (int ks = 0; ks < DK / 32; ++ks) {
          const bf16x8 kf = *(const bf16x8*)(sK + (m * 64 + nt * 16 + c) * KST + ks * 32 + g * 8);
          S[nt] = __builtin_amdgcn_mfma_f32_16x16x32_bf16(qf[m][ks], kf, S[nt], 0, 0, 0);
        }
        MEMBAR();
      }
      if (kt == qb) {
#pragma unroll
        for (int nt = 0; nt < 4; ++nt)
#pragma unroll
          for (int r = 0; r < 4; ++r)
            if (nt * 16 + c > w * 16 + g * 4 + r) S[nt][r] = -INFINITY;
      }
      bf16_t* pw = sP + (size_t)((w * NM + m) * 16) * 72;
#pragma unroll
      for (int r = 0; r < 4; ++r) {
        float mx = fmaxf(fmaxf(S[0][r], S[1][r]), fmaxf(S[2][r], S[3][r]));
        mx = fmaxf(mx, __shfl_xor(mx, 1, 64));
        mx = fmaxf(mx, __shfl_xor(mx, 2, 64));
        mx = fmaxf(mx, __shfl_xor(mx, 4, 64));
        mx = fmaxf(mx, __shfl_xor(mx, 8, 64));
        const float mnew = fmaxf(mrow[m][r], mx);
        const float sc = __builtin_amdgcn_exp2f(mrow[m][r] - mnew);
        mrow[m][r] = mnew;
        float ps = 0.f;
#pragma unroll
        for (int nt = 0; nt < 4; ++nt) {
          const float pv = __builtin_amdgcn_exp2f(S[nt][r] - mnew);
          ps += pv;
          pw[(g * 4 + r) * 72 + nt * 16 + c] = f2bf(pv);
        }
        ps += __shfl_xor(ps, 1, 64);
        ps += __shfl_xor(ps, 2, 64);
        ps += __shfl_xor(ps, 4, 64);
        ps += __shfl_xor(ps, 8, 64);
        lsum[m][r] = lsum[m][r] * sc + ps;
#pragma unroll
        for (int nt = 0; nt < 8; ++nt) O[m][nt][r] *= sc;
      }
    }
    __syncthreads();
    if (kt < qb) gloadV(kt + 1);
#pragma unroll
    for (int m = 0; m < NM; ++m) {
      const bf16_t* pw = sP + (size_t)((w * NM + m) * 16) * 72;
#pragma unroll
      for (int ks = 0; ks < 2; ++ks) {
        const bf16x8 pf = *(const bf16x8*)(pw + c * 72 + ks * 32 + g * 8);
#pragma unroll
        for (int nt = 0; nt < 8; ++nt) {
          const bf16x8 vf = *(const bf16x8*)(sV + (nt * 16 + c) * 72 + ks * 32 + g * 8);
          O[m][nt] = __builtin_amdgcn_mfma_f32_16x16x32_bf16(pf, vf, O[m][nt], 0, 0, 0);
        }
        MEMBAR();
      }
    }
  }
}

__device__ __forceinline__ void da_attn_item(const Params& p, int layer, int bh, int qb, bf16_t* smem, bool dry = false) {
  bf16_t* PROJ = (bf16_t*)(p.ws + OFF_PROJ);
  const bf16_t* VTA = (const bf16_t*)(p.ws + OFF_VTA);
  const int b = bh >> 2, h = bh & 3;
  f32x4 O[2][8];
  float ls[2][4];
  {
    f32x4 O1[1][8];
    float l1[1][4];
#pragma unroll 1
    for (int m = 0; m < 2; ++m) {
      attn_core<64, 1>(PROJ + (size_t)b * 2048 * LDP + C_DAQ + h * 128 + m * 64, LDP, PROJ + (size_t)b * 2048 * LDP + C_DAK + h * 128 + m * 64, LDP,
                       VTA + (size_t)(b * 4 + h) * 128 * 2048, qb, smem, O1, l1);
      if (m == 0) {
#pragma unroll
        for (int nt = 0; nt < 8; ++nt) O[0][nt] = O1[0][nt];
#pragma unroll
        for (int r = 0; r < 4; ++r) ls[0][r] = l1[0][r];
      } else {
#pragma unroll
        for (int nt = 0; nt < 8; ++nt) O[1][nt] = O1[0][nt];
#pragma unroll
        for (int r = 0; r < 4; ++r) ls[1][r] = l1[0][r];
      }
    }
  }
  const int tid = otid(), w = tid >> 6, l = tid & 63, g = l >> 4, c = l & 15;
  const float lam = ((const float*)(p.ws + OFF_LAM))[layer];
  const float linit = 0.8f - 0.6f * expf(-0.3f * (float)layer);
  const float* sg = p.in[10] + layer * 128;
#pragma unroll
  for (int r = 0; r < 4; ++r) {
    const float i0 = 1.0f / ls[0][r], i1 = lam / ls[1][r];
    float o[8];
    float ss = 0.f;
#pragma unroll
    for (int nt = 0; nt < 8; ++nt) {
      o[nt] = O[0][nt][r] * i0 - O[1][nt][r] * i1;
      ss += o[nt] * o[nt];
    }
    ss += __shfl_xor(ss, 1, 64);
    ss += __shfl_xor(ss, 2, 64);
    ss += __shfl_xor(ss, 4, 64);
    ss += __shfl_xor(ss, 8, 64);
    const float rs = rsqrtf(ss * (1.0f / 128.0f) + EPS) * (1.0f - linit);
    const size_t row = (size_t)b * 2048 + qb * 64 + w * 16 + g * 4 + r;
#pragma unroll
    for (int nt = 0; nt < 8; ++nt) {
      const int dv = nt * 16 + c;
      bf16_t* gp = PROJ + row * LDP + C_DAG + h * 128 + dv;
      const float gt = bf2f(*gp);
      if (!dry) *gp = f2bf(o[nt] * rs * sg[dv] * siluf_(gt));
    }
  }
}

__device__ __forceinline__ void mla_attn_item(const Params& p, int bh, int qb, bf16_t* smem, bool dry = false) {
  bf16_t* PROJ = (bf16_t*)(p.ws + OFF_PROJ);
  const bf16_t* QM = (const bf16_t*)(p.ws + OFF_QM);
  const bf16_t* KM = (const bf16_t*)(p.ws + OFF_KM);
  const bf16_t* VTD = (const bf16_t*)(p.ws + OFF_VTD);
  const int b = bh >> 2, h = bh & 3;
  f32x4 O[1][8];
  float ls[1][4];
  attn_core<192, 1>(QM + (size_t)b * 2048 * 768 + h * 192, 768, KM + (size_t)b * 2048 * 768 + h * 192, 768,
                    VTD + (size_t)(b * 4 + h) * 128 * 2048, qb, smem, O, ls);
  const int tid = otid(), w = tid >> 6, l = tid & 63, g = l >> 4, c = l & 15;
#pragma unroll
  for (int r = 0; r < 4; ++r) {
    const float i0 = 1.0f / ls[0][r];
    const size_t row = (size_t)b * 2048 + qb * 64 + w * 16 + g * 4 + r;
#pragma unroll
    for (int nt = 0; nt < 8; ++nt) {
      const int dv = nt * 16 + c;
      bf16_t* gp = PROJ + row * LDP + C_MLG + h * 128 + dv;
      const float gt = bf2f(*gp);
      if (!dry) *gp = f2bf(O[0][nt][r] * i0 * siluf_(gt));
    }
  }
}

__device__ __forceinline__ void mb_out_item(const Params& p, int layer, int item, bf16_t* smem) {
  bf16_t* PROJ = (bf16_t*)(p.ws + OFF_PROJ);
  const bf16_t* XC = (const bf16_t*)(p.ws + OFF_XC);
  const float* DT = (const float*)(p.ws + OFF_DT);
  const float* AC = (const float*)(p.ws + OFF_ACUM);
  const bf16_t* SIN = (const bf16_t*)(p.ws + OFF_SIN);
  bf16_t* MS = (bf16_t*)(p.ws + OFF_MS) + (size_t)blockIdx.x * 128 * 128;
  float* rowss = (float*)((unsigned char*)smem + 73728);
  const int grp = item & 1, bc = item >> 1;
  const int row0 = bc * 128;
  __syncthreads();
  const bf16_t* Cp = XC + (size_t)row0 * 1024 + 768 + grp * 128;
  const bf16_t* Bp = XC + (size_t)row0 * 1024 + 512 + grp * 128;
#pragma unroll 1
  for (int r4 = 0; r4 < 4; ++r4) {
    const int h = grp * 4 + r4;
    const int tid = otid(), w = tid >> 6, l = tid & 63, g = l >> 4, c = l & 15, wr = w >> 1, wc = w & 1;
    {
      f32x4 cb[4][4];
      zero_acc<4>(cb);
      gemm_tile<128, false, false, false>(cb, Cp, 1024, Bp, 1024, 128, smem);
      float acs[4], dts[4];
#pragma unroll
      for (int j = 0; j < 4; ++j) {
        const int s = wc * 64 + j * 16 + c;
        acs[j] = AC[(size_t)(row0 + s) * 8 + h];
        dts[j] = DT[(size_t)(row0 + s) * 8 + h];
      }
#pragma unroll
      for (int i = 0; i < 4; ++i)
#pragma unroll
        for (int r = 0; r < 4; ++r) {
          const int lr = wr * 64 + i * 16 + g * 4 + r;
          const float acl = AC[(size_t)(row0 + lr) * 8 + h];
#pragma unroll
          for (int j = 0; j < 4; ++j) {
            const int s = wc * 64 + j * 16 + c;
            const float v = (s <= lr) ? cb[i][j][r] * __expf(acl - acs[j]) * dts[j] : 0.f;
            MS[lr * 128 + s] = f2bf(v);
          }
          MEMBAR();
        }
    }
    block_global_handoff();
    f32x4 ad[4][2], ao[4][2];
    zero_acc<2>(ad);
    zero_acc<2>(ao);
    gemm_tile<64, false, true, false>(ad, MS, 128, XC + (size_t)row0 * 1024 + h * 64, 1024, 128, smem);
    gemm_tile<64, false, false, false>(ao, Cp, 1024, SIN + ((size_t)(bc * 8 + h)) * 8192, 128, 128, smem);
    const float dsk = p.in[15][layer * 8 + h];
#pragma unroll
    for (int i = 0; i < 4; ++i)
#pragma unroll
      for (int r = 0; r < 4; ++r) {
        const int lr = wr * 64 + i * 16 + g * 4 + r;
        const size_t row = (size_t)row0 + lr;
        const float ea = __expf(AC[row * 8 + h]);
        float ssq = 0.f;
#pragma unroll
        for (int j = 0; j < 2; ++j) {
          const int ch = h * 64 + wc * 32 + j * 16 + c;
          const float xv = bf2f(XC[row * 1024 + ch]);
          bf16_t* zp = PROJ + row * LDP + C_MBZ + ch;
          const float z = bf2f(*zp);
          float y = ad[i][j][r] + ea * ao[i][j][r] + dsk * xv;
          y *= siluf_(z);
          ssq += y * y;
          *zp = f2bf(y);
        }
        ssq += __shfl_xor(ssq, 1, 64);
        ssq += __shfl_xor(ssq, 2, 64);
        ssq += __shfl_xor(ssq, 4, 64);
        ssq += __shfl_xor(ssq, 8, 64);
        if (c == 0) rowss[(r4 * 2 + wc) * 128 + lr] = ssq;
        MEMBAR();
      }
  }
  block_global_handoff();
  const float* ng = p.in[16] + layer * 512 + grp * 256;
  {
    const int cc = otid();
    const float gcc = ng[cc];
    for (int l0 = 0; l0 < 128; l0 += 16) {
      bf16_t vals[16];
#pragma unroll
      for (int u = 0; u < 16; ++u) vals[u] = PROJ[(size_t)(row0 + l0 + u) * LDP + C_MBZ + grp * 256 + cc];
#pragma unroll
      for (int u = 0; u < 16; ++u) {
        const int lr = l0 + u;
        float tot = 0.f;
#pragma unroll
        for (int q = 0; q < 8; ++q) tot += rowss[q * 128 + lr];
        PROJ[(size_t)(row0 + lr) * LDP + C_MBZ + grp * 256 + cc] = f2bf(bf2f(vals[u]) * rsqrtf(tot * (1.0f / 256.0f) + EPS) * gcc);
      }
    }
  }
}

__device__ __forceinline__ void s5_glu_tile(const Params& p, int layer, int rt, int ct, bf16_t* smem) {
  bf16_t* PROJ = (bf16_t*)(p.ws + OFF_PROJ);
  const bf16_t* YG = (const bf16_t*)(p.ws + OFF_YG);
  const bf16_t* W = (const bf16_t*)(p.ws + OFF_WGLUT) + (size_t)layer * 512 * 512;
  f32x4 acc[4][4];
  zero_acc<4>(acc);
  gemm_tile<128, false, false, false>(acc, YG + (size_t)rt * 128 * 512, 512, W + (size_t)ct * 128 * 512, 512, 512, smem);
  const int tid = otid(), w = tid >> 6, l = tid & 63, g = l >> 4, c = l & 15, wr = w >> 1, wc = w & 1;
  const float* bg = p.in[26] + layer * 512;
#pragma unroll
  for (int i = 0; i < 4; ++i)
#pragma unroll
    for (int j = 0; j < 4; ++j) {
      const int col = ct * 128 + wc * 64 + j * 16 + c;
      const float bb = bg[col];
#pragma unroll
      for (int r = 0; r < 4; ++r) {
        const size_t row = (size_t)rt * 128 + wr * 64 + i * 16 + g * 4 + r;
        const float yv = bf2f(YG[row * 512 + col]);
        bf16_t* gp = PROJ + row * LDP + C_S5G + col;
        const float gt = bf2f(*gp);
        *gp = f2bf(yv * sigmoidf_(acc[i][j][r] + bb) * siluf_(gt));
      }
    }
}

__device__ __forceinline__ void merge_tile(const Params& p, int layer, int rt, int ct, bf16_t* smem) {
  const bf16_t* PROJ = (const bf16_t*)(p.ws + OFF_PROJ);
  bf16_t* MG = (bf16_t*)(p.ws + OFF_MERGED);
  f32x4 macc[4][2];
  zero_acc<2>(macc);
  const int tid = otid(), w = tid >> 6, l = tid & 63, g = l >> 4, c = l & 15, wr = w >> 1, wc = w & 1;
  for (int n = 0; n < 4; ++n) {
    const int ycol = (n == 0) ? C_DAG : (n == 1) ? C_MBZ : (n == 2) ? C_S5G : C_MLG;
    const bf16_t* W = (const bf16_t*)(p.ws + OFF_WBRT) + (size_t)(layer * 4 + n) * 1024 * 512;
    f32x4 acc[4][2];
    zero_acc<2>(acc);
    gemm_tile<64, false, false, false>(acc, PROJ + (size_t)rt * 128 * LDP + ycol, LDP, W + (size_t)ct * 64 * 512, 512, 512, smem);
#pragma unroll
    for (int i = 0; i < 4; ++i) {
#pragma unroll
      for (int r = 0; r < 4; ++r) {
        const size_t row = (size_t)rt * 128 + wr * 64 + i * 16 + g * 4 + r;
        const bf16_t* gp = PROJ + row * LDP + C_GATE + n * 1024 + ct * 64 + wc * 32 + c;
#pragma unroll
        for (int j = 0; j < 2; ++j) macc[i][j][r] += bf2f(gp[j * 16]) * acc[i][j][r];
      }
      MEMBAR();
    }
  }
#pragma unroll
  for (int i = 0; i < 4; ++i) {
#pragma unroll
    for (int r = 0; r < 4; ++r) {
      const size_t row = (size_t)rt * 128 + wr * 64 + i * 16 + g * 4 + r;
      bf16_t* op = MG + row * 1024 + ct * 64 + wc * 32 + c;
#pragma unroll
      for (int j = 0; j < 2; ++j) op[j * 16] = f2bf(macc[i][j][r]);
    }
    MEMBAR();
  }
}

__device__ __forceinline__ void out_tile(const Params& p, int layer, const float* xo, float* xn, int rt, int ct, bf16_t* smem) {
  const bf16_t* MG = (const bf16_t*)(p.ws + OFF_MERGED);
  const bf16_t* W = (const bf16_t*)(p.ws + OFF_WOUTT) + (size_t)layer * 1024 * 1024;
  f32x4 acc[4][4];
  zero_acc<4>(acc);
  gemm_tile<128, false, false, false>(acc, MG + (size_t)rt * 128 * 1024, 1024, W + (size_t)ct * 128 * 1024, 1024, 1024, smem);
  const int tid = otid(), w = tid >> 6, l = tid & 63, g = l >> 4, c = l & 15, wr = w >> 1, wc = w & 1;
#pragma unroll
  for (int i = 0; i < 4; ++i)
#pragma unroll
    for (int j = 0; j < 4; ++j) {
      const int col = ct * 128 + wc * 64 + j * 16 + c;
#pragma unroll
      for (int r = 0; r < 4; ++r) {
        const size_t row = (size_t)rt * 128 + wr * 64 + i * 16 + g * 4 + r;
        xn[row * 1024 + col] = xo[row * 1024 + col] + acc[i][j][r];
      }
    }
}

__device__ __forceinline__ void gsync(cg::grid_group& grid, unsigned* bar, unsigned& epoch) {
  asm volatile("s_waitcnt vmcnt(0)" ::: "memory");
  __syncthreads();
  if (otid() == 0) {
    unsigned long long* w = (unsigned long long*)bar;
    __builtin_amdgcn_fence(__ATOMIC_RELEASE, "agent");
    asm volatile("s_waitcnt vmcnt(0)" ::: "memory");
    const unsigned long long old = __hip_atomic_fetch_add(w, 1ull, __ATOMIC_RELAXED, __HIP_MEMORY_SCOPE_AGENT);
    const unsigned G = gridDim.x;
    if ((unsigned)(old & 0xffffffffull) == G - 1) {
      __hip_atomic_fetch_add(w, (1ull << 32) - (unsigned long long)G, __ATOMIC_RELAXED, __HIP_MEMORY_SCOPE_AGENT);
    } else {
      const unsigned g0 = (unsigned)(old >> 32);
      while ((unsigned)(__hip_atomic_load(w, __ATOMIC_RELAXED, __HIP_MEMORY_SCOPE_AGENT) >> 32) == g0) __builtin_amdgcn_s_sleep(2);
    }
    __builtin_amdgcn_fence(__ATOMIC_ACQUIRE, "agent");
    asm volatile("s_waitcnt vmcnt(0)" ::: "memory");
  }
  __syncthreads();
}

#ifdef SELFCHECK
__device__ __forceinline__ void cksum(const void* ptr, size_t bytes, unsigned long long* slot) {
  const u32x4* q = (const u32x4*)ptr;
  const size_t n = bytes / 16;
  unsigned long long s = 0;
  for (size_t i = (size_t)blockIdx.x * 256 + otid(); i < n; i += (size_t)gridDim.x * 256) {
    const u32x4 v = q[i];
    s += (unsigned long long)v.x + 3ull * v.y + 5ull * v.z + 7ull * v.w;
  }
  unsigned lo = (unsigned)s, hi = (unsigned)(s >> 32);
  unsigned long long t = s;
#pragma unroll
  for (int d = 32; d >= 1; d >>= 1) {
    const unsigned l2 = __shfl_xor((unsigned)t, d, 64), h2 = __shfl_xor((unsigned)(t >> 32), d, 64);
    t += ((unsigned long long)h2 << 32) | l2;
  }
  (void)lo; (void)hi;
  if ((otid() & 63) == 0) atomicAdd(slot, t);
}
#define CK(ptr, bytes) cksum((ptr), (bytes), slots + slot)
#else
#define CK(ptr, bytes) do {} while (0)
#endif

__device__ __forceinline__ void cksum_acc(const void* ptr, size_t bytes, unsigned long long& s) {
  const u32x4* q = (const u32x4*)ptr;
  const size_t n = bytes / 16;
  for (size_t i = (size_t)blockIdx.x * 256 + otid(); i < n; i += (size_t)gridDim.x * 256) {
    const u32x4 v = __builtin_nontemporal_load(q + i);
    s += (unsigned long long)v.x + 3ull * v.y + 5ull * v.z + 7ull * v.w;
  }
}
__device__ __forceinline__ void cksum_commit(unsigned long long t, unsigned long long* slot) {
#pragma unroll
  for (int d = 32; d >= 1; d >>= 1) {
    const unsigned l2 = __shfl_xor((unsigned)t, d, 64), h2 = __shfl_xor((unsigned)(t >> 32), d, 64);
    t += ((unsigned long long)h2 << 32) | l2;
  }
  if ((otid() & 63) == 0) atomicAdd(slot, t);
}

__global__ void __launch_bounds__(256, 2) fwd_megakernel(Params p) {
  cg::grid_group grid = cg::this_grid();
  __shared__ __attribute__((aligned(16))) unsigned char smem_raw[SMEM_BYTES];
  bf16_t* smem = (bf16_t*)smem_raw;
  float* smf = (float*)smem_raw;
  const int G = gridDim.x, bid = blockIdx.x;
  unsigned* bar = (unsigned*)(p.ws + OFF_BAR);
  unsigned epoch = 0;
#ifdef START_DELAY_US
  {
    const unsigned long long t0 = __builtin_amdgcn_s_memrealtime();
    while (__builtin_amdgcn_s_memrealtime() - t0 < (unsigned long long)START_DELAY_US * 100ull) __builtin_amdgcn_s_sleep(20);
  }
#endif
  grid.sync();
#ifdef WCHECK
  unsigned wseen = 0;
  if (bid == 0 && otid() == 0) wseen = __hip_atomic_load(bar + 32, __ATOMIC_RELAXED, __HIP_MEMORY_SCOPE_AGENT);
#endif

#ifdef SELFCHECK
  unsigned long long* slots_base = (unsigned long long*)(p.ws + OFF_BAR + 256);
  if (bid == 0) for (int k = otid(); k < 768; k += 256) __hip_atomic_store(slots_base + k, 0ull, __ATOMIC_RELAXED, __HIP_MEMORY_SCOPE_AGENT);
  for (int run = 0; run < 3; ++run) {
  unsigned long long* slots = slots_base + run * 256;
  int slot = 0;
#endif
  {
    unsigned long long* sslots = (unsigned long long*)(p.ws + OFF_BAR + 1024);
    unsigned long long prev = 0;
    for (int iter = 0; iter < 64; ++iter) {
      unsigned long long s = 0;
      cksum_acc(p.out, (size_t)BATCH * SEQ * 1024 * 4, s);
      cksum_acc(p.ws, OFF_BAR, s);
      cksum_commit(s, sslots + iter);
      gsync(grid, bar, epoch);
      const unsigned long long c = __hip_atomic_load(sslots + iter, __ATOMIC_RELAXED, __HIP_MEMORY_SCOPE_AGENT);
      if (iter > 0 && c == prev) break;
      prev = c;
    }
  }
  phase_prep(p, smf);
  gsync(grid, bar, epoch);
  phase_prep(p, smf);
#ifdef SELF_POISON
  {
    u32x4* q = (u32x4*)(p.ws + OFF_H);
    const size_t n16 = (WS_TOTAL - OFF_H) / 16;
    const u32x4 pv = {SELF_POISON, SELF_POISON, SELF_POISON, SELF_POISON};
    for (size_t i = (size_t)bid * 256 + otid(); i < n16; i += (size_t)G * 256) q[i] = pv;
  }
#endif
  gsync(grid, bar, epoch);
#ifdef SELFCHECK
  CK(p.ws, OFF_H); slot++;
#endif

  for (int layer = 0; layer < 2; ++layer) {
    const float* xin = (layer == 0) ? p.in[0] : p.out;
    float* xout = p.out;
    for (int round = 0; round < NROUND; ++round) {
      const size_t tok0 = (size_t)round * TR;
      phase_hnorm(xin + tok0 * 1024, p.in[2] + layer * 1024, (bf16_t*)(p.ws + OFF_H));
      gsync(grid, bar, epoch);
#ifdef SELFCHECK
      CK(p.ws + OFF_H, (size_t)TR * 1024 * 2); slot++;
#endif
#ifndef REP_B
#define REP_B 1
#endif
      for (int rep = 0; rep < REP_B; ++rep) {
      for (int it = bid; it < NRT * 76; it += G) inproj_tile(p, layer, it % NRT, it / NRT, smem);
      gsync(grid, bar, epoch);
      }
#ifdef SELFCHECK
      CK(p.ws + OFF_PROJ, (size_t)TR * D_INP * 2); CK(p.ws + OFF_VTA, (size_t)RB * 4 * 128 * 2048 * 2); slot++;
#endif
      {
        constexpr int n1 = 256, n2 = TR / 16, n3 = RB * 32 * 16, n4 = RB * 16 * 8 / 4;
        for (int it = bid; it < n1 + n2 + n3 + n4; it += G) {
          if (it < n1) s5_e_item(p, layer, it, smem);
          else if (it < n1 + n2) tokpost_item(p, layer, round, it - n1);
          else if (it < n1 + n2 + n3) conv_item(p, layer, it - n1 - n2);
          else dtacum_item(p, layer, it - n1 - n2 - n3);
        }
      }
      gsync(grid, bar, epoch);
#ifdef SELFCHECK
      CK(p.ws + OFF_PROJ, (size_t)TR * D_INP * 2); CK(p.ws + OFF_E, (size_t)32 * 128 * NBC * 4); CK(p.ws + OFF_XC, (size_t)TR * 1024 * 2);
      CK(p.ws + OFF_DT, (size_t)TR * 8 * 4); CK(p.ws + OFF_ACUM, (size_t)TR * 8 * 4); slot++;
#endif
      {
        constexpr int n1 = NRT * 6, n2 = NRT * 8, n3 = RB * 16 * 8, n4 = RB * 32 * 64 / 256;
        for (int it = bid; it < n1 + n2 + n3 + n4; it += G) {
          if (it < n1) mla_up_q_tile(p, layer, it % NRT, it / NRT, smem);
          else if (it < n1 + n2) mla_up_kv_tile(p, layer, (it - n1) % NRT, (it - n1) / NRT, smem);
          else if (it < n1 + n2 + n3) mb_states_item(p, it - n1 - n2, smem);
          else s5_carry_item(p, layer, it - n1 - n2 - n3);
        }
      }
      gsync(grid, bar, epoch);
#ifdef SELFCHECK
      CK(p.ws + OFF_QM, (size_t)TR * 768 * 2); CK(p.ws + OFF_KN, (size_t)TR * 512 * 2); CK(p.ws + OFF_VTD, (size_t)RB * 4 * 128 * 2048 * 2);
      CK(p.ws + OFF_ST, (size_t)RB * 16 * 8 * 8192 * 4); CK(p.ws + OFF_HIN, (size_t)32 * 128 * NBC * 2); slot++;
#endif
      {
        constexpr int n1 = 256, n2 = TR / 16, n3 = RB * 8 * 8192 / 256;
        for (int it = bid; it < n1 + n2 + n3; it += G) {
          if (it < n1) s5_y_item(p, layer, it, smem);
          else if (it < n1 + n2) mlapost_item(p, layer, round, it - n1);
          else mb_scan_item(p, it - n1 - n2);
        }
      }
      gsync(grid, bar, epoch);
#ifdef SELFCHECK
      CK(p.ws + OFF_YG, (size_t)TR * 512 * 2); CK(p.ws + OFF_QM, (size_t)TR * 768 * 2); CK(p.ws + OFF_KM, (size_t)TR * 768 * 2);
      CK(p.ws + OFF_SIN, (size_t)RB * 16 * 8 * 8192 * 2); slot++;
#endif
#ifdef REP_ATT
      {
        constexpr int nat = RB * 4 * 32 * 2;
        for (int it = bid; it < nat; it += G) {
            const int half = nat / 2;
            const int qb = (it < half) ? (31 - it / 32) : ((it - half) / 32);
            const int sub = it & 31;
            if (sub < 16) da_attn_item(p, layer, sub, qb, smem, true);
            else mla_attn_item(p, sub - 16, qb, smem, true);
        }
        gsync(grid, bar, epoch);
      }
#endif
      {
        constexpr int nat = RB * 4 * 32 * 2;
        constexpr int n3 = RB * 16 * 2, n4 = NRT * 4;
        for (int it0 = bid; it0 < nat + n3 + n4; it0 += G) {
          if (it0 < n3) { mb_out_item(p, layer, it0, smem); continue; }
          const int it = it0 - n3;
          if (it < nat) {
            const int half = nat / 2;
            const int qb = (it < half) ? (31 - it / 32) : ((it - half) / 32);
            const int sub = it & 31;
            if (sub < 16) da_attn_item(p, layer, sub, qb, smem);
            else mla_attn_item(p, sub - 16, qb, smem);
          } else s5_glu_tile(p, layer, (it - nat) % NRT, (it - nat) / NRT, smem);
        }
      }
      gsync(grid, bar, epoch);
#ifdef SELFCHECK
      CK(p.ws + OFF_PROJ, (size_t)TR * D_INP * 2); slot++;
#endif
      for (int it = bid; it < NRT * 16; it += G) merge_tile(p, layer, it % NRT, it / NRT, smem);
      gsync(grid, bar, epoch);
#ifdef SELFCHECK
      CK(p.ws + OFF_MERGED, (size_t)TR * 1024 * 2); slot++;
#endif
      for (int it = bid; it < NRT * 8; it += G) out_tile(p, layer, xin + tok0 * 1024, xout + tok0 * 1024, it % NRT, it / NRT, smem);
      gsync(grid, bar, epoch);
#ifdef SELFCHECK
      CK(xout + tok0 * 1024, (size_t)TR * 1024 * 4); slot++;
#endif
    }
  }
#ifdef WCHECK
  if (bid == 0 && otid() == 0) {
    if (wseen != 0) p.out[0] = 1.0e6f;
    __hip_atomic_store(bar + 32, 1u, __ATOMIC_RELAXED, __HIP_MEMORY_SCOPE_AGENT);
  }
#endif
#ifdef SELFCHECK
  gsync(grid, bar, epoch);
  }
  gsync(grid, bar, epoch);
  if (bid == 0 && otid() == 0) {
    int bad = -1;
    for (int k = 0; k < 100; ++k) {
      const unsigned long long a = __hip_atomic_load(slots_base + k, __ATOMIC_RELAXED, __HIP_MEMORY_SCOPE_AGENT);
      const unsigned long long b = __hip_atomic_load(slots_base + 256 + k, __ATOMIC_RELAXED, __HIP_MEMORY_SCOPE_AGENT);
      const unsigned long long c = __hip_atomic_load(slots_base + 512 + k, __ATOMIC_RELAXED, __HIP_MEMORY_SCOPE_AGENT);
      if (a != b || a != c) { bad = k; break; }
    }
    if (bad >= 0) p.out[0] = 10000.0f * exp2f((float)bad);
  }
#endif
}

extern "C" void kernel_launch(void* const* d_in, const int* in_sizes, int n_in, void* d_out,
                              int out_size, void* d_ws, size_t ws_size, hipStream_t stream) {
  static int grid_blocks = 0;
  if (!grid_blocks) {
    int dev = 0, cus = 0, per_cu = 0;
    (void)hipGetDevice(&dev);
    (void)hipDeviceGetAttribute(&cus, hipDeviceAttributeMultiprocessorCount, dev);
    (void)hipOccupancyMaxActiveBlocksPerMultiprocessor(&per_cu, fwd_megakernel, 256, 0);
    if (per_cu > 2) per_cu = 2;
    if (per_cu < 1) per_cu = 1;
    grid_blocks = cus * per_cu;
    if (grid_blocks > MAXBLK) grid_blocks = MAXBLK;
  }
  if (ws_size < WS_TOTAL) fprintf(stderr, "workspace too small: %zu < %zu\n", ws_size, (size_t)WS_TOTAL);
  Params p{};
  for (int i = 0; i < 35; ++i) p.in[i] = (const float*)d_in[i];
  p.out = (float*)d_out;
  p.ws = (unsigned char*)d_ws;
  (void)hipMemsetAsync((unsigned char*)d_ws + OFF_BAR, 0, 2048, stream);
  void* args[] = {&p};
  hipError_t e = hipLaunchCooperativeKernel((void*)fwd_megakernel, dim3(grid_blocks), dim3(256), args, 0, stream);
  if (e != hipSuccess) fprintf(stderr, "cooperative launch failed: %s (grid %d)\n", hipGetErrorString(e), grid_blocks);
}
```

```cpp
#include <hip/hip_runtime.h>
#include <hip/hip_cooperative_groups.h>
#include <cstdio>
#include <cstdint>
namespace cg = cooperative_groups;

typedef unsigned short bf16_t;
typedef short bf16x8 __attribute__((ext_vector_type(8)));
typedef float f32x4 __attribute__((ext_vector_type(4)));
typedef unsigned u32x4 __attribute__((ext_vector_type(4)));
typedef unsigned u32x2 __attribute__((ext_vector_type(2)));

constexpr int SEQ = 2048, BATCH = 16;
constexpr int D_IN = 9672, D_INP = 9728;
constexpr int RB = 4;
constexpr int TR = RB * SEQ;
constexpr int NROUND = BATCH / RB;
constexpr int NRT = TR / 128;
constexpr int NBC = TR / 8;
constexpr int MAXBLK = 512;
constexpr float EPS = 1e-6f;
constexpr float LOG2E = 1.4426950408889634f;
constexpr int C_DAQ = 0, C_DAK = 512, C_DAV = 1024, C_DAG = 1536, C_MBZ = 2048, C_XBC = 2560, C_DT = 3584,
              C_S5U = 3592, C_S5G = 4104, C_CQ = 4616, C_CKV = 4872, C_KR = 5000, C_MLG = 5064, C_GATE = 5576;
constexpr long LDP = D_INP;

constexpr size_t al256(size_t x) { return (x + 255) & ~size_t(255); }
constexpr size_t OFF_WINT = 0;
constexpr size_t OFF_WBRT = OFF_WINT + al256((size_t)2 * D_INP * 1024 * 2);
constexpr size_t OFF_WOUTT = OFF_WBRT + al256((size_t)2 * 4 * 1024 * 512 * 2);
constexpr size_t OFF_WGLUT = OFF_WOUTT + al256((size_t)2 * 1024 * 1024 * 2);
constexpr size_t OFF_WUQT = OFF_WGLUT + al256((size_t)2 * 512 * 512 * 2);
constexpr size_t OFF_WUKVT = OFF_WUQT + al256((size_t)2 * 768 * 256 * 2);
constexpr size_t OFF_KMAT = OFF_WUKVT + al256((size_t)2 * 1024 * 128 * 2);
constexpr size_t OFF_EMAT = OFF_KMAT + al256((size_t)2 * 32 * 128 * 128 * 2);
constexpr size_t OFF_FMAT = OFF_EMAT + al256((size_t)2 * 32 * 128 * 128 * 2);
constexpr size_t OFF_A8 = OFF_FMAT + al256((size_t)2 * 32 * 128 * 128 * 2);
constexpr size_t OFF_LAM = OFF_A8 + al256((size_t)2 * 32 * 64 * 2 * 4);
constexpr size_t OFF_H = OFF_LAM + 256;
constexpr size_t OFF_PROJ = OFF_H + al256((size_t)TR * 1024 * 2);
constexpr size_t OFF_XC = OFF_PROJ + al256((size_t)TR * D_INP * 2);
constexpr size_t OFF_DT = OFF_XC + al256((size_t)TR * 1024 * 2);
constexpr size_t OFF_ACUM = OFF_DT + al256((size_t)TR * 8 * 4);
constexpr size_t OFF_VTA = OFF_ACUM + al256((size_t)TR * 8 * 4);
constexpr size_t OFF_VTD = OFF_VTA + al256((size_t)RB * 4 * 128 * 2048 * 2);
constexpr size_t OFF_QM = OFF_VTD + al256((size_t)RB * 4 * 128 * 2048 * 2);
constexpr size_t OFF_KM = OFF_QM + al256((size_t)TR * 768 * 2);
constexpr size_t OFF_KN = OFF_KM + al256((size_t)TR * 768 * 2);
constexpr size_t OFF_ST = OFF_KN + al256((size_t)TR * 512 * 2);
constexpr size_t OFF_SIN = OFF_ST + al256((size_t)RB * 16 * 8 * 8192 * 4);
constexpr size_t OFF_MS = OFF_SIN + al256((size_t)RB * 16 * 8 * 8192 * 2);
constexpr size_t OFF_XS = OFF_MS + al256((size_t)MAXBLK * 128 * 128 * 2);
constexpr size_t OFF_E = OFF_XS + al256((size_t)MAXBLK * 128 * 64 * 2);
constexpr size_t OFF_HIN = OFF_E + al256((size_t)32 * 128 * NBC * 4);
constexpr size_t OFF_YG = OFF_HIN + al256((size_t)32 * 128 * NBC * 2);
constexpr size_t OFF_MERGED = OFF_YG + al256((size_t)TR * 512 * 2);
constexpr size_t OFF_BAR = OFF_MERGED + al256((size_t)TR * 1024 * 2);
constexpr size_t WS_TOTAL = OFF_BAR + 8192;

constexpr int SMEM_BYTES = 73728 + 4096;

struct Params {
  const float* in[35];
  float* out;
  unsigned char* ws;
};

#define MEMBAR() do { asm volatile("" ::: "memory"); __builtin_amdgcn_sched_barrier(0); } while (0)
__device__ __forceinline__ int otid() { int t = threadIdx.x; asm volatile("" : "+v"(t)); return t; }
__device__ __forceinline__ bf16_t f2bf(float f) {
  unsigned u = __float_as_uint(f);
  u += 0x7fffu + ((u >> 16) & 1u);
  return (bf16_t)(u >> 16);
}
__device__ __forceinline__ float bf2f(bf16_t b) { return __uint_as_float(((unsigned)b) << 16); }
__device__ __forceinline__ unsigned pack2(float a, float b) { return (unsigned)f2bf(a) | ((unsigned)f2bf(b) << 16); }
__device__ __forceinline__ float sigmoidf_(float x) { return 1.0f / (1.0f + __expf(-x)); }
__device__ __forceinline__ float siluf_(float x) { return x / (1.0f + __expf(-x)); }
__device__ __forceinline__ float gelu_tanh(float x) {
  float u = 0.7978845608028654f * (x + 0.044715f * x * x * x);
  float t = 1.0f - 2.0f / (__expf(2.0f * u) + 1.0f);
  return 0.5f * x * (1.0f + t);
}
__device__ __forceinline__ float wave_sum(float v) {
#pragma unroll
  for (int d = 32; d >= 1; d >>= 1) v += __shfl_xor(v, d, 64);
  return v;
}

__device__ __forceinline__ void block_global_handoff() {
  asm volatile("s_waitcnt vmcnt(0)" ::: "memory");
  __syncthreads();
  if (otid() < 64) {
    __builtin_amdgcn_fence(__ATOMIC_ACQUIRE, "agent");
    asm volatile("s_waitcnt vmcnt(0)" ::: "memory");
  }
  __syncthreads();
}
template <int R, bool T, bool SEG, int N>
__device__ __forceinline__ void g_load(u32x4 (&rg)[N], const bf16_t* __restrict__ P, long ld, int k0, long segs, int tid) {
#pragma unroll
  for (int i = 0; i < N; ++i) {
    const int ch = tid + i * 256;
    if (!T) {
      const int row = ch >> 3, kc = k0 + (ch & 7) * 8;
      const long ko = SEG ? ((long)(kc >> 4) * segs + (kc & 15)) : (long)kc;
      rg[i] = *(const u32x4*)(P + (long)row * ld + ko);
    } else {
      constexpr int CPR = R / 8;
      const int kk = ch / CPR, m0 = (ch % CPR) * 8;
      rg[i] = *(const u32x4*)(P + (long)(k0 + kk) * ld + m0);
    }
  }
}
template <int R, bool T, int N>
__device__ __forceinline__ void s_store(const u32x4 (&rg)[N], bf16_t* sm, int tid) {
  constexpr int LS = 72;
#pragma unroll
  for (int i = 0; i < N; ++i) {
    const int ch = tid + i * 256;
    if (!T) {
      const int row = ch >> 3, kc = (ch & 7) * 8;
      *(u32x4*)(sm + row * LS + kc) = rg[i];
    } else {
      constexpr int CPR = R / 8;
      const int kk = ch / CPR, m0 = (ch % CPR) * 8;
      bf16_t* d = sm + m0 * LS + kk;
      d[0 * LS] = (bf16_t)(rg[i].x & 0xffffu); d[1 * LS] = (bf16_t)(rg[i].x >> 16);
      d[2 * LS] = (bf16_t)(rg[i].y & 0xffffu); d[3 * LS] = (bf16_t)(rg[i].y >> 16);
      d[4 * LS] = (bf16_t)(rg[i].z & 0xffffu); d[5 * LS] = (bf16_t)(rg[i].z >> 16);
      d[6 * LS] = (bf16_t)(rg[i].w & 0xffffu); d[7 * LS] = (bf16_t)(rg[i].w >> 16);
    }
  }
}
template <int BN, bool TA, bool TB, bool SEGA>
__device__ __forceinline__ void gemm_tile(f32x4 (&acc)[4][BN / 32], const bf16_t* __restrict__ A, long lda,
                                          const bf16_t* __restrict__ B, long ldb, int K, bf16_t* smem, long segs = 0) {
  constexpr int LS = 72;
  constexpr int STAGE = 2 * 128 * LS;
  const int tid = otid(), w = tid >> 6, l = tid & 63, g = l >> 4, c = l & 15;
  const int wr = w >> 1, wc = w & 1;
  constexpr int NA = 4, NB = BN / 32;
  u32x4 ra[NA], rb[NB];
  const int nk = K / 64;
  g_load<128, TA, SEGA, NA>(ra, A, lda, 0, segs, tid);
  g_load<BN, TB, false, NB>(rb, B, ldb, 0, 0, tid);
  __syncthreads();
  s_store<128, TA, NA>(ra, smem, tid);
  s_store<BN, TB, NB>(rb, smem + 128 * LS, tid);
  __syncthreads();
  for (int kt = 0; kt < nk; ++kt) {
    const bf16_t* sA = smem + (kt & 1) * STAGE;
    const bf16_t* sB = sA + 128 * LS;
    if (kt + 1 < nk) {
      g_load<128, TA, SEGA, NA>(ra, A, lda, (kt + 1) * 64, segs, tid);
      g_load<BN, TB, false, NB>(rb, B, ldb, (kt + 1) * 64, 0, tid);
    }
    const bf16_t* pa = sA + (wr * 64 + c) * LS + g * 8;
    const bf16_t* pb = sB + (wc * (BN / 2) + c) * LS + g * 8;
#pragma unroll
    for (int ks = 0; ks < 2; ++ks) {
      bf16x8 af[4], bfr[BN / 32];
#pragma unroll
      for (int i = 0; i < 4; ++i) af[i] = *(const bf16x8*)(pa + i * 16 * LS + ks * 32);
#pragma unroll
      for (int j = 0; j < BN / 32; ++j) bfr[j] = *(const bf16x8*)(pb + j * 16 * LS + ks * 32);
#pragma unroll
      for (int i = 0; i < 4; ++i)
#pragma unroll
        for (int j = 0; j < BN / 32; ++j) acc[i][j] = __builtin_amdgcn_mfma_f32_16x16x32_bf16(af[i], bfr[j], acc[i][j], 0, 0, 0);
    }
    if (kt + 1 < nk) {
      bf16_t* nA = smem + ((kt + 1) & 1) * STAGE;
      s_store<128, TA, NA>(ra, nA, tid);
      s_store<BN, TB, NB>(rb, nA + 128 * LS, tid);
    }
    __syncthreads();
  }
}

template <int NJ>
__device__ __forceinline__ void zero_acc(f32x4 (&acc)[4][NJ]) {
#pragma unroll
  for (int i = 0; i < 4; ++i)
#pragma unroll
    for (int j = 0; j < NJ; ++j) acc[i][j] = (f32x4){0.f, 0.f, 0.f, 0.f};
}

__device__ __forceinline__ void tconv_tile(const float* __restrict__ src, bf16_t* __restrict__ dst, int K, int N, int tk, int tn, float* sm) {
  const int tid = otid();
  const int k0 = tk * 64, n0 = tn * 64;
  __syncthreads();
#pragma unroll 4
  for (int i = 0; i < 16; ++i) {
    const int kk = i * 4 + (tid >> 6), nn = tid & 63;
    float v = 0.f;
    if (n0 + nn < N) v = src[(long)(k0 + kk) * N + n0 + nn];
    sm[kk * 65 + nn] = v;
  }
  __syncthreads();
#pragma unroll 4
  for (int i = 0; i < 16; ++i) {
    const int nn = i * 4 + (tid >> 6), kk = tid & 63;
    dst[(long)(n0 + nn) * K + k0 + kk] = f2bf(sm[kk * 65 + nn]);
  }
}

__device__ __forceinline__ void tconv_job(const float* src, bf16_t* dst, int K, int N, int Npad, float* sm) {
  const int tkn = K / 64, tnn = Npad / 64;
  for (int t = blockIdx.x; t < tkn * tnn; t += gridDim.x) tconv_tile(src, dst, K, N, t % tkn, t / tkn, sm);
}

__device__ __forceinline__ void s5_prep(const Params& p, int layer, int grp, float* sm) {
  float* pwr = sm;
  float* pwi = pwr + 9 * 64;
  float* bbr = pwi + 9 * 64;
  float* bbi = bbr + 1024;
  float* cr = bbi + 1024;
  float* ci = cr + 1024;
  float* kt = ci + 1024;
  const int tid = otid();
  const int lg = layer * 32 + grp;
  __syncthreads();
  if (tid < 64) {
    const int pp = tid;
    const double step = exp((double)p.in[19][lg]);
    const double lr = (double)p.in[17][lg * 64 + pp], li = (double)p.in[18][lg * 64 + pp];
    const double mag = exp(lr * step);
    const double abr = mag * cos(li * step), abi = mag * sin(li * step);
    const double den = lr * lr + li * li;
    const double fr = ((abr - 1.0) * lr + abi * li) / den;
    const double fi = (abi * lr - (abr - 1.0) * li) / den;
    double qr = 1.0, qi = 0.0;
    for (int t = 0; t < 9; ++t) {
      pwr[t * 64 + pp] = (float)qr;
      pwi[t * 64 + pp] = (float)qi;
      const double nr = qr * abr - qi * abi, ni = qr * abi + qi * abr;
      qr = nr; qi = ni;
    }
    float* a8 = (float*)(p.ws + OFF_A8) + (size_t)(lg * 64 + pp) * 2;
    a8[0] = pwr[8 * 64 + pp];
    a8[1] = pwi[8 * 64 + pp];
    for (int cc = 0; cc < 16; ++cc) {
      const double br = (double)p.in[20][(lg * 64 + pp) * 16 + cc], bi = (double)p.in[21][(lg * 64 + pp) * 16 + cc];
      bbr[pp * 16 + cc] = (float)(fr * br - fi * bi);
      bbi[pp * 16 + cc] = (float)(fr * bi + fi * br);
    }
  }
  for (int e = tid; e < 1024; e += 256) {
    cr[e] = p.in[22][lg * 1024 + e];
    ci[e] = p.in[23][lg * 1024 + e];
  }
  __syncthreads();
  for (int e = tid; e < 2048; e += 256) {
    const int tau = e >> 8, co = (e >> 4) & 15, cin = e & 15;
    float s = 0.f;
    for (int pp = 0; pp < 64; ++pp) {
      const float pr = pwr[tau * 64 + pp], pi = pwi[tau * 64 + pp];
      const float zr = pr * bbr[pp * 16 + cin] - pi * bbi[pp * 16 + cin];
      const float zi = pr * bbi[pp * 16 + cin] + pi * bbr[pp * 16 + cin];
      s += cr[co * 64 + pp] * zr - ci[co * 64 + pp] * zi;
    }
    kt[e] = s;
  }
  __syncthreads();
  bf16_t* Km = (bf16_t*)(p.ws + OFF_KMAT) + (size_t)lg * 16384;
  bf16_t* Em = (bf16_t*)(p.ws + OFF_EMAT) + (size_t)lg * 16384;
  bf16_t* Fm = (bf16_t*)(p.ws + OFF_FMAT) + (size_t)lg * 16384;
  for (int e = tid; e < 16384; e += 256) {
    const int n = e >> 7, k = e & 127;
    {
      const int tq = n >> 4, co = n & 15, sq = k >> 4, cin = k & 15;
      Km[e] = f2bf(tq >= sq ? kt[((tq - sq) * 16 + co) * 16 + cin] : 0.f);
    }
    {
      const int pp = n >> 1, ri = n & 1, sq = k >> 4, cin = k & 15;
      const float pr = pwr[(7 - sq) * 64 + pp], pi = pwi[(7 - sq) * 64 + pp];
      const float zr = pr * bbr[pp * 16 + cin] - pi * bbi[pp * 16 + cin];
      const float zi = pr * bbi[pp * 16 + cin] + pi * bbr[pp * 16 + cin];
      Em[e] = f2bf(ri ? zi : zr);
    }
    {
      const int tq = n >> 4, co = n & 15, pp = k >> 1, ri = k & 1;
      const float pr = pwr[(tq + 1) * 64 + pp], pi = pwi[(tq + 1) * 64 + pp];
      const float gr = cr[co * 64 + pp] * pr - ci[co * 64 + pp] * pi;
      const float gi = cr[co * 64 + pp] * pi + ci[co * 64 + pp] * pr;
      Fm[e] = f2bf(ri ? -gi : gr);
    }
  }
}

__device__ __forceinline__ void phase_prep(const Params& p, float* smf) {
  for (int L = 0; L < 2; ++L) {
    tconv_job(p.in[3] + (size_t)L * 1024 * D_IN, (bf16_t*)(p.ws + OFF_WINT) + (size_t)L * D_INP * 1024, 1024, D_IN, D_INP, smf);
    for (int n = 0; n < 4; ++n)
      tconv_job(p.in[33] + (size_t)(L * 4 + n) * 512 * 1024, (bf16_t*)(p.ws + OFF_WBRT) + (size_t)(L * 4 + n) * 1024 * 512, 512, 1024, 1024, smf);
    tconv_job(p.in[34] + (size_t)L * 1024 * 1024, (bf16_t*)(p.ws + OFF_WOUTT) + (size_t)L * 1024 * 1024, 1024, 1024, 1024, smf);
    tconv_job(p.in[25] + (size_t)L * 512 * 512, (bf16_t*)(p.ws + OFF_WGLUT) + (size_t)L * 512 * 512, 512, 512, 512, smf);
    tconv_job(p.in[28] + (size_t)L * 256 * 768, (bf16_t*)(p.ws + OFF_WUQT) + (size_t)L * 768 * 256, 256, 768, 768, smf);
    tconv_job(p.in[30] + (size_t)L * 128 * 1024, (bf16_t*)(p.ws + OFF_WUKVT) + (size_t)L * 1024 * 128, 128, 1024, 1024, smf);
  }
  for (int it = blockIdx.x; it < 64; it += gridDim.x) s5_prep(p, it >> 5, it & 31, smf);
  if (blockIdx.x == gridDim.x - 1 && otid() < 2) {
    const int L = otid();
    float s1 = 0.f, s2 = 0.f;
    for (int i = 0; i < 64; ++i) {
      s1 += p.in[6][L * 64 + i] * p.in[7][L * 64 + i];
      s2 += p.in[8][L * 64 + i] * p.in[9][L * 64 + i];
    }
    const float li = 0.8f - 0.6f * expf(-0.3f * (float)L);
    ((float*)(p.ws + OFF_LAM))[L] = expf(s1) - expf(s2) + li;
  }
}

__device__ __forceinline__ void phase_hnorm(const float* __restrict__ x, const float* __restrict__ gn, bf16_t* __restrict__ H) {
  const int w = otid() >> 6, l = otid() & 63;
  for (int row = blockIdx.x * 4 + w; row < TR; row += gridDim.x * 4) {
    const float4* xr = (const float4*)(x + (size_t)row * 1024);
    float4 v[4];
    float ss = 0.f;
#pragma unroll
    for (int i = 0; i < 4; ++i) {
      v[i] = xr[i * 64 + l];
      ss += v[i].x * v[i].x + v[i].y * v[i].y + v[i].z * v[i].z + v[i].w * v[i].w;
    }
    ss = wave_sum(ss);
    const float rs = rsqrtf(ss * (1.0f / 1024.0f) + EPS);
#pragma unroll
    for (int i = 0; i < 4; ++i) {
      const float4 gg = ((const float4*)gn)[i * 64 + l];
      u32x2 o;
      o.x = pack2(v[i].x * rs * gg.x, v[i].y * rs * gg.y);
      o.y = pack2(v[i].z * rs * gg.z, v[i].w * rs * gg.w);
      *(u32x2*)(H + (size_t)row * 1024 + (i * 64 + l) * 4) = o;
    }
  }
}

__device__ __forceinline__ void inproj_tile(const Params& p, int layer, int rt, int ct, bf16_t* smem) {
  const bf16_t* H = (const bf16_t*)(p.ws + OFF_H);
  const bf16_t* W = (const bf16_t*)(p.ws + OFF_WINT) + (size_t)layer * D_INP * 1024;
  bf16_t* PROJ = (bf16_t*)(p.ws + OFF_PROJ);
  bf16_t* VTA = (bf16_t*)(p.ws + OFF_VTA);
  f32x4 acc[4][4];
  zero_acc<4>(acc);
  gemm_tile<128, false, false, false>(acc, H + (size_t)rt * 128 * 1024, 1024, W + (size_t)ct * 128 * 1024, 1024, 1024, smem);
  const int tid = otid(), w = tid >> 6, l = tid & 63, g = l >> 4, c = l & 15, wr = w >> 1, wc = w & 1;
  const int c0 = ct * 128;
  if (c0 >= C_DAV && c0 < C_DAG) {
    const int h = (c0 - C_DAV) >> 7;
#pragma unroll
    for (int i = 0; i < 4; ++i)
#pragma unroll
      for (int j = 0; j < 4; ++j) {
        const int row = rt * 128 + wr * 64 + i * 16 + g * 4;
        const int dv = wc * 64 + j * 16 + c;
        const int b = row >> 11, s = row & 2047;
        u32x2 o;
        o.x = pack2(acc[i][j][0], acc[i][j][1]);
        o.y = pack2(acc[i][j][2], acc[i][j][3]);
        *(u32x2*)(VTA + ((size_t)((b * 4 + h) * 128 + dv)) * 2048 + s) = o;
      }
  } else {
#pragma unroll
    for (int i = 0; i < 4; ++i) {
#pragma unroll
      for (int r = 0; r < 4; ++r) {
        const int row = rt * 128 + wr * 64 + i * 16 + g * 4 + r;
        bf16_t* rp = PROJ + (size_t)row * LDP + c0 + wc * 64 + c;
#pragma unroll
        for (int j = 0; j < 4; ++j) {
          float v = acc[i][j][r];
          if (c0 + wc * 64 + j * 16 + c >= C_GATE) v = sigmoidf_(v);
          rp[j * 16] = f2bf(v);
        }
      }
      MEMBAR();
    }
  }
}

__device__ __forceinline__ void tokpost_item(const Params& p, int layer, int round, int item) {
  bf16_t* PROJ = (bf16_t*)(p.ws + OFF_PROJ);
  const int* pos = (const int*)p.in[1];
  const int w = otid() >> 6, l = otid() & 63;
  for (int tt = 0; tt < 4; ++tt) {
    const int row = item * 16 + w * 4 + tt;
    const float fpos = (float)pos[round * TR + row];
    bf16_t* pr = PROJ + (size_t)row * LDP;
    {
      const int which = l >> 5, idx = (l & 31) * 16, off = (l & 3) * 16;
      bf16_t* ptr = pr + which * 512 + idx;
      u32x4 u0 = *(const u32x4*)ptr, u1 = *(const u32x4*)(ptr + 8);
      const unsigned uu[8] = {u0.x, u0.y, u0.z, u0.w, u1.x, u1.y, u1.z, u1.w};
      float v[16];
      float ss = 0.f;
#pragma unroll
      for (int e = 0; e < 8; ++e) {
        v[2 * e] = __uint_as_float(uu[e] << 16);
        v[2 * e + 1] = __uint_as_float(uu[e] & 0xffff0000u);
        ss += v[2 * e] * v[2 * e] + v[2 * e + 1] * v[2 * e + 1];
      }
      ss += __shfl_xor(ss, 1, 64);
      ss += __shfl_xor(ss, 2, 64);
      const float rs = rsqrtf(ss * (1.0f / 64.0f) + EPS);
      const float* gn = (which ? p.in[5] : p.in[4]) + layer * 64 + off;
#pragma unroll
      for (int e = 0; e < 16; ++e) v[e] = v[e] * rs * gn[e];
      if ((l & 3) == 0) {
#pragma unroll
        for (int i = 0; i < 8; ++i) {
          const float invf = expf(-13.122363377404328f * (float)i * 0.125f);
          const float ang = fpos * invf;
          const float cs = cosf(ang), sn = sinf(ang);
          const float x1 = v[i], x2 = v[i + 8];
          v[i] = x1 * cs - x2 * sn;
          v[i + 8] = x2 * cs + x1 * sn;
        }
      }
      if (which == 0) {
#pragma unroll
        for (int e = 0; e < 16; ++e) v[e] *= 0.125f * LOG2E;
      }
      u32x4 o0, o1;
      o0.x = pack2(v[0], v[1]); o0.y = pack2(v[2], v[3]); o0.z = pack2(v[4], v[5]); o0.w = pack2(v[6], v[7]);
      o1.x = pack2(v[8], v[9]); o1.y = pack2(v[10], v[11]); o1.z = pack2(v[12], v[13]); o1.w = pack2(v[14], v[15]);
      *(u32x4*)ptr = o0;
      *(u32x4*)(ptr + 8) = o1;
    }
    {
      bf16_t* ptr = pr + C_CQ + l * 4;
      u32x2 u = *(const u32x2*)ptr;
      float v0 = __uint_as_float(u.x << 16), v1 = __uint_as_float(u.x & 0xffff0000u);
      float v2 = __uint_as_float(u.y << 16), v3 = __uint_as_float(u.y & 0xffff0000u);
      float ss = wave_sum(v0 * v0 + v1 * v1 + v2 * v2 + v3 * v3);
      const float rs = rsqrtf(ss * (1.0f / 256.0f) + EPS);
      const float* gn = p.in[27] + layer * 256 + l * 4;
      u32x2 o;
      o.x = pack2(v0 * rs * gn[0], v1 * rs * gn[1]);
      o.y = pack2(v2 * rs * gn[2], v3 * rs * gn[3]);
      *(u32x2*)ptr = o;
    }
    {
      bf16_t* ptr = pr + C_CKV + l * 2;
      unsigned u = *(const unsigned*)ptr;
      float v0 = __uint_as_float(u << 16), v1 = __uint_as_float(u & 0xffff0000u);
      float ss = wave_sum(v0 * v0 + v1 * v1);
      const float rs = rsqrtf(ss * (1.0f / 128.0f) + EPS);
      const float* gn = p.in[29] + layer * 128 + l * 2;
      *(unsigned*)ptr = pack2(v0 * rs * gn[0], v1 * rs * gn[1]);
    }
  }
}

__device__ __forceinline__ void conv_item(const Params& p, int layer, int item) {
  const bf16_t* PROJ = (const bf16_t*)(p.ws + OFF_PROJ);
  bf16_t* XC = (bf16_t*)(p.ws + OFF_XC);
  const int chtile = item & 15, tt = (item >> 4) & 31, b = item >> 9;
  const int ch = chtile * 64 + (otid() & 63);
  const int tr0 = otid() >> 6;
  const float* cw = p.in[11] + (size_t)layer * 4 * 1024;
  const float w0 = cw[ch], w1 = cw[1024 + ch], w2 = cw[2048 + ch], w3 = cw[3072 + ch];
  const float bias = p.in[12][layer * 1024 + ch];
  for (int i0 = 0; i0 < 16; i0 += 8) {
    float x0[8], x1[8], x2[8], x3[8];
#pragma unroll
    for (int u = 0; u < 8; ++u) {
      const int t = tt * 64 + (i0 + u) * 4 + tr0;
      const bf16_t* base = PROJ + (size_t)(b * 2048 + t) * LDP + C_XBC + ch;
      x3[u] = bf2f(base[0]);
      x2[u] = (t >= 1) ? bf2f(*(base - LDP)) : 0.f;
      x1[u] = (t >= 2) ? bf2f(*(base - 2 * LDP)) : 0.f;
      x0[u] = (t >= 3) ? bf2f(*(base - 3 * LDP)) : 0.f;
    }
#pragma unroll
    for (int u = 0; u < 8; ++u) {
      const int t = tt * 64 + (i0 + u) * 4 + tr0;
      const float y = bias + w3 * x3[u] + w2 * x2[u] + w1 * x1[u] + w0 * x0[u];
      XC[(size_t)(b * 2048 + t) * 1024 + ch] = f2bf(siluf_(y));
    }
  }
}

__device__ __forceinline__ void dtacum_item(const Params& p, int layer, int item) {
  const bf16_t* PROJ = (const bf16_t*)(p.ws + OFF_PROJ);
  float* DT = (float*)(p.ws + OFF_DT);
  float* AC = (float*)(p.ws + OFF_ACUM);
  const int w = otid() >> 6, l = otid() & 63;
  const int id = item * 4 + w;
  const int h = id & 7, bc = id >> 3;
  const int row0 = bc * 128 + 2 * l;
  const float bias = p.in[13][layer * 8 + h];
  const float A = -expf(p.in[14][layer * 8 + h]);
  float x0 = bf2f(PROJ[(size_t)row0 * LDP + C_DT + h]) + bias;
  float x1 = bf2f(PROJ[(size_t)(row0 + 1) * LDP + C_DT + h]) + bias;
  const float d0 = x0 > 20.f ? x0 : log1pf(expf(x0));
  const float d1 = x1 > 20.f ? x1 : log1pf(expf(x1));
  const float a0 = d0 * A, a1 = d1 * A;
  float s = a0 + a1;
#pragma unroll
  for (int d = 1; d < 64; d <<= 1) {
    const float t = __shfl_up(s, d, 64);
    if (l >= d) s += t;
  }
  DT[(size_t)row0 * 8 + h] = d0;
  DT[(size_t)(row0 + 1) * 8 + h] = d1;
  AC[(size_t)row0 * 8 + h] = s - a1;
  AC[(size_t)(row0 + 1) * 8 + h] = s;
}

__device__ __forceinline__ void s5_e_item(const Params& p, int layer, int item, bf16_t* smem) {
  const bf16_t* PROJ = (const bf16_t*)(p.ws + OFF_PROJ);
  const int grp = item >> 3, mt = item & 7;
  const bf16_t* Em = (const bf16_t*)(p.ws + OFF_EMAT) + (size_t)(layer * 32 + grp) * 16384;
  float* E = (float*)(p.ws + OFF_E);
  f32x4 acc[4][4];
  zero_acc<4>(acc);
  gemm_tile<128, false, false, true>(acc, PROJ + (size_t)mt * 128 * 8 * LDP + C_S5U + grp * 16, 8 * LDP, Em, 128, 128, smem, LDP);
  const int tid = otid(), w = tid >> 6, l = tid & 63, g = l >> 4, c = l & 15, wr = w >> 1, wc = w & 1;
#pragma unroll
  for (int i = 0; i < 4; ++i)
#pragma unroll
    for (int j = 0; j < 4; ++j) {
      const int m = mt * 128 + wr * 64 + i * 16 + g * 4;
      const int n = wc * 64 + j * 16 + c;
      *(f32x4*)(E + ((size_t)(grp * 128 + n)) * NBC + m) = acc[i][j];
    }
}

__device__ __forceinline__ void mla_up_q_tile(const Params& p, int layer, int rt, int ct, bf16_t* smem) {
  const bf16_t* PROJ = (const bf16_t*)(p.ws + OFF_PROJ);
  const bf16_t* W = (const bf16_t*)(p.ws + OFF_WUQT) + (size_t)layer * 768 * 256;
  bf16_t* QM = (bf16_t*)(p.ws + OFF_QM);
  f32x4 acc[4][4];
  zero_acc<4>(acc);
  gemm_tile<128, false, false, false>(acc, PROJ + (size_t)rt * 128 * LDP + C_CQ, LDP, W + (size_t)ct * 128 * 256, 256, 256, smem);
  const int tid = otid(), w = tid >> 6, l = tid & 63, g = l >> 4, c = l & 15, wr = w >> 1, wc = w & 1;
#pragma unroll
  for (int i = 0; i < 4; ++i)
#pragma unroll
    for (int j = 0; j < 4; ++j)
#pragma unroll
      for (int r = 0; r < 4; ++r) {
        const int row = rt * 128 + wr * 64 + i * 16 + g * 4 + r, col = ct * 128 + wc * 64 + j * 16 + c;
        QM[(size_t)row * 768 + col] = f2bf(acc[i][j][r]);
      }
}
__device__ __forceinline__ void mla_up_kv_tile(const Params& p, int layer, int rt, int ct, bf16_t* smem) {
  const bf16_t* PROJ = (const bf16_t*)(p.ws + OFF_PROJ);
  const bf16_t* W = (const bf16_t*)(p.ws + OFF_WUKVT) + (size_t)layer * 1024 * 128;
  bf16_t* KN = (bf16_t*)(p.ws + OFF_KN);
  bf16_t* VTD = (bf16_t*)(p.ws + OFF_VTD);
  f32x4 acc[4][4];
  zero_acc<4>(acc);
  gemm_tile<128, false, false, false>(acc, PROJ + (size_t)rt * 128 * LDP + C_CKV, LDP, W + (size_t)ct * 128 * 128, 128, 128, smem);
  const int tid = otid(), w = tid >> 6, l = tid & 63, g = l >> 4, c = l & 15, wr = w >> 1, wc = w & 1;
  const int h = ct >> 1;
  if ((ct & 1) == 0) {
#pragma unroll
    for (int i = 0; i < 4; ++i)
#pragma unroll
      for (int j = 0; j < 4; ++j)
#pragma unroll
        for (int r = 0; r < 4; ++r) {
          const int row = rt * 128 + wr * 64 + i * 16 + g * 4 + r, cc = wc * 64 + j * 16 + c;
          KN[(size_t)row * 512 + h * 128 + cc] = f2bf(acc[i][j][r]);
        }
  } else {
#pragma unroll
    for (int i = 0; i < 4; ++i)
#pragma unroll
      for (int j = 0; j < 4; ++j) {
        const int row = rt * 128 + wr * 64 + i * 16 + g * 4, dv = wc * 64 + j * 16 + c;
        const int b = row >> 11, s = row & 2047;
        u32x2 o;
        o.x = pack2(acc[i][j][0], acc[i][j][1]);
        o.y = pack2(acc[i][j][2], acc[i][j][3]);
        *(u32x2*)(VTD + ((size_t)((b * 4 + h) * 128 + dv)) * 2048 + s) = o;
      }
  }
}

__device__ __forceinline__ void mb_states_item(const Params& p, int item, bf16_t* smem) {
  const bf16_t* XC = (const bf16_t*)(p.ws + OFF_XC);
  const float* DT = (const float*)(p.ws + OFF_DT);
  const float* AC = (const float*)(p.ws + OFF_ACUM);
  bf16_t* XS = (bf16_t*)(p.ws + OFF_XS) + (size_t)blockIdx.x * 128 * 64;
  float* ST = (float*)(p.ws + OFF_ST);
  const int h = item & 7, bc = item >> 3;
  const int grp = h >> 2;
  const int row0 = bc * 128;
  const int tid = otid();
  __syncthreads();
  const float alast = AC[(size_t)(row0 + 127) * 8 + h];
  for (int e0 = tid; e0 < 8192; e0 += 2048) {
    float dv[8], av[8];
    bf16_t xv[8];
#pragma unroll
    for (int u = 0; u < 8; ++u) {
      const int e = e0 + u * 256;
      const int row = row0 + (e >> 6);
      dv[u] = DT[(size_t)row * 8 + h];
      av[u] = AC[(size_t)row * 8 + h];
      xv[u] = XC[(size_t)row * 1024 + h * 64 + (e & 63)];
    }
#pragma unroll
    for (int u = 0; u < 8; ++u) XS[e0 + u * 256] = f2bf(bf2f(xv[u]) * dv[u] * __expf(alast - av[u]));
  }
  block_global_handoff();
  f32x4 acc[4][2];
  zero_acc<2>(acc);
  gemm_tile<64, true, true, false>(acc, XC + (size_t)row0 * 1024 + 512 + grp * 128, 1024, XS, 64, 128, smem);
  const int w = tid >> 6, l = tid & 63, g = l >> 4, c = l & 15, wr = w >> 1, wc = w & 1;
#pragma unroll
  for (int i = 0; i < 4; ++i)
#pragma unroll
    for (int j = 0; j < 2; ++j) {
      const int n = wr * 64 + i * 16 + g * 4;
      const int pp = wc * 32 + j * 16 + c;
      *(f32x4*)(ST + ((size_t)(bc * 8 + h) * 64 + pp) * 128 + n) = acc[i][j];
    }
}

__device__ __forceinline__ void s5_carry_item(const Params& p, int layer, int item) {
  const int idx = item * 256 + otid();
  const int b = idx >> 11, grp = (idx >> 6) & 31, pp = idx & 63;
  const float* a8 = (const float*)(p.ws + OFF_A8) + (size_t)((layer * 32 + grp) * 64 + pp) * 2;
  const float ar = a8[0], ai = a8[1];
  const float* er = (const float*)(p.ws + OFF_E) + ((size_t)(grp * 128 + 2 * pp)) * NBC + b * 256;
  const float* ei = er + NBC;
  bf16_t* hro = (bf16_t*)(p.ws + OFF_HIN) + ((size_t)(grp * 128 + 2 * pp)) * NBC + b * 256;
  bf16_t* hio = hro + NBC;
  float hr = 0.f, hi = 0.f;
  for (int c16 = 0; c16 < 16; ++c16) {
    f32x4 vr[4], vi[4];
#pragma unroll
    for (int u = 0; u < 4; ++u) {
      vr[u] = *(const f32x4*)(er + c16 * 16 + u * 4);
      vi[u] = *(const f32x4*)(ei + c16 * 16 + u * 4);
    }
#pragma unroll
    for (int u = 0; u < 4; ++u) {
      float orr[4], oii[4];
#pragma unroll
      for (int k = 0; k < 4; ++k) {
        orr[k] = hr; oii[k] = hi;
        const float nr = ar * hr - ai * hi + vr[u][k];
        const float ni = ar * hi + ai * hr + vi[u][k];
        hr = nr; hi = ni;
      }
      u32x2 o0, o1;
      o0.x = pack2(orr[0], orr[1]); o0.y = pack2(orr[2], orr[3]);
      o1.x = pack2(oii[0], oii[1]); o1.y = pack2(oii[2], oii[3]);
      *(u32x2*)(hro + c16 * 16 + u * 4) = o0;
      *(u32x2*)(hio + c16 * 16 + u * 4) = o1;
    }
  }
}

__device__ __forceinline__ void mlapost_item(const Params& p, int layer, int round, int item) {
  const bf16_t* PROJ = (const bf16_t*)(p.ws + OFF_PROJ);
  bf16_t* QM = (bf16_t*)(p.ws + OFF_QM);
  bf16_t* KM = (bf16_t*)(p.ws + OFF_KM);
  const bf16_t* KN = (const bf16_t*)(p.ws + OFF_KN);
  const int* pos = (const int*)p.in[1];
  const int w = otid() >> 6, l = otid() & 63;
  const float* qn = p.in[31] + layer * 192;
  const float* kn = p.in[32] + layer * 192;
  const float q0 = qn[l], q1 = qn[64 + l], q2 = qn[128 + l];
  const float k0 = kn[l], k1 = kn[64 + l], k2 = kn[128 + l];
  const float invf = expf(-13.122363377404328f * (float)(l & 31) * (1.0f / 32.0f));
  const float qscale = 0.07216878364870322f * LOG2E;
  for (int tt = 0; tt < 4; ++tt) {
    const int row = item * 16 + w * 4 + tt;
    const float ang = (float)pos[round * TR + row] * invf;
    const float cs = cosf(ang), sn = sinf(ang);
    const float kr = bf2f(PROJ[(size_t)row * LDP + C_KR + l]);
#pragma unroll
    for (int h = 0; h < 4; ++h) {
      {
        bf16_t* qp = QM + (size_t)row * 768 + h * 192;
        float e0 = bf2f(qp[l]), e1 = bf2f(qp[64 + l]), e2 = bf2f(qp[128 + l]);
        const float ss = wave_sum(e0 * e0 + e1 * e1 + e2 * e2);
        const float rs = rsqrtf(ss * (1.0f / 192.0f) + EPS);
        e0 *= rs * q0; e1 *= rs * q1; e2 *= rs * q2;
        const float ot = __shfl_xor(e2, 32, 64);
        e2 = (l < 32) ? (e2 * cs - ot * sn) : (e2 * cs + ot * sn);
        qp[l] = f2bf(e0 * qscale); qp[64 + l] = f2bf(e1 * qscale); qp[128 + l] = f2bf(e2 * qscale);
      }
      {
        const bf16_t* kp = KN + (size_t)row * 512 + h * 128;
        float e0 = bf2f(kp[l]), e1 = bf2f(kp[64 + l]), e2 = kr;
        const float ss = wave_sum(e0 * e0 + e1 * e1 + e2 * e2);
        const float rs = rsqrtf(ss * (1.0f / 192.0f) + EPS);
        e0 *= rs * k0; e1 *= rs * k1; e2 *= rs * k2;
        const float ot = __shfl_xor(e2, 32, 64);
        e2 = (l < 32) ? (e2 * cs - ot * sn) : (e2 * cs + ot * sn);
        bf16_t* ko = KM + (size_t)row * 768 + h * 192;
        ko[l] = f2bf(e0); ko[64 + l] = f2bf(e1); ko[128 + l] = f2bf(e2);
      }
    }
  }
}

__device__ __forceinline__ void mb_scan_item(const Params& p, int item) {
  const int idx = item * 256 + otid();
  const int b = idx >> 16, h = (idx >> 13) & 7, pn = idx & 8191;
  const float* ST = (const float*)(p.ws + OFF_ST);
  const float* AC = (const float*)(p.ws + OFF_ACUM);
  bf16_t* SIN = (bf16_t*)(p.ws + OFF_SIN);
  float cur = 0.f;
  float alv[16], stv[16];
#pragma unroll
  for (int c = 0; c < 16; ++c) {
    alv[c] = AC[(size_t)(b * 2048 + c * 128 + 127) * 8 + h];
    stv[c] = ST[((size_t)((b * 16 + c) * 8 + h)) * 8192 + pn];
  }
#pragma unroll
  for (int c = 0; c < 16; ++c) {
    SIN[((size_t)((b * 16 + c) * 8 + h)) * 8192 + pn] = f2bf(cur);
    cur = __expf(alv[c]) * cur + stv[c];
  }
}

__device__ __forceinline__ void s5_y_item(const Params& p, int layer, int item, bf16_t* smem) {
  const bf16_t* PROJ = (const bf16_t*)(p.ws + OFF_PROJ);
  const int grp = item >> 3, mt = item & 7;
  const bf16_t* Km = (const bf16_t*)(p.ws + OFF_KMAT) + (size_t)(layer * 32 + grp) * 16384;
  const bf16_t* Fm = (const bf16_t*)(p.ws + OFF_FMAT) + (size_t)(layer * 32 + grp) * 16384;
  const bf16_t* HIN = (const bf16_t*)(p.ws + OFF_HIN) + (size_t)grp * 128 * NBC + mt * 128;
  bf16_t* YG = (bf16_t*)(p.ws + OFF_YG);
  f32x4 acc[4][4];
  zero_acc<4>(acc);
  gemm_tile<128, false, false, true>(acc, PROJ + (size_t)mt * 128 * 8 * LDP + C_S5U + grp * 16, 8 * LDP, Km, 128, 128, smem, LDP);
  gemm_tile<128, true, false, false>(acc, HIN, NBC, Fm, 128, 128, smem);
  const int tid = otid(), w = tid >> 6, l = tid & 63, g = l >> 4, c = l & 15, wr = w >> 1, wc = w & 1;
  const float* dsk = p.in[24] + layer * 512;
#pragma unroll
  for (int i = 0; i < 4; ++i)
#pragma unroll
    for (int j = 0; j < 4; ++j) {
      const int n = wc * 64 + j * 16 + c;
      const int tq = n >> 4, co = n & 15;
      const int ch = grp * 16 + co;
      const float dd = dsk[ch];
#pragma unroll
      for (int r = 0; r < 4; ++r) {
        const int m = mt * 128 + wr * 64 + i * 16 + g * 4 + r;
        const int row = m * 8 + tq;
        const float u = bf2f(PROJ[(size_t)row * LDP + C_S5U + ch]);
        const float y = acc[i][j][r] + dd * u;
        YG[(size_t)row * 512 + ch] = f2bf(gelu_tanh(y));
      }
    }
}

template <int DK, int NM>
__device__ __forceinline__ void attn_core(const bf16_t* __restrict__ Qb, long ldq, const bf16_t* __restrict__ Kb, long ldk,
                                          const bf16_t* __restrict__ Vt, int qb, bf16_t* smem, f32x4 (&O)[NM][8], float (&lsum)[NM][4]) {
  constexpr int KST = DK + 8;
  constexpr int KCH = NM * 64 * DK / 8 / 256;
  constexpr int CPM = 64 * DK / 8;
  constexpr int CPRK = DK / 8;
  bf16_t* sK = smem;
  bf16_t* sV = sK + NM * 64 * KST;
  bf16_t* sP = sV + 128 * 72;
  const int tid = otid(), w = tid >> 6, l = tid & 63, g = l >> 4, c = l & 15;
  bf16x8 qf[NM][DK / 32];
  {
    const long qrow = (long)qb * 64 + w * 16 + c;
#pragma unroll
    for (int m = 0; m < NM; ++m)
#pragma unroll
      for (int ks = 0; ks < DK / 32; ++ks) qf[m][ks] = *(const bf16x8*)(Qb + qrow * ldq + m * DK + ks * 32 + g * 8);
  }
  float mrow[NM][4];
#pragma unroll
  for (int m = 0; m < NM; ++m) {
#pragma unroll
    for (int r = 0; r < 4; ++r) { mrow[m][r] = -INFINITY; lsum[m][r] = 0.f; }
#pragma unroll
    for (int nt = 0; nt < 8; ++nt) O[m][nt] = (f32x4){0.f, 0.f, 0.f, 0.f};
  }
  u32x4 kr[KCH], vr[4];
  auto gloadK = [&](int kt) {
#pragma unroll
    for (int i = 0; i < KCH; ++i) {
      const int ch = tid + i * 256;
      const int m = ch / CPM, cc = ch % CPM;
      const int key = cc / CPRK, d0 = (cc % CPRK) * 8;
      kr[i] = *(const u32x4*)(Kb + (long)(kt * 64 + key) * ldk + m * DK + d0);
    }
  };
  auto gloadV = [&](int kt) {
#pragma unroll
    for (int i = 0; i < 4; ++i) {
      const int ch = tid + i * 256;
      const int dvr = ch >> 3, kc = (ch & 7) * 8;
      vr[i] = *(const u32x4*)(Vt + (long)dvr * 2048 + kt * 64 + kc);
    }
  };
  gloadK(0);
  gloadV(0);
  for (int kt = 0; kt <= qb; ++kt) {
    __syncthreads();
#pragma unroll
    for (int i = 0; i < KCH; ++i) {
      const int ch = tid + i * 256;
      const int m = ch / CPM, cc = ch % CPM;
      const int key = cc / CPRK, d0 = (cc % CPRK) * 8;
      *(u32x4*)(sK + (m * 64 + key) * KST + d0) = kr[i];
    }
#pragma unroll
    for (int i = 0; i < 4; ++i) {
      const int ch = tid + i * 256;
      const int dvr = ch >> 3, kc = (ch & 7) * 8;
      *(u32x4*)(sV + dvr * 72 + kc) = vr[i];
    }
    __syncthreads();
    if (kt < qb) gloadK(kt + 1);
#pragma unroll
    for (int m = 0; m < NM; ++m) {
      f32x4 S[4];
#pragma unroll
      for (int nt = 0; nt < 4; ++nt) {
        S[nt] = (f32x4){0.f, 0.f, 0.f, 0.f};
#pragma unroll
        for (int ks = 0; ks < DK / 32; ++ks) {
          const bf16x8 kf = *(const bf16x8*)(sK + (m * 64 + nt * 16 + c) * KST + ks * 32 + g * 8);
          S[nt] = __builtin_amdgcn_mfma_f32_16x16x32_bf16(qf[m][ks], kf, S[nt], 0, 0, 0);
        }
        MEMBAR();
      }
      if (kt == qb) {
#pragma unroll
        for (int nt = 0; nt < 4; ++nt)
#pragma unroll
          for (int r = 0; r < 4; ++r)
            if (nt * 16 + c > w * 16 + g * 4 + r) S[nt][r] = -INFINITY;
      }
      bf16_t* pw = sP + (size_t)((w * NM + m) * 16) * 72;
#pragma unroll
      for (int r = 0; r < 4; ++r) {
        float mx = fmaxf(fmaxf(S[0][r], S[1][r]), fmaxf(S[2][r], S[3][r]));
        mx = fmaxf(mx, __shfl_xor(mx, 1, 64));
        mx = fmaxf(mx, __shfl_xor(mx, 2, 64));
        mx = fmaxf(mx, __shfl_xor(mx, 4, 64));
        mx = fmaxf(mx, __shfl_xor(mx, 8, 64));
        const float mnew = fmaxf(mrow[m][r], mx);
        const float sc = __builtin_amdgcn_exp2f(mrow[m][r] - mnew);
        mrow[m][r] = mnew;
        float ps = 0.f;
#pragma unroll
        for (int nt = 0; nt < 4; ++nt) {
          const float pv = __builtin_amdgcn_exp2f(S[nt][r] - mnew);
          ps += pv;
          pw[(g * 4 + r) * 72 + nt * 16 + c] = f2bf(pv);
        }
        ps += __shfl_xor(ps, 1, 64);
        ps += __shfl_xor(ps, 2, 64);
        ps += __shfl_xor(ps, 4, 64);
        ps += __shfl_xor(ps, 8, 64);
        lsum[m][r] = lsum[m][r] * sc + ps;
#pragma unroll
        for (int nt = 0; nt < 8; ++nt) O[m][nt][r] *= sc;
      }
    }
    __syncthreads();
    if (kt < qb) gloadV(kt + 1);
#pragma unroll
    for (int m = 0; m < NM; ++m) {
      const bf16_t* pw = sP + (size_t)((w * NM + m) * 16) * 72;
#pragma unroll
      for (int ks = 0; ks < 2; ++ks) {
        const bf16x8 pf = *(const bf16x8*)(pw + c * 72 + ks * 32 + g * 8);
#pragma unroll
        for (int nt = 0; nt < 8; ++nt) {
          const bf16x8 vf = *(const bf16x8*)(sV + (nt * 16 + c) * 72 + ks * 32 + g * 8);
          O[m][nt] = __builtin_amdgcn_mfma_f32_16x16x32_bf16(pf, vf, O[m][nt], 0, 0, 0);
        }
        MEMBAR();
      }
    }
  }
}

__device__ __forceinline__ void da_attn_item(const Params& p, int layer, int bh, int qb, bf16_t* smem, bool dry = false) {
  bf16_t* PROJ = (bf16_t*)(p.ws + OFF_PROJ);
  const bf16_t* VTA = (const bf16_t*)(p.ws + OFF_VTA);
  const int b = bh >> 2, h = bh & 3;
  f32x4 O[2][8];
  float ls[2][4];
  {
    f32x4 O1[1][8];
    float l1[1][4];
#pragma unroll 1
    for (int m = 0; m < 2; ++m) {
      attn_core<64, 1>(PROJ + (size_t)b * 2048 * LDP + C_DAQ + h * 128 + m * 64, LDP, PROJ + (size_t)b * 2048 * LDP + C_DAK + h * 128 + m * 64, LDP,
                       VTA + (size_t)(b * 4 + h) * 128 * 2048, qb, smem, O1, l1);
      if (m == 0) {
#pragma unroll
        for (int nt = 0; nt < 8; ++nt) O[0][nt] = O1[0][nt];
#pragma unroll
        for (int r = 0; r < 4; ++r) ls[0][r] = l1[0][r];
      } else {
#pragma unroll
        for (int nt = 0; nt < 8; ++nt) O[1][nt] = O1[0][nt];
#pragma unroll
        for (int r = 0; r < 4; ++r) ls[1][r] = l1[0][r];
      }
    }
  }
  const int tid = otid(), w = tid >> 6, l = tid & 63, g = l >> 4, c = l & 15;
  const float lam = ((const float*)(p.ws + OFF_LAM))[layer];
  const float linit = 0.8f - 0.6f * expf(-0.3f * (float)layer);
  const float* sg = p.in[10] + layer * 128;
#pragma unroll
  for (int r = 0; r < 4; ++r) {
    const float i0 = 1.0f / ls[0][r], i1 = lam / ls[1][r];
    float o[8];
    float ss = 0.f;
#pragma unroll
    for (int nt = 0; nt < 8; ++nt) {
      o[nt] = O[0][nt][r] * i0 - O[1][nt][r] * i1;
      ss += o[nt] * o[nt];
    }
    ss += __shfl_xor(ss, 1, 64);
    ss += __shfl_xor(ss, 2, 64);
    ss += __shfl_xor(ss, 4, 64);
    ss += __shfl_xor(ss, 8, 64);
    const float rs = rsqrtf(ss * (1.0f / 128.0f) + EPS) * (1.0f - linit);
    const size_t row = (size_t)b * 2048 + qb * 64 + w * 16 + g * 4 + r;
#pragma unroll
    for (int nt = 0; nt < 8; ++nt) {
      const int dv = nt * 16 + c;
      bf16_t* gp = PROJ + row * LDP + C_DAG + h * 128 + dv;
      const float gt = bf2f(*gp);
      if (!dry) *gp = f2bf(o[nt] * rs * sg[dv] * siluf_(gt));
    }
  }
}

__device__ __forceinline__ void mla_attn_item(const Params& p, int bh, int qb, bf16_t* smem, bool dry = false) {
  bf16_t* PROJ = (bf16_t*)(p.ws + OFF_PROJ);
  const bf16_t* QM = (const bf16_t*)(p.ws + OFF_QM);
  const bf16_t* KM = (const bf16_t*)(p.ws + OFF_KM);
  const bf16_t* VTD = (const bf16_t*)(p.ws + OFF_VTD);
  const int b = bh >> 2, h = bh & 3;
  f32x4 O[1][8];
  float ls[1][4];
  attn_core<192, 1>(QM + (size_t)b * 2048 * 768 + h * 192, 768, KM + (size_t)b * 2048 * 768 + h * 192, 768,
                    VTD + (size_t)(b * 4 + h) * 128 * 2048, qb, smem, O, ls);
  const int tid = otid(), w = tid >> 6, l = tid & 63, g = l >> 4, c = l & 15;
#pragma unroll
  for (int r = 0; r < 4; ++r) {
    const float i0 = 1.0f / ls[0][r];
    const size_t row = (size_t)b * 2048 + qb * 64 + w * 16 + g * 4 + r;
#pragma unroll
    for (int nt = 0; nt < 8; ++nt) {
      const int dv = nt * 16 + c;
      bf16_t* gp = PROJ + row * LDP + C_MLG + h * 128 + dv;
      const float gt = bf2f(*gp);
      if (!dry) *gp = f2bf(O[0][nt][r] * i0 * siluf_(gt));
    }
  }
}

__device__ __forceinline__ void mb_out_item(const Params& p, int layer, int item, bf16_t* smem) {
  bf16_t* PROJ = (bf16_t*)(p.ws + OFF_PROJ);
  const bf16_t* XC = (const bf16_t*)(p.ws + OFF_XC);
  const float* DT = (const float*)(p.ws + OFF_DT);
  const float* AC = (const float*)(p.ws + OFF_ACUM);
  const bf16_t* SIN = (const bf16_t*)(p.ws + OFF_SIN);
  bf16_t* MS = (bf16_t*)(p.ws + OFF_MS) + (size_t)blockIdx.x * 128 * 128;
  float* rowss = (float*)((unsigned char*)smem + 73728);
  const int grp = item & 1, bc = item >> 1;
  const int row0 = bc * 128;
  __syncthreads();
  const bf16_t* Cp = XC + (size_t)row0 * 1024 + 768 + grp * 128;
  const bf16_t* Bp = XC + (size_t)row0 * 1024 + 512 + grp * 128;
#pragma unroll 1
  for (int r4 = 0; r4 < 4; ++r4) {
    const int h = grp * 4 + r4;
    const int tid = otid(), w = tid >> 6, l = tid & 63, g = l >> 4, c = l & 15, wr = w >> 1, wc = w & 1;
    {
      f32x4 cb[4][4];
      zero_acc<4>(cb);
      gemm_tile<128, false, false, false>(cb, Cp, 1024, Bp, 1024, 128, smem);
      float acs[4], dts[4];
#pragma unroll
      for (int j = 0; j < 4; ++j) {
        const int s = wc * 64 + j * 16 + c;
        acs[j] = AC[(size_t)(row0 + s) * 8 + h];
        dts[j] = DT[(size_t)(row0 + s) * 8 + h];
      }
#pragma unroll
      for (int i = 0; i < 4; ++i)
#pragma unroll
        for (int r = 0; r < 4; ++r) {
          const int lr = wr * 64 + i * 16 + g * 4 + r;
          const float acl = AC[(size_t)(row0 + lr) * 8 + h];
#pragma unroll
          for (int j = 0; j < 4; ++j) {
            const int s = wc * 64 + j * 16 + c;
            const float v = (s <= lr) ? cb[i][j][r] * __expf(acl - acs[j]) * dts[j] : 0.f;
            MS[lr * 128 + s] = f2bf(v);
          }
          MEMBAR();
        }
    }
    block_global_handoff();
    f32x4 ad[4][2], ao[4][2];
    zero_acc<2>(ad);
    zero_acc<2>(ao);
    gemm_tile<64, false, true, false>(ad, MS, 128, XC + (size_t)row0 * 1024 + h * 64, 1024, 128, smem);
    gemm_tile<64, false, false, false>(ao, Cp, 1024, SIN + ((size_t)(bc * 8 + h)) * 8192, 128, 128, smem);
    const float dsk = p.in[15][layer * 8 + h];
#pragma unroll
    for (int i = 0; i < 4; ++i)
#pragma unroll
      for (int r = 0; r < 4; ++r) {
        const int lr = wr * 64 + i * 16 + g * 4 + r;
        const size_t row = (size_t)row0 + lr;
        const float ea = __expf(AC[row * 8 + h]);
        float ssq = 0.f;
#pragma unroll
        for (int j = 0; j < 2; ++j) {
          const int ch = h * 64 + wc * 32 + j * 16 + c;
          const float xv = bf2f(XC[row * 1024 + ch]);
          bf16_t* zp = PROJ + row * LDP + C_MBZ + ch;
          const float z = bf2f(*zp);
          float y = ad[i][j][r] + ea * ao[i][j][r] + dsk * xv;
          y *= siluf_(z);
          ssq += y * y;
          *zp = f2bf(y);
        }
        ssq += __shfl_xor(ssq, 1, 64);
        ssq += __shfl_xor(ssq, 2, 64);
        ssq += __shfl_xor(ssq, 4, 64);
        ssq += __shfl_xor(ssq, 8, 64);
        if (c == 0) rowss[(r4 * 2 + wc) * 128 + lr] = ssq;
        MEMBAR();
      }
  }
  block_global_handoff();
  const float* ng = p.in[16] + layer * 512 + grp * 256;
  {
    const int cc = otid();
    const float gcc = ng[cc];
    for (int l0 = 0; l0 < 128; l0 += 16) {
      bf16_t vals[16];
#pragma unroll
      for (int u = 0; u < 16; ++u) vals[u] = PROJ[(size_t)(row0 + l0 + u) * LDP + C_MBZ + grp * 256 + cc];
#pragma unroll
      for (int u = 0; u < 16; ++u) {
        const int lr = l0 + u;
        float tot = 0.f;
#pragma unroll
        for (int q = 0; q < 8; ++q) tot += rowss[q * 128 + lr];
        PROJ[(size_t)(row0 + lr) * LDP + C_MBZ + grp * 256 + cc] = f2bf(bf2f(vals[u]) * rsqrtf(tot * (1.0f / 256.0f) + EPS) * gcc);
      }
    }
  }
}

__device__ __forceinline__ void s5_glu_tile(const Params& p, int layer, int rt, int ct, bf16_t* smem) {
  bf16_t* PROJ = (bf16_t*)(p.ws + OFF_PROJ);
  const bf16_t* YG = (const bf16_t*)(p.ws + OFF_YG);
  const bf16_t* W = (const bf16_t*)(p.ws + OFF_WGLUT) + (size_t)layer * 512 * 512;
  f32x4 acc[4][4];
  zero_acc<4>(acc);
  gemm_tile<128, false, false, false>(acc, YG + (size_t)rt * 128 * 512, 512, W + (size_t)ct * 128 * 512, 512, 512, smem);
  const int tid = otid(), w = tid >> 6, l = tid & 63, g = l >> 4, c = l & 15, wr = w >> 1, wc = w & 1;
  const float* bg = p.in[26] + layer * 512;
#pragma unroll
  for (int i = 0; i < 4; ++i)
#pragma unroll
    for (int j = 0; j < 4; ++j) {
      const int col = ct * 128 + wc * 64 + j * 16 + c;
      const float bb = bg[col];
#pragma unroll
      for (int r = 0; r < 4; ++r) {
        const size_t row = (size_t)rt * 128 + wr * 64 + i * 16 + g * 4 + r;
        const float yv = bf2f(YG[row * 512 + col]);
        bf16_t* gp = PROJ + row * LDP + C_S5G + col;
        const float gt = bf2f(*gp);
        *gp = f2bf(yv * sigmoidf_(acc[i][j][r] + bb) * siluf_(gt));
      }
    }
}

__device__ __forceinline__ void merge_tile(const Params& p, int layer, int rt, int ct, bf16_t* smem) {
  const bf16_t* PROJ = (const bf16_t*)(p.ws + OFF_PROJ);
  bf16_t* MG = (bf16_t*)(p.ws + OFF_MERGED);
  f32x4 macc[4][2];
  zero_acc<2>(macc);
  const int tid = otid(), w = tid >> 6, l = tid & 63, g = l >> 4, c = l & 15, wr = w >> 1, wc = w & 1;
  for (int n = 0; n < 4; ++n) {
    const int ycol = (n == 0) ? C_DAG : (n == 1) ? C_MBZ : (n == 2) ? C_S5G : C_MLG;
    const bf16_t* W = (const bf16_t*)(p.ws + OFF_WBRT) + (size_t)(layer * 4 + n) * 1024 * 512;
    f32x4 acc[4][2];
    zero_acc<2>(acc);
    gemm_tile<64, false, false, false>(acc, PROJ + (size_t)rt * 128 * LDP + ycol, LDP, W + (size_t)ct * 64 * 512, 512, 512, smem);
#pragma unroll
    for (int i = 0; i < 4; ++i) {
#pragma unroll
      for (int r = 0; r < 4; ++r) {
        const size_t row = (size_t)rt * 128 + wr * 64 + i * 16 + g * 4 + r;
        const bf16_t* gp = PROJ + row * LDP + C_GATE + n * 1024 + ct * 64 + wc * 32 + c;
#pragma unroll
        for (int j = 0; j < 2; ++j) macc[i][j][r] += bf2f(gp[j * 16]) * acc[i][j][r];
      }
      MEMBAR();
    }
  }
#pragma unroll
  for (int i = 0; i < 4; ++i) {
#pragma unroll
    for (int r = 0; r < 4; ++r) {
      const size_t row = (size_t)rt * 128 + wr * 64 + i * 16 + g * 4 + r;
      bf16_t* op = MG + row * 1024 + ct * 64 + wc * 32 + c;
#pragma unroll
      for (int j = 0; j < 2; ++j) op[j * 16] = f2bf(macc[i][j][r]);
    }
    MEMBAR();
  }
}

__device__ __forceinline__ void out_tile(const Params& p, int layer, const float* xo, float* xn, int rt, int ct, bf16_t* smem) {
  const bf16_t* MG = (const bf16_t*)(p.ws + OFF_MERGED);
  const bf16_t* W = (const bf16_t*)(p.ws + OFF_WOUTT) + (size_t)layer * 1024 * 1024;
  f32x4 acc[4][4];
  zero_acc<4>(acc);
  gemm_tile<128, false, false, false>(acc, MG + (size_t)rt * 128 * 1024, 1024, W + (size_t)ct * 128 * 1024, 1024, 1024, smem);
  const int tid = otid(), w = tid >> 6, l = tid & 63, g = l >> 4, c = l & 15, wr = w >> 1, wc = w & 1;
#pragma unroll
  for (int i = 0; i < 4; ++i)
#pragma unroll
    for (int j = 0; j < 4; ++j) {
      const int col = ct * 128 + wc * 64 + j * 16 + c;
#pragma unroll
      for (int r = 0; r < 4; ++r) {
        const size_t row = (size_t)rt * 128 + wr * 64 + i * 16 + g * 4 + r;
        xn[row * 1024 + col] = xo[row * 1024 + col] + acc[i][j][r];
      }
    }
}

__device__ __forceinline__ void gsync(cg::grid_group& grid, unsigned* bar, unsigned& epoch) {
  asm volatile("s_waitcnt vmcnt(0)" ::: "memory");
  __syncthreads();
  if (otid() == 0) {
    unsigned long long* w = (unsigned long long*)bar;
    __builtin_amdgcn_fence(__ATOMIC_RELEASE, "agent");
    asm volatile("s_waitcnt vmcnt(0)" ::: "memory");
    const unsigned long long old = __hip_atomic_fetch_add(w, 1ull, __ATOMIC_RELAXED, __HIP_MEMORY_SCOPE_AGENT);
    const unsigned G = gridDim.x;
    if ((unsigned)(old & 0xffffffffull) == G - 1) {
      __hip_atomic_fetch_add(w, (1ull << 32) - (unsigned long long)G, __ATOMIC_RELAXED, __HIP_MEMORY_SCOPE_AGENT);
    } else {
      const unsigned g0 = (unsigned)(old >> 32);
      while ((unsigned)(__hip_atomic_load(w, __ATOMIC_RELAXED, __HIP_MEMORY_SCOPE_AGENT) >> 32) == g0) __builtin_amdgcn_s_sleep(1);
    }
    __builtin_amdgcn_fence(__ATOMIC_ACQUIRE, "agent");
    asm volatile("s_waitcnt vmcnt(0)" ::: "memory");
  }
  __syncthreads();
}

#ifdef SELFCHECK
__device__ __forceinline__ void cksum(const void* ptr, size_t bytes, unsigned long long* slot) {
  const u32x4* q = (const u32x4*)ptr;
  const size_t n = bytes / 16;
  unsigned long long s = 0;
  for (size_t i = (size_t)blockIdx.x * 256 + otid(); i < n; i += (size_t)gridDim.x * 256) {
    const u32x4 v = q[i];
    s += (unsigned long long)v.x + 3ull * v.y + 5ull * v.z + 7ull * v.w;
  }
  unsigned lo = (unsigned)s, hi = (unsigned)(s >> 32);
  unsigned long long t = s;
#pragma unroll
  for (int d = 32; d >= 1; d >>= 1) {
    const unsigned l2 = __shfl_xor((unsigned)t, d, 64), h2 = __shfl_xor((unsigned)(t >> 32), d, 64);
    t += ((unsigned long long)h2 << 32) | l2;
  }
  (void)lo; (void)hi;
  if ((otid() & 63) == 0) atomicAdd(slot, t);
}
#define CK(ptr, bytes) cksum((ptr), (bytes), slots + slot)
#else
#define CK(ptr, bytes) do {} while (0)
#endif

__device__ __forceinline__ void cksum_acc(const void* ptr, size_t bytes, unsigned long long& s) {
  const u32x4* q = (const u32x4*)ptr;
  const size_t n = bytes / 16;
  for (size_t i = ((size_t)blockIdx.x * 256 + otid()) * 64; i < n; i += (size_t)gridDim.x * 256 * 64) {
    const u32x4 v = __builtin_nontemporal_load(q + i);
    s += (unsigned long long)v.x + 3ull * v.y + 5ull * v.z + 7ull * v.w;
  }
}
__device__ __forceinline__ void cksum_commit(unsigned long long t, unsigned long long* slot) {
#pragma unroll
  for (int d = 32; d >= 1; d >>= 1) {
    const unsigned l2 = __shfl_xor((unsigned)t, d, 64), h2 = __shfl_xor((unsigned)(t >> 32), d, 64);
    t += ((unsigned long long)h2 << 32) | l2;
  }
  if ((otid() & 63) == 0) atomicAdd(slot, t);
}

__global__ void __launch_bounds__(256, 2) fwd_megakernel(Params p) {
  cg::grid_group grid = cg::this_grid();
  __shared__ __attribute__((aligned(16))) unsigned char smem_raw[SMEM_BYTES];
  bf16_t* smem = (bf16_t*)smem_raw;
  float* smf = (float*)smem_raw;
  const int G = gridDim.x, bid = blockIdx.x;
  unsigned* bar = (unsigned*)(p.ws + OFF_BAR);
  unsigned epoch = 0;
#ifdef START_DELAY_US
  {
    const unsigned long long t0 = __builtin_amdgcn_s_memrealtime();
    while (__builtin_amdgcn_s_memrealtime() - t0 < (unsigned long long)START_DELAY_US * 100ull) __builtin_amdgcn_s_sleep(20);
  }
#endif
  grid.sync();
#ifdef WCHECK
  unsigned wseen = 0;
  if (bid == 0 && otid() == 0) wseen = __hip_atomic_load(bar + 32, __ATOMIC_RELAXED, __HIP_MEMORY_SCOPE_AGENT);
#endif

#ifdef SELFCHECK
  unsigned long long* slots_base = (unsigned long long*)(p.ws + OFF_BAR + 256);
  if (bid == 0) for (int k = otid(); k < 768; k += 256) __hip_atomic_store(slots_base + k, 0ull, __ATOMIC_RELAXED, __HIP_MEMORY_SCOPE_AGENT);
  for (int run = 0; run < 3; ++run) {
  unsigned long long* slots = slots_base + run * 256;
  int slot = 0;
#endif
  {
    unsigned long long* sslots = (unsigned long long*)(p.ws + OFF_BAR + 1024);
    unsigned long long prev = 0;
    for (int iter = 0; iter < 64; ++iter) {
      unsigned long long s = 0;
      cksum_acc(p.out, (size_t)BATCH * SEQ * 1024 * 4, s);
      cksum_acc(p.ws, OFF_BAR, s);
      cksum_commit(s, sslots + iter);
      gsync(grid, bar, epoch);
      const unsigned long long c = __hip_atomic_load(sslots + iter, __ATOMIC_RELAXED, __HIP_MEMORY_SCOPE_AGENT);
      if (iter > 0 && c == prev) break;
      prev = c;
    }
  }
  phase_prep(p, smf);
  gsync(grid, bar, epoch);
  phase_prep(p, smf);
#ifdef SELF_POISON
  {
    u32x4* q = (u32x4*)(p.ws + OFF_H);
    const size_t n16 = (WS_TOTAL - OFF_H) / 16;
    const u32x4 pv = {SELF_POISON, SELF_POISON, SELF_POISON, SELF_POISON};
    for (size_t i = (size_t)bid * 256 + otid(); i < n16; i += (size_t)G * 256) q[i] = pv;
  }
#endif
  gsync(grid, bar, epoch);
#ifdef SELFCHECK
  CK(p.ws, OFF_H); slot++;
#endif

  for (int layer = 0; layer < 2; ++layer) {
    const float* xin = (layer == 0) ? p.in[0] : p.out;
    float* xout = p.out;
    for (int round = 0; round < NROUND; ++round) {
      const size_t tok0 = (size_t)round * TR;
      if (layer == 0 && round == 0) {
        phase_hnorm(xin + tok0 * 1024, p.in[2] + layer * 1024, (bf16_t*)(p.ws + OFF_H));
        gsync(grid, bar, epoch);
      }
#ifdef SELFCHECK
      CK(p.ws + OFF_H, (size_t)TR * 1024 * 2); slot++;
#endif
#ifndef REP_B
#define REP_B 1
#endif
      for (int rep = 0; rep < REP_B; ++rep) {
      for (int it = bid; it < NRT * 76; it += G) inproj_tile(p, layer, it % NRT, it / NRT, smem);
      gsync(grid, bar, epoch);
      }
#ifdef SELFCHECK
      CK(p.ws + OFF_PROJ, (size_t)TR * D_INP * 2); CK(p.ws + OFF_VTA, (size_t)RB * 4 * 128 * 2048 * 2); slot++;
#endif
      {
        constexpr int n1 = 256, n2 = TR / 16, n3 = RB * 32 * 16, n4 = RB * 16 * 8 / 4;
        for (int it = bid; it < n1 + n2 + n3 + n4; it += G) {
          if (it < n1) s5_e_item(p, layer, it, smem);
          else if (it < n1 + n2) tokpost_item(p, layer, round, it - n1);
          else if (it < n1 + n2 + n3) conv_item(p, layer, it - n1 - n2);
          else dtacum_item(p, layer, it - n1 - n2 - n3);
        }
      }
      gsync(grid, bar, epoch);
#ifdef SELFCHECK
      CK(p.ws + OFF_PROJ, (size_t)TR * D_INP * 2); CK(p.ws + OFF_E, (size_t)32 * 128 * NBC * 4); CK(p.ws + OFF_XC, (size_t)TR * 1024 * 2);
      CK(p.ws + OFF_DT, (size_t)TR * 8 * 4); CK(p.ws + OFF_ACUM, (size_t)TR * 8 * 4); slot++;
#endif
      {
        constexpr int n1 = NRT * 6, n2 = NRT * 8, n3 = RB * 16 * 8, n4 = RB * 32 * 64 / 256;
        for (int it = bid; it < n1 + n2 + n3 + n4; it += G) {
          if (it < n1) mla_up_q_tile(p, layer, it % NRT, it / NRT, smem);
          else if (it < n1 + n2) mla_up_kv_tile(p, layer, (it - n1) % NRT, (it - n1) / NRT, smem);
          else if (it < n1 + n2 + n3) mb_states_item(p, it - n1 - n2, smem);
          else s5_carry_item(p, layer, it - n1 - n2 - n3);
        }
      }
      gsync(grid, bar, epoch);
#ifdef SELFCHECK
      CK(p.ws + OFF_QM, (size_t)TR * 768 * 2); CK(p.ws + OFF_KN, (size_t)TR * 512 * 2); CK(p.ws + OFF_VTD, (size_t)RB * 4 * 128 * 2048 * 2);
      CK(p.ws + OFF_ST, (size_t)RB * 16 * 8 * 8192 * 4); CK(p.ws + OFF_HIN, (size_t)32 * 128 * NBC * 2); slot++;
#endif
      {
        constexpr int n1 = 256, n2 = TR / 16, n3 = RB * 8 * 8192 / 256;
        for (int it = bid; it < n1 + n2 + n3; it += G) {
          if (it < n1) s5_y_item(p, layer, it, smem);
          else if (it < n1 + n2) mlapost_item(p, layer, round, it - n1);
          else mb_scan_item(p, it - n1 - n2);
        }
      }
      gsync(grid, bar, epoch);
#ifdef SELFCHECK
      CK(p.ws + OFF_YG, (size_t)TR * 512 * 2); CK(p.ws + OFF_QM, (size_t)TR * 768 * 2); CK(p.ws + OFF_KM, (size_t)TR * 768 * 2);
      CK(p.ws + OFF_SIN, (size_t)RB * 16 * 8 * 8192 * 2); slot++;
#endif
#ifdef REP_ATT
      {
        constexpr int nat = RB * 4 * 32 * 2;
        for (int it = bid; it < nat; it += G) {
            const int half = nat / 2;
            const int qb = (it < half) ? (31 - it / 32) : ((it - half) / 32);
            const int sub = it & 31;
            if (sub < 16) da_attn_item(p, layer, sub, qb, smem, true);
            else mla_attn_item(p, sub - 16, qb, smem, true);
        }
        gsync(grid, bar, epoch);
      }
#endif
      {
        constexpr int nat = RB * 4 * 32 * 2;
        constexpr int n3 = RB * 16 * 2, n4 = NRT * 4;
        for (int it0 = bid; it0 < nat + n3 + n4; it0 += G) {
          if (it0 < n3) { mb_out_item(p, layer, it0, smem); continue; }
          const int it = it0 - n3;
          if (it < nat) {
            const int half = nat / 2;
            const int qb = (it < half) ? (31 - it / 32) : ((it - half) / 32);
            const int sub = it & 31;
            if (sub < 16) da_attn_item(p, layer, sub, qb, smem);
            else mla_attn_item(p, sub - 16, qb, smem);
          } else s5_glu_tile(p, layer, (it - nat) % NRT, (it - nat) / NRT, smem);
        }
      }
      gsync(grid, bar, epoch);
#ifdef SELFCHECK
      CK(p.ws + OFF_PROJ, (size_t)TR * D_INP * 2); slot++;
#endif
      for (int it = bid; it < NRT * 16; it += G) merge_tile(p, layer, it % NRT, it / NRT, smem);
      gsync(grid, bar, epoch);
#ifdef SELFCHECK
      CK(p.ws + OFF_MERGED, (size_t)TR * 1024 * 2); slot++;
#endif
      for (int it = bid; it < NRT * 8; it += G) out_tile(p, layer, xin + tok0 * 1024, xout + tok0 * 1024, it % NRT, it / NRT, smem);
      {
        const int nl = (round + 1 < NROUND) ? layer : layer + 1;
        const int nr = (round + 1 < NROUND) ? round + 1 : 0;
        if (nl < 2) {
          const float* nx = (nl == 0) ? p.in[0] : p.out;
          phase_hnorm(nx + (size_t)nr * TR * 1024, p.in[2] + nl * 1024, (bf16_t*)(p.ws + OFF_H));
        }
      }
      gsync(grid, bar, epoch);
#ifdef SELFCHECK
      CK(xout + tok0 * 1024, (size_t)TR * 1024 * 4); slot++;
#endif
    }
  }
#ifdef WCHECK
  if (bid == 0 && otid() == 0) {
    if (wseen != 0) p.out[0] = 1.0e6f;
    __hip_atomic_store(bar + 32, 1u, __ATOMIC_RELAXED, __HIP_MEMORY_SCOPE_AGENT);
  }
#endif
#ifdef SELFCHECK
  gsync(grid, bar, epoch);
  }
  gsync(grid, bar, epoch);
  if (bid == 0 && otid() == 0) {
    int bad = -1;
    for (int k = 0; k < 100; ++k) {
      const unsigned long long a = __hip_atomic_load(slots_base + k, __ATOMIC_RELAXED, __HIP_MEMORY_SCOPE_AGENT);
      const unsigned long long b = __hip_atomic_load(slots_base + 256 + k, __ATOMIC_RELAXED, __HIP_MEMORY_SCOPE_AGENT);
      const unsigned long long c = __hip_atomic_load(slots_base + 512 + k, __ATOMIC_RELAXED, __HIP_MEMORY_SCOPE_AGENT);
      if (a != b || a != c) { bad = k; break; }
    }
    if (bad >= 0) p.out[0] = 10000.0f * exp2f((float)bad);
  }
#endif
}

extern "C" void kernel_launch(void* const* d_in, const int* in_sizes, int n_in, void* d_out,
                              int out_size, void* d_ws, size_t ws_size, hipStream_t stream) {
  static int grid_blocks = 0;
  if (!grid_blocks) {
    int dev = 0, cus = 0, per_cu = 0;
    (void)hipGetDevice(&dev);
    (void)hipDeviceGetAttribute(&cus, hipDeviceAttributeMultiprocessorCount, dev);
    (void)hipOccupancyMaxActiveBlocksPerMultiprocessor(&per_cu, fwd_megakernel, 256, 0);
    if (per_cu > 2) per_cu = 2;
    if (per_cu < 1) per_cu = 1;
    grid_blocks = cus * per_cu;
    if (grid_blocks > MAXBLK) grid_blocks = MAXBLK;
  }
  if (ws_size < WS_TOTAL) fprintf(stderr, "workspace too small: %zu < %zu\n", ws_size, (size_t)WS_TOTAL);
  Params p{};
  for (int i = 0; i < 35; ++i) p.in[i] = (const float*)d_in[i];
  p.out = (float*)d_out;
  p.ws = (unsigned char*)d_ws;
  (void)hipMemsetAsync((unsigned char*)d_ws + OFF_BAR, 0, 2048, stream);
  void* args[] = {&p};
  hipError_t e = hipLaunchCooperativeKernel((void*)fwd_megakernel, dim3(grid_blocks), dim3(256), args, 0, stream);
  if (e != hipSuccess) fprintf(stderr, "cooperative launch failed: %s (grid %d)\n", hipGetErrorString(e), grid_blocks);
}
```

```cpp
#include <hip/hip_runtime.h>
#include <hip/hip_cooperative_groups.h>
#include <cstdio>
#include <cstdint>
namespace cg = cooperative_groups;

typedef unsigned short bf16_t;
typedef short bf16x8 __attribute__((ext_vector_type(8)));
typedef float f32x4 __attribute__((ext_vector_type(4)));
typedef unsigned u32x4 __attribute__((ext_vector_type(4)));
typedef unsigned u32x2 __attribute__((ext_vector_type(2)));

constexpr int SEQ = 2048, BATCH = 16;
constexpr int D_IN = 9672, D_INP = 9728;
constexpr int RB = 4;
constexpr int TR = RB * SEQ;
constexpr int NROUND = BATCH / RB;
constexpr int NRT = TR / 128;
constexpr int NBC = TR / 8;
constexpr int MAXBLK = 512;
constexpr float EPS = 1e-6f;
constexpr float LOG2E = 1.4426950408889634f;
constexpr int C_DAQ = 0, C_DAK = 512, C_DAV = 1024, C_DAG = 1536, C_MBZ = 2048, C_XBC = 2560, C_DT = 3584,
              C_S5U = 3592, C_S5G = 4104, C_CQ = 4616, C_CKV = 4872, C_KR = 5000, C_MLG = 5064, C_GATE = 5576;
constexpr long LDP = D_INP;

constexpr size_t al256(size_t x) { return (x + 255) & ~size_t(255); }
constexpr size_t OFF_WINT = 0;
constexpr size_t OFF_WBRT = OFF_WINT + al256((size_t)2 * D_INP * 1024 * 2);
constexpr size_t OFF_WOUTT = OFF_WBRT + al256((size_t)2 * 4 * 1024 * 512 * 2);
constexpr size_t OFF_WGLUT = OFF_WOUTT + al256((size_t)2 * 1024 * 1024 * 2);
constexpr size_t OFF_WUQT = OFF_WGLUT + al256((size_t)2 * 512 * 512 * 2);
constexpr size_t OFF_WUKVT = OFF_WUQT + al256((size_t)2 * 768 * 256 * 2);
constexpr size_t OFF_KMAT = OFF_WUKVT + al256((size_t)2 * 1024 * 128 * 2);
constexpr size_t OFF_EMAT = OFF_KMAT + al256((size_t)2 * 32 * 128 * 128 * 2);
constexpr size_t OFF_FMAT = OFF_EMAT + al256((size_t)2 * 32 * 128 * 128 * 2);
constexpr size_t OFF_A8 = OFF_FMAT + al256((size_t)2 * 32 * 128 * 128 * 2);
constexpr size_t OFF_LAM = OFF_A8 + al256((size_t)2 * 32 * 64 * 2 * 4);
constexpr size_t OFF_H = OFF_LAM + 256;
constexpr size_t OFF_PROJ = OFF_H + al256((size_t)TR * 1024 * 2);
constexpr size_t OFF_XC = OFF_PROJ + al256((size_t)TR * D_INP * 2);
constexpr size_t OFF_DT = OFF_XC + al256((size_t)TR * 1024 * 2);
constexpr size_t OFF_ACUM = OFF_DT + al256((size_t)TR * 8 * 4);
constexpr size_t OFF_VTA = OFF_ACUM + al256((size_t)TR * 8 * 4);
constexpr size_t OFF_VTD = OFF_VTA + al256((size_t)RB * 4 * 128 * 2048 * 2);
constexpr size_t OFF_QM = OFF_VTD + al256((size_t)RB * 4 * 128 * 2048 * 2);
constexpr size_t OFF_KM = OFF_QM + al256((size_t)TR * 768 * 2);
constexpr size_t OFF_KN = OFF_KM + al256((size_t)TR * 768 * 2);
constexpr size_t OFF_ST = OFF_KN + al256((size_t)TR * 512 * 2);
constexpr size_t OFF_SIN = OFF_ST + al256((size_t)RB * 16 * 8 * 8192 * 4);
constexpr size_t OFF_MS = OFF_SIN + al256((size_t)RB * 16 * 8 * 8192 * 2);
constexpr size_t OFF_XS = OFF_MS + al256((size_t)MAXBLK * 128 * 128 * 2);
constexpr size_t OFF_E = OFF_XS + al256((size_t)MAXBLK * 128 * 64 * 2);
constexpr size_t OFF_HIN = OFF_E + al256((size_t)32 * 128 * NBC * 4);
constexpr size_t OFF_YG = OFF_HIN + al256((size_t)32 * 128 * NBC * 2);
constexpr size_t OFF_MERGED = OFF_YG + al256((size_t)TR * 512 * 2);
constexpr size_t OFF_BAR = OFF_MERGED + al256((size_t)TR * 1024 * 2);
constexpr size_t WS_TOTAL = OFF_BAR + 8192;

constexpr int SMEM_BYTES = 73728 + 4096;

struct Params {
  const float* in[35];
  float* out;
  unsigned char* ws;
};

#define MEMBAR() do { asm volatile("" ::: "memory"); __builtin_amdgcn_sched_barrier(0); } while (0)
__device__ __forceinline__ int otid() { int t = threadIdx.x; asm volatile("" : "+v"(t)); return t; }
__device__ __forceinline__ bf16_t f2bf(float f) {
  unsigned u = __float_as_uint(f);
  u += 0x7fffu + ((u >> 16) & 1u);
  return (bf16_t)(u >> 16);
}
__device__ __forceinline__ float bf2f(bf16_t b) { return __uint_as_float(((unsigned)b) << 16); }
__device__ __forceinline__ unsigned pack2(float a, float b) { return (unsigned)f2bf(a) | ((unsigned)f2bf(b) << 16); }
__device__ __forceinline__ float sigmoidf_(float x) { return 1.0f / (1.0f + __expf(-x)); }
__device__ __forceinline__ float siluf_(float x) { return x / (1.0f + __expf(-x)); }
__device__ __forceinline__ float gelu_tanh(float x) {
  float u = 0.7978845608028654f * (x + 0.044715f * x * x * x);
  float t = 1.0f - 2.0f / (__expf(2.0f * u) + 1.0f);
  return 0.5f * x * (1.0f + t);
}
__device__ __forceinline__ float wave_sum(float v) {
#pragma unroll
  for (int d = 32; d >= 1; d >>= 1) v += __shfl_xor(v, d, 64);
  return v;
}

__device__ __forceinline__ void block_global_handoff() {
  asm volatile("s_waitcnt vmcnt(0)" ::: "memory");
  __syncthreads();
  if (otid() < 64) {
    __builtin_amdgcn_fence(__ATOMIC_ACQUIRE, "agent");
    asm volatile("s_waitcnt vmcnt(0)" ::: "memory");
  }
  __syncthreads();
}
template <int R, bool T, bool SEG, int N>
__device__ __forceinline__ void g_load(u32x4 (&rg)[N], const bf16_t* __restrict__ P, long ld, int k0, long segs, int tid) {
#pragma unroll
  for (int i = 0; i < N; ++i) {
    const int ch = tid + i * 256;
    if (!T) {
      const int row = ch >> 3, kc = k0 + (ch & 7) * 8;
      const long ko = SEG ? ((long)(kc >> 4) * segs + (kc & 15)) : (long)kc;
      rg[i] = *(const u32x4*)(P + (long)row * ld + ko);
    } else {
      constexpr int CPR = R / 8;
      const int kk = ch / CPR, m0 = (ch % CPR) * 8;
      rg[i] = *(const u32x4*)(P + (long)(k0 + kk) * ld + m0);
    }
  }
}
template <int R, bool T, int N>
__device__ __forceinline__ void s_store(const u32x4 (&rg)[N], bf16_t* sm, int tid) {
  constexpr int LS = 72;
#pragma unroll
  for (int i = 0; i < N; ++i) {
    const int ch = tid + i * 256;
    if (!T) {
      const int row = ch >> 3, kc = (ch & 7) * 8;
      *(u32x4*)(sm + row * LS + kc) = rg[i];
    } else {
      constexpr int CPR = R / 8;
      const int kk = ch / CPR, m0 = (ch % CPR) * 8;
      bf16_t* d = sm + m0 * LS + kk;
      d[0 * LS] = (bf16_t)(rg[i].x & 0xffffu); d[1 * LS] = (bf16_t)(rg[i].x >> 16);
      d[2 * LS] = (bf16_t)(rg[i].y & 0xffffu); d[3 * LS] = (bf16_t)(rg[i].y >> 16);
      d[4 * LS] = (bf16_t)(rg[i].z & 0xffffu); d[5 * LS] = (bf16_t)(rg[i].z >> 16);
      d[6 * LS] = (bf16_t)(rg[i].w & 0xffffu); d[7 * LS] = (bf16_t)(rg[i].w >> 16);
    }
  }
}
template <int BN>
__device__ __forceinline__ void mfma_stage(f32x4 (&acc)[4][BN / 32], const bf16_t* sA, const bf16_t* sB, int wr, int wc, int g, int c) {
  constexpr int LS = 72;
  const bf16_t* pa = sA + (wr * 64 + c) * LS + g * 8;
  const bf16_t* pb = sB + (wc * (BN / 2) + c) * LS + g * 8;
#pragma unroll
  for (int ks = 0; ks < 2; ++ks) {
    bf16x8 af[4], bfr[BN / 32];
#pragma unroll
    for (int i = 0; i < 4; ++i) af[i] = *(const bf16x8*)(pa + i * 16 * LS + ks * 32);
#pragma unroll
    for (int j = 0; j < BN / 32; ++j) bfr[j] = *(const bf16x8*)(pb + j * 16 * LS + ks * 32);
#pragma unroll
    for (int i = 0; i < 4; ++i)
#pragma unroll
      for (int j = 0; j < BN / 32; ++j) acc[i][j] = __builtin_amdgcn_mfma_f32_16x16x32_bf16(af[i], bfr[j], acc[i][j], 0, 0, 0);
  }
}
template <int BN, bool TA, bool TB, bool SEGA>
__device__ __forceinline__ void gemm_tile(f32x4 (&acc)[4][BN / 32], const bf16_t* __restrict__ A, long lda,
                                          const bf16_t* __restrict__ B, long ldb, int K, bf16_t* smem, long segs = 0) {
  constexpr int LS = 72;
  constexpr int STAGE = 2 * 128 * LS;
  const int tid = otid(), w = tid >> 6, l = tid & 63, g = l >> 4, c = l & 15;
  const int wr = w >> 1, wc = w & 1;
  constexpr int NA = 4, NB = BN / 32;
  u32x4 ra0[NA], rb0[NB], ra1[NA], rb1[NB];
  const int nk = K / 64;
  bf16_t* s0A = smem;
  bf16_t* s0B = smem + 128 * LS;
  bf16_t* s1A = smem + STAGE;
  bf16_t* s1B = smem + STAGE + 128 * LS;
  g_load<128, TA, SEGA, NA>(ra0, A, lda, 0, segs, tid);
  g_load<BN, TB, false, NB>(rb0, B, ldb, 0, 0, tid);
  g_load<128, TA, SEGA, NA>(ra1, A, lda, 64, segs, tid);
  g_load<BN, TB, false, NB>(rb1, B, ldb, 64, 0, tid);
  __syncthreads();
  s_store<128, TA, NA>(ra0, s0A, tid);
  s_store<BN, TB, NB>(rb0, s0B, tid);
  __syncthreads();
  for (int kt = 0; kt < nk; kt += 2) {
    if (kt + 2 < nk) {
      g_load<128, TA, SEGA, NA>(ra0, A, lda, (kt + 2) * 64, segs, tid);
      g_load<BN, TB, false, NB>(rb0, B, ldb, (kt + 2) * 64, 0, tid);
    }
    mfma_stage<BN>(acc, s0A, s0B, wr, wc, g, c);
    s_store<128, TA, NA>(ra1, s1A, tid);
    s_store<BN, TB, NB>(rb1, s1B, tid);
    __syncthreads();
    if (kt + 3 < nk) {
      g_load<128, TA, SEGA, NA>(ra1, A, lda, (kt + 3) * 64, segs, tid);
      g_load<BN, TB, false, NB>(rb1, B, ldb, (kt + 3) * 64, 0, tid);
    }
    mfma_stage<BN>(acc, s1A, s1B, wr, wc, g, c);
    if (kt + 2 < nk) {
      s_store<128, TA, NA>(ra0, s0A, tid);
      s_store<BN, TB, NB>(rb0, s0B, tid);
    }
    __syncthreads();
  }
}

template <int NJ>
__device__ __forceinline__ void zero_acc(f32x4 (&acc)[4][NJ]) {
#pragma unroll
  for (int i = 0; i < 4; ++i)
#pragma unroll
    for (int j = 0; j < NJ; ++j) acc[i][j] = (f32x4){0.f, 0.f, 0.f, 0.f};
}

__device__ __forceinline__ void tconv_tile(const float* __restrict__ src, bf16_t* __restrict__ dst, int K, int N, int tk, int tn, float* sm) {
  const int tid = otid();
  const int k0 = tk * 64, n0 = tn * 64;
  __syncthreads();
#pragma unroll 4
  for (int i = 0; i < 16; ++i) {
    const int kk = i * 4 + (tid >> 6), nn = tid & 63;
    float v = 0.f;
    if (n0 + nn < N) v = src[(long)(k0 + kk) * N + n0 + nn];
    sm[kk * 65 + nn] = v;
  }
  __syncthreads();
#pragma unroll 4
  for (int i = 0; i < 16; ++i) {
    const int nn = i * 4 + (tid >> 6), kk = tid & 63;
    dst[(long)(n0 + nn) * K + k0 + kk] = f2bf(sm[kk * 65 + nn]);
  }
}

__device__ __forceinline__ void tconv_job(const float* src, bf16_t* dst, int K, int N, int Npad, float* sm) {
  const int tkn = K / 64, tnn = Npad / 64;
  for (int t = blockIdx.x; t < tkn * tnn; t += gridDim.x) tconv_tile(src, dst, K, N, t % tkn, t / tkn, sm);
}

__device__ __forceinline__ void s5_prep(const Params& p, int layer, int grp, float* sm) {
  float* pwr = sm;
  float* pwi = pwr + 9 * 64;
  float* bbr = pwi + 9 * 64;
  float* bbi = bbr + 1024;
  float* cr = bbi + 1024;
  float* ci = cr + 1024;
  float* kt = ci + 1024;
  const int tid = otid();
  const int lg = layer * 32 + grp;
  __syncthreads();
  if (tid < 64) {
    const int pp = tid;
    const double step = exp((double)p.in[19][lg]);
    const double lr = (double)p.in[17][lg * 64 + pp], li = (double)p.in[18][lg * 64 + pp];
    const double mag = exp(lr * step);
    const double abr = mag * cos(li * step), abi = mag * sin(li * step);
    const double den = lr * lr + li * li;
    const double fr = ((abr - 1.0) * lr + abi * li) / den;
    const double fi = (abi * lr - (abr - 1.0) * li) / den;
    double qr = 1.0, qi = 0.0;
    for (int t = 0; t < 9; ++t) {
      pwr[t * 64 + pp] = (float)qr;
      pwi[t * 64 + pp] = (float)qi;
      const double nr = qr * abr - qi * abi, ni = qr * abi + qi * abr;
      qr = nr; qi = ni;
    }
    float* a8 = (float*)(p.ws + OFF_A8) + (size_t)(lg * 64 + pp) * 2;
    a8[0] = pwr[8 * 64 + pp];
    a8[1] = pwi[8 * 64 + pp];
    for (int cc = 0; cc < 16; ++cc) {
      const double br = (double)p.in[20][(lg * 64 + pp) * 16 + cc], bi = (double)p.in[21][(lg * 64 + pp) * 16 + cc];
      bbr[pp * 16 + cc] = (float)(fr * br - fi * bi);
      bbi[pp * 16 + cc] = (float)(fr * bi + fi * br);
    }
  }
  for (int e = tid; e < 1024; e += 256) {
    cr[e] = p.in[22][lg * 1024 + e];
    ci[e] = p.in[23][lg * 1024 + e];
  }
  __syncthreads();
  for (int e = tid; e < 2048; e += 256) {
    const int tau = e >> 8, co = (e >> 4) & 15, cin = e & 15;
    float s = 0.f;
    for (int pp = 0; pp < 64; ++pp) {
      const float pr = pwr[tau * 64 + pp], pi = pwi[tau * 64 + pp];
      const float zr = pr * bbr[pp * 16 + cin] - pi * bbi[pp * 16 + cin];
      const float zi = pr * bbi[pp * 16 + cin] + pi * bbr[pp * 16 + cin];
      s += cr[co * 64 + pp] * zr - ci[co * 64 + pp] * zi;
    }
    kt[e] = s;
  }
  __syncthreads();
  bf16_t* Km = (bf16_t*)(p.ws + OFF_KMAT) + (size_t)lg * 16384;
  bf16_t* Em = (bf16_t*)(p.ws + OFF_EMAT) + (size_t)lg * 16384;
  bf16_t* Fm = (bf16_t*)(p.ws + OFF_FMAT) + (size_t)lg * 16384;
  for (int e = tid; e < 16384; e += 256) {
    const int n = e >> 7, k = e & 127;
    {
      const int tq = n >> 4, co = n & 15, sq = k >> 4, cin = k & 15;
      Km[e] = f2bf(tq >= sq ? kt[((tq - sq) * 16 + co) * 16 + cin] : 0.f);
    }
    {
      const int pp = n >> 1, ri = n & 1, sq = k >> 4, cin = k & 15;
      const float pr = pwr[(7 - sq) * 64 + pp], pi = pwi[(7 - sq) * 64 + pp];
      const float zr = pr * bbr[pp * 16 + cin] - pi * bbi[pp * 16 + cin];
      const float zi = pr * bbi[pp * 16 + cin] + pi * bbr[pp * 16 + cin];
      Em[e] = f2bf(ri ? zi : zr);
    }
    {
      const int tq = n >> 4, co = n & 15, pp = k >> 1, ri = k & 1;
      const float pr = pwr[(tq + 1) * 64 + pp], pi = pwi[(tq + 1) * 64 + pp];
      const float gr = cr[co * 64 + pp] * pr - ci[co * 64 + pp] * pi;
      const float gi = cr[co * 64 + pp] * pi + ci[co * 64 + pp] * pr;
      Fm[e] = f2bf(ri ? -gi : gr);
    }
  }
}

__device__ __forceinline__ void phase_prep(const Params& p, float* smf) {
  for (int L = 0; L < 2; ++L) {
    tconv_job(p.in[3] + (size_t)L * 1024 * D_IN, (bf16_t*)(p.ws + OFF_WINT) + (size_t)L * D_INP * 1024, 1024, D_IN, D_INP, smf);
    for (int n = 0; n < 4; ++n)
      tconv_job(p.in[33] + (size_t)(L * 4 + n) * 512 * 1024, (bf16_t*)(p.ws + OFF_WBRT) + (size_t)(L * 4 + n) * 1024 * 512, 512, 1024, 1024, smf);
    tconv_job(p.in[34] + (size_t)L * 1024 * 1024, (bf16_t*)(p.ws + OFF_WOUTT) + (size_t)L * 1024 * 1024, 1024, 1024, 1024, smf);
    tconv_job(p.in[25] + (size_t)L * 512 * 512, (bf16_t*)(p.ws + OFF_WGLUT) + (size_t)L * 512 * 512, 512, 512, 512, smf);
    tconv_job(p.in[28] + (size_t)L * 256 * 768, (bf16_t*)(p.ws + OFF_WUQT) + (size_t)L * 768 * 256, 256, 768, 768, smf);
    tconv_job(p.in[30] + (size_t)L * 128 * 1024, (bf16_t*)(p.ws + OFF_WUKVT) + (size_t)L * 1024 * 128, 128, 1024, 1024, smf);
  }
  for (int it = blockIdx.x; it < 64; it += gridDim.x) s5_prep(p, it >> 5, it & 31, smf);
  if (blockIdx.x == gridDim.x - 1 && otid() < 2) {
    const int L = otid();
    float s1 = 0.f, s2 = 0.f;
    for (int i = 0; i < 64; ++i) {
      s1 += p.in[6][L * 64 + i] * p.in[7][L * 64 + i];
      s2 += p.in[8][L * 64 + i] * p.in[9][L * 64 + i];
    }
    const float li = 0.8f - 0.6f * expf(-0.3f * (float)L);
    ((float*)(p.ws + OFF_LAM))[L] = expf(s1) - expf(s2) + li;
  }
}

__device__ __forceinline__ void phase_hnorm(const float* __restrict__ x, const float* __restrict__ gn, bf16_t* __restrict__ H) {
  const int w = otid() >> 6, l = otid() & 63;
  for (int row = blockIdx.x * 4 + w; row < TR; row += gridDim.x * 4) {
    const float4* xr = (const float4*)(x + (size_t)row * 1024);
    float4 v[4];
    float ss = 0.f;
#pragma unroll
    for (int i = 0; i < 4; ++i) {
      v[i] = xr[i * 64 + l];
      ss += v[i].x * v[i].x + v[i].y * v[i].y + v[i].z * v[i].z + v[i].w * v[i].w;
    }
    ss = wave_sum(ss);
    const float rs = rsqrtf(ss * (1.0f / 1024.0f) + EPS);
#pragma unroll
    for (int i = 0; i < 4; ++i) {
      const float4 gg = ((const float4*)gn)[i * 64 + l];
      u32x2 o;
      o.x = pack2(v[i].x * rs * gg.x, v[i].y * rs * gg.y);
      o.y = pack2(v[i].z * rs * gg.z, v[i].w * rs * gg.w);
      *(u32x2*)(H + (size_t)row * 1024 + (i * 64 + l) * 4) = o;
    }
  }
}

__device__ __forceinline__ void inproj_tile(const Params& p, int layer, int rt, int ct, bf16_t* smem) {
  const bf16_t* H = (const bf16_t*)(p.ws + OFF_H);
  const bf16_t* W = (const bf16_t*)(p.ws + OFF_WINT) + (size_t)layer * D_INP * 1024;
  bf16_t* PROJ = (bf16_t*)(p.ws + OFF_PROJ);
  bf16_t* VTA = (bf16_t*)(p.ws + OFF_VTA);
  f32x4 acc[4][4];
  zero_acc<4>(acc);
  gemm_tile<128, false, false, false>(acc, H + (size_t)rt * 128 * 1024, 1024, W + (size_t)ct * 128 * 1024, 1024, 1024, smem);
  const int tid = otid(), w = tid >> 6, l = tid & 63, g = l >> 4, c = l & 15, wr = w >> 1, wc = w & 1;
  const int c0 = ct * 128;
  if (c0 >= C_DAV && c0 < C_DAG) {
    const int h = (c0 - C_DAV) >> 7;
#pragma unroll
    for (int i = 0; i < 4; ++i)
#pragma unroll
      for (int j = 0; j < 4; ++j) {
        const int row = rt * 128 + wr * 64 + i * 16 + g * 4;
        const int dv = wc * 64 + j * 16 + c;
        const int b = row >> 11, s = row & 2047;
        u32x2 o;
        o.x = pack2(acc[i][j][0], acc[i][j][1]);
        o.y = pack2(acc[i][j][2], acc[i][j][3]);
        *(u32x2*)(VTA + ((size_t)((b * 4 + h) * 128 + dv)) * 2048 + s) = o;
      }
  } else {
#pragma unroll
    for (int i = 0; i < 4; ++i) {
#pragma unroll
      for (int r = 0; r < 4; ++r) {
        const int row = rt * 128 + wr * 64 + i * 16 + g * 4 + r;
        bf16_t* rp = PROJ + (size_t)row * LDP + c0 + wc * 64 + c;
#pragma unroll
        for (int j = 0; j < 4; ++j) {
          float v = acc[i][j][r];
          if (c0 + wc * 64 + j * 16 + c >= C_GATE) v = sigmoidf_(v);
          rp[j * 16] = f2bf(v);
        }
      }
      MEMBAR();
    }
  }
}

__device__ __forceinline__ void tokpost_item(const Params& p, int layer, int round, int item) {
  bf16_t* PROJ = (bf16_t*)(p.ws + OFF_PROJ);
  const int* pos = (const int*)p.in[1];
  const int w = otid() >> 6, l = otid() & 63;
  for (int tt = 0; tt < 4; ++tt) {
    const int row = item * 16 + w * 4 + tt;
    const float fpos = (float)pos[round * TR + row];
    bf16_t* pr = PROJ + (size_t)row * LDP;
    {
      const int which = l >> 5, idx = (l & 31) * 16, off = (l & 3) * 16;
      bf16_t* ptr = pr + which * 512 + idx;
      u32x4 u0 = *(const u32x4*)ptr, u1 = *(const u32x4*)(ptr + 8);
      const unsigned uu[8] = {u0.x, u0.y, u0.z, u0.w, u1.x, u1.y, u1.z, u1.w};
      float v[16];
      float ss = 0.f;
#pragma unroll
      for (int e = 0; e < 8; ++e) {
        v[2 * e] = __uint_as_float(uu[e] << 16);
        v[2 * e + 1] = __uint_as_float(uu[e] & 0xffff0000u);
        ss += v[2 * e] * v[2 * e] + v[2 * e + 1] * v[2 * e + 1];
      }
      ss += __shfl_xor(ss, 1, 64);
      ss += __shfl_xor(ss, 2, 64);
      const float rs = rsqrtf(ss * (1.0f / 64.0f) + EPS);
      const float* gn = (which ? p.in[5] : p.in[4]) + layer * 64 + off;
#pragma unroll
      for (int e = 0; e < 16; ++e) v[e] = v[e] * rs * gn[e];
      if ((l & 3) == 0) {
#pragma unroll
        for (int i = 0; i < 8; ++i) {
          const float invf = expf(-13.122363377404328f * (float)i * 0.125f);
          const float ang = fpos * invf;
          const float cs = cosf(ang), sn = sinf(ang);
          const float x1 = v[i], x2 = v[i + 8];
          v[i] = x1 * cs - x2 * sn;
          v[i + 8] = x2 * cs + x1 * sn;
        }
      }
      if (which == 0) {
#pragma unroll
        for (int e = 0; e < 16; ++e) v[e] *= 0.125f * LOG2E;
      }
      u32x4 o0, o1;
      o0.x = pack2(v[0], v[1]); o0.y = pack2(v[2], v[3]); o0.z = pack2(v[4], v[5]); o0.w = pack2(v[6], v[7]);
      o1.x = pack2(v[8], v[9]); o1.y = pack2(v[10], v[11]); o1.z = pack2(v[12], v[13]); o1.w = pack2(v[14], v[15]);
      *(u32x4*)ptr = o0;
      *(u32x4*)(ptr + 8) = o1;
    }
    {
      bf16_t* ptr = pr + C_CQ + l * 4;
      u32x2 u = *(const u32x2*)ptr;
      float v0 = __uint_as_float(u.x << 16), v1 = __uint_as_float(u.x & 0xffff0000u);
      float v2 = __uint_as_float(u.y << 16), v3 = __uint_as_float(u.y & 0xffff0000u);
      float ss = wave_sum(v0 * v0 + v1 * v1 + v2 * v2 + v3 * v3);
      const float rs = rsqrtf(ss * (1.0f / 256.0f) + EPS);
      const float* gn = p.in[27] + layer * 256 + l * 4;
      u32x2 o;
      o.x = pack2(v0 * rs * gn[0], v1 * rs * gn[1]);
      o.y = pack2(v2 * rs * gn[2], v3 * rs * gn[3]);
      *(u32x2*)ptr = o;
    }
    {
      bf16_t* ptr = pr + C_CKV + l * 2;
      unsigned u = *(const unsigned*)ptr;
      float v0 = __uint_as_float(u << 16), v1 = __uint_as_float(u & 0xffff0000u);
      float ss = wave_sum(v0 * v0 + v1 * v1);
      const float rs = rsqrtf(ss * (1.0f / 128.0f) + EPS);
      const float* gn = p.in[29] + layer * 128 + l * 2;
      *(unsigned*)ptr = pack2(v0 * rs * gn[0], v1 * rs * gn[1]);
    }
  }
}

__device__ __forceinline__ void conv_item(const Params& p, int layer, int item) {
  const bf16_t* PROJ = (const bf16_t*)(p.ws + OFF_PROJ);
  bf16_t* XC = (bf16_t*)(p.ws + OFF_XC);
  const int chtile = item & 15, tt = (item >> 4) & 31, b = item >> 9;
  const int ch = chtile * 64 + (otid() & 63);
  const int tr0 = otid() >> 6;
  const float* cw = p.in[11] + (size_t)layer * 4 * 1024;
  const float w0 = cw[ch], w1 = cw[1024 + ch], w2 = cw[2048 + ch], w3 = cw[3072 + ch];
  const float bias = p.in[12][layer * 1024 + ch];
  for (int i0 = 0; i0 < 16; i0 += 8) {
    float x0[8], x1[8], x2[8], x3[8];
#pragma unroll
    for (int u = 0; u < 8; ++u) {
      const int t = tt * 64 + (i0 + u) * 4 + tr0;
      const bf16_t* base = PROJ + (size_t)(b * 2048 + t) * LDP + C_XBC + ch;
      x3[u] = bf2f(base[0]);
      x2[u] = (t >= 1) ? bf2f(*(base - LDP)) : 0.f;
      x1[u] = (t >= 2) ? bf2f(*(base - 2 * LDP)) : 0.f;
      x0[u] = (t >= 3) ? bf2f(*(base - 3 * LDP)) : 0.f;
    }
#pragma unroll
    for (int u = 0; u < 8; ++u) {
      const int t = tt * 64 + (i0 + u) * 4 + tr0;
      const float y = bias + w3 * x3[u] + w2 * x2[u] + w1 * x1[u] + w0 * x0[u];
      XC[(size_t)(b * 2048 + t) * 1024 + ch] = f2bf(siluf_(y));
    }
  }
}

__device__ __forceinline__ void dtacum_item(const Params& p, int layer, int item) {
  const bf16_t* PROJ = (const bf16_t*)(p.ws + OFF_PROJ);
  float* DT = (float*)(p.ws + OFF_DT);
  float* AC = (float*)(p.ws + OFF_ACUM);
  const int w = otid() >> 6, l = otid() & 63;
  const int id = item * 4 + w;
  const int h = id & 7, bc = id >> 3;
  const int row0 = bc * 128 + 2 * l;
  const float bias = p.in[13][layer * 8 + h];
  const float A = -expf(p.in[14][layer * 8 + h]);
  float x0 = bf2f(PROJ[(size_t)row0 * LDP + C_DT + h]) + bias;
  float x1 = bf2f(PROJ[(size_t)(row0 + 1) * LDP + C_DT + h]) + bias;
  const float d0 = x0 > 20.f ? x0 : log1pf(expf(x0));
  const float d1 = x1 > 20.f ? x1 : log1pf(expf(x1));
  const float a0 = d0 * A, a1 = d1 * A;
  float s = a0 + a1;
#pragma unroll
  for (int d = 1; d < 64; d <<= 1) {
    const float t = __shfl_up(s, d, 64);
    if (l >= d) s += t;
  }
  DT[(size_t)row0 * 8 + h] = d0;
  DT[(size_t)(row0 + 1) * 8 + h] = d1;
  AC[(size_t)row0 * 8 + h] = s - a1;
  AC[(size_t)(row0 + 1) * 8 + h] = s;
}

__device__ __forceinline__ void s5_e_item(const Params& p, int layer, int item, bf16_t* smem) {
  const bf16_t* PROJ = (const bf16_t*)(p.ws + OFF_PROJ);
  const int grp = item >> 3, mt = item & 7;
  const bf16_t* Em = (const bf16_t*)(p.ws + OFF_EMAT) + (size_t)(layer * 32 + grp) * 16384;
  float* E = (float*)(p.ws + OFF_E);
  f32x4 acc[4][4];
  zero_acc<4>(acc);
  gemm_tile<128, false, false, true>(acc, PROJ + (size_t)mt * 128 * 8 * LDP + C_S5U + grp * 16, 8 * LDP, Em, 128, 128, smem, LDP);
  const int tid = otid(), w = tid >> 6, l = tid & 63, g = l >> 4, c = l & 15, wr = w >> 1, wc = w & 1;
#pragma unroll
  for (int i = 0; i < 4; ++i)
#pragma unroll
    for (int j = 0; j < 4; ++j) {
      const int m = mt * 128 + wr * 64 + i * 16 + g * 4;
      const int n = wc * 64 + j * 16 + c;
      *(f32x4*)(E + ((size_t)(grp * 128 + n)) * NBC + m) = acc[i][j];
    }
}

__device__ __forceinline__ void mla_up_q_tile(const Params& p, int layer, int rt, int ct, bf16_t* smem) {
  const bf16_t* PROJ = (const bf16_t*)(p.ws + OFF_PROJ);
  const bf16_t* W = (const bf16_t*)(p.ws + OFF_WUQT) + (size_t)layer * 768 * 256;
  bf16_t* QM = (bf16_t*)(p.ws + OFF_QM);
  f32x4 acc[4][4];
  zero_acc<4>(acc);
  gemm_tile<128, false, false, false>(acc, PROJ + (size_t)rt * 128 * LDP + C_CQ, LDP, W + (size_t)ct * 128 * 256, 256, 256, smem);
  const int tid = otid(), w = tid >> 6, l = tid & 63, g = l >> 4, c = l & 15, wr = w >> 1, wc = w & 1;
#pragma unroll
  for (int i = 0; i < 4; ++i)
#pragma unroll
    for (int j = 0; j < 4; ++j)
#pragma unroll
      for (int r = 0; r < 4; ++r) {
        const int row = rt * 128 + wr * 64 + i * 16 + g * 4 + r, col = ct * 128 + wc * 64 + j * 16 + c;
        QM[(size_t)row * 768 + col] = f2bf(acc[i][j][r]);
      }
}
__device__ __forceinline__ void mla_up_kv_tile(const Params& p, int layer, int rt, int ct, bf16_t* smem) {
  const bf16_t* PROJ = (const bf16_t*)(p.ws + OFF_PROJ);
  const bf16_t* W = (const bf16_t*)(p.ws + OFF_WUKVT) + (size_t)layer * 1024 * 128;
  bf16_t* KN = (bf16_t*)(p.ws + OFF_KN);
  bf16_t* VTD = (bf16_t*)(p.ws + OFF_VTD);
  f32x4 acc[4][4];
  zero_acc<4>(acc);
  gemm_tile<128, false, false, false>(acc, PROJ + (size_t)rt * 128 * LDP + C_CKV, LDP, W + (size_t)ct * 128 * 128, 128, 128, smem);
  const int tid = otid(), w = tid >> 6, l = tid & 63, g = l >> 4, c = l & 15, wr = w >> 1, wc = w & 1;
  const int h = ct >> 1;
  if ((ct & 1) == 0) {
#pragma unroll
    for (int i = 0; i < 4; ++i)
#pragma unroll
      for (int j = 0; j < 4; ++j)
#pragma unroll
        for (int r = 0; r < 4; ++r) {
          const int row = rt * 128 + wr * 64 + i * 16 + g * 4 + r, cc = wc * 64 + j * 16 + c;
          KN[(size_t)row * 512 + h * 128 + cc] = f2bf(acc[i][j][r]);
        }
  } else {
#pragma unroll
    for (int i = 0; i < 4; ++i)
#pragma unroll
      for (int j = 0; j < 4; ++j) {
        const int row = rt * 128 + wr * 64 + i * 16 + g * 4, dv = wc * 64 + j * 16 + c;
        const int b = row >> 11, s = row & 2047;
        u32x2 o;
        o.x = pack2(acc[i][j][0], acc[i][j][1]);
        o.y = pack2(acc[i][j][2], acc[i][j][3]);
        *(u32x2*)(VTD + ((size_t)((b * 4 + h) * 128 + dv)) * 2048 + s) = o;
      }
  }
}

__device__ __forceinline__ void mb_states_item(const Params& p, int item, bf16_t* smem) {
  const bf16_t* XC = (const bf16_t*)(p.ws + OFF_XC);
  const float* DT = (const float*)(p.ws + OFF_DT);
  const float* AC = (const float*)(p.ws + OFF_ACUM);
  bf16_t* XS = (bf16_t*)(p.ws + OFF_XS) + (size_t)blockIdx.x * 128 * 64;
  float* ST = (float*)(p.ws + OFF_ST);
  const int h = item & 7, bc = item >> 3;
  const int grp = h >> 2;
  const int row0 = bc * 128;
  const int tid = otid();
  __syncthreads();
  const float alast = AC[(size_t)(row0 + 127) * 8 + h];
  for (int e0 = tid; e0 < 8192; e0 += 2048) {
    float dv[8], av[8];
    bf16_t xv[8];
#pragma unroll
    for (int u = 0; u < 8; ++u) {
      const int e = e0 + u * 256;
      const int row = row0 + (e >> 6);
      dv[u] = DT[(size_t)row * 8 + h];
      av[u] = AC[(size_t)row * 8 + h];
      xv[u] = XC[(size_t)row * 1024 + h * 64 + (e & 63)];
    }
#pragma unroll
    for (int u = 0; u < 8; ++u) XS[e0 + u * 256] = f2bf(bf2f(xv[u]) * dv[u] * __expf(alast - av[u]));
  }
  block_global_handoff();
  f32x4 acc[4][2];
  zero_acc<2>(acc);
  gemm_tile<64, true, true, false>(acc, XC + (size_t)row0 * 1024 + 512 + grp * 128, 1024, XS, 64, 128, smem);
  const int w = tid >> 6, l = tid & 63, g = l >> 4, c = l & 15, wr = w >> 1, wc = w & 1;
#pragma unroll
  for (int i = 0; i < 4; ++i)
#pragma unroll
    for (int j = 0; j < 2; ++j) {
      const int n = wr * 64 + i * 16 + g * 4;
      const int pp = wc * 32 + j * 16 + c;
      *(f32x4*)(ST + ((size_t)(bc * 8 + h) * 64 + pp) * 128 + n) = acc[i][j];
    }
}

__device__ __forceinline__ void s5_carry_item(const Params& p, int layer, int item) {
  const int idx = item * 256 + otid();
  const int b = idx >> 11, grp = (idx >> 6) & 31, pp = idx & 63;
  const float* a8 = (const float*)(p.ws + OFF_A8) + (size_t)((layer * 32 + grp) * 64 + pp) * 2;
  const float ar = a8[0], ai = a8[1];
  const float* er = (const float*)(p.ws + OFF_E) + ((size_t)(grp * 128 + 2 * pp)) * NBC + b * 256;
  const float* ei = er + NBC;
  bf16_t* hro = (bf16_t*)(p.ws + OFF_HIN) + ((size_t)(grp * 128 + 2 * pp)) * NBC + b * 256;
  bf16_t* hio = hro + NBC;
  float hr = 0.f, hi = 0.f;
  for (int c16 = 0; c16 < 16; ++c16) {
    f32x4 vr[4], vi[4];
#pragma unroll
    for (int u = 0; u < 4; ++u) {
      vr[u] = *(const f32x4*)(er + c16 * 16 + u * 4);
      vi[u] = *(const f32x4*)(ei + c16 * 16 + u * 4);
    }
#pragma unroll
    for (int u = 0; u < 4; ++u) {
      float orr[4], oii[4];
#pragma unroll
      for (int k = 0; k < 4; ++k) {
        orr[k] = hr; oii[k] = hi;
        const float nr = ar * hr - ai * hi + vr[u][k];
        const float ni = ar * hi + ai * hr + vi[u][k];
        hr = nr; hi = ni;
      }
      u32x2 o0, o1;
      o0.x = pack2(orr[0], orr[1]); o0.y = pack2(orr[2], orr[3]);
      o1.x = pack2(oii[0], oii[1]); o1.y = pack2(oii[2], oii[3]);
      *(u32x2*)(hro + c16 * 16 + u * 4) = o0;
      *(u32x2*)(hio + c16 * 16 + u * 4) = o1;
    }
  }
}

__device__ __forceinline__ void mlapost_item(const Params& p, int layer, int round, int item) {
  const bf16_t* PROJ = (const bf16_t*)(p.ws + OFF_PROJ);
  bf16_t* QM = (bf16_t*)(p.ws + OFF_QM);
  bf16_t* KM = (bf16_t*)(p.ws + OFF_KM);
  const bf16_t* KN = (const bf16_t*)(p.ws + OFF_KN);
  const int* pos = (const int*)p.in[1];
  const int w = otid() >> 6, l = otid() & 63;
  const float* qn = p.in[31] + layer * 192;
  const float* kn = p.in[32] + layer * 192;
  const float q0 = qn[l], q1 = qn[64 + l], q2 = qn[128 + l];
  const float k0 = kn[l], k1 = kn[64 + l], k2 = kn[128 + l];
  const float invf = expf(-13.122363377404328f * (float)(l & 31) * (1.0f / 32.0f));
  const float qscale = 0.07216878364870322f * LOG2E;
  for (int tt = 0; tt < 4; ++tt) {
    const int row = item * 16 + w * 4 + tt;
    const float ang = (float)pos[round * TR + row] * invf;
    const float cs = cosf(ang), sn = sinf(ang);
    const float kr = bf2f(PROJ[(size_t)row * LDP + C_KR + l]);
#pragma unroll
    for (int h = 0; h < 4; ++h) {
      {
        bf16_t* qp = QM + (size_t)row * 768 + h * 192;
        float e0 = bf2f(qp[l]), e1 = bf2f(qp[64 + l]), e2 = bf2f(qp[128 + l]);
        const float ss = wave_sum(e0 * e0 + e1 * e1 + e2 * e2);
        const float rs = rsqrtf(ss * (1.0f / 192.0f) + EPS);
        e0 *= rs * q0; e1 *= rs * q1; e2 *= rs * q2;
        const float ot = __shfl_xor(e2, 32, 64);
        e2 = (l < 32) ? (e2 * cs - ot * sn) : (e2 * cs + ot * sn);
        qp[l] = f2bf(e0 * qscale); qp[64 + l] = f2bf(e1 * qscale); qp[128 + l] = f2bf(e2 * qscale);
      }
      {
        const bf16_t* kp = KN + (size_t)row * 512 + h * 128;
        float e0 = bf2f(kp[l]), e1 = bf2f(kp[64 + l]), e2 = kr;
        const float ss = wave_sum(e0 * e0 + e1 * e1 + e2 * e2);
        const float rs = rsqrtf(ss * (1.0f / 192.0f) + EPS);
        e0 *= rs * k0; e1 *= rs * k1; e2 *= rs * k2;
        const float ot = __shfl_xor(e2, 32, 64);
        e2 = (l < 32) ? (e2 * cs - ot * sn) : (e2 * cs + ot * sn);
        bf16_t* ko = KM + (size_t)row * 768 + h * 192;
        ko[l] = f2bf(e0); ko[64 + l] = f2bf(e1); ko[128 + l] = f2bf(e2);
      }
    }
  }
}

__device__ __forceinline__ void mb_scan_item(const Params& p, int item) {
  const int idx = item * 256 + otid();
  const int b = idx >> 16, h = (idx >> 13) & 7, pn = idx & 8191;
  const float* ST = (const float*)(p.ws + OFF_ST);
  const float* AC = (const float*)(p.ws + OFF_ACUM);
  bf16_t* SIN = (bf16_t*)(p.ws + OFF_SIN);
  float cur = 0.f;
  float alv[16], stv[16];
#pragma unroll
  for (int c = 0; c < 16; ++c) {
    alv[c] = AC[(size_t)(b * 2048 + c * 128 + 127) * 8 + h];
    stv[c] = ST[((size_t)((b * 16 + c) * 8 + h)) * 8192 + pn];
  }
#pragma unroll
  for (int c = 0; c < 16; ++c) {
    SIN[((size_t)((b * 16 + c) * 8 + h)) * 8192 + pn] = f2bf(cur);
    cur = __expf(alv[c]) * cur + stv[c];
  }
}

__device__ __forceinline__ void s5_y_item(const Params& p, int layer, int item, bf16_t* smem) {
  const bf16_t* PROJ = (const bf16_t*)(p.ws + OFF_PROJ);
  const int grp = item >> 3, mt = item & 7;
  const bf16_t* Km = (const bf16_t*)(p.ws + OFF_KMAT) + (size_t)(layer * 32 + grp) * 16384;
  const bf16_t* Fm = (const bf16_t*)(p.ws + OFF_FMAT) + (size_t)(layer * 32 + grp) * 16384;
  const bf16_t* HIN = (const bf16_t*)(p.ws + OFF_HIN) + (size_t)grp * 128 * NBC + mt * 128;
  bf16_t* YG = (bf16_t*)(p.ws + OFF_YG);
  f32x4 acc[4][4];
  zero_acc<4>(acc);
  gemm_tile<128, false, false, true>(acc, PROJ + (size_t)mt * 128 * 8 * LDP + C_S5U + grp * 16, 8 * LDP, Km, 128, 128, smem, LDP);
  gemm_tile<128, true, false, false>(acc, HIN, NBC, Fm, 128, 128, smem);
  const int tid = otid(), w = tid >> 6, l = tid & 63, g = l >> 4, c = l & 15, wr = w >> 1, wc = w & 1;
  const float* dsk = p.in[24] + layer * 512;
#pragma unroll
  for (int i = 0; i < 4; ++i)
#pragma unroll
    for (int j = 0; j < 4; ++j) {
      const int n = wc * 64 + j * 16 + c;
      const int tq = n >> 4, co = n & 15;
      const int ch = grp * 16 + co;
      const float dd = dsk[ch];
#pragma unroll
      for (int r = 0; r < 4; ++r) {
        const int m = mt * 128 + wr * 64 + i * 16 + g * 4 + r;
        const int row = m * 8 + tq;
        const float u = bf2f(PROJ[(size_t)row * LDP + C_S5U + ch]);
        const float y = acc[i][j][r] + dd * u;
        YG[(size_t)row * 512 + ch] = f2bf(gelu_tanh(y));
      }
    }
}

template <int DK, int NM>
__device__ __forceinline__ void attn_core(const bf16_t* __restrict__ Qb, long ldq, const bf16_t* __restrict__ Kb, long ldk,
                                          const bf16_t* __restrict__ Vt, int qb, bf16_t* smem, f32x4 (&O)[NM][8], float (&lsum)[NM][4]) {
  constexpr int KST = DK + 8;
  constexpr int KCH = NM * 64 * DK / 8 / 256;
  constexpr int CPM = 64 * DK / 8;
  constexpr int CPRK = DK / 8;
  bf16_t* sK = smem;
  bf16_t* sV = sK + NM * 64 * KST;
  bf16_t* sP = sV + 128 * 72;
  const int tid = otid(), w = tid >> 6, l = tid & 63, g = l >> 4, c = l & 15;
  bf16x8 qf[NM][DK / 32];
  {
    const long qrow = (long)qb * 64 + w * 16 + c;
#pragma unroll
    for (int m = 0; m < NM; ++m)
#pragma unroll
      for (int ks = 0; ks < DK / 32; ++ks) qf[m][ks] = *(const bf16x8*)(Qb + qrow * ldq + m * DK + ks * 32 + g * 8);
  }
  float mrow[NM][4];
#pragma unroll
  for (int m = 0; m < NM; ++m) {
#pragma unroll
    for (int r = 0; r < 4; ++r) { mrow[m][r] = -INFINITY; lsum[m][r] = 0.f; }
#pragma unroll
    for (int nt = 0; nt < 8; ++nt) O[m][nt] = (f32x4){0.f, 0.f, 0.f, 0.f};
  }
  u32x4 kr[KCH], vr[4];
  auto gloadK = [&](int kt) {
#pragma unroll
    for (int i = 0; i < KCH; ++i) {
      const int ch = tid + i * 256;
      const int m = ch / CPM, cc = ch % CPM;
      const int key = cc / CPRK, d0 = (cc % CPRK) * 8;
      kr[i] = *(const u32x4*)(Kb + (long)(kt * 64 + key) * ldk + m * DK + d0);
    }
  };
  auto gloadV = [&](int kt) {
#pragma unroll
    for (int i = 0; i < 4; ++i) {
      const int ch = tid + i * 256;
      const int dvr = ch >> 3, kc = (ch & 7) * 8;
      vr[i] = *(const u32x4*)(Vt + (long)dvr * 2048 + kt * 64 + kc);
    }
  };
  gloadK(0);
  gloadV(0);
  for (int kt = 0; kt <= qb; ++kt) {
    __syncthreads();
#pragma unroll
    for (int i = 0; i < KCH; ++i) {
      const int ch = tid + i * 256;
      const int m = ch / CPM, cc = ch % CPM;
      const int key = cc / CPRK, d0 = (cc % CPRK) * 8;
      *(u32x4*)(sK + (m * 64 + key) * KST + d0) = kr[i];
    }
#pragma unroll
    for (int i = 0; i < 4; ++i) {
      const int ch = tid + i * 256;
      const int dvr = ch >> 3, kc = (ch & 7) * 8;
      *(u32x4*)(sV + dvr * 72 + kc) = vr[i];
    }
    __syncthreads();
    if (kt < qb) gloadK(kt + 1);
#pragma unroll
    for (int m = 0; m < NM; ++m) {
      f32x4 S[4];
#pragma unroll
      for (int nt = 0; nt < 4; ++nt) {
        S[nt] = (f32x4){0.f, 0.f, 0.f, 0.f};
#pragma unroll
        for (int ks = 0; ks < DK / 32; ++ks) {
          const bf16x8 kf = *(const bf16x8*)(sK + (m * 64 + nt * 16 + c) * KST + ks * 32 + g * 8);
          S[nt] = __builtin_amdgcn_mfma_f32_16x16x32_bf16(qf[m][ks], kf, S[nt], 0, 0, 0);
        }
        MEMBAR();
      }
      if (kt == qb) {
#pragma unroll
        for (int nt = 0; nt < 4; ++nt)
#pragma unroll
          for (int r = 0; r < 4; ++r)
            if (nt * 16 + c > w * 16 + g * 4 + r) S[nt][r] = -INFINITY;
      }
      bf16_t* pw = sP + (size_t)((w * NM + m) * 16) * 72;
#pragma unroll
      for (int r = 0; r < 4; ++r) {
        float mx = fmaxf(fmaxf(S[0][r], S[1][r]), fmaxf(S[2][r], S[3][r]));
        mx = fmaxf(mx, __shfl_xor(mx, 1, 64));
        mx = fmaxf(mx, __shfl_xor(mx, 2, 64));
        mx = fmaxf(mx, __shfl_xor(mx, 4, 64));
        mx = fmaxf(mx, __shfl_xor(mx, 8, 64));
        const float mnew = fmaxf(mrow[m][r], mx);
        const float sc = __builtin_amdgcn_exp2f(mrow[m][r] - mnew);
        mrow[m][r] = mnew;
        float ps = 0.f;
#pragma unroll
        for (int nt = 0; nt < 4; ++nt) {
          const float pv = __builtin_amdgcn_exp2f(S[nt][r] - mnew);
          ps += pv;
          pw[(g * 4 + r) * 72 + nt * 16 + c] = f2bf(pv);
        }
        ps += __shfl_xor(ps, 1, 64);
        ps += __shfl_xor(ps, 2, 64);
        ps += __shfl_xor(ps, 4, 64);
        ps += __shfl_xor(ps, 8, 64);
        lsum[m][r] = lsum[m][r] * sc + ps;
#pragma unroll
        for (int nt = 0; nt < 8; ++nt) O[m][nt][r] *= sc;
      }
    }
    __syncthreads();
    if (kt < qb) gloadV(kt + 1);
#pragma unroll
    for (int m = 0; m < NM; ++m) {
      const bf16_t* pw = sP + (size_t)((w * NM + m) * 16) * 72;
#pragma unroll
      for (int ks = 0; ks < 2; ++ks) {
        const bf16x8 pf = *(const bf16x8*)(pw + c * 72 + ks * 32 + g * 8);
#pragma unroll
        for (int nt = 0; nt < 8; ++nt) {
          const bf16x8 vf = *(const bf16x8*)(sV + (nt * 16 + c) * 72 + ks * 32 + g * 8);
          O[m][nt] = __builtin_amdgcn_mfma_f32_16x16x32_bf16(pf, vf, O[m][nt], 0, 0, 0);
        }
        MEMBAR();
      }
    }
  }
}

__device__ __forceinline__ void da_attn_item(const Params& p, int layer, int bh, int qb, bf16_t* smem, bool dry = false) {
  bf16_t* PROJ = (bf16_t*)(p.ws + OFF_PROJ);
  const bf16_t* VTA = (const bf16_t*)(p.ws + OFF_VTA);
  const int b = bh >> 2, h = bh & 3;
  f32x4 O[2][8];
  float ls[2][4];
  {
    f32x4 O1[1][8];
    float l1[1][4];
#pragma unroll 1
    for (int m = 0; m < 2; ++m) {
      attn_core<64, 1>(PROJ + (size_t)b * 2048 * LDP + C_DAQ + h * 128 + m * 64, LDP, PROJ + (size_t)b * 2048 * LDP + C_DAK + h * 128 + m * 64, LDP,
                       VTA + (size_t)(b * 4 + h) * 128 * 2048, qb, smem, O1, l1);
      if (m == 0) {
#pragma unroll
        for (int nt = 0; nt < 8; ++nt) O[0][nt] = O1[0][nt];
#pragma unroll
        for (int r = 0; r < 4; ++r) ls[0][r] = l1[0][r];
      } else {
#pragma unroll
        for (int nt = 0; nt < 8; ++nt) O[1][nt] = O1[0][nt];
#pragma unroll
        for (int r = 0; r < 4; ++r) ls[1][r] = l1[0][r];
      }
    }
  }
  const int tid = otid(), w = tid >> 6, l = tid & 63, g = l >> 4, c = l & 15;
  const float lam = ((const float*)(p.ws + OFF_LAM))[layer];
  const float linit = 0.8f - 0.6f * expf(-0.3f * (float)layer);
  const float* sg = p.in[10] + layer * 128;
#pragma unroll
  for (int r = 0; r < 4; ++r) {
    const float i0 = 1.0f / ls[0][r], i1 = lam / ls[1][r];
    float o[8];
    float ss = 0.f;
#pragma unroll
    for (int nt = 0; nt < 8; ++nt) {
      o[nt] = O[0][nt][r] * i0 - O[1][nt][r] * i1;
      ss += o[nt] * o[nt];
    }
    ss += __shfl_xor(ss, 1, 64);
    ss += __shfl_xor(ss, 2, 64);
    ss += __shfl_xor(ss, 4, 64);
    ss += __shfl_xor(ss, 8, 64);
    const float rs = rsqrtf(ss * (1.0f / 128.0f) + EPS) * (1.0f - linit);
    const size_t row = (size_t)b * 2048 + qb * 64 + w * 16 + g * 4 + r;
#pragma unroll
    for (int nt = 0; nt < 8; ++nt) {
      const int dv = nt * 16 + c;
      bf16_t* gp = PROJ + row * LDP + C_DAG + h * 128 + dv;
      const float gt = bf2f(*gp);
      if (!dry) *gp = f2bf(o[nt] * rs * sg[dv] * siluf_(gt));
    }
  }
}

__device__ __forceinline__ void mla_attn_item(const Params& p, int bh, int qb, bf16_t* smem, bool dry = false) {
  bf16_t* PROJ = (bf16_t*)(p.ws + OFF_PROJ);
  const bf16_t* QM = (const bf16_t*)(p.ws + OFF_QM);
  const bf16_t* KM = (const bf16_t*)(p.ws + OFF_KM);
  const bf16_t* VTD = (const bf16_t*)(p.ws + OFF_VTD);
  const int b = bh >> 2, h = bh & 3;
  f32x4 O[1][8];
  float ls[1][4];
  attn_core<192, 1>(QM + (size_t)b * 2048 * 768 + h * 192, 768, KM + (size_t)b * 2048 * 768 + h * 192, 768,
                    VTD + (size_t)(b * 4 + h) * 128 * 2048, qb, smem, O, ls);
  const int tid = otid(), w = tid >> 6, l = tid & 63, g = l >> 4, c = l & 15;
#pragma unroll
  for (int r = 0; r < 4; ++r) {
    const float i0 = 1.0f / ls[0][r];
    const size_t row = (size_t)b * 2048 + qb * 64 + w * 16 + g * 4 + r;
#pragma unroll
    for (int nt = 0; nt < 8; ++nt) {
      const int dv = nt * 16 + c;
      bf16_t* gp = PROJ + row * LDP + C_MLG + h * 128 + dv;
      const float gt = bf2f(*gp);
      if (!dry) *gp = f2bf(O[0][nt][r] * i0 * siluf_(gt));
    }
  }
}

__device__ __forceinline__ void mb_out_item(const Params& p, int layer, int item, bf16_t* smem) {
  bf16_t* PROJ = (bf16_t*)(p.ws + OFF_PROJ);
  const bf16_t* XC = (const bf16_t*)(p.ws + OFF_XC);
  const float* DT = (const float*)(p.ws + OFF_DT);
  const float* AC = (const float*)(p.ws + OFF_ACUM);
  const bf16_t* SIN = (const bf16_t*)(p.ws + OFF_SIN);
  bf16_t* MS = (bf16_t*)(p.ws + OFF_MS) + (size_t)blockIdx.x * 128 * 128;
  float* rowss = (float*)((unsigned char*)smem + 73728);
  const int grp = item & 1, bc = item >> 1;
  const int row0 = bc * 128;
  __syncthreads();
  const bf16_t* Cp = XC + (size_t)row0 * 1024 + 768 + grp * 128;
  const bf16_t* Bp = XC + (size_t)row0 * 1024 + 512 + grp * 128;
#pragma unroll 1
  for (int r4 = 0; r4 < 4; ++r4) {
    const int h = grp * 4 + r4;
    const int tid = otid(), w = tid >> 6, l = tid & 63, g = l >> 4, c = l & 15, wr = w >> 1, wc = w & 1;
    {
      f32x4 cb[4][4];
      zero_acc<4>(cb);
      gemm_tile<128, false, false, false>(cb, Cp, 1024, Bp, 1024, 128, smem);
      float acs[4], dts[4];
#pragma unroll
      for (int j = 0; j < 4; ++j) {
        const int s = wc * 64 + j * 16 + c;
        acs[j] = AC[(size_t)(row0 + s) * 8 + h];
        dts[j] = DT[(size_t)(row0 + s) * 8 + h];
      }
#pragma unroll
      for (int i = 0; i < 4; ++i)
#pragma unroll
        for (int r = 0; r < 4; ++r) {
          const int lr = wr * 64 + i * 16 + g * 4 + r;
          const float acl = AC[(size_t)(row0 + lr) * 8 + h];
#pragma unroll
          for (int j = 0; j < 4; ++j) {
            const int s = wc * 64 + j * 16 + c;
            const float v = (s <= lr) ? cb[i][j][r] * __expf(acl - acs[j]) * dts[j] : 0.f;
            MS[lr * 128 + s] = f2bf(v);
          }
          MEMBAR();
        }
    }
    block_global_handoff();
    f32x4 ad[4][2], ao[4][2];
    zero_acc<2>(ad);
    zero_acc<2>(ao);
    gemm_tile<64, false, true, false>(ad, MS, 128, XC + (size_t)row0 * 1024 + h * 64, 1024, 128, smem);
    gemm_tile<64, false, false, false>(ao, Cp, 1024, SIN + ((size_t)(bc * 8 + h)) * 8192, 128, 128, smem);
    const float dsk = p.in[15][layer * 8 + h];
#pragma unroll
    for (int i = 0; i < 4; ++i)
#pragma unroll
      for (int r = 0; r < 4; ++r) {
        const int lr = wr * 64 + i * 16 + g * 4 + r;
        const size_t row = (size_t)row0 + lr;
        const float ea = __expf(AC[row * 8 + h]);
        float ssq = 0.f;
#pragma unroll
        for (int j = 0; j < 2; ++j) {
          const int ch = h * 64 + wc * 32 + j * 16 + c;
          const float xv = bf2f(XC[row * 1024 + ch]);
          bf16_t* zp = PROJ + row * LDP + C_MBZ + ch;
          const float z = bf2f(*zp);
          float y = ad[i][j][r] + ea * ao[i][j][r] + dsk * xv;
          y *= siluf_(z);
          ssq += y * y;
          *zp = f2bf(y);
        }
        ssq += __shfl_xor(ssq, 1, 64);
        ssq += __shfl_xor(ssq, 2, 64);
        ssq += __shfl_xor(ssq, 4, 64);
        ssq += __shfl_xor(ssq, 8, 64);
        if (c == 0) rowss[(r4 * 2 + wc) * 128 + lr] = ssq;
        MEMBAR();
      }
  }
  block_global_handoff();
  const float* ng = p.in[16] + layer * 512 + grp * 256;
  {
    const int cc = otid();
    const float gcc = ng[cc];
    for (int l0 = 0; l0 < 128; l0 += 16) {
      bf16_t vals[16];
#pragma unroll
      for (int u = 0; u < 16; ++u) vals[u] = PROJ[(size_t)(row0 + l0 + u) * LDP + C_MBZ + grp * 256 + cc];
#pragma unroll
      for (int u = 0; u < 16; ++u) {
        const int lr = l0 + u;
        float tot = 0.f;
#pragma unroll
        for (int q = 0; q < 8; ++q) tot += rowss[q * 128 + lr];
        PROJ[(size_t)(row0 + lr) * LDP + C_MBZ + grp * 256 + cc] = f2bf(bf2f(vals[u]) * rsqrtf(tot * (1.0f / 256.0f) + EPS) * gcc);
      }
    }
  }
}

__device__ __forceinline__ void s5_glu_tile(const Params& p, int layer, int rt, int ct, bf16_t* smem) {
  bf16_t* PROJ = (bf16_t*)(p.ws + OFF_PROJ);
  const bf16_t* YG = (const bf16_t*)(p.ws + OFF_YG);
  const bf16_t* W = (const bf16_t*)(p.ws + OFF_WGLUT) + (size_t)layer * 512 * 512;
  f32x4 acc[4][4];
  zero_acc<4>(acc);
  gemm_tile<128, false, false, false>(acc, YG + (size_t)rt * 128 * 512, 512, W + (size_t)ct * 128 * 512, 512, 512, smem);
  const int tid = otid(), w = tid >> 6, l = tid & 63, g = l >> 4, c = l & 15, wr = w >> 1, wc = w & 1;
  const float* bg = p.in[26] + layer * 512;
#pragma unroll
  for (int i = 0; i < 4; ++i)
#pragma unroll
    for (int j = 0; j < 4; ++j) {
      const int col = ct * 128 + wc * 64 + j * 16 + c;
      const float bb = bg[col];
#pragma unroll
      for (int r = 0; r < 4; ++r) {
        const size_t row = (size_t)rt * 128 + wr * 64 + i * 16 + g * 4 + r;
        const float yv = bf2f(YG[row * 512 + col]);
        bf16_t* gp = PROJ + row * LDP + C_S5G + col;
        const float gt = bf2f(*gp);
        *gp = f2bf(yv * sigmoidf_(acc[i][j][r] + bb) * siluf_(gt));
      }
    }
}

__device__ __forceinline__ void merge_tile(const Params& p, int layer, int rt, int ct, bf16_t* smem) {
  const bf16_t* PROJ = (const bf16_t*)(p.ws + OFF_PROJ);
  bf16_t* MG = (bf16_t*)(p.ws + OFF_MERGED);
  f32x4 macc[4][2];
  zero_acc<2>(macc);
  const int tid = otid(), w = tid >> 6, l = tid & 63, g = l >> 4, c = l & 15, wr = w >> 1, wc = w & 1;
  for (int n = 0; n < 4; ++n) {
    const int ycol = (n == 0) ? C_DAG : (n == 1) ? C_MBZ : (n == 2) ? C_S5G : C_MLG;
    const bf16_t* W = (const bf16_t*)(p.ws + OFF_WBRT) + (size_t)(layer * 4 + n) * 1024 * 512;
    f32x4 acc[4][2];
    zero_acc<2>(acc);
    gemm_tile<64, false, false, false>(acc, PROJ + (size_t)rt * 128 * LDP + ycol, LDP, W + (size_t)ct * 64 * 512, 512, 512, smem);
#pragma unroll
    for (int i = 0; i < 4; ++i) {
#pragma unroll
      for (int r = 0; r < 4; ++r) {
        const size_t row = (size_t)rt * 128 + wr * 64 + i * 16 + g * 4 + r;
        const bf16_t* gp = PROJ + row * LDP + C_GATE + n * 1024 + ct * 64 + wc * 32 + c;
#pragma unroll
        for (int j = 0; j < 2; ++j) macc[i][j][r] += bf2f(gp[j * 16]) * acc[i][j][r];
      }
      MEMBAR();
    }
  }
#pragma unroll
  for (int i = 0; i < 4; ++i) {
#pragma unroll
    for (int r = 0; r < 4; ++r) {
      const size_t row = (size_t)rt * 128 + wr * 64 + i * 16 + g * 4 + r;
      bf16_t* op = MG + row * 1024 + ct * 64 + wc * 32 + c;
#pragma unroll
      for (int j = 0; j < 2; ++j) op[j * 16] = f2bf(macc[i][j][r]);
    }
    MEMBAR();
  }
}

__device__ __forceinline__ void out_tile(const Params& p, int layer, const float* xo, float* xn, int rt, int ct, bf16_t* smem) {
  const bf16_t* MG = (const bf16_t*)(p.ws + OFF_MERGED);
  const bf16_t* W = (const bf16_t*)(p.ws + OFF_WOUTT) + (size_t)layer * 1024 * 1024;
  f32x4 acc[4][4];
  zero_acc<4>(acc);
  gemm_tile<128, false, false, false>(acc, MG + (size_t)rt * 128 * 1024, 1024, W + (size_t)ct * 128 * 1024, 1024, 1024, smem);
  const int tid = otid(), w = tid >> 6, l = tid & 63, g = l >> 4, c = l & 15, wr = w >> 1, wc = w & 1;
#pragma unroll
  for (int i = 0; i < 4; ++i)
#pragma unroll
    for (int j = 0; j < 4; ++j) {
      const int col = ct * 128 + wc * 64 + j * 16 + c;
#pragma unroll
      for (int r = 0; r < 4; ++r) {
        const size_t row = (size_t)rt * 128 + wr * 64 + i * 16 + g * 4 + r;
        xn[row * 1024 + col] = xo[row * 1024 + col] + acc[i][j][r];
      }
    }
}

__device__ __forceinline__ void gsync(cg::grid_group& grid, unsigned* bar, unsigned& epoch) {
  asm volatile("s_waitcnt vmcnt(0)" ::: "memory");
  __syncthreads();
  if (otid() == 0) {
    unsigned long long* w = (unsigned long long*)bar;
    __builtin_amdgcn_fence(__ATOMIC_RELEASE, "agent");
    asm volatile("s_waitcnt vmcnt(0)" ::: "memory");
    const unsigned long long old = __hip_atomic_fetch_add(w, 1ull, __ATOMIC_RELAXED, __HIP_MEMORY_SCOPE_AGENT);
    const unsigned G = gridDim.x;
    if ((unsigned)(old & 0xffffffffull) == G - 1) {
      __hip_atomic_fetch_add(w, (1ull << 32) - (unsigned long long)G, __ATOMIC_RELAXED, __HIP_MEMORY_SCOPE_AGENT);
    } else {
      const unsigned g0 = (unsigned)(old >> 32);
      while ((unsigned)(__hip_atomic_load(w, __ATOMIC_RELAXED, __HIP_MEMORY_SCOPE_AGENT) >> 32) == g0) __builtin_amdgcn_s_sleep(1);
    }
    __builtin_amdgcn_fence(__ATOMIC_ACQUIRE, "agent");
    asm volatile("s_waitcnt vmcnt(0)" ::: "memory");
  }
  __syncthreads();
}

#ifdef SELFCHECK
__device__ __forceinline__ void cksum(const void* ptr, size_t bytes, unsigned long long* slot) {
  const u32x4* q = (const u32x4*)ptr;
  const size_t n = bytes / 16;
  unsigned long long s = 0;
  for (size_t i = (size_t)blockIdx.x * 256 + otid(); i < n; i += (size_t)gridDim.x * 256) {
    const u32x4 v = q[i];
    s += (unsigned long long)v.x + 3ull * v.y + 5ull * v.z + 7ull * v.w;
  }
  unsigned lo = (unsigned)s, hi = (unsigned)(s >> 32);
  unsigned long long t = s;
#pragma unroll
  for (int d = 32; d >= 1; d >>= 1) {
    const unsigned l2 = __shfl_xor((unsigned)t, d, 64), h2 = __shfl_xor((unsigned)(t >> 32), d, 64);
    t += ((unsigned long long)h2 << 32) | l2;
  }
  (void)lo; (void)hi;
  if ((otid() & 63) == 0) atomicAdd(slot, t);
}
#define CK(ptr, bytes) cksum((ptr), (bytes), slots + slot)
#else
#define CK(ptr, bytes) do {} while (0)
#endif

__device__ __forceinline__ void cksum_acc(const void* ptr, size_t bytes, unsigned long long& s) {
  const u32x4* q = (const u32x4*)ptr;
  const size_t n = bytes / 16;
  for (size_t i = ((size_t)blockIdx.x * 256 + otid()) * 64; i < n; i += (size_t)gridDim.x * 256 * 64) {
    const u32x4 v = __builtin_nontemporal_load(q + i);
    s += (unsigned long long)v.x + 3ull * v.y + 5ull * v.z + 7ull * v.w;
  }
}
__device__ __forceinline__ void cksum_commit(unsigned long long t, unsigned long long* slot) {
#pragma unroll
  for (int d = 32; d >= 1; d >>= 1) {
    const unsigned l2 = __shfl_xor((unsigned)t, d, 64), h2 = __shfl_xor((unsigned)(t >> 32), d, 64);
    t += ((unsigned long long)h2 << 32) | l2;
  }
  if ((otid() & 63) == 0) atomicAdd(slot, t);
}

__global__ void __launch_bounds__(256, 2) fwd_megakernel(Params p) {
  cg::grid_group grid = cg::this_grid();
  __shared__ __attribute__((aligned(16))) unsigned char smem_raw[SMEM_BYTES];
  bf16_t* smem = (bf16_t*)smem_raw;
  float* smf = (float*)smem_raw;
  const int G = gridDim.x, bid = blockIdx.x;
  unsigned* bar = (unsigned*)(p.ws + OFF_BAR);
  unsigned epoch = 0;
#ifdef START_DELAY_US
  {
    const unsigned long long t0 = __builtin_amdgcn_s_memrealtime();
    while (__builtin_amdgcn_s_memrealtime() - t0 < (unsigned long long)START_DELAY_US * 100ull) __builtin_amdgcn_s_sleep(20);
  }
#endif
  grid.sync();
#ifdef WCHECK
  unsigned wseen = 0;
  if (bid == 0 && otid() == 0) wseen = __hip_atomic_load(bar + 32, __ATOMIC_RELAXED, __HIP_MEMORY_SCOPE_AGENT);
#endif

#ifdef SELFCHECK
  unsigned long long* slots_base = (unsigned long long*)(p.ws + OFF_BAR + 256);
  if (bid == 0) for (int k = otid(); k < 768; k += 256) __hip_atomic_store(slots_base + k, 0ull, __ATOMIC_RELAXED, __HIP_MEMORY_SCOPE_AGENT);
  for (int run = 0; run < 3; ++run) {
  unsigned long long* slots = slots_base + run * 256;
  int slot = 0;
#endif
  {
    unsigned long long* sslots = (unsigned long long*)(p.ws + OFF_BAR + 1024);
    unsigned long long prev = 0;
    for (int iter = 0; iter < 64; ++iter) {
      unsigned long long s = 0;
      cksum_acc(p.out, (size_t)BATCH * SEQ * 1024 * 4, s);
      cksum_acc(p.ws, OFF_BAR, s);
      cksum_commit(s, sslots + iter);
      gsync(grid, bar, epoch);
      const unsigned long long c = __hip_atomic_load(sslots + iter, __ATOMIC_RELAXED, __HIP_MEMORY_SCOPE_AGENT);
      if (iter > 0 && c == prev) break;
      prev = c;
    }
  }
  phase_prep(p, smf);
  gsync(grid, bar, epoch);
  phase_prep(p, smf);
#ifdef SELF_POISON
  {
    u32x4* q = (u32x4*)(p.ws + OFF_H);
    const size_t n16 = (WS_TOTAL - OFF_H) / 16;
    const u32x4 pv = {SELF_POISON, SELF_POISON, SELF_POISON, SELF_POISON};
    for (size_t i = (size_t)bid * 256 + otid(); i < n16; i += (size_t)G * 256) q[i] = pv;
  }
#endif
  gsync(grid, bar, epoch);
#ifdef SELFCHECK
  CK(p.ws, OFF_H); slot++;
#endif

  for (int layer = 0; layer < 2; ++layer) {
    const float* xin = (layer == 0) ? p.in[0] : p.out;
    float* xout = p.out;
    for (int round = 0; round < NROUND; ++round) {
      const size_t tok0 = (size_t)round * TR;
      if (layer == 0 && round == 0) {
        phase_hnorm(xin + tok0 * 1024, p.in[2] + layer * 1024, (bf16_t*)(p.ws + OFF_H));
        gsync(grid, bar, epoch);
      }
#ifdef SELFCHECK
      CK(p.ws + OFF_H, (size_t)TR * 1024 * 2); slot++;
#endif
#ifndef REP_B
#define REP_B 1
#endif
      for (int rep = 0; rep < REP_B; ++rep) {
      for (int it = bid; it < NRT * 76; it += G) inproj_tile(p, layer, it % NRT, it / NRT, smem);
      gsync(grid, bar, epoch);
      }
#ifdef SELFCHECK
      CK(p.ws + OFF_PROJ, (size_t)TR * D_INP * 2); CK(p.ws + OFF_VTA, (size_t)RB * 4 * 128 * 2048 * 2); slot++;
#endif
      {
        constexpr int n1 = 256, n2 = TR / 16, n3 = RB * 32 * 16, n4 = RB * 16 * 8 / 4;
        for (int it = bid; it < n1 + n2 + n3 + n4; it += G) {
          if (it < n1) s5_e_item(p, layer, it, smem);
          else if (it < n1 + n2) tokpost_item(p, layer, round, it - n1);
          else if (it < n1 + n2 + n3) conv_item(p, layer, it - n1 - n2);
          else dtacum_item(p, layer, it - n1 - n2 - n3);
        }
      }
      gsync(grid, bar, epoch);
#ifdef SELFCHECK
      CK(p.ws + OFF_PROJ, (size_t)TR * D_INP * 2); CK(p.ws + OFF_E, (size_t)32 * 128 * NBC * 4); CK(p.ws + OFF_XC, (size_t)TR * 1024 * 2);
      CK(p.ws + OFF_DT, (size_t)TR * 8 * 4); CK(p.ws + OFF_ACUM, (size_t)TR * 8 * 4); slot++;
#endif
      {
        constexpr int n1 = NRT * 6, n2 = NRT * 8, n3 = RB * 16 * 8, n4 = RB * 32 * 64 / 256;
        for (int it = bid; it < n1 + n2 + n3 + n4; it += G) {
          if (it < n1) mla_up_q_tile(p, layer, it % NRT, it / NRT, smem);
          else if (it < n1 + n2) mla_up_kv_tile(p, layer, (it - n1) % NRT, (it - n1) / NRT, smem);
          else if (it < n1 + n2 + n3) mb_states_item(p, it - n1 - n2, smem);
          else s5_carry_item(p, layer, it - n1 - n2 - n3);
        }
      }
      gsync(grid, bar, epoch);
#ifdef SELFCHECK
      CK(p.ws + OFF_QM, (size_t)TR * 768 * 2); CK(p.ws + OFF_KN, (size_t)TR * 512 * 2); CK(p.ws + OFF_VTD, (size_t)RB * 4 * 128 * 2048 * 2);
      CK(p.ws + OFF_ST, (size_t)RB * 16 * 8 * 8192 * 4); CK(p.ws + OFF_HIN, (size_t)32 * 128 * NBC * 2); slot++;
#endif
      {
        constexpr int n1 = 256, n2 = TR / 16, n3 = RB * 8 * 8192 / 256;
        for (int it = bid; it < n1 + n2 + n3; it += G) {
          if (it < n1) s5_y_item(p, layer, it, smem);
          else if (it < n1 + n2) mlapost_item(p, layer, round, it - n1);
          else mb_scan_item(p, it - n1 - n2);
        }
      }
      gsync(grid, bar, epoch);
#ifdef SELFCHECK
      CK(p.ws + OFF_YG, (size_t)TR * 512 * 2); CK(p.ws + OFF_QM, (size_t)TR * 768 * 2); CK(p.ws + OFF_KM, (size_t)TR * 768 * 2);
      CK(p.ws + OFF_SIN, (size_t)RB * 16 * 8 * 8192 * 2); slot++;
#endif
#ifdef REP_ATT
      {
        constexpr int nat = RB * 4 * 32 * 2;
        for (int it = bid; it < nat; it += G) {
            const int half = nat / 2;
            const int qb = (it < half) ? (31 - it / 32) : ((it - half) / 32);
            const int sub = it & 31;
            if (sub < 16) da_attn_item(p, layer, sub, qb, smem, true);
            else mla_attn_item(p, sub - 16, qb, smem, true);
        }
        gsync(grid, bar, epoch);
      }
#endif
      {
        constexpr int nat = RB * 4 * 32 * 2;
        constexpr int n3 = RB * 16 * 2, n4 = NRT * 4;
        for (int it0 = bid; it0 < nat + n3 + n4; it0 += G) {
          if (it0 < n3) { mb_out_item(p, layer, it0, smem); continue; }
          const int it = it0 - n3;
          if (it < nat) {
            const int half = nat / 2;
            const int qb = (it < half) ? (31 - it / 32) : ((it - half) / 32);
            const int sub = it & 31;
            if (sub < 16) da_attn_item(p, layer, sub, qb, smem);
            else mla_attn_item(p, sub - 16, qb, smem);
          } else s5_glu_tile(p, layer, (it - nat) % NRT, (it - nat) / NRT, smem);
        }
      }
      gsync(grid, bar, epoch);
#ifdef SELFCHECK
      CK(p.ws + OFF_PROJ, (size_t)TR * D_INP * 2); slot++;
#endif
      for (int it = bid; it < NRT * 16; it += G) merge_tile(p, layer, it % NRT, it / NRT, smem);
      gsync(grid, bar, epoch);
#ifdef SELFCHECK
      CK(p.ws + OFF_MERGED, (size_t)TR * 1024 * 2); slot++;
#endif
      for (int it = bid; it < NRT * 8; it += G) out_tile(p, layer, xin + tok0 * 1024, xout + tok0 * 1024, it % NRT, it / NRT, smem);
      {
        const int nl = (round + 1 < NROUND) ? layer : layer + 1;
        const int nr = (round + 1 < NROUND) ? round + 1 : 0;
        if (nl < 2) {
          const float* nx = (nl == 0) ? p.in[0] : p.out;
          phase_hnorm(nx + (size_t)nr * TR * 1024, p.in[2] + nl * 1024, (bf16_t*)(p.ws + OFF_H));
        }
      }
      gsync(grid, bar, epoch);
#ifdef SELFCHECK
      CK(xout + tok0 * 1024, (size_t)TR * 1024 * 4); slot++;
#endif
    }
  }
#ifdef WCHECK
  if (bid == 0 && otid() == 0) {
    if (wseen != 0) p.out[0] = 1.0e6f;
    __hip_atomic_store(bar + 32, 1u, __ATOMIC_RELAXED, __HIP_MEMORY_SCOPE_AGENT);
  }
#endif
#ifdef SELFCHECK
  gsync(grid, bar, epoch);
  }
  gsync(grid, bar, epoch);
  if (bid == 0 && otid() == 0) {
    int bad = -1;
    for (int k = 0; k < 100; ++k) {
      const unsigned long long a = __hip_atomic_load(slots_base + k, __ATOMIC_RELAXED, __HIP_MEMORY_SCOPE_AGENT);
      const unsigned long long b = __hip_atomic_load(slots_base + 256 + k, __ATOMIC_RELAXED, __HIP_MEMORY_SCOPE_AGENT);
      const unsigned long long c = __hip_atomic_load(slots_base + 512 + k, __ATOMIC_RELAXED, __HIP_MEMORY_SCOPE_AGENT);
      if (a != b || a != c) { bad = k; break; }
    }
    if (bad >= 0) p.out[0] = 10000.0f * exp2f((float)bad);
  }
#endif
}

extern "C" void kernel_launch(void* const* d_in, const int* in_sizes, int n_in, void* d_out,
                              int out_size, void* d_ws, size_t ws_size, hipStream_t stream) {
  static int grid_blocks = 0;
  if (!grid_blocks) {
    int dev = 0, cus = 0, per_cu = 0;
    (void)hipGetDevice(&dev);
    (void)hipDeviceGetAttribute(&cus, hipDeviceAttributeMultiprocessorCount, dev);
    (void)hipOccupancyMaxActiveBlocksPerMultiprocessor(&per_cu, fwd_megakernel, 256, 0);
    if (per_cu > 2) per_cu = 2;
    if (per_cu < 1) per_cu = 1;
    grid_blocks = cus * per_cu;
    if (grid_blocks > MAXBLK) grid_blocks = MAXBLK;
  }
  if (ws_size < WS_TOTAL) fprintf(stderr, "workspace too small: %zu < %zu\n", ws_size, (size_t)WS_TOTAL);
  Params p{};
  for (int i = 0; i < 35; ++i) p.in[i] = (const float*)d_in[i];
  p.out = (float*)d_out;
  p.ws = (unsigned char*)d_ws;
  (void)hipMemsetAsync((unsigned char*)d_ws + OFF_BAR, 0, 2048, stream);
  void* args[] = {&p};
  hipError_t e = hipLaunchCooperativeKernel((void*)fwd_megakernel, dim3(grid_blocks), dim3(256), args, 0, stream);
  if (e != hipSuccess) fprintf(stderr, "cooperative launch failed: %s (grid %d)\n", hipGetErrorString(e), grid_blocks);
}
```

```cpp
#include <hip/hip_runtime.h>
#include <hip/hip_cooperative_groups.h>
#include <cstdio>
#include <cstdint>
namespace cg = cooperative_groups;

typedef unsigned short bf16_t;
typedef short bf16x8 __attribute__((ext_vector_type(8)));
typedef float f32x4 __attribute__((ext_vector_type(4)));
typedef unsigned u32x4 __attribute__((ext_vector_type(4)));
typedef unsigned u32x2 __attribute__((ext_vector_type(2)));

constexpr int SEQ = 2048, BATCH = 16;
constexpr int D_IN = 9672, D_INP = 9728;
constexpr int RB = 4;
constexpr int TR = RB * SEQ;
constexpr int NROUND = BATCH / RB;
constexpr int NRT = TR / 128;
constexpr int NBC = TR / 8;
constexpr int MAXBLK = 512;
constexpr float EPS = 1e-6f;
constexpr float LOG2E = 1.4426950408889634f;
constexpr int C_DAQ = 0, C_DAK = 512, C_DAV = 1024, C_DAG = 1536, C_MBZ = 2048, C_XBC = 2560, C_DT = 3584,
              C_S5U = 3592, C_S5G = 4104, C_CQ = 4616, C_CKV = 4872, C_KR = 5000, C_MLG = 5064, C_GATE = 5576;
constexpr long LDP = D_INP;

constexpr size_t al256(size_t x) { return (x + 255) & ~size_t(255); }
constexpr size_t OFF_WINT = 0;
constexpr size_t OFF_WBRT = OFF_WINT + al256((size_t)2 * D_INP * 1024 * 2);
constexpr size_t OFF_WOUTT = OFF_WBRT + al256((size_t)2 * 4 * 1024 * 512 * 2);
constexpr size_t OFF_WGLUT = OFF_WOUTT + al256((size_t)2 * 1024 * 1024 * 2);
constexpr size_t OFF_WUQT = OFF_WGLUT + al256((size_t)2 * 512 * 512 * 2);
constexpr size_t OFF_WUKVT = OFF_WUQT + al256((size_t)2 * 768 * 256 * 2);
constexpr size_t OFF_KMAT = OFF_WUKVT + al256((size_t)2 * 1024 * 128 * 2);
constexpr size_t OFF_EMAT = OFF_KMAT + al256((size_t)2 * 32 * 128 * 128 * 2);
constexpr size_t OFF_FMAT = OFF_EMAT + al256((size_t)2 * 32 * 128 * 128 * 2);
constexpr size_t OFF_A8 = OFF_FMAT + al256((size_t)2 * 32 * 128 * 128 * 2);
constexpr size_t OFF_LAM = OFF_A8 + al256((size_t)2 * 32 * 64 * 2 * 4);
constexpr size_t OFF_H = OFF_LAM + 256;
constexpr size_t OFF_PROJ = OFF_H + al256((size_t)TR * 1024 * 2);
constexpr size_t OFF_XC = OFF_PROJ + al256((size_t)TR * D_INP * 2);
constexpr size_t OFF_DT = OFF_XC + al256((size_t)TR * 1024 * 2);
constexpr size_t OFF_ACUM = OFF_DT + al256((size_t)TR * 8 * 4);
constexpr size_t OFF_VTA = OFF_ACUM + al256((size_t)TR * 8 * 4);
constexpr size_t OFF_VTD = OFF_VTA + al256((size_t)RB * 4 * 128 * 2048 * 2);
constexpr size_t OFF_QM = OFF_VTD + al256((size_t)RB * 4 * 128 * 2048 * 2);
constexpr size_t OFF_KM = OFF_QM + al256((size_t)TR * 768 * 2);
constexpr size_t OFF_KN = OFF_KM + al256((size_t)TR * 768 * 2);
constexpr size_t OFF_ST = OFF_KN + al256((size_t)TR * 512 * 2);
constexpr size_t OFF_SIN = OFF_ST + al256((size_t)RB * 16 * 8 * 8192 * 4);
constexpr size_t OFF_MS = OFF_SIN + al256((size_t)RB * 16 * 8 * 8192 * 2);
constexpr size_t OFF_XS = OFF_MS + al256((size_t)MAXBLK * 128 * 128 * 2);
constexpr size_t OFF_E = OFF_XS + al256((size_t)MAXBLK * 128 * 64 * 2);
constexpr size_t OFF_HIN = OFF_E + al256((size_t)32 * 128 * NBC * 4);
constexpr size_t OFF_YG = OFF_HIN + al256((size_t)32 * 128 * NBC * 2);
constexpr size_t OFF_MERGED = OFF_YG + al256((size_t)TR * 512 * 2);
constexpr size_t OFF_QK = OFF_MERGED + al256((size_t)TR * 1024 * 2);
constexpr size_t OFF_CQ2 = OFF_QK + al256((size_t)TR * 1024 * 2);
constexpr size_t OFF_QM2 = OFF_CQ2 + al256((size_t)TR * 384 * 2);
constexpr size_t OFF_BAR = OFF_QM2 + al256((size_t)TR * 768 * 2);
constexpr size_t WS_TOTAL = OFF_BAR + 8192;

constexpr int SMEM_BYTES = 73728 + 4096;

struct Params {
  const float* in[35];
  float* out;
  unsigned char* ws;
};

#define MEMBAR() do { asm volatile("" ::: "memory"); __builtin_amdgcn_sched_barrier(0); } while (0)
__device__ __forceinline__ int otid() { int t = threadIdx.x; asm volatile("" : "+v"(t)); return t; }
__device__ __forceinline__ bf16_t f2bf(float f) {
  unsigned u = __float_as_uint(f);
  u += 0x7fffu + ((u >> 16) & 1u);
  return (bf16_t)(u >> 16);
}
__device__ __forceinline__ float bf2f(bf16_t b) { return __uint_as_float(((unsigned)b) << 16); }
__device__ __forceinline__ unsigned pack2(float a, float b) { return (unsigned)f2bf(a) | ((unsigned)f2bf(b) << 16); }
__device__ __forceinline__ float sigmoidf_(float x) { return 1.0f / (1.0f + __expf(-x)); }
__device__ __forceinline__ float siluf_(float x) { return x / (1.0f + __expf(-x)); }
__device__ __forceinline__ float gelu_tanh(float x) {
  float u = 0.7978845608028654f * (x + 0.044715f * x * x * x);
  float t = 1.0f - 2.0f / (__expf(2.0f * u) + 1.0f);
  return 0.5f * x * (1.0f + t);
}
__device__ __forceinline__ float wave_sum(float v) {
#pragma unroll
  for (int d = 32; d >= 1; d >>= 1) v += __shfl_xor(v, d, 64);
  return v;
}

__device__ __forceinline__ void block_global_handoff() {
  asm volatile("s_waitcnt vmcnt(0)" ::: "memory");
  __syncthreads();
  if (otid() < 64) {
    __builtin_amdgcn_fence(__ATOMIC_ACQUIRE, "agent");
    asm volatile("s_waitcnt vmcnt(0)" ::: "memory");
  }
  __syncthreads();
}
template <int R, bool T, bool SEG, int N>
__device__ __forceinline__ void g_load(u32x4 (&rg)[N], const bf16_t* __restrict__ P, long ld, int k0, long segs, int tid) {
#pragma unroll
  for (int i = 0; i < N; ++i) {
    const int ch = tid + i * 256;
    if (!T) {
      const int row = ch >> 3, kc = k0 + (ch & 7) * 8;
      const long ko = SEG ? ((long)(kc >> 4) * segs + (kc & 15)) : (long)kc;
      rg[i] = *(const u32x4*)(P + (long)row * ld + ko);
    } else {
      constexpr int CPR = R / 8;
      const int kk = ch / CPR, m0 = (ch % CPR) * 8;
      rg[i] = *(const u32x4*)(P + (long)(k0 + kk) * ld + m0);
    }
  }
}
template <int R, bool T, int N>
__device__ __forceinline__ void s_store(const u32x4 (&rg)[N], bf16_t* sm, int tid) {
  constexpr int LS = 72;
#pragma unroll
  for (int i = 0; i < N; ++i) {
    const int ch = tid + i * 256;
    if (!T) {
      const int row = ch >> 3, kc = (ch & 7) * 8;
      *(u32x4*)(sm + row * LS + kc) = rg[i];
    } else {
      constexpr int CPR = R / 8;
      const int kk = ch / CPR, m0 = (ch % CPR) * 8;
      bf16_t* d = sm + m0 * LS + kk;
      d[0 * LS] = (bf16_t)(rg[i].x & 0xffffu); d[1 * LS] = (bf16_t)(rg[i].x >> 16);
      d[2 * LS] = (bf16_t)(rg[i].y & 0xffffu); d[3 * LS] = (bf16_t)(rg[i].y >> 16);
      d[4 * LS] = (bf16_t)(rg[i].z & 0xffffu); d[5 * LS] = (bf16_t)(rg[i].z >> 16);
      d[6 * LS] = (bf16_t)(rg[i].w & 0xffffu); d[7 * LS] = (bf16_t)(rg[i].w >> 16);
    }
  }
}
template <int BN>
__device__ __forceinline__ void mfma_stage(f32x4 (&acc)[4][BN / 32], const bf16_t* sA, const bf16_t* sB, int wr, int wc, int g, int c) {
  constexpr int LS = 72;
  const bf16_t* pa = sA + (wr * 64 + c) * LS + g * 8;
  const bf16_t* pb = sB + (wc * (BN / 2) + c) * LS + g * 8;
#pragma unroll
  for (int ks = 0; ks < 2; ++ks) {
    bf16x8 af[4], bfr[BN / 32];
#pragma unroll
    for (int i = 0; i < 4; ++i) af[i] = *(const bf16x8*)(pa + i * 16 * LS + ks * 32);
#pragma unroll
    for (int j = 0; j < BN / 32; ++j) bfr[j] = *(const bf16x8*)(pb + j * 16 * LS + ks * 32);
#pragma unroll
    for (int i = 0; i < 4; ++i)
#pragma unroll
      for (int j = 0; j < BN / 32; ++j) acc[i][j] = __builtin_amdgcn_mfma_f32_16x16x32_bf16(af[i], bfr[j], acc[i][j], 0, 0, 0);
  }
}
template <int BN, bool TA, bool TB, bool SEGA>
__device__ __forceinline__ void gemm_tile(f32x4 (&acc)[4][BN / 32], const bf16_t* __restrict__ A, long lda,
                                          const bf16_t* __restrict__ B, long ldb, int K, bf16_t* smem, long segs = 0) {
  constexpr int LS = 72;
  constexpr int STAGE = 2 * 128 * LS;
  const int tid = otid(), w = tid >> 6, l = tid & 63, g = l >> 4, c = l & 15;
  const int wr = w >> 1, wc = w & 1;
  constexpr int NA = 4, NB = BN / 32;
  u32x4 ra0[NA], rb0[NB], ra1[NA], rb1[NB];
  const int nk = K / 64;
  bf16_t* s0A = smem;
  bf16_t* s0B = smem + 128 * LS;
  bf16_t* s1A = smem + STAGE;
  bf16_t* s1B = smem + STAGE + 128 * LS;
  g_load<128, TA, SEGA, NA>(ra0, A, lda, 0, segs, tid);
  g_load<BN, TB, false, NB>(rb0, B, ldb, 0, 0, tid);
  g_load<128, TA, SEGA, NA>(ra1, A, lda, 64, segs, tid);
  g_load<BN, TB, false, NB>(rb1, B, ldb, 64, 0, tid);
  __syncthreads();
  s_store<128, TA, NA>(ra0, s0A, tid);
  s_store<BN, TB, NB>(rb0, s0B, tid);
  __syncthreads();
  for (int kt = 0; kt < nk; kt += 2) {
    if (kt + 2 < nk) {
      g_load<128, TA, SEGA, NA>(ra0, A, lda, (kt + 2) * 64, segs, tid);
      g_load<BN, TB, false, NB>(rb0, B, ldb, (kt + 2) * 64, 0, tid);
    }
    mfma_stage<BN>(acc, s0A, s0B, wr, wc, g, c);
    s_store<128, TA, NA>(ra1, s1A, tid);
    s_store<BN, TB, NB>(rb1, s1B, tid);
    __syncthreads();
    if (kt + 3 < nk) {
      g_load<128, TA, SEGA, NA>(ra1, A, lda, (kt + 3) * 64, segs, tid);
      g_load<BN, TB, false, NB>(rb1, B, ldb, (kt + 3) * 64, 0, tid);
    }
    mfma_stage<BN>(acc, s1A, s1B, wr, wc, g, c);
    if (kt + 2 < nk) {
      s_store<128, TA, NA>(ra0, s0A, tid);
      s_store<BN, TB, NB>(rb0, s0B, tid);
    }
    __syncthreads();
  }
}

template <int NJ>
__device__ __forceinline__ void zero_acc(f32x4 (&acc)[4][NJ]) {
#pragma unroll
  for (int i = 0; i < 4; ++i)
#pragma unroll
    for (int j = 0; j < NJ; ++j) acc[i][j] = (f32x4){0.f, 0.f, 0.f, 0.f};
}

__device__ __forceinline__ void tconv_tile(const float* __restrict__ src, bf16_t* __restrict__ dst, int K, int N, int tk, int tn, float* sm) {
  const int tid = otid();
  const int k0 = tk * 64, n0 = tn * 64;
  __syncthreads();
#pragma unroll 4
  for (int i = 0; i < 16; ++i) {
    const int kk = i * 4 + (tid >> 6), nn = tid & 63;
    float v = 0.f;
    if (n0 + nn < N) v = src[(long)(k0 + kk) * N + n0 + nn];
    sm[kk * 65 + nn] = v;
  }
  __syncthreads();
#pragma unroll 4
  for (int i = 0; i < 16; ++i) {
    const int nn = i * 4 + (tid >> 6), kk = tid & 63;
    dst[(long)(n0 + nn) * K + k0 + kk] = f2bf(sm[kk * 65 + nn]);
  }
}

__device__ __forceinline__ void tconv_job(const float* src, bf16_t* dst, int K, int N, int Npad, float* sm) {
  const int tkn = K / 64, tnn = Npad / 64;
  for (int t = blockIdx.x; t < tkn * tnn; t += gridDim.x) tconv_tile(src, dst, K, N, t % tkn, t / tkn, sm);
}

__device__ __forceinline__ void s5_prep(const Params& p, int layer, int grp, float* sm) {
  float* pwr = sm;
  float* pwi = pwr + 9 * 64;
  float* bbr = pwi + 9 * 64;
  float* bbi = bbr + 1024;
  float* cr = bbi + 1024;
  float* ci = cr + 1024;
  float* kt = ci + 1024;
  const int tid = otid();
  const int lg = layer * 32 + grp;
  __syncthreads();
  if (tid < 64) {
    const int pp = tid;
    const double step = exp((double)p.in[19][lg]);
    const double lr = (double)p.in[17][lg * 64 + pp], li = (double)p.in[18][lg * 64 + pp];
    const double mag = exp(lr * step);
    const double abr = mag * cos(li * step), abi = mag * sin(li * step);
    const double den = lr * lr + li * li;
    const double fr = ((abr - 1.0) * lr + abi * li) / den;
    const double fi = (abi * lr - (abr - 1.0) * li) / den;
    double qr = 1.0, qi = 0.0;
    for (int t = 0; t < 9; ++t) {
      pwr[t * 64 + pp] = (float)qr;
      pwi[t * 64 + pp] = (float)qi;
      const double nr = qr * abr - qi * abi, ni = qr * abi + qi * abr;
      qr = nr; qi = ni;
    }
    float* a8 = (float*)(p.ws + OFF_A8) + (size_t)(lg * 64 + pp) * 2;
    a8[0] = pwr[8 * 64 + pp];
    a8[1] = pwi[8 * 64 + pp];
    for (int cc = 0; cc < 16; ++cc) {
      const double br = (double)p.in[20][(lg * 64 + pp) * 16 + cc], bi = (double)p.in[21][(lg * 64 + pp) * 16 + cc];
      bbr[pp * 16 + cc] = (float)(fr * br - fi * bi);
      bbi[pp * 16 + cc] = (float)(fr * bi + fi * br);
    }
  }
  for (int e = tid; e < 1024; e += 256) {
    cr[e] = p.in[22][lg * 1024 + e];
    ci[e] = p.in[23][lg * 1024 + e];
  }
  __syncthreads();
  for (int e = tid; e < 2048; e += 256) {
    const int tau = e >> 8, co = (e >> 4) & 15, cin = e & 15;
    float s = 0.f;
    for (int pp = 0; pp < 64; ++pp) {
      const float pr = pwr[tau * 64 + pp], pi = pwi[tau * 64 + pp];
      const float zr = pr * bbr[pp * 16 + cin] - pi * bbi[pp * 16 + cin];
      const float zi = pr * bbi[pp * 16 + cin] + pi * bbr[pp * 16 + cin];
      s += cr[co * 64 + pp] * zr - ci[co * 64 + pp] * zi;
    }
    kt[e] = s;
  }
  __syncthreads();
  bf16_t* Km = (bf16_t*)(p.ws + OFF_KMAT) + (size_t)lg * 16384;
  bf16_t* Em = (bf16_t*)(p.ws + OFF_EMAT) + (size_t)lg * 16384;
  bf16_t* Fm = (bf16_t*)(p.ws + OFF_FMAT) + (size_t)lg * 16384;
  for (int e = tid; e < 16384; e += 256) {
    const int n = e >> 7, k = e & 127;
    {
      const int tq = n >> 4, co = n & 15, sq = k >> 4, cin = k & 15;
      Km[e] = f2bf(tq >= sq ? kt[((tq - sq) * 16 + co) * 16 + cin] : 0.f);
    }
    {
      const int pp = n >> 1, ri = n & 1, sq = k >> 4, cin = k & 15;
      const float pr = pwr[(7 - sq) * 64 + pp], pi = pwi[(7 - sq) * 64 + pp];
      const float zr = pr * bbr[pp * 16 + cin] - pi * bbi[pp * 16 + cin];
      const float zi = pr * bbi[pp * 16 + cin] + pi * bbr[pp * 16 + cin];
      Em[e] = f2bf(ri ? zi : zr);
    }
    {
      const int tq = n >> 4, co = n & 15, pp = k >> 1, ri = k & 1;
      const float pr = pwr[(tq + 1) * 64 + pp], pi = pwi[(tq + 1) * 64 + pp];
      const float gr = cr[co * 64 + pp] * pr - ci[co * 64 + pp] * pi;
      const float gi = cr[co * 64 + pp] * pi + ci[co * 64 + pp] * pr;
      Fm[e] = f2bf(ri ? -gi : gr);
    }
  }
}

__device__ __forceinline__ void phase_prep(const Params& p, float* smf) {
  for (int L = 0; L < 2; ++L) {
    tconv_job(p.in[3] + (size_t)L * 1024 * D_IN, (bf16_t*)(p.ws + OFF_WINT) + (size_t)L * D_INP * 1024, 1024, D_IN, D_INP, smf);
    for (int n = 0; n < 4; ++n)
      tconv_job(p.in[33] + (size_t)(L * 4 + n) * 512 * 1024, (bf16_t*)(p.ws + OFF_WBRT) + (size_t)(L * 4 + n) * 1024 * 512, 512, 1024, 1024, smf);
    tconv_job(p.in[34] + (size_t)L * 1024 * 1024, (bf16_t*)(p.ws + OFF_WOUTT) + (size_t)L * 1024 * 1024, 1024, 1024, 1024, smf);
    tconv_job(p.in[25] + (size_t)L * 512 * 512, (bf16_t*)(p.ws + OFF_WGLUT) + (size_t)L * 512 * 512, 512, 512, 512, smf);
    tconv_job(p.in[28] + (size_t)L * 256 * 768, (bf16_t*)(p.ws + OFF_WUQT) + (size_t)L * 768 * 256, 256, 768, 768, smf);
    tconv_job(p.in[30] + (size_t)L * 128 * 1024, (bf16_t*)(p.ws + OFF_WUKVT) + (size_t)L * 1024 * 128, 128, 1024, 1024, smf);
  }
  for (int it = blockIdx.x; it < 64; it += gridDim.x) s5_prep(p, it >> 5, it & 31, smf);
  if (blockIdx.x == gridDim.x - 1 && otid() < 2) {
    const int L = otid();
    float s1 = 0.f, s2 = 0.f;
    for (int i = 0; i < 64; ++i) {
      s1 += p.in[6][L * 64 + i] * p.in[7][L * 64 + i];
      s2 += p.in[8][L * 64 + i] * p.in[9][L * 64 + i];
    }
    const float li = 0.8f - 0.6f * expf(-0.3f * (float)L);
    ((float*)(p.ws + OFF_LAM))[L] = expf(s1) - expf(s2) + li;
  }
}

__device__ __forceinline__ void phase_hnorm(const float* __restrict__ x, const float* __restrict__ gn, bf16_t* __restrict__ H) {
  const int w = otid() >> 6, l = otid() & 63;
  for (int row = blockIdx.x * 4 + w; row < TR; row += gridDim.x * 4) {
    const float4* xr = (const float4*)(x + (size_t)row * 1024);
    float4 v[4];
    float ss = 0.f;
#pragma unroll
    for (int i = 0; i < 4; ++i) {
      v[i] = xr[i * 64 + l];
      ss += v[i].x * v[i].x + v[i].y * v[i].y + v[i].z * v[i].z + v[i].w * v[i].w;
    }
    ss = wave_sum(ss);
    const float rs = rsqrtf(ss * (1.0f / 1024.0f) + EPS);
#pragma unroll
    for (int i = 0; i < 4; ++i) {
      const float4 gg = ((const float4*)gn)[i * 64 + l];
      u32x2 o;
      o.x = pack2(v[i].x * rs * gg.x, v[i].y * rs * gg.y);
      o.y = pack2(v[i].z * rs * gg.z, v[i].w * rs * gg.w);
      *(u32x2*)(H + (size_t)row * 1024 + (i * 64 + l) * 4) = o;
    }
  }
}

__device__ __forceinline__ void inproj_tile(const Params& p, int layer, int rt, int ct, bf16_t* smem) {
  const bf16_t* H = (const bf16_t*)(p.ws + OFF_H);
  const bf16_t* W = (const bf16_t*)(p.ws + OFF_WINT) + (size_t)layer * D_INP * 1024;
  bf16_t* PROJ = (bf16_t*)(p.ws + OFF_PROJ);
  bf16_t* VTA = (bf16_t*)(p.ws + OFF_VTA);
  f32x4 acc[4][4];
  zero_acc<4>(acc);
  gemm_tile<128, false, false, false>(acc, H + (size_t)rt * 128 * 1024, 1024, W + (size_t)ct * 128 * 1024, 1024, 1024, smem);
  const int tid = otid(), w = tid >> 6, l = tid & 63, g = l >> 4, c = l & 15, wr = w >> 1, wc = w & 1;
  const int c0 = ct * 128;
  if (c0 >= C_DAV && c0 < C_DAG) {
    const int h = (c0 - C_DAV) >> 7;
#pragma unroll
    for (int i = 0; i < 4; ++i)
#pragma unroll
      for (int j = 0; j < 4; ++j) {
        const int row = rt * 128 + wr * 64 + i * 16 + g * 4;
        const int dv = wc * 64 + j * 16 + c;
        const int b = row >> 11, s = row & 2047;
        u32x2 o;
        o.x = pack2(acc[i][j][0], acc[i][j][1]);
        o.y = pack2(acc[i][j][2], acc[i][j][3]);
        *(u32x2*)(VTA + ((size_t)((b * 4 + h) * 128 + dv)) * 2048 + s) = o;
      }
  } else {
#pragma unroll
    for (int i = 0; i < 4; ++i) {
#pragma unroll
      for (int r = 0; r < 4; ++r) {
        const int row = rt * 128 + wr * 64 + i * 16 + g * 4 + r;
        bf16_t* rp = PROJ + (size_t)row * LDP + c0 + wc * 64 + c;
#pragma unroll
        for (int j = 0; j < 4; ++j) {
          float v = acc[i][j][r];
          if (c0 + wc * 64 + j * 16 + c >= C_GATE) v = sigmoidf_(v);
          rp[j * 16] = f2bf(v);
        }
      }
      MEMBAR();
    }
  }
}

__device__ __forceinline__ void tokpost_item(const Params& p, int layer, int round, int item) {
  bf16_t* PROJ = (bf16_t*)(p.ws + OFF_PROJ);
  const int* pos = (const int*)p.in[1];
  const int w = otid() >> 6, l = otid() & 63;
  for (int tt = 0; tt < 4; ++tt) {
    const int row = item * 16 + w * 4 + tt;
    const float fpos = (float)pos[round * TR + row];
    bf16_t* pr = PROJ + (size_t)row * LDP;
    {
      const int which = l >> 5, idx = (l & 31) * 16, off = (l & 3) * 16;
      bf16_t* ptr = pr + which * 512 + idx;
      u32x4 u0 = *(const u32x4*)ptr, u1 = *(const u32x4*)(ptr + 8);
      const unsigned uu[8] = {u0.x, u0.y, u0.z, u0.w, u1.x, u1.y, u1.z, u1.w};
      float v[16];
      float ss = 0.f;
#pragma unroll
      for (int e = 0; e < 8; ++e) {
        v[2 * e] = __uint_as_float(uu[e] << 16);
        v[2 * e + 1] = __uint_as_float(uu[e] & 0xffff0000u);
        ss += v[2 * e] * v[2 * e] + v[2 * e + 1] * v[2 * e + 1];
      }
      ss += __shfl_xor(ss, 1, 64);
      ss += __shfl_xor(ss, 2, 64);
      const float rs = rsqrtf(ss * (1.0f / 64.0f) + EPS);
      const float* gn = (which ? p.in[5] : p.in[4]) + layer * 64 + off;
#pragma unroll
      for (int e = 0; e < 16; ++e) v[e] = v[e] * rs * gn[e];
      if ((l & 3) == 0) {
#pragma unroll
        for (int i = 0; i < 8; ++i) {
          const float invf = expf(-13.122363377404328f * (float)i * 0.125f);
          const float ang = fpos * invf;
          const float cs = cosf(ang), sn = sinf(ang);
          const float x1 = v[i], x2 = v[i + 8];
          v[i] = x1 * cs - x2 * sn;
          v[i + 8] = x2 * cs + x1 * sn;
        }
      }
      if (which == 0) {
#pragma unroll
        for (int e = 0; e < 16; ++e) v[e] *= 0.125f * LOG2E;
      }
      u32x4 o0, o1;
      o0.x = pack2(v[0], v[1]); o0.y = pack2(v[2], v[3]); o0.z = pack2(v[4], v[5]); o0.w = pack2(v[6], v[7]);
      o1.x = pack2(v[8], v[9]); o1.y = pack2(v[10], v[11]); o1.z = pack2(v[12], v[13]); o1.w = pack2(v[14], v[15]);
      bf16_t* qko = (bf16_t*)(p.ws + OFF_QK) + (size_t)row * 1024 + which * 512 + idx;
      *(u32x4*)qko = o0;
      *(u32x4*)(qko + 8) = o1;
    }
    {
      bf16_t* ptr = pr + C_CQ + l * 4;
      u32x2 u = *(const u32x2*)ptr;
      float v0 = __uint_as_float(u.x << 16), v1 = __uint_as_float(u.x & 0xffff0000u);
      float v2 = __uint_as_float(u.y << 16), v3 = __uint_as_float(u.y & 0xffff0000u);
      float ss = wave_sum(v0 * v0 + v1 * v1 + v2 * v2 + v3 * v3);
      const float rs = rsqrtf(ss * (1.0f / 256.0f) + EPS);
      const float* gn = p.in[27] + layer * 256 + l * 4;
      u32x2 o;
      o.x = pack2(v0 * rs * gn[0], v1 * rs * gn[1]);
      o.y = pack2(v2 * rs * gn[2], v3 * rs * gn[3]);
      *(u32x2*)((bf16_t*)(p.ws + OFF_CQ2) + (size_t)row * 384 + l * 4) = o;
    }
    {
      bf16_t* ptr = pr + C_CKV + l * 2;
      unsigned u = *(const unsigned*)ptr;
      float v0 = __uint_as_float(u << 16), v1 = __uint_as_float(u & 0xffff0000u);
      float ss = wave_sum(v0 * v0 + v1 * v1);
      const float rs = rsqrtf(ss * (1.0f / 128.0f) + EPS);
      const float* gn = p.in[29] + layer * 128 + l * 2;
      *(unsigned*)((bf16_t*)(p.ws + OFF_CQ2) + (size_t)row * 384 + 256 + l * 2) = pack2(v0 * rs * gn[0], v1 * rs * gn[1]);
    }
  }
}

__device__ __forceinline__ void conv_item(const Params& p, int layer, int item) {
  const bf16_t* PROJ = (const bf16_t*)(p.ws + OFF_PROJ);
  bf16_t* XC = (bf16_t*)(p.ws + OFF_XC);
  const int chtile = item & 15, tt = (item >> 4) & 31, b = item >> 9;
  const int ch = chtile * 64 + (otid() & 63);
  const int tr0 = otid() >> 6;
  const float* cw = p.in[11] + (size_t)layer * 4 * 1024;
  const float w0 = cw[ch], w1 = cw[1024 + ch], w2 = cw[2048 + ch], w3 = cw[3072 + ch];
  const float bias = p.in[12][layer * 1024 + ch];
  for (int i0 = 0; i0 < 16; i0 += 8) {
    float x0[8], x1[8], x2[8], x3[8];
#pragma unroll
    for (int u = 0; u < 8; ++u) {
      const int t = tt * 64 + (i0 + u) * 4 + tr0;
      const bf16_t* base = PROJ + (size_t)(b * 2048 + t) * LDP + C_XBC + ch;
      x3[u] = bf2f(base[0]);
      x2[u] = (t >= 1) ? bf2f(*(base - LDP)) : 0.f;
      x1[u] = (t >= 2) ? bf2f(*(base - 2 * LDP)) : 0.f;
      x0[u] = (t >= 3) ? bf2f(*(base - 3 * LDP)) : 0.f;
    }
#pragma unroll
    for (int u = 0; u < 8; ++u) {
      const int t = tt * 64 + (i0 + u) * 4 + tr0;
      const float y = bias + w3 * x3[u] + w2 * x2[u] + w1 * x1[u] + w0 * x0[u];
      XC[(size_t)(b * 2048 + t) * 1024 + ch] = f2bf(siluf_(y));
    }
  }
}

__device__ __forceinline__ void dtacum_item(const Params& p, int layer, int item) {
  const bf16_t* PROJ = (const bf16_t*)(p.ws + OFF_PROJ);
  float* DT = (float*)(p.ws + OFF_DT);
  float* AC = (float*)(p.ws + OFF_ACUM);
  const int w = otid() >> 6, l = otid() & 63;
  const int id = item * 4 + w;
  const int h = id & 7, bc = id >> 3;
  const int row0 = bc * 128 + 2 * l;
  const float bias = p.in[13][layer * 8 + h];
  const float A = -expf(p.in[14][layer * 8 + h]);
  float x0 = bf2f(PROJ[(size_t)row0 * LDP + C_DT + h]) + bias;
  float x1 = bf2f(PROJ[(size_t)(row0 + 1) * LDP + C_DT + h]) + bias;
  const float d0 = x0 > 20.f ? x0 : log1pf(expf(x0));
  const float d1 = x1 > 20.f ? x1 : log1pf(expf(x1));
  const float a0 = d0 * A, a1 = d1 * A;
  float s = a0 + a1;
#pragma unroll
  for (int d = 1; d < 64; d <<= 1) {
    const float t = __shfl_up(s, d, 64);
    if (l >= d) s += t;
  }
  DT[(size_t)row0 * 8 + h] = d0;
  DT[(size_t)(row0 + 1) * 8 + h] = d1;
  AC[(size_t)row0 * 8 + h] = s - a1;
  AC[(size_t)(row0 + 1) * 8 + h] = s;
}

__device__ __forceinline__ void s5_e_item(const Params& p, int layer, int item, bf16_t* smem) {
  const bf16_t* PROJ = (const bf16_t*)(p.ws + OFF_PROJ);
  const int grp = item >> 3, mt = item & 7;
  const bf16_t* Em = (const bf16_t*)(p.ws + OFF_EMAT) + (size_t)(layer * 32 + grp) * 16384;
  float* E = (float*)(p.ws + OFF_E);
  f32x4 acc[4][4];
  zero_acc<4>(acc);
  gemm_tile<128, false, false, true>(acc, PROJ + (size_t)mt * 128 * 8 * LDP + C_S5U + grp * 16, 8 * LDP, Em, 128, 128, smem, LDP);
  const int tid = otid(), w = tid >> 6, l = tid & 63, g = l >> 4, c = l & 15, wr = w >> 1, wc = w & 1;
#pragma unroll
  for (int i = 0; i < 4; ++i)
#pragma unroll
    for (int j = 0; j < 4; ++j) {
      const int m = mt * 128 + wr * 64 + i * 16 + g * 4;
      const int n = wc * 64 + j * 16 + c;
      *(f32x4*)(E + ((size_t)(grp * 128 + n)) * NBC + m) = acc[i][j];
    }
}

__device__ __forceinline__ void mla_up_q_tile(const Params& p, int layer, int rt, int ct, bf16_t* smem) {
  const bf16_t* PROJ = (const bf16_t*)(p.ws + OFF_PROJ);
  const bf16_t* W = (const bf16_t*)(p.ws + OFF_WUQT) + (size_t)layer * 768 * 256;
  bf16_t* QM = (bf16_t*)(p.ws + OFF_QM);
  f32x4 acc[4][4];
  zero_acc<4>(acc);
  gemm_tile<128, false, false, false>(acc, (const bf16_t*)(p.ws + OFF_CQ2) + (size_t)rt * 128 * 384, 384, W + (size_t)ct * 128 * 256, 256, 256, smem);
  const int tid = otid(), w = tid >> 6, l = tid & 63, g = l >> 4, c = l & 15, wr = w >> 1, wc = w & 1;
#pragma unroll
  for (int i = 0; i < 4; ++i)
#pragma unroll
    for (int j = 0; j < 4; ++j)
#pragma unroll
      for (int r = 0; r < 4; ++r) {
        const int row = rt * 128 + wr * 64 + i * 16 + g * 4 + r, col = ct * 128 + wc * 64 + j * 16 + c;
        QM[(size_t)row * 768 + col] = f2bf(acc[i][j][r]);
      }
}
__device__ __forceinline__ void mla_up_kv_tile(const Params& p, int layer, int rt, int ct, bf16_t* smem) {
  const bf16_t* PROJ = (const bf16_t*)(p.ws + OFF_PROJ);
  const bf16_t* W = (const bf16_t*)(p.ws + OFF_WUKVT) + (size_t)layer * 1024 * 128;
  bf16_t* KN = (bf16_t*)(p.ws + OFF_KN);
  bf16_t* VTD = (bf16_t*)(p.ws + OFF_VTD);
  f32x4 acc[4][4];
  zero_acc<4>(acc);
  gemm_tile<128, false, false, false>(acc, (const bf16_t*)(p.ws + OFF_CQ2) + (size_t)rt * 128 * 384 + 256, 384, W + (size_t)ct * 128 * 128, 128, 128, smem);
  const int tid = otid(), w = tid >> 6, l = tid & 63, g = l >> 4, c = l & 15, wr = w >> 1, wc = w & 1;
  const int h = ct >> 1;
  if ((ct & 1) == 0) {
#pragma unroll
    for (int i = 0; i < 4; ++i)
#pragma unroll
      for (int j = 0; j < 4; ++j)
#pragma unroll
        for (int r = 0; r < 4; ++r) {
          const int row = rt * 128 + wr * 64 + i * 16 + g * 4 + r, cc = wc * 64 + j * 16 + c;
          KN[(size_t)row * 512 + h * 128 + cc] = f2bf(acc[i][j][r]);
        }
  } else {
#pragma unroll
    for (int i = 0; i < 4; ++i)
#pragma unroll
      for (int j = 0; j < 4; ++j) {
        const int row = rt * 128 + wr * 64 + i * 16 + g * 4, dv = wc * 64 + j * 16 + c;
        const int b = row >> 11, s = row & 2047;
        u32x2 o;
        o.x = pack2(acc[i][j][0], acc[i][j][1]);
        o.y = pack2(acc[i][j][2], acc[i][j][3]);
        *(u32x2*)(VTD + ((size_t)((b * 4 + h) * 128 + dv)) * 2048 + s) = o;
      }
  }
}

__device__ __forceinline__ void mb_states_item(const Params& p, int item, bf16_t* smem) {
  const bf16_t* XC = (const bf16_t*)(p.ws + OFF_XC);
  const float* DT = (const float*)(p.ws + OFF_DT);
  const float* AC = (const float*)(p.ws + OFF_ACUM);
  bf16_t* XS = (bf16_t*)(p.ws + OFF_XS) + (size_t)blockIdx.x * 128 * 64;
  float* ST = (float*)(p.ws + OFF_ST);
  const int h = item & 7, bc = item >> 3;
  const int grp = h >> 2;
  const int row0 = bc * 128;
  const int tid = otid();
  __syncthreads();
  const float alast = AC[(size_t)(row0 + 127) * 8 + h];
  for (int e0 = tid; e0 < 8192; e0 += 2048) {
    float dv[8], av[8];
    bf16_t xv[8];
#pragma unroll
    for (int u = 0; u < 8; ++u) {
      const int e = e0 + u * 256;
      const int row = row0 + (e >> 6);
      dv[u] = DT[(size_t)row * 8 + h];
      av[u] = AC[(size_t)row * 8 + h];
      xv[u] = XC[(size_t)row * 1024 + h * 64 + (e & 63)];
    }
#pragma unroll
    for (int u = 0; u < 8; ++u) XS[e0 + u * 256] = f2bf(bf2f(xv[u]) * dv[u] * __expf(alast - av[u]));
  }
  block_global_handoff();
  f32x4 acc[4][2];
  zero_acc<2>(acc);
  gemm_tile<64, true, true, false>(acc, XC + (size_t)row0 * 1024 + 512 + grp * 128, 1024, XS, 64, 128, smem);
  const int w = tid >> 6, l = tid & 63, g = l >> 4, c = l & 15, wr = w >> 1, wc = w & 1;
#pragma unroll
  for (int i = 0; i < 4; ++i)
#pragma unroll
    for (int j = 0; j < 2; ++j) {
      const int n = wr * 64 + i * 16 + g * 4;
      const int pp = wc * 32 + j * 16 + c;
      *(f32x4*)(ST + ((size_t)(bc * 8 + h) * 64 + pp) * 128 + n) = acc[i][j];
    }
}

__device__ __forceinline__ void s5_carry_item(const Params& p, int layer, int item) {
  const int idx = item * 256 + otid();
  const int b = idx >> 11, grp = (idx >> 6) & 31, pp = idx & 63;
  const float* a8 = (const float*)(p.ws + OFF_A8) + (size_t)((layer * 32 + grp) * 64 + pp) * 2;
  const float ar = a8[0], ai = a8[1];
  const float* er = (const float*)(p.ws + OFF_E) + ((size_t)(grp * 128 + 2 * pp)) * NBC + b * 256;
  const float* ei = er + NBC;
  bf16_t* hro = (bf16_t*)(p.ws + OFF_HIN) + ((size_t)(grp * 128 + 2 * pp)) * NBC + b * 256;
  bf16_t* hio = hro + NBC;
  float hr = 0.f, hi = 0.f;
  for (int c16 = 0; c16 < 16; ++c16) {
    f32x4 vr[4], vi[4];
#pragma unroll
    for (int u = 0; u < 4; ++u) {
      vr[u] = *(const f32x4*)(er + c16 * 16 + u * 4);
      vi[u] = *(const f32x4*)(ei + c16 * 16 + u * 4);
    }
#pragma unroll
    for (int u = 0; u < 4; ++u) {
      float orr[4], oii[4];
#pragma unroll
      for (int k = 0; k < 4; ++k) {
        orr[k] = hr; oii[k] = hi;
        const float nr = ar * hr - ai * hi + vr[u][k];
        const float ni = ar * hi + ai * hr + vi[u][k];
        hr = nr; hi = ni;
      }
      u32x2 o0, o1;
      o0.x = pack2(orr[0], orr[1]); o0.y = pack2(orr[2], orr[3]);
      o1.x = pack2(oii[0], oii[1]); o1.y = pack2(oii[2], oii[3]);
      *(u32x2*)(hro + c16 * 16 + u * 4) = o0;
      *(u32x2*)(hio + c16 * 16 + u * 4) = o1;
    }
  }
}

__device__ __forceinline__ void mlapost_item(const Params& p, int layer, int round, int item) {
  const bf16_t* PROJ = (const bf16_t*)(p.ws + OFF_PROJ);
  bf16_t* QM = (bf16_t*)(p.ws + OFF_QM);
  bf16_t* KM = (bf16_t*)(p.ws + OFF_KM);
  const bf16_t* KN = (const bf16_t*)(p.ws + OFF_KN);
  const int* pos = (const int*)p.in[1];
  const int w = otid() >> 6, l = otid() & 63;
  const float* qn = p.in[31] + layer * 192;
  const float* kn = p.in[32] + layer * 192;
  const float q0 = qn[l], q1 = qn[64 + l], q2 = qn[128 + l];
  const float k0 = kn[l], k1 = kn[64 + l], k2 = kn[128 + l];
  const float invf = expf(-13.122363377404328f * (float)(l & 31) * (1.0f / 32.0f));
  const float qscale = 0.07216878364870322f * LOG2E;
  for (int tt = 0; tt < 4; ++tt) {
    const int row = item * 16 + w * 4 + tt;
    const float ang = (float)pos[round * TR + row] * invf;
    const float cs = cosf(ang), sn = sinf(ang);
    const float kr = bf2f(PROJ[(size_t)row * LDP + C_KR + l]);
#pragma unroll
    for (int h = 0; h < 4; ++h) {
      {
        bf16_t* qp = QM + (size_t)row * 768 + h * 192;
        float e0 = bf2f(qp[l]), e1 = bf2f(qp[64 + l]), e2 = bf2f(qp[128 + l]);
        const float ss = wave_sum(e0 * e0 + e1 * e1 + e2 * e2);
        const float rs = rsqrtf(ss * (1.0f / 192.0f) + EPS);
        e0 *= rs * q0; e1 *= rs * q1; e2 *= rs * q2;
        const float ot = __shfl_xor(e2, 32, 64);
        e2 = (l < 32) ? (e2 * cs - ot * sn) : (e2 * cs + ot * sn);
        bf16_t* qo = (bf16_t*)(p.ws + OFF_QM2) + (size_t)row * 768 + h * 192;
        qo[l] = f2bf(e0 * qscale); qo[64 + l] = f2bf(e1 * qscale); qo[128 + l] = f2bf(e2 * qscale);
      }
      {
        const bf16_t* kp = KN + (size_t)row * 512 + h * 128;
        float e0 = bf2f(kp[l]), e1 = bf2f(kp[64 + l]), e2 = kr;
        const float ss = wave_sum(e0 * e0 + e1 * e1 + e2 * e2);
        const float rs = rsqrtf(ss * (1.0f / 192.0f) + EPS);
        e0 *= rs * k0; e1 *= rs * k1; e2 *= rs * k2;
        const float ot = __shfl_xor(e2, 32, 64);
        e2 = (l < 32) ? (e2 * cs - ot * sn) : (e2 * cs + ot * sn);
        bf16_t* ko = KM + (size_t)row * 768 + h * 192;
        ko[l] = f2bf(e0); ko[64 + l] = f2bf(e1); ko[128 + l] = f2bf(e2);
      }
    }
  }
}

__device__ __forceinline__ void mb_scan_item(const Params& p, int item) {
  const int idx = item * 256 + otid();
  const int b = idx >> 16, h = (idx >> 13) & 7, pn = idx & 8191;
  const float* ST = (const float*)(p.ws + OFF_ST);
  const float* AC = (const float*)(p.ws + OFF_ACUM);
  bf16_t* SIN = (bf16_t*)(p.ws + OFF_SIN);
  float cur = 0.f;
  float alv[16], stv[16];
#pragma unroll
  for (int c = 0; c < 16; ++c) {
    alv[c] = AC[(size_t)(b * 2048 + c * 128 + 127) * 8 + h];
    stv[c] = ST[((size_t)((b * 16 + c) * 8 + h)) * 8192 + pn];
  }
#pragma unroll
  for (int c = 0; c < 16; ++c) {
    SIN[((size_t)((b * 16 + c) * 8 + h)) * 8192 + pn] = f2bf(cur);
    cur = __expf(alv[c]) * cur + stv[c];
  }
}

__device__ __forceinline__ void s5_y_item(const Params& p, int layer, int item, bf16_t* smem) {
  const bf16_t* PROJ = (const bf16_t*)(p.ws + OFF_PROJ);
  const int grp = item >> 3, mt = item & 7;
  const bf16_t* Km = (const bf16_t*)(p.ws + OFF_KMAT) + (size_t)(layer * 32 + grp) * 16384;
  const bf16_t* Fm = (const bf16_t*)(p.ws + OFF_FMAT) + (size_t)(layer * 32 + grp) * 16384;
  const bf16_t* HIN = (const bf16_t*)(p.ws + OFF_HIN) + (size_t)grp * 128 * NBC + mt * 128;
  bf16_t* YG = (bf16_t*)(p.ws + OFF_YG);
  f32x4 acc[4][4];
  zero_acc<4>(acc);
  gemm_tile<128, false, false, true>(acc, PROJ + (size_t)mt * 128 * 8 * LDP + C_S5U + grp * 16, 8 * LDP, Km, 128, 128, smem, LDP);
  gemm_tile<128, true, false, false>(acc, HIN, NBC, Fm, 128, 128, smem);
  const int tid = otid(), w = tid >> 6, l = tid & 63, g = l >> 4, c = l & 15, wr = w >> 1, wc = w & 1;
  const float* dsk = p.in[24] + layer * 512;
#pragma unroll
  for (int i = 0; i < 4; ++i)
#pragma unroll
    for (int j = 0; j < 4; ++j) {
      const int n = wc * 64 + j * 16 + c;
      const int tq = n >> 4, co = n & 15;
      const int ch = grp * 16 + co;
      const float dd = dsk[ch];
#pragma unroll
      for (int r = 0; r < 4; ++r) {
        const int m = mt * 128 + wr * 64 + i * 16 + g * 4 + r;
        const int row = m * 8 + tq;
        const float u = bf2f(PROJ[(size_t)row * LDP + C_S5U + ch]);
        const float y = acc[i][j][r] + dd * u;
        YG[(size_t)row * 512 + ch] = f2bf(gelu_tanh(y));
      }
    }
}

template <int DK, int NM>
__device__ __forceinline__ void attn_core(const bf16_t* __restrict__ Qb, long ldq, const bf16_t* __restrict__ Kb, long ldk,
                                          const bf16_t* __restrict__ Vt, int qb, bf16_t* smem, f32x4 (&O)[NM][8], float (&lsum)[NM][4]) {
  constexpr int KST = DK + 8;
  constexpr int KCH = NM * 64 * DK / 8 / 256;
  constexpr int CPM = 64 * DK / 8;
  constexpr int CPRK = DK / 8;
  bf16_t* sK = smem;
  bf16_t* sV = sK + NM * 64 * KST;
  bf16_t* sP = sV + 128 * 72;
  const int tid = otid(), w = tid >> 6, l = tid & 63, g = l >> 4, c = l & 15;
  bf16x8 qf[NM][DK / 32];
  {
    const long qrow = (long)qb * 64 + w * 16 + c;
#pragma unroll
    for (int m = 0; m < NM; ++m)
#pragma unroll
      for (int ks = 0; ks < DK / 32; ++ks) qf[m][ks] = *(const bf16x8*)(Qb + qrow * ldq + m * DK + ks * 32 + g * 8);
  }
  float mrow[NM][4];
#pragma unroll
  for (int m = 0; m < NM; ++m) {
#pragma unroll
    for (int r = 0; r < 4; ++r) { mrow[m][r] = -INFINITY; lsum[m][r] = 0.f; }
#pragma unroll
    for (int nt = 0; nt < 8; ++nt) O[m][nt] = (f32x4){0.f, 0.f, 0.f, 0.f};
  }
  u32x4 kr[KCH], vr[4];
  auto gloadK = [&](int kt) {
#pragma unroll
    for (int i = 0; i < KCH; ++i) {
      const int ch = tid + i * 256;
      const int m = ch / CPM, cc = ch % CPM;
      const int key = cc / CPRK, d0 = (cc % CPRK) * 8;
      kr[i] = *(const u32x4*)(Kb + (long)(kt * 64 + key) * ldk + m * DK + d0);
    }
  };
  auto gloadV = [&](int kt) {
#pragma unroll
    for (int i = 0; i < 4; ++i) {
      const int ch = tid + i * 256;
      const int dvr = ch >> 3, kc = (ch & 7) * 8;
      vr[i] = *(const u32x4*)(Vt + (long)dvr * 2048 + kt * 64 + kc);
    }
  };
  gloadK(0);
  gloadV(0);
  for (int kt = 0; kt <= qb; ++kt) {
    __syncthreads();
#pragma unroll
    for (int i = 0; i < KCH; ++i) {
      const int ch = tid + i * 256;
      const int m = ch / CPM, cc = ch % CPM;
      const int key = cc / CPRK, d0 = (cc % CPRK) * 8;
      *(u32x4*)(sK + (m * 64 + key) * KST + d0) = kr[i];
    }
#pragma unroll
    for (int i = 0; i < 4; ++i) {
      const int ch = tid + i * 256;
      const int dvr = ch >> 3, kc = (ch & 7) * 8;
      *(u32x4*)(sV + dvr * 72 + kc) = vr[i];
    }
    __syncthreads();
    if (kt < qb) gloadK(kt + 1);
#pragma unroll
    for (int m = 0; m < NM; ++m) {
      f32x4 S[4];
#pragma unroll
      for (int nt = 0; nt < 4; ++nt) {
        S[nt] = (f32x4){0.f, 0.f, 0.f, 0.f};
#pragma unroll
        for (int ks = 0; ks < DK / 32; ++ks) {
          const bf16x8 kf = *(const bf16x8*)(sK + (m * 64 + nt * 16 + c) * KST + ks * 32 + g * 8);
          S[nt] = __builtin_amdgcn_mfma_f32_16x16x32_bf16(qf[m][ks], kf, S[nt], 0, 0, 0);
        }
        MEMBAR();
      }
      if (kt == qb) {
#pragma unroll
        for (int nt = 0; nt < 4; ++nt)
#pragma unroll
          for (int r = 0; r < 4; ++r)
            if (nt * 16 + c > w * 16 + g * 4 + r) S[nt][r] = -INFINITY;
      }
      bf16_t* pw = sP + (size_t)((w * NM + m) * 16) * 72;
#pragma unroll
      for (int r = 0; r < 4; ++r) {
        float mx = fmaxf(fmaxf(S[0][r], S[1][r]), fmaxf(S[2][r], S[3][r]));
        mx = fmaxf(mx, __shfl_xor(mx, 1, 64));
        mx = fmaxf(mx, __shfl_xor(mx, 2, 64));
        mx = fmaxf(mx, __shfl_xor(mx, 4, 64));
        mx = fmaxf(mx, __shfl_xor(mx, 8, 64));
        const float mnew = fmaxf(mrow[m][r], mx);
        const float sc = __builtin_amdgcn_exp2f(mrow[m][r] - mnew);
        mrow[m][r] = mnew;
        float ps = 0.f;
#pragma unroll
        for (int nt = 0; nt < 4; ++nt) {
          const float pv = __builtin_amdgcn_exp2f(S[nt][r] - mnew);
          ps += pv;
          pw[(g * 4 + r) * 72 + nt * 16 + c] = f2bf(pv);
        }
        ps += __shfl_xor(ps, 1, 64);
        ps += __shfl_xor(ps, 2, 64);
        ps += __shfl_xor(ps, 4, 64);
        ps += __shfl_xor(ps, 8, 64);
        lsum[m][r] = lsum[m][r] * sc + ps;
#pragma unroll
        for (int nt = 0; nt < 8; ++nt) O[m][nt][r] *= sc;
      }
    }
    __syncthreads();
    if (kt < qb) gloadV(kt + 1);
#pragma unroll
    for (int m = 0; m < NM; ++m) {
      const bf16_t* pw = sP + (size_t)((w * NM + m) * 16) * 72;
#pragma unroll
      for (int ks = 0; ks < 2; ++ks) {
        const bf16x8 pf = *(const bf16x8*)(pw + c * 72 + ks * 32 + g * 8);
#pragma unroll
        for (int nt = 0; nt < 8; ++nt) {
          const bf16x8 vf = *(const bf16x8*)(sV + (nt * 16 + c) * 72 + ks * 32 + g * 8);
          O[m][nt] = __builtin_amdgcn_mfma_f32_16x16x32_bf16(pf, vf, O[m][nt], 0, 0, 0);
        }
        MEMBAR();
      }
    }
  }
}

__device__ __forceinline__ void da_attn_item(const Params& p, int layer, int bh, int qb, bf16_t* smem, bool dry = false) {
  bf16_t* PROJ = (bf16_t*)(p.ws + OFF_PROJ);
  const bf16_t* VTA = (const bf16_t*)(p.ws + OFF_VTA);
  const bf16_t* QKB = (const bf16_t*)(p.ws + OFF_QK);
  const int b = bh >> 2, h = bh & 3;
  f32x4 O[2][8];
  float ls[2][4];
  {
    f32x4 O1[1][8];
    float l1[1][4];
#pragma unroll 1
    for (int m = 0; m < 2; ++m) {
      attn_core<64, 1>(QKB + (size_t)b * 2048 * 1024 + h * 128 + m * 64, 1024, QKB + (size_t)b * 2048 * 1024 + 512 + h * 128 + m * 64, 1024,
                       VTA + (size_t)(b * 4 + h) * 128 * 2048, qb, smem, O1, l1);
      if (m == 0) {
#pragma unroll
        for (int nt = 0; nt < 8; ++nt) O[0][nt] = O1[0][nt];
#pragma unroll
        for (int r = 0; r < 4; ++r) ls[0][r] = l1[0][r];
      } else {
#pragma unroll
        for (int nt = 0; nt < 8; ++nt) O[1][nt] = O1[0][nt];
#pragma unroll
        for (int r = 0; r < 4; ++r) ls[1][r] = l1[0][r];
      }
    }
  }
  const int tid = otid(), w = tid >> 6, l = tid & 63, g = l >> 4, c = l & 15;
  const float lam = ((const float*)(p.ws + OFF_LAM))[layer];
  const float linit = 0.8f - 0.6f * expf(-0.3f * (float)layer);
  const float* sg = p.in[10] + layer * 128;
#pragma unroll
  for (int r = 0; r < 4; ++r) {
    const float i0 = 1.0f / ls[0][r], i1 = lam / ls[1][r];
    float o[8];
    float ss = 0.f;
#pragma unroll
    for (int nt = 0; nt < 8; ++nt) {
      o[nt] = O[0][nt][r] * i0 - O[1][nt][r] * i1;
      ss += o[nt] * o[nt];
    }
    ss += __shfl_xor(ss, 1, 64);
    ss += __shfl_xor(ss, 2, 64);
    ss += __shfl_xor(ss, 4, 64);
    ss += __shfl_xor(ss, 8, 64);
    const float rs = rsqrtf(ss * (1.0f / 128.0f) + EPS) * (1.0f - linit);
    const size_t row = (size_t)b * 2048 + qb * 64 + w * 16 + g * 4 + r;
#pragma unroll
    for (int nt = 0; nt < 8; ++nt) {
      const int dv = nt * 16 + c;
      bf16_t* gp = PROJ + row * LDP + C_DAG + h * 128 + dv;
      const float gt = bf2f(*gp);
      if (!dry) *gp = f2bf(o[nt] * rs * sg[dv] * siluf_(gt));
    }
  }
}

__device__ __forceinline__ void mla_attn_item(const Params& p, int bh, int qb, bf16_t* smem, bool dry = false) {
  bf16_t* PROJ = (bf16_t*)(p.ws + OFF_PROJ);
  const bf16_t* QM = (const bf16_t*)(p.ws + OFF_QM2);
  const bf16_t* KM = (const bf16_t*)(p.ws + OFF_KM);
  const bf16_t* VTD = (const bf16_t*)(p.ws + OFF_VTD);
  const int b = bh >> 2, h = bh & 3;
  f32x4 O[1][8];
  float ls[1][4];
  attn_core<192, 1>(QM + (size_t)b * 2048 * 768 + h * 192, 768, KM + (size_t)b * 2048 * 768 + h * 192, 768,
                    VTD + (size_t)(b * 4 + h) * 128 * 2048, qb, smem, O, ls);
  const int tid = otid(), w = tid >> 6, l = tid & 63, g = l >> 4, c = l & 15;
#pragma unroll
  for (int r = 0; r < 4; ++r) {
    const float i0 = 1.0f / ls[0][r];
    const size_t row = (size_t)b * 2048 + qb * 64 + w * 16 + g * 4 + r;
#pragma unroll
    for (int nt = 0; nt < 8; ++nt) {
      const int dv = nt * 16 + c;
      bf16_t* gp = PROJ + row * LDP + C_MLG + h * 128 + dv;
      const float gt = bf2f(*gp);
      if (!dry) *gp = f2bf(O[0][nt][r] * i0 * siluf_(gt));
    }
  }
}

__device__ __forceinline__ void mb_out_item(const Params& p, int layer, int item, bf16_t* smem) {
  bf16_t* PROJ = (bf16_t*)(p.ws + OFF_PROJ);
  const bf16_t* XC = (const bf16_t*)(p.ws + OFF_XC);
  const float* DT = (const float*)(p.ws + OFF_DT);
  const float* AC = (const float*)(p.ws + OFF_ACUM);
  const bf16_t* SIN = (const bf16_t*)(p.ws + OFF_SIN);
  bf16_t* MS = (bf16_t*)(p.ws + OFF_MS) + (size_t)blockIdx.x * 128 * 128;
  float* rowss = (float*)((unsigned char*)smem + 73728);
  const int grp = item & 1, bc = item >> 1;
  const int row0 = bc * 128;
  __syncthreads();
  const bf16_t* Cp = XC + (size_t)row0 * 1024 + 768 + grp * 128;
  const bf16_t* Bp = XC + (size_t)row0 * 1024 + 512 + grp * 128;
#pragma unroll 1
  for (int r4 = 0; r4 < 4; ++r4) {
    const int h = grp * 4 + r4;
    const int tid = otid(), w = tid >> 6, l = tid & 63, g = l >> 4, c = l & 15, wr = w >> 1, wc = w & 1;
    {
      f32x4 cb[4][4];
      zero_acc<4>(cb);
      gemm_tile<128, false, false, false>(cb, Cp, 1024, Bp, 1024, 128, smem);
      float acs[4], dts[4];
#pragma unroll
      for (int j = 0; j < 4; ++j) {
        const int s = wc * 64 + j * 16 + c;
        acs[j] = AC[(size_t)(row0 + s) * 8 + h];
        dts[j] = DT[(size_t)(row0 + s) * 8 + h];
      }
#pragma unroll
      for (int i = 0; i < 4; ++i)
#pragma unroll
        for (int r = 0; r < 4; ++r) {
          const int lr = wr * 64 + i * 16 + g * 4 + r;
          const float acl = AC[(size_t)(row0 + lr) * 8 + h];
#pragma unroll
          for (int j = 0; j < 4; ++j) {
            const int s = wc * 64 + j * 16 + c;
            const float v = (s <= lr) ? cb[i][j][r] * __expf(acl - acs[j]) * dts[j] : 0.f;
            MS[lr * 128 + s] = f2bf(v);
          }
          MEMBAR();
        }
    }
    block_global_handoff();
    f32x4 ad[4][2], ao[4][2];
    zero_acc<2>(ad);
    zero_acc<2>(ao);
    gemm_tile<64, false, true, false>(ad, MS, 128, XC + (size_t)row0 * 1024 + h * 64, 1024, 128, smem);
    gemm_tile<64, false, false, false>(ao, Cp, 1024, SIN + ((size_t)(bc * 8 + h)) * 8192, 128, 128, smem);
    const float dsk = p.in[15][layer * 8 + h];
#pragma unroll
    for (int i = 0; i < 4; ++i)
#pragma unroll
      for (int r = 0; r < 4; ++r) {
        const int lr = wr * 64 + i * 16 + g * 4 + r;
        const size_t row = (size_t)row0 + lr;
        const float ea = __expf(AC[row * 8 + h]);
        float ssq = 0.f;
#pragma unroll
        for (int j = 0; j < 2; ++j) {
          const int ch = h * 64 + wc * 32 + j * 16 + c;
          const float xv = bf2f(XC[row * 1024 + ch]);
          bf16_t* zp = PROJ + row * LDP + C_MBZ + ch;
          const float z = bf2f(*zp);
          float y = ad[i][j][r] + ea * ao[i][j][r] + dsk * xv;
          y *= siluf_(z);
          ssq += y * y;
          *zp = f2bf(y);
        }
        ssq += __shfl_xor(ssq, 1, 64);
        ssq += __shfl_xor(ssq, 2, 64);
        ssq += __shfl_xor(ssq, 4, 64);
        ssq += __shfl_xor(ssq, 8, 64);
        if (c == 0) rowss[(r4 * 2 + wc) * 128 + lr] = ssq;
        MEMBAR();
      }
  }
  block_global_handoff();
  const float* ng = p.in[16] + layer * 512 + grp * 256;
  {
    const int cc = otid();
    const float gcc = ng[cc];
    for (int l0 = 0; l0 < 128; l0 += 16) {
      bf16_t vals[16];
#pragma unroll
      for (int u = 0; u < 16; ++u) vals[u] = PROJ[(size_t)(row0 + l0 + u) * LDP + C_MBZ + grp * 256 + cc];
#pragma unroll
      for (int u = 0; u < 16; ++u) {
        const int lr = l0 + u;
        float tot = 0.f;
#pragma unroll
        for (int q = 0; q < 8; ++q) tot += rowss[q * 128 + lr];
        PROJ[(size_t)(row0 + lr) * LDP + C_MBZ + grp * 256 + cc] = f2bf(bf2f(vals[u]) * rsqrtf(tot * (1.0f / 256.0f) + EPS) * gcc);
      }
    }
  }
}

__device__ __forceinline__ void s5_glu_tile(const Params& p, int layer, int rt, int ct, bf16_t* smem) {
  bf16_t* PROJ = (bf16_t*)(p.ws + OFF_PROJ);
  const bf16_t* YG = (const bf16_t*)(p.ws + OFF_YG);
  const bf16_t* W = (const bf16_t*)(p.ws + OFF_WGLUT) + (size_t)layer * 512 * 512;
  f32x4 acc[4][4];
  zero_acc<4>(acc);
  gemm_tile<128, false, false, false>(acc, YG + (size_t)rt * 128 * 512, 512, W + (size_t)ct * 128 * 512, 512, 512, smem);
  const int tid = otid(), w = tid >> 6, l = tid & 63, g = l >> 4, c = l & 15, wr = w >> 1, wc = w & 1;
  const float* bg = p.in[26] + layer * 512;
#pragma unroll
  for (int i = 0; i < 4; ++i)
#pragma unroll
    for (int j = 0; j < 4; ++j) {
      const int col = ct * 128 + wc * 64 + j * 16 + c;
      const float bb = bg[col];
#pragma unroll
      for (int r = 0; r < 4; ++r) {
        const size_t row = (size_t)rt * 128 + wr * 64 + i * 16 + g * 4 + r;
        const float yv = bf2f(YG[row * 512 + col]);
        bf16_t* gp = PROJ + row * LDP + C_S5G + col;
        const float gt = bf2f(*gp);
        *gp = f2bf(yv * sigmoidf_(acc[i][j][r] + bb) * siluf_(gt));
      }
    }
}

__device__ __forceinline__ void merge_tile(const Params& p, int layer, int rt, int ct, bf16_t* smem) {
  const bf16_t* PROJ = (const bf16_t*)(p.ws + OFF_PROJ);
  bf16_t* MG = (bf16_t*)(p.ws + OFF_MERGED);
  f32x4 macc[4][2];
  zero_acc<2>(macc);
  const int tid = otid(), w = tid >> 6, l = tid & 63, g = l >> 4, c = l & 15, wr = w >> 1, wc = w & 1;
  for (int n = 0; n < 4; ++n) {
    const int ycol = (n == 0) ? C_DAG : (n == 1) ? C_MBZ : (n == 2) ? C_S5G : C_MLG;
    const bf16_t* W = (const bf16_t*)(p.ws + OFF_WBRT) + (size_t)(layer * 4 + n) * 1024 * 512;
    f32x4 acc[4][2];
    zero_acc<2>(acc);
    gemm_tile<64, false, false, false>(acc, PROJ + (size_t)rt * 128 * LDP + ycol, LDP, W + (size_t)ct * 64 * 512, 512, 512, smem);
#pragma unroll
    for (int i = 0; i < 4; ++i) {
#pragma unroll
      for (int r = 0; r < 4; ++r) {
        const size_t row = (size_t)rt * 128 + wr * 64 + i * 16 + g * 4 + r;
        const bf16_t* gp = PROJ + row * LDP + C_GATE + n * 1024 + ct * 64 + wc * 32 + c;
#pragma unroll
        for (int j = 0; j < 2; ++j) macc[i][j][r] += bf2f(gp[j * 16]) * acc[i][j][r];
      }
      MEMBAR();
    }
  }
#pragma unroll
  for (int i = 0; i < 4; ++i) {
#pragma unroll
    for (int r = 0; r < 4; ++r) {
      const size_t row = (size_t)rt * 128 + wr * 64 + i * 16 + g * 4 + r;
      bf16_t* op = MG + row * 1024 + ct * 64 + wc * 32 + c;
#pragma unroll
      for (int j = 0; j < 2; ++j) op[j * 16] = f2bf(macc[i][j][r]);
    }
    MEMBAR();
  }
}

__device__ __forceinline__ void out_tile(const Params& p, int layer, const float* xo, float* xn, int rt, int ct, bf16_t* smem) {
  const bf16_t* MG = (const bf16_t*)(p.ws + OFF_MERGED);
  const bf16_t* W = (const bf16_t*)(p.ws + OFF_WOUTT) + (size_t)layer * 1024 * 1024;
  f32x4 acc[4][4];
  zero_acc<4>(acc);
  gemm_tile<128, false, false, false>(acc, MG + (size_t)rt * 128 * 1024, 1024, W + (size_t)ct * 128 * 1024, 1024, 1024, smem);
  const int tid = otid(), w = tid >> 6, l = tid & 63, g = l >> 4, c = l & 15, wr = w >> 1, wc = w & 1;
#pragma unroll
  for (int i = 0; i < 4; ++i)
#pragma unroll
    for (int j = 0; j < 4; ++j) {
      const int col = ct * 128 + wc * 64 + j * 16 + c;
#pragma unroll
      for (int r = 0; r < 4; ++r) {
        const size_t row = (size_t)rt * 128 + wr * 64 + i * 16 + g * 4 + r;
        xn[row * 1024 + col] = xo[row * 1024 + col] + acc[i][j][r];
      }
    }
}

__device__ __forceinline__ void gsync(cg::grid_group& grid, unsigned* bar, unsigned& epoch) {
  asm volatile("s_waitcnt vmcnt(0)" ::: "memory");
  __syncthreads();
  if (otid() == 0) {
    unsigned long long* w = (unsigned long long*)bar;
    __builtin_amdgcn_fence(__ATOMIC_RELEASE, "agent");
    asm volatile("s_waitcnt vmcnt(0)" ::: "memory");
    const unsigned long long old = __hip_atomic_fetch_add(w, 1ull, __ATOMIC_RELAXED, __HIP_MEMORY_SCOPE_AGENT);
    const unsigned G = gridDim.x;
    if ((unsigned)(old & 0xffffffffull) == G - 1) {
      __hip_atomic_fetch_add(w, (1ull << 32) - (unsigned long long)G, __ATOMIC_RELAXED, __HIP_MEMORY_SCOPE_AGENT);
    } else {
      const unsigned g0 = (unsigned)(old >> 32);
      while ((unsigned)(__hip_atomic_load(w, __ATOMIC_RELAXED, __HIP_MEMORY_SCOPE_AGENT) >> 32) == g0) __builtin_amdgcn_s_sleep(1);
    }
    __builtin_amdgcn_fence(__ATOMIC_ACQUIRE, "agent");
    asm volatile("s_waitcnt vmcnt(0)" ::: "memory");
  }
  __syncthreads();
}

#ifdef SELFCHECK
__device__ __forceinline__ void cksum(const void* ptr, size_t bytes, unsigned long long* slot) {
  const u32x4* q = (const u32x4*)ptr;
  const size_t n = bytes / 16;
  unsigned long long s = 0;
  for (size_t i = (size_t)blockIdx.x * 256 + otid(); i < n; i += (size_t)gridDim.x * 256) {
    const u32x4 v = q[i];
    s += (unsigned long long)v.x + 3ull * v.y + 5ull * v.z + 7ull * v.w;
  }
  unsigned lo = (unsigned)s, hi = (unsigned)(s >> 32);
  unsigned long long t = s;
#pragma unroll
  for (int d = 32; d >= 1; d >>= 1) {
    const unsigned l2 = __shfl_xor((unsigned)t, d, 64), h2 = __shfl_xor((unsigned)(t >> 32), d, 64);
    t += ((unsigned long long)h2 << 32) | l2;
  }
  (void)lo; (void)hi;
  if ((otid() & 63) == 0) atomicAdd(slot, t);
}
#define CK(ptr, bytes) cksum((ptr), (bytes), slots + slot)
#else
#define CK(ptr, bytes) do {} while (0)
#endif

__device__ __forceinline__ void cksum_acc(const void* ptr, size_t bytes, unsigned long long& s) {
  const u32x4* q = (const u32x4*)ptr;
  const size_t n = bytes / 16;
  for (size_t i = ((size_t)blockIdx.x * 256 + otid()) * 64; i < n; i += (size_t)gridDim.x * 256 * 64) {
    const u32x4 v = __builtin_nontemporal_load(q + i);
    s += (unsigned long long)v.x + 3ull * v.y + 5ull * v.z + 7ull * v.w;
  }
}
__device__ __forceinline__ void cksum_commit(unsigned long long t, unsigned long long* slot) {
#pragma unroll
  for (int d = 32; d >= 1; d >>= 1) {
    const unsigned l2 = __shfl_xor((unsigned)t, d, 64), h2 = __shfl_xor((unsigned)(t >> 32), d, 64);
    t += ((unsigned long long)h2 << 32) | l2;
  }
  if ((otid() & 63) == 0) atomicAdd(slot, t);
}

__global__ void __launch_bounds__(256, 2) fwd_megakernel(Params p) {
  cg::grid_group grid = cg::this_grid();
  __shared__ __attribute__((aligned(16))) unsigned char smem_raw[SMEM_BYTES];
  bf16_t* smem = (bf16_t*)smem_raw;
  float* smf = (float*)smem_raw;
  const int G = gridDim.x, bid = blockIdx.x;
  unsigned* bar = (unsigned*)(p.ws + OFF_BAR);
  unsigned epoch = 0;
#ifdef START_DELAY_US
  {
    const unsigned long long t0 = __builtin_amdgcn_s_memrealtime();
    while (__builtin_amdgcn_s_memrealtime() - t0 < (unsigned long long)START_DELAY_US * 100ull) __builtin_amdgcn_s_sleep(20);
  }
#endif
  grid.sync();
#ifdef WCHECK
  unsigned wseen = 0;
  if (bid == 0 && otid() == 0) wseen = __hip_atomic_load(bar + 32, __ATOMIC_RELAXED, __HIP_MEMORY_SCOPE_AGENT);
#endif

#ifdef SELFCHECK
  unsigned long long* slots_base = (unsigned long long*)(p.ws + OFF_BAR + 256);
  if (bid == 0) for (int k = otid(); k < 768; k += 256) __hip_atomic_store(slots_base + k, 0ull, __ATOMIC_RELAXED, __HIP_MEMORY_SCOPE_AGENT);
  for (int run = 0; run < 3; ++run) {
  unsigned long long* slots = slots_base + run * 256;
  int slot = 0;
#endif
  {
    unsigned long long* sslots = (unsigned long long*)(p.ws + OFF_BAR + 1024);
    unsigned long long prev = 0;
    for (int iter = 0; iter < 64; ++iter) {
      unsigned long long s = 0;
      cksum_acc(p.out, (size_t)BATCH * SEQ * 1024 * 4, s);
      cksum_acc(p.ws, OFF_BAR, s);
      cksum_commit(s, sslots + iter);
      gsync(grid, bar, epoch);
      const unsigned long long c = __hip_atomic_load(sslots + iter, __ATOMIC_RELAXED, __HIP_MEMORY_SCOPE_AGENT);
      if (iter > 0 && c == prev) break;
      prev = c;
    }
  }
  phase_prep(p, smf);
  gsync(grid, bar, epoch);
  phase_prep(p, smf);
#ifdef SELF_POISON
  {
    u32x4* q = (u32x4*)(p.ws + OFF_H);
    const size_t n16 = (WS_TOTAL - OFF_H) / 16;
    const u32x4 pv = {SELF_POISON, SELF_POISON, SELF_POISON, SELF_POISON};
    for (size_t i = (size_t)bid * 256 + otid(); i < n16; i += (size_t)G * 256) q[i] = pv;
  }
#endif
  gsync(grid, bar, epoch);
#ifdef SELFCHECK
  CK(p.ws, OFF_H); slot++;
#endif

  for (int layer = 0; layer < 2; ++layer) {
    const float* xin = (layer == 0) ? p.in[0] : p.out;
    float* xout = p.out;
    for (int round = 0; round < NROUND; ++round) {
      const size_t tok0 = (size_t)round * TR;
      if (layer == 0 && round == 0) {
        phase_hnorm(xin + tok0 * 1024, p.in[2] + layer * 1024, (bf16_t*)(p.ws + OFF_H));
        gsync(grid, bar, epoch);
      }
#ifdef SELFCHECK
      CK(p.ws + OFF_H, (size_t)TR * 1024 * 2); slot++;
#endif
#ifndef REP_B
#define REP_B 1
#endif
      for (int rep = 0; rep < REP_B; ++rep) {
      for (int it = bid; it < NRT * 76; it += G) inproj_tile(p, layer, it % NRT, it / NRT, smem);
      gsync(grid, bar, epoch);
      }
#ifdef SELFCHECK
      CK(p.ws + OFF_PROJ, (size_t)TR * D_INP * 2); CK(p.ws + OFF_VTA, (size_t)RB * 4 * 128 * 2048 * 2); slot++;
#endif
      {
        constexpr int n1 = 256, n2 = TR / 16, n3 = RB * 32 * 16, n4 = RB * 16 * 8 / 4;
        for (int it = bid; it < n1 + n2 + n3 + n4; it += G) {
          if (it < n1) s5_e_item(p, layer, it, smem);
          else if (it < n1 + n2) tokpost_item(p, layer, round, it - n1);
          else if (it < n1 + n2 + n3) conv_item(p, layer, it - n1 - n2);
          else dtacum_item(p, layer, it - n1 - n2 - n3);
        }
      }
      gsync(grid, bar, epoch);
#ifdef SELFCHECK
      CK(p.ws + OFF_PROJ, (size_t)TR * D_INP * 2); CK(p.ws + OFF_E, (size_t)32 * 128 * NBC * 4); CK(p.ws + OFF_XC, (size_t)TR * 1024 * 2);
      CK(p.ws + OFF_DT, (size_t)TR * 8 * 4); CK(p.ws + OFF_ACUM, (size_t)TR * 8 * 4); slot++;
#endif
      {
        constexpr int n1 = NRT * 6, n2 = NRT * 8, n3 = RB * 16 * 8, n4 = RB * 32 * 64 / 256;
        for (int it = bid; it < n1 + n2 + n3 + n4; it += G) {
          if (it < n1) mla_up_q_tile(p, layer, it % NRT, it / NRT, smem);
          else if (it < n1 + n2) mla_up_kv_tile(p, layer, (it - n1) % NRT, (it - n1) / NRT, smem);
          else if (it < n1 + n2 + n3) mb_states_item(p, it - n1 - n2, smem);
          else s5_carry_item(p, layer, it - n1 - n2 - n3);
        }
      }
      gsync(grid, bar, epoch);
#ifdef SELFCHECK
      CK(p.ws + OFF_QM, (size_t)TR * 768 * 2); CK(p.ws + OFF_KN, (size_t)TR * 512 * 2); CK(p.ws + OFF_VTD, (size_t)RB * 4 * 128 * 2048 * 2);
      CK(p.ws + OFF_ST, (size_t)RB * 16 * 8 * 8192 * 4); CK(p.ws + OFF_HIN, (size_t)32 * 128 * NBC * 2); slot++;
#endif
      {
        constexpr int n1 = 256, n2 = TR / 16, n3 = RB * 8 * 8192 / 256;
        for (int it = bid; it < n1 + n2 + n3; it += G) {
          if (it < n1) s5_y_item(p, layer, it, smem);
          else if (it < n1 + n2) mlapost_item(p, layer, round, it - n1);
          else mb_scan_item(p, it - n1 - n2);
        }
      }
      gsync(grid, bar, epoch);
#ifdef SELFCHECK
      CK(p.ws + OFF_YG, (size_t)TR * 512 * 2); CK(p.ws + OFF_QM, (size_t)TR * 768 * 2); CK(p.ws + OFF_KM, (size_t)TR * 768 * 2);
      CK(p.ws + OFF_SIN, (size_t)RB * 16 * 8 * 8192 * 2); slot++;
#endif
#ifdef REP_ATT
      {
        constexpr int nat = RB * 4 * 32 * 2;
        for (int it = bid; it < nat; it += G) {
            const int half = nat / 2;
            const int qb = (it < half) ? (31 - it / 32) : ((it - half) / 32);
            const int sub = it & 31;
            if (sub < 16) da_attn_item(p, layer, sub, qb, smem, true);
            else mla_attn_item(p, sub - 16, qb, smem, true);
        }
        gsync(grid, bar, epoch);
      }
#endif
      {
        constexpr int nat = RB * 4 * 32 * 2;
        constexpr int n3 = RB * 16 * 2, n4 = NRT * 4;
        for (int it0 = bid; it0 < nat + n3 + n4; it0 += G) {
          if (it0 < n3) { mb_out_item(p, layer, it0, smem); continue; }
          const int it = it0 - n3;
          if (it < nat) {
            const int half = nat / 2;
            const int qb = (it < half) ? (31 - it / 32) : ((it - half) / 32);
            const int sub = it & 31;
            if (sub < 16) da_attn_item(p, layer, sub, qb, smem);
            else mla_attn_item(p, sub - 16, qb, smem);
          } else s5_glu_tile(p, layer, (it - nat) % NRT, (it - nat) / NRT, smem);
        }
      }
      gsync(grid, bar, epoch);
#ifdef SELFCHECK
      CK(p.ws + OFF_PROJ, (size_t)TR * D_INP * 2); slot++;
#endif
      for (int it = bid; it < NRT * 16; it += G) merge_tile(p, layer, it % NRT, it / NRT, smem);
      gsync(grid, bar, epoch);
#ifdef SELFCHECK
      CK(p.ws + OFF_MERGED, (size_t)TR * 1024 * 2); slot++;
#endif
      for (int it = bid; it < NRT * 8; it += G) out_tile(p, layer, xin + tok0 * 1024, xout + tok0 * 1024, it % NRT, it / NRT, smem);
      {
        const int nl = (round + 1 < NROUND) ? layer : layer + 1;
        const int nr = (round + 1 < NROUND) ? round + 1 : 0;
        if (nl < 2) {
          const float* nx = (nl == 0) ? p.in[0] : p.out;
          phase_hnorm(nx + (size_t)nr * TR * 1024, p.in[2] + nl * 1024, (bf16_t*)(p.ws + OFF_H));
        }
      }
      gsync(grid, bar, epoch);
#ifdef SELFCHECK
      CK(xout + tok0 * 1024, (size_t)TR * 1024 * 4); slot++;
#endif
    }
  }
#ifdef WCHECK
  if (bid == 0 && otid() == 0) {
    if (wseen != 0) p.out[0] = 1.0e6f;
    __hip_atomic_store(bar + 32, 1u, __ATOMIC_RELAXED, __HIP_MEMORY_SCOPE_AGENT);
  }
#endif
#ifdef SELFCHECK
  gsync(grid, bar, epoch);
  }
  gsync(grid, bar, epoch);
  if (bid == 0 && otid() == 0) {
    int bad = -1;
    for (int k = 0; k < 100; ++k) {
      const unsigned long long a = __hip_atomic_load(slots_base + k, __ATOMIC_RELAXED, __HIP_MEMORY_SCOPE_AGENT);
      const unsigned long long b = __hip_atomic_load(slots_base + 256 + k, __ATOMIC_RELAXED, __HIP_MEMORY_SCOPE_AGENT);
      const unsigned long long c = __hip_atomic_load(slots_base + 512 + k, __ATOMIC_RELAXED, __HIP_MEMORY_SCOPE_AGENT);
      if (a != b || a != c) { bad = k; break; }
    }
    if (bad >= 0) p.out[0] = 10000.0f * exp2f((float)bad);
  }
#endif
}

extern "C" void kernel_launch(void* const* d_in, const int* in_sizes, int n_in, void* d_out,
                              int out_size, void* d_ws, size_t ws_size, hipStream_t stream) {
  static int grid_blocks = 0;
  if (!grid_blocks) {
    int dev = 0, cus = 0, per_cu = 0;
    (void)hipGetDevice(&dev);
    (void)hipDeviceGetAttribute(&cus, hipDeviceAttributeMultiprocessorCount, dev);
    (void)hipOccupancyMaxActiveBlocksPerMultiprocessor(&per_cu, fwd_megakernel, 256, 0);
    if (per_cu > 2) per_cu = 2;
    if (per_cu < 1) per_cu = 1;
    grid_blocks = cus * per_cu;
    if (grid_blocks > MAXBLK) grid_blocks = MAXBLK;
  }
  if (ws_size < WS_TOTAL) fprintf(stderr, "workspace too small: %zu < %zu\n", ws_size, (size_t)WS_TOTAL);
  Params p{};
  for (int i = 0; i < 35; ++i) p.in[i] = (const float*)d_in[i];
  p.out = (float*)d_out;
  p.ws = (unsigned char*)d_ws;
  (void)hipMemsetAsync((unsigned char*)d_ws + OFF_BAR, 0, 2048, stream);
  void* args[] = {&p};
  hipError_t e = hipLaunchCooperativeKernel((void*)fwd_megakernel, dim3(grid_blocks), dim3(256), args, 0, stream);
  if (e != hipSuccess) fprintf(stderr, "cooperative launch failed: %s (grid %d)\n", hipGetErrorString(e), grid_blocks);
}
```

```cpp
#include <hip/hip_runtime.h>
#include <hip/hip_cooperative_groups.h>
#include <cstdio>
#include <cstdint>
namespace cg = cooperative_groups;

typedef unsigned short bf16_t;
typedef short bf16x8 __attribute__((ext_vector_type(8)));
typedef float f32x4 __attribute__((ext_vector_type(4)));
typedef unsigned u32x4 __attribute__((ext_vector_type(4)));
typedef unsigned u32x2 __attribute__((ext_vector_type(2)));

constexpr int SEQ = 2048, BATCH = 16;
constexpr int D_IN = 9672, D_INP = 9728;
constexpr int RB = 4;
constexpr int TR = RB * SEQ;
constexpr int NROUND = BATCH / RB;
constexpr int NRT = TR / 128;
constexpr int NBC = TR / 8;
constexpr int MAXBLK = 512;
constexpr float EPS = 1e-6f;
constexpr float LOG2E = 1.4426950408889634f;
constexpr int C_DAQ = 0, C_DAK = 512, C_DAV = 1024, C_DAG = 1536, C_MBZ = 2048, C_XBC = 2560, C_DT = 3584,
              C_S5U = 3592, C_S5G = 4104, C_CQ = 4616, C_CKV = 4872, C_KR = 5000, C_MLG = 5064, C_GATE = 5576;
constexpr long LDP = D_INP;

constexpr size_t al256(size_t x) { return (x + 255) & ~size_t(255); }
constexpr size_t OFF_WINT = 0;
constexpr size_t OFF_WBRT = OFF_WINT + al256((size_t)2 * D_INP * 1024 * 2);
constexpr size_t OFF_WOUTT = OFF_WBRT + al256((size_t)2 * 4 * 1024 * 512 * 2);
constexpr size_t OFF_WGLUT = OFF_WOUTT + al256((size_t)2 * 1024 * 1024 * 2);
constexpr size_t OFF_WUQT = OFF_WGLUT + al256((size_t)2 * 512 * 512 * 2);
constexpr size_t OFF_WUKVT = OFF_WUQT + al256((size_t)2 * 768 * 256 * 2);
constexpr size_t OFF_KMAT = OFF_WUKVT + al256((size_t)2 * 1024 * 128 * 2);
constexpr size_t OFF_EMAT = OFF_KMAT + al256((size_t)2 * 32 * 128 * 128 * 2);
constexpr size_t OFF_FMAT = OFF_EMAT + al256((size_t)2 * 32 * 128 * 128 * 2);
constexpr size_t OFF_A8 = OFF_FMAT + al256((size_t)2 * 32 * 128 * 128 * 2);
constexpr size_t OFF_LAM = OFF_A8 + al256((size_t)2 * 32 * 64 * 2 * 4);
constexpr size_t OFF_H = OFF_LAM + 256;
constexpr size_t OFF_PROJ = OFF_H + al256((size_t)TR * 1024 * 2);
constexpr size_t OFF_XC = OFF_PROJ + al256((size_t)TR * D_INP * 2);
constexpr size_t OFF_DT = OFF_XC + al256((size_t)TR * 1024 * 2);
constexpr size_t OFF_ACUM = OFF_DT + al256((size_t)TR * 8 * 4);
constexpr size_t OFF_VTA = OFF_ACUM + al256((size_t)TR * 8 * 4);
constexpr size_t OFF_VTD = OFF_VTA + al256((size_t)RB * 4 * 128 * 2048 * 2);
constexpr size_t OFF_QM = OFF_VTD + al256((size_t)RB * 4 * 128 * 2048 * 2);
constexpr size_t OFF_KM = OFF_QM + al256((size_t)TR * 768 * 2);
constexpr size_t OFF_KN = OFF_KM + al256((size_t)TR * 768 * 2);
constexpr size_t OFF_ST = OFF_KN + al256((size_t)TR * 512 * 2);
constexpr size_t OFF_SIN = OFF_ST + al256((size_t)RB * 16 * 8 * 8192 * 4);
constexpr size_t OFF_MS = OFF_SIN + al256((size_t)RB * 16 * 8 * 8192 * 2);
constexpr size_t OFF_XS = OFF_MS + al256((size_t)MAXBLK * 128 * 128 * 2);
constexpr size_t OFF_E = OFF_XS + al256((size_t)MAXBLK * 128 * 64 * 2);
constexpr size_t OFF_HIN = OFF_E + al256((size_t)32 * 128 * NBC * 4);
constexpr size_t OFF_YG = OFF_HIN + al256((size_t)32 * 128 * NBC * 2);
constexpr size_t OFF_MERGED = OFF_YG + al256((size_t)TR * 512 * 2);
constexpr size_t OFF_QK = OFF_MERGED + al256((size_t)TR * 1024 * 2);
constexpr size_t OFF_CQ2 = OFF_QK + al256((size_t)TR * 1024 * 2);
constexpr size_t OFF_QM2 = OFF_CQ2 + al256((size_t)TR * 384 * 2);
constexpr size_t OFF_BAR = OFF_QM2 + al256((size_t)TR * 768 * 2);
constexpr size_t WS_TOTAL = OFF_BAR + 8192;

constexpr int SMEM_BYTES = 73728 + 4096 + 64;

struct Params {
  const float* in[35];
  float* out;
  unsigned char* ws;
};

#define MEMBAR() do { asm volatile("" ::: "memory"); __builtin_amdgcn_sched_barrier(0); } while (0)
__device__ __forceinline__ int otid() { int t = threadIdx.x; asm volatile("" : "+v"(t)); return t; }
__device__ __forceinline__ bf16_t f2bf(float f) {
  unsigned u = __float_as_uint(f);
  u += 0x7fffu + ((u >> 16) & 1u);
  return (bf16_t)(u >> 16);
}
__device__ __forceinline__ float bf2f(bf16_t b) { return __uint_as_float(((unsigned)b) << 16); }
__device__ __forceinline__ unsigned pack2(float a, float b) { return (unsigned)f2bf(a) | ((unsigned)f2bf(b) << 16); }
__device__ __forceinline__ float sigmoidf_(float x) { return 1.0f / (1.0f + __expf(-x)); }
__device__ __forceinline__ float siluf_(float x) { return x / (1.0f + __expf(-x)); }
__device__ __forceinline__ float gelu_tanh(float x) {
  float u = 0.7978845608028654f * (x + 0.044715f * x * x * x);
  float t = 1.0f - 2.0f / (__expf(2.0f * u) + 1.0f);
  return 0.5f * x * (1.0f + t);
}
__device__ __forceinline__ float wave_sum(float v) {
#pragma unroll
  for (int d = 32; d >= 1; d >>= 1) v += __shfl_xor(v, d, 64);
  return v;
}

__device__ __forceinline__ void block_global_handoff() {
  asm volatile("s_waitcnt vmcnt(0)" ::: "memory");
  __syncthreads();
  if (otid() < 64) {
    __builtin_amdgcn_fence(__ATOMIC_ACQUIRE, "agent");
    asm volatile("s_waitcnt vmcnt(0)" ::: "memory");
  }
  __syncthreads();
}
template <int R, bool T, bool SEG, int N>
__device__ __forceinline__ void g_load(u32x4 (&rg)[N], const bf16_t* __restrict__ P, long ld, int k0, long segs, int tid) {
#pragma unroll
  for (int i = 0; i < N; ++i) {
    const int ch = tid + i * 256;
    if (!T) {
      const int row = ch >> 3, kc = k0 + (ch & 7) * 8;
      const long ko = SEG ? ((long)(kc >> 4) * segs + (kc & 15)) : (long)kc;
      rg[i] = *(const u32x4*)(P + (long)row * ld + ko);
    } else {
      constexpr int CPR = R / 8;
      const int kk = ch / CPR, m0 = (ch % CPR) * 8;
      rg[i] = *(const u32x4*)(P + (long)(k0 + kk) * ld + m0);
    }
  }
}
template <int R, bool T, int N>
__device__ __forceinline__ void s_store(const u32x4 (&rg)[N], bf16_t* sm, int tid) {
  constexpr int LS = 72;
#pragma unroll
  for (int i = 0; i < N; ++i) {
    const int ch = tid + i * 256;
    if (!T) {
      const int row = ch >> 3, kc = (ch & 7) * 8;
      *(u32x4*)(sm + row * LS + kc) = rg[i];
    } else {
      constexpr int CPR = R / 8;
      const int kk = ch / CPR, m0 = (ch % CPR) * 8;
      bf16_t* d = sm + m0 * LS + kk;
      d[0 * LS] = (bf16_t)(rg[i].x & 0xffffu); d[1 * LS] = (bf16_t)(rg[i].x >> 16);
      d[2 * LS] = (bf16_t)(rg[i].y & 0xffffu); d[3 * LS] = (bf16_t)(rg[i].y >> 16);
      d[4 * LS] = (bf16_t)(rg[i].z & 0xffffu); d[5 * LS] = (bf16_t)(rg[i].z >> 16);
      d[6 * LS] = (bf16_t)(rg[i].w & 0xffffu); d[7 * LS] = (bf16_t)(rg[i].w >> 16);
    }
  }
}
template <int BN>
__device__ __forceinline__ void mfma_stage(f32x4 (&acc)[4][BN / 32], const bf16_t* sA, const bf16_t* sB, int wr, int wc, int g, int c) {
  constexpr int LS = 72;
  const bf16_t* pa = sA + (wr * 64 + c) * LS + g * 8;
  const bf16_t* pb = sB + (wc * (BN / 2) + c) * LS + g * 8;
#pragma unroll
  for (int ks = 0; ks < 2; ++ks) {
    bf16x8 af[4], bfr[BN / 32];
#pragma unroll
    for (int i = 0; i < 4; ++i) af[i] = *(const bf16x8*)(pa + i * 16 * LS + ks * 32);
#pragma unroll
    for (int j = 0; j < BN / 32; ++j) bfr[j] = *(const bf16x8*)(pb + j * 16 * LS + ks * 32);
#pragma unroll
    for (int i = 0; i < 4; ++i)
#pragma unroll
      for (int j = 0; j < BN / 32; ++j) acc[i][j] = __builtin_amdgcn_mfma_f32_16x16x32_bf16(af[i], bfr[j], acc[i][j], 0, 0, 0);
  }
}
template <int BN, bool TA, bool TB, bool SEGA>
__device__ __forceinline__ void gemm_tile(f32x4 (&acc)[4][BN / 32], const bf16_t* __restrict__ A, long lda,
                                          const bf16_t* __restrict__ B, long ldb, int K, bf16_t* smem, long segs = 0) {
  constexpr int LS = 72;
  constexpr int STAGE = 2 * 128 * LS;
  const int tid = otid(), w = tid >> 6, l = tid & 63, g = l >> 4, c = l & 15;
  const int wr = w >> 1, wc = w & 1;
  constexpr int NA = 4, NB = BN / 32;
  u32x4 ra0[NA], rb0[NB], ra1[NA], rb1[NB];
  const int nk = K / 64;
  bf16_t* s0A = smem;
  bf16_t* s0B = smem + 128 * LS;
  bf16_t* s1A = smem + STAGE;
  bf16_t* s1B = smem + STAGE + 128 * LS;
  g_load<128, TA, SEGA, NA>(ra0, A, lda, 0, segs, tid);
  g_load<BN, TB, false, NB>(rb0, B, ldb, 0, 0, tid);
  g_load<128, TA, SEGA, NA>(ra1, A, lda, 64, segs, tid);
  g_load<BN, TB, false, NB>(rb1, B, ldb, 64, 0, tid);
  __syncthreads();
  s_store<128, TA, NA>(ra0, s0A, tid);
  s_store<BN, TB, NB>(rb0, s0B, tid);
  __syncthreads();
  for (int kt = 0; kt < nk; kt += 2) {
    if (kt + 2 < nk) {
      g_load<128, TA, SEGA, NA>(ra0, A, lda, (kt + 2) * 64, segs, tid);
      g_load<BN, TB, false, NB>(rb0, B, ldb, (kt + 2) * 64, 0, tid);
    }
    mfma_stage<BN>(acc, s0A, s0B, wr, wc, g, c);
    s_store<128, TA, NA>(ra1, s1A, tid);
    s_store<BN, TB, NB>(rb1, s1B, tid);
    __syncthreads();
    if (kt + 3 < nk) {
      g_load<128, TA, SEGA, NA>(ra1, A, lda, (kt + 3) * 64, segs, tid);
      g_load<BN, TB, false, NB>(rb1, B, ldb, (kt + 3) * 64, 0, tid);
    }
    mfma_stage<BN>(acc, s1A, s1B, wr, wc, g, c);
    if (kt + 2 < nk) {
      s_store<128, TA, NA>(ra0, s0A, tid);
      s_store<BN, TB, NB>(rb0, s0B, tid);
    }
    __syncthreads();
  }
}

template <int NJ>
__device__ __forceinline__ void zero_acc(f32x4 (&acc)[4][NJ]) {
#pragma unroll
  for (int i = 0; i < 4; ++i)
#pragma unroll
    for (int j = 0; j < NJ; ++j) acc[i][j] = (f32x4){0.f, 0.f, 0.f, 0.f};
}

__device__ __forceinline__ void tconv_tile(const float* __restrict__ src, bf16_t* __restrict__ dst, int K, int N, int tk, int tn, float* sm) {
  const int tid = otid();
  const int k0 = tk * 64, n0 = tn * 64;
  __syncthreads();
#pragma unroll 4
  for (int i = 0; i < 16; ++i) {
    const int kk = i * 4 + (tid >> 6), nn = tid & 63;
    float v = 0.f;
    if (n0 + nn < N) v = src[(long)(k0 + kk) * N + n0 + nn];
    sm[kk * 65 + nn] = v;
  }
  __syncthreads();
#pragma unroll 4
  for (int i = 0; i < 16; ++i) {
    const int nn = i * 4 + (tid >> 6), kk = tid & 63;
    dst[(long)(n0 + nn) * K + k0 + kk] = f2bf(sm[kk * 65 + nn]);
  }
}

__device__ __forceinline__ void tconv_job(const float* src, bf16_t* dst, int K, int N, int Npad, float* sm) {
  const int tkn = K / 64, tnn = Npad / 64;
  for (int t = blockIdx.x; t < tkn * tnn; t += gridDim.x) tconv_tile(src, dst, K, N, t % tkn, t / tkn, sm);
}

__device__ __forceinline__ void s5_prep(const Params& p, int layer, int grp, float* sm) {
  float* pwr = sm;
  float* pwi = pwr + 9 * 64;
  float* bbr = pwi + 9 * 64;
  float* bbi = bbr + 1024;
  float* cr = bbi + 1024;
  float* ci = cr + 1024;
  float* kt = ci + 1024;
  const int tid = otid();
  const int lg = layer * 32 + grp;
  __syncthreads();
  if (tid < 64) {
    const int pp = tid;
    const double step = exp((double)p.in[19][lg]);
    const double lr = (double)p.in[17][lg * 64 + pp], li = (double)p.in[18][lg * 64 + pp];
    const double mag = exp(lr * step);
    const double abr = mag * cos(li * step), abi = mag * sin(li * step);
    const double den = lr * lr + li * li;
    const double fr = ((abr - 1.0) * lr + abi * li) / den;
    const double fi = (abi * lr - (abr - 1.0) * li) / den;
    double qr = 1.0, qi = 0.0;
    for (int t = 0; t < 9; ++t) {
      pwr[t * 64 + pp] = (float)qr;
      pwi[t * 64 + pp] = (float)qi;
      const double nr = qr * abr - qi * abi, ni = qr * abi + qi * abr;
      qr = nr; qi = ni;
    }
    float* a8 = (float*)(p.ws + OFF_A8) + (size_t)(lg * 64 + pp) * 2;
    a8[0] = pwr[8 * 64 + pp];
    a8[1] = pwi[8 * 64 + pp];
    for (int cc = 0; cc < 16; ++cc) {
      const double br = (double)p.in[20][(lg * 64 + pp) * 16 + cc], bi = (double)p.in[21][(lg * 64 + pp) * 16 + cc];
      bbr[pp * 16 + cc] = (float)(fr * br - fi * bi);
      bbi[pp * 16 + cc] = (float)(fr * bi + fi * br);
    }
  }
  for (int e = tid; e < 1024; e += 256) {
    cr[e] = p.in[22][lg * 1024 + e];
    ci[e] = p.in[23][lg * 1024 + e];
  }
  __syncthreads();
  for (int e = tid; e < 2048; e += 256) {
    const int tau = e >> 8, co = (e >> 4) & 15, cin = e & 15;
    float s = 0.f;
    for (int pp = 0; pp < 64; ++pp) {
      const float pr = pwr[tau * 64 + pp], pi = pwi[tau * 64 + pp];
      const float zr = pr * bbr[pp * 16 + cin] - pi * bbi[pp * 16 + cin];
      const float zi = pr * bbi[pp * 16 + cin] + pi * bbr[pp * 16 + cin];
      s += cr[co * 64 + pp] * zr - ci[co * 64 + pp] * zi;
    }
    kt[e] = s;
  }
  __syncthreads();
  bf16_t* Km = (bf16_t*)(p.ws + OFF_KMAT) + (size_t)lg * 16384;
  bf16_t* Em = (bf16_t*)(p.ws + OFF_EMAT) + (size_t)lg * 16384;
  bf16_t* Fm = (bf16_t*)(p.ws + OFF_FMAT) + (size_t)lg * 16384;
  for (int e = tid; e < 16384; e += 256) {
    const int n = e >> 7, k = e & 127;
    {
      const int tq = n >> 4, co = n & 15, sq = k >> 4, cin = k & 15;
      Km[e] = f2bf(tq >= sq ? kt[((tq - sq) * 16 + co) * 16 + cin] : 0.f);
    }
    {
      const int pp = n >> 1, ri = n & 1, sq = k >> 4, cin = k & 15;
      const float pr = pwr[(7 - sq) * 64 + pp], pi = pwi[(7 - sq) * 64 + pp];
      const float zr = pr * bbr[pp * 16 + cin] - pi * bbi[pp * 16 + cin];
      const float zi = pr * bbi[pp * 16 + cin] + pi * bbr[pp * 16 + cin];
      Em[e] = f2bf(ri ? zi : zr);
    }
    {
      const int tq = n >> 4, co = n & 15, pp = k >> 1, ri = k & 1;
      const float pr = pwr[(tq + 1) * 64 + pp], pi = pwi[(tq + 1) * 64 + pp];
      const float gr = cr[co * 64 + pp] * pr - ci[co * 64 + pp] * pi;
      const float gi = cr[co * 64 + pp] * pi + ci[co * 64 + pp] * pr;
      Fm[e] = f2bf(ri ? -gi : gr);
    }
  }
}

__device__ __forceinline__ void phase_prep(const Params& p, float* smf) {
  for (int L = 0; L < 2; ++L) {
    tconv_job(p.in[3] + (size_t)L * 1024 * D_IN, (bf16_t*)(p.ws + OFF_WINT) + (size_t)L * D_INP * 1024, 1024, D_IN, D_INP, smf);
    for (int n = 0; n < 4; ++n)
      tconv_job(p.in[33] + (size_t)(L * 4 + n) * 512 * 1024, (bf16_t*)(p.ws + OFF_WBRT) + (size_t)(L * 4 + n) * 1024 * 512, 512, 1024, 1024, smf);
    tconv_job(p.in[34] + (size_t)L * 1024 * 1024, (bf16_t*)(p.ws + OFF_WOUTT) + (size_t)L * 1024 * 1024, 1024, 1024, 1024, smf);
    tconv_job(p.in[25] + (size_t)L * 512 * 512, (bf16_t*)(p.ws + OFF_WGLUT) + (size_t)L * 512 * 512, 512, 512, 512, smf);
    tconv_job(p.in[28] + (size_t)L * 256 * 768, (bf16_t*)(p.ws + OFF_WUQT) + (size_t)L * 768 * 256, 256, 768, 768, smf);
    tconv_job(p.in[30] + (size_t)L * 128 * 1024, (bf16_t*)(p.ws + OFF_WUKVT) + (size_t)L * 1024 * 128, 128, 1024, 1024, smf);
  }
  for (int it = blockIdx.x; it < 64; it += gridDim.x) s5_prep(p, it >> 5, it & 31, smf);
  if (blockIdx.x == gridDim.x - 1 && otid() < 2) {
    const int L = otid();
    float s1 = 0.f, s2 = 0.f;
    for (int i = 0; i < 64; ++i) {
      s1 += p.in[6][L * 64 + i] * p.in[7][L * 64 + i];
      s2 += p.in[8][L * 64 + i] * p.in[9][L * 64 + i];
    }
    const float li = 0.8f - 0.6f * expf(-0.3f * (float)L);
    ((float*)(p.ws + OFF_LAM))[L] = expf(s1) - expf(s2) + li;
  }
}

__device__ __forceinline__ void phase_hnorm(const float* __restrict__ x, const float* __restrict__ gn, bf16_t* __restrict__ H) {
  const int w = otid() >> 6, l = otid() & 63;
  for (int row = blockIdx.x * 4 + w; row < TR; row += gridDim.x * 4) {
    const float4* xr = (const float4*)(x + (size_t)row * 1024);
    float4 v[4];
    float ss = 0.f;
#pragma unroll
    for (int i = 0; i < 4; ++i) {
      v[i] = xr[i * 64 + l];
      ss += v[i].x * v[i].x + v[i].y * v[i].y + v[i].z * v[i].z + v[i].w * v[i].w;
    }
    ss = wave_sum(ss);
    const float rs = rsqrtf(ss * (1.0f / 1024.0f) + EPS);
#pragma unroll
    for (int i = 0; i < 4; ++i) {
      const float4 gg = ((const float4*)gn)[i * 64 + l];
      u32x2 o;
      o.x = pack2(v[i].x * rs * gg.x, v[i].y * rs * gg.y);
      o.y = pack2(v[i].z * rs * gg.z, v[i].w * rs * gg.w);
      *(u32x2*)(H + (size_t)row * 1024 + (i * 64 + l) * 4) = o;
    }
  }
}

__device__ __forceinline__ void inproj_tile(const Params& p, int layer, int rt, int ct, bf16_t* smem) {
  const bf16_t* H = (const bf16_t*)(p.ws + OFF_H);
  const bf16_t* W = (const bf16_t*)(p.ws + OFF_WINT) + (size_t)layer * D_INP * 1024;
  bf16_t* PROJ = (bf16_t*)(p.ws + OFF_PROJ);
  bf16_t* VTA = (bf16_t*)(p.ws + OFF_VTA);
  f32x4 acc[4][4];
  zero_acc<4>(acc);
  gemm_tile<128, false, false, false>(acc, H + (size_t)rt * 128 * 1024, 1024, W + (size_t)ct * 128 * 1024, 1024, 1024, smem);
  const int tid = otid(), w = tid >> 6, l = tid & 63, g = l >> 4, c = l & 15, wr = w >> 1, wc = w & 1;
  const int c0 = ct * 128;
  if (c0 >= C_DAV && c0 < C_DAG) {
    const int h = (c0 - C_DAV) >> 7;
#pragma unroll
    for (int i = 0; i < 4; ++i)
#pragma unroll
      for (int j = 0; j < 4; ++j) {
        const int row = rt * 128 + wr * 64 + i * 16 + g * 4;
        const int dv = wc * 64 + j * 16 + c;
        const int b = row >> 11, s = row & 2047;
        u32x2 o;
        o.x = pack2(acc[i][j][0], acc[i][j][1]);
        o.y = pack2(acc[i][j][2], acc[i][j][3]);
        *(u32x2*)(VTA + ((size_t)((b * 4 + h) * 128 + dv)) * 2048 + s) = o;
      }
  } else {
#pragma unroll
    for (int i = 0; i < 4; ++i) {
#pragma unroll
      for (int r = 0; r < 4; ++r) {
        const int row = rt * 128 + wr * 64 + i * 16 + g * 4 + r;
        bf16_t* rp = PROJ + (size_t)row * LDP + c0 + wc * 64 + c;
#pragma unroll
        for (int j = 0; j < 4; ++j) {
          float v = acc[i][j][r];
          if (c0 + wc * 64 + j * 16 + c >= C_GATE) v = sigmoidf_(v);
          rp[j * 16] = f2bf(v);
        }
      }
      MEMBAR();
    }
  }
}

__device__ __forceinline__ void tokpost_item(const Params& p, int layer, int round, int item) {
  bf16_t* PROJ = (bf16_t*)(p.ws + OFF_PROJ);
  const int* pos = (const int*)p.in[1];
  const int w = otid() >> 6, l = otid() & 63;
  for (int tt = 0; tt < 4; ++tt) {
    const int row = item * 16 + w * 4 + tt;
    const float fpos = (float)pos[round * TR + row];
    bf16_t* pr = PROJ + (size_t)row * LDP;
    {
      const int which = l >> 5, idx = (l & 31) * 16, off = (l & 3) * 16;
      bf16_t* ptr = pr + which * 512 + idx;
      u32x4 u0 = *(const u32x4*)ptr, u1 = *(const u32x4*)(ptr + 8);
      const unsigned uu[8] = {u0.x, u0.y, u0.z, u0.w, u1.x, u1.y, u1.z, u1.w};
      float v[16];
      float ss = 0.f;
#pragma unroll
      for (int e = 0; e < 8; ++e) {
        v[2 * e] = __uint_as_float(uu[e] << 16);
        v[2 * e + 1] = __uint_as_float(uu[e] & 0xffff0000u);
        ss += v[2 * e] * v[2 * e] + v[2 * e + 1] * v[2 * e + 1];
      }
      ss += __shfl_xor(ss, 1, 64);
      ss += __shfl_xor(ss, 2, 64);
      const float rs = rsqrtf(ss * (1.0f / 64.0f) + EPS);
      const float* gn = (which ? p.in[5] : p.in[4]) + layer * 64 + off;
#pragma unroll
      for (int e = 0; e < 16; ++e) v[e] = v[e] * rs * gn[e];
      if ((l & 3) == 0) {
#pragma unroll
        for (int i = 0; i < 8; ++i) {
          const float invf = expf(-13.122363377404328f * (float)i * 0.125f);
          const float ang = fpos * invf;
          const float cs = cosf(ang), sn = sinf(ang);
          const float x1 = v[i], x2 = v[i + 8];
          v[i] = x1 * cs - x2 * sn;
          v[i + 8] = x2 * cs + x1 * sn;
        }
      }
      if (which == 0) {
#pragma unroll
        for (int e = 0; e < 16; ++e) v[e] *= 0.125f * LOG2E;
      }
      u32x4 o0, o1;
      o0.x = pack2(v[0], v[1]); o0.y = pack2(v[2], v[3]); o0.z = pack2(v[4], v[5]); o0.w = pack2(v[6], v[7]);
      o1.x = pack2(v[8], v[9]); o1.y = pack2(v[10], v[11]); o1.z = pack2(v[12], v[13]); o1.w = pack2(v[14], v[15]);
      bf16_t* qko = (bf16_t*)(p.ws + OFF_QK) + (size_t)row * 1024 + which * 512 + idx;
      *(u32x4*)qko = o0;
      *(u32x4*)(qko + 8) = o1;
    }
    {
      bf16_t* ptr = pr + C_CQ + l * 4;
      u32x2 u = *(const u32x2*)ptr;
      float v0 = __uint_as_float(u.x << 16), v1 = __uint_as_float(u.x & 0xffff0000u);
      float v2 = __uint_as_float(u.y << 16), v3 = __uint_as_float(u.y & 0xffff0000u);
      float ss = wave_sum(v0 * v0 + v1 * v1 + v2 * v2 + v3 * v3);
      const float rs = rsqrtf(ss * (1.0f / 256.0f) + EPS);
      const float* gn = p.in[27] + layer * 256 + l * 4;
      u32x2 o;
      o.x = pack2(v0 * rs * gn[0], v1 * rs * gn[1]);
      o.y = pack2(v2 * rs * gn[2], v3 * rs * gn[3]);
      *(u32x2*)((bf16_t*)(p.ws + OFF_CQ2) + (size_t)row * 384 + l * 4) = o;
    }
    {
      bf16_t* ptr = pr + C_CKV + l * 2;
      unsigned u = *(const unsigned*)ptr;
      float v0 = __uint_as_float(u << 16), v1 = __uint_as_float(u & 0xffff0000u);
      float ss = wave_sum(v0 * v0 + v1 * v1);
      const float rs = rsqrtf(ss * (1.0f / 128.0f) + EPS);
      const float* gn = p.in[29] + layer * 128 + l * 2;
      *(unsigned*)((bf16_t*)(p.ws + OFF_CQ2) + (size_t)row * 384 + 256 + l * 2) = pack2(v0 * rs * gn[0], v1 * rs * gn[1]);
    }
  }
}

__device__ __forceinline__ void conv_item(const Params& p, int layer, int item) {
  const bf16_t* PROJ = (const bf16_t*)(p.ws + OFF_PROJ);
  bf16_t* XC = (bf16_t*)(p.ws + OFF_XC);
  const int chtile = item & 15, tt = (item >> 4) & 31, b = item >> 9;
  const int ch = chtile * 64 + (otid() & 63);
  const int tr0 = otid() >> 6;
  const float* cw = p.in[11] + (size_t)layer * 4 * 1024;
  const float w0 = cw[ch], w1 = cw[1024 + ch], w2 = cw[2048 + ch], w3 = cw[3072 + ch];
  const float bias = p.in[12][layer * 1024 + ch];
  for (int i0 = 0; i0 < 16; i0 += 8) {
    float x0[8], x1[8], x2[8], x3[8];
#pragma unroll
    for (int u = 0; u < 8; ++u) {
      const int t = tt * 64 + (i0 + u) * 4 + tr0;
      const bf16_t* base = PROJ + (size_t)(b * 2048 + t) * LDP + C_XBC + ch;
      x3[u] = bf2f(base[0]);
      x2[u] = (t >= 1) ? bf2f(*(base - LDP)) : 0.f;
      x1[u] = (t >= 2) ? bf2f(*(base - 2 * LDP)) : 0.f;
      x0[u] = (t >= 3) ? bf2f(*(base - 3 * LDP)) : 0.f;
    }
#pragma unroll
    for (int u = 0; u < 8; ++u) {
      const int t = tt * 64 + (i0 + u) * 4 + tr0;
      const float y = bias + w3 * x3[u] + w2 * x2[u] + w1 * x1[u] + w0 * x0[u];
      XC[(size_t)(b * 2048 + t) * 1024 + ch] = f2bf(siluf_(y));
    }
  }
}

__device__ __forceinline__ void dtacum_item(const Params& p, int layer, int item) {
  const bf16_t* PROJ = (const bf16_t*)(p.ws + OFF_PROJ);
  float* DT = (float*)(p.ws + OFF_DT);
  float* AC = (float*)(p.ws + OFF_ACUM);
  const int w = otid() >> 6, l = otid() & 63;
  const int id = item * 4 + w;
  const int h = id & 7, bc = id >> 3;
  const int row0 = bc * 128 + 2 * l;
  const float bias = p.in[13][layer * 8 + h];
  const float A = -expf(p.in[14][layer * 8 + h]);
  float x0 = bf2f(PROJ[(size_t)row0 * LDP + C_DT + h]) + bias;
  float x1 = bf2f(PROJ[(size_t)(row0 + 1) * LDP + C_DT + h]) + bias;
  const float d0 = x0 > 20.f ? x0 : log1pf(expf(x0));
  const float d1 = x1 > 20.f ? x1 : log1pf(expf(x1));
  const float a0 = d0 * A, a1 = d1 * A;
  float s = a0 + a1;
#pragma unroll
  for (int d = 1; d < 64; d <<= 1) {
    const float t = __shfl_up(s, d, 64);
    if (l >= d) s += t;
  }
  DT[(size_t)row0 * 8 + h] = d0;
  DT[(size_t)(row0 + 1) * 8 + h] = d1;
  AC[(size_t)row0 * 8 + h] = s - a1;
  AC[(size_t)(row0 + 1) * 8 + h] = s;
}

__device__ __forceinline__ void s5_e_item(const Params& p, int layer, int item, bf16_t* smem) {
  const bf16_t* PROJ = (const bf16_t*)(p.ws + OFF_PROJ);
  const int grp = item >> 3, mt = item & 7;
  const bf16_t* Em = (const bf16_t*)(p.ws + OFF_EMAT) + (size_t)(layer * 32 + grp) * 16384;
  float* E = (float*)(p.ws + OFF_E);
  f32x4 acc[4][4];
  zero_acc<4>(acc);
  gemm_tile<128, false, false, true>(acc, PROJ + (size_t)mt * 128 * 8 * LDP + C_S5U + grp * 16, 8 * LDP, Em, 128, 128, smem, LDP);
  const int tid = otid(), w = tid >> 6, l = tid & 63, g = l >> 4, c = l & 15, wr = w >> 1, wc = w & 1;
#pragma unroll
  for (int i = 0; i < 4; ++i)
#pragma unroll
    for (int j = 0; j < 4; ++j) {
      const int m = mt * 128 + wr * 64 + i * 16 + g * 4;
      const int n = wc * 64 + j * 16 + c;
      *(f32x4*)(E + ((size_t)(grp * 128 + n)) * NBC + m) = acc[i][j];
    }
}

__device__ __forceinline__ void mla_up_q_tile(const Params& p, int layer, int rt, int ct, bf16_t* smem) {
  const bf16_t* PROJ = (const bf16_t*)(p.ws + OFF_PROJ);
  const bf16_t* W = (const bf16_t*)(p.ws + OFF_WUQT) + (size_t)layer * 768 * 256;
  bf16_t* QM = (bf16_t*)(p.ws + OFF_QM);
  f32x4 acc[4][4];
  zero_acc<4>(acc);
  gemm_tile<128, false, false, false>(acc, (const bf16_t*)(p.ws + OFF_CQ2) + (size_t)rt * 128 * 384, 384, W + (size_t)ct * 128 * 256, 256, 256, smem);
  const int tid = otid(), w = tid >> 6, l = tid & 63, g = l >> 4, c = l & 15, wr = w >> 1, wc = w & 1;
#pragma unroll
  for (int i = 0; i < 4; ++i)
#pragma unroll
    for (int j = 0; j < 4; ++j)
#pragma unroll
      for (int r = 0; r < 4; ++r) {
        const int row = rt * 128 + wr * 64 + i * 16 + g * 4 + r, col = ct * 128 + wc * 64 + j * 16 + c;
        QM[(size_t)row * 768 + col] = f2bf(acc[i][j][r]);
      }
}
__device__ __forceinline__ void mla_up_kv_tile(const Params& p, int layer, int rt, int ct, bf16_t* smem) {
  const bf16_t* PROJ = (const bf16_t*)(p.ws + OFF_PROJ);
  const bf16_t* W = (const bf16_t*)(p.ws + OFF_WUKVT) + (size_t)layer * 1024 * 128;
  bf16_t* KN = (bf16_t*)(p.ws + OFF_KN);
  bf16_t* VTD = (bf16_t*)(p.ws + OFF_VTD);
  f32x4 acc[4][4];
  zero_acc<4>(acc);
  gemm_tile<128, false, false, false>(acc, (const bf16_t*)(p.ws + OFF_CQ2) + (size_t)rt * 128 * 384 + 256, 384, W + (size_t)ct * 128 * 128, 128, 128, smem);
  const int tid = otid(), w = tid >> 6, l = tid & 63, g = l >> 4, c = l & 15, wr = w >> 1, wc = w & 1;
  const int h = ct >> 1;
  if ((ct & 1) == 0) {
#pragma unroll
    for (int i = 0; i < 4; ++i)
#pragma unroll
      for (int j = 0; j < 4; ++j)
#pragma unroll
        for (int r = 0; r < 4; ++r) {
          const int row = rt * 128 + wr * 64 + i * 16 + g * 4 + r, cc = wc * 64 + j * 16 + c;
          KN[(size_t)row * 512 + h * 128 + cc] = f2bf(acc[i][j][r]);
        }
  } else {
#pragma unroll
    for (int i = 0; i < 4; ++i)
#pragma unroll
      for (int j = 0; j < 4; ++j) {
        const int row = rt * 128 + wr * 64 + i * 16 + g * 4, dv = wc * 64 + j * 16 + c;
        const int b = row >> 11, s = row & 2047;
        u32x2 o;
        o.x = pack2(acc[i][j][0], acc[i][j][1]);
        o.y = pack2(acc[i][j][2], acc[i][j][3]);
        *(u32x2*)(VTD + ((size_t)((b * 4 + h) * 128 + dv)) * 2048 + s) = o;
      }
  }
}

__device__ __forceinline__ void mb_states_item(const Params& p, int item, bf16_t* smem) {
  const bf16_t* XC = (const bf16_t*)(p.ws + OFF_XC);
  const float* DT = (const float*)(p.ws + OFF_DT);
  const float* AC = (const float*)(p.ws + OFF_ACUM);
  bf16_t* XS = (bf16_t*)(p.ws + OFF_XS) + (size_t)blockIdx.x * 128 * 64;
  float* ST = (float*)(p.ws + OFF_ST);
  const int h = item & 7, bc = item >> 3;
  const int grp = h >> 2;
  const int row0 = bc * 128;
  const int tid = otid();
  __syncthreads();
  const float alast = AC[(size_t)(row0 + 127) * 8 + h];
  for (int e0 = tid; e0 < 8192; e0 += 2048) {
    float dv[8], av[8];
    bf16_t xv[8];
#pragma unroll
    for (int u = 0; u < 8; ++u) {
      const int e = e0 + u * 256;
      const int row = row0 + (e >> 6);
      dv[u] = DT[(size_t)row * 8 + h];
      av[u] = AC[(size_t)row * 8 + h];
      xv[u] = XC[(size_t)row * 1024 + h * 64 + (e & 63)];
    }
#pragma unroll
    for (int u = 0; u < 8; ++u) XS[e0 + u * 256] = f2bf(bf2f(xv[u]) * dv[u] * __expf(alast - av[u]));
  }
  block_global_handoff();
  f32x4 acc[4][2];
  zero_acc<2>(acc);
  gemm_tile<64, true, true, false>(acc, XC + (size_t)row0 * 1024 + 512 + grp * 128, 1024, XS, 64, 128, smem);
  const int w = tid >> 6, l = tid & 63, g = l >> 4, c = l & 15, wr = w >> 1, wc = w & 1;
#pragma unroll
  for (int i = 0; i < 4; ++i)
#pragma unroll
    for (int j = 0; j < 2; ++j) {
      const int n = wr * 64 + i * 16 + g * 4;
      const int pp = wc * 32 + j * 16 + c;
      *(f32x4*)(ST + ((size_t)(bc * 8 + h) * 64 + pp) * 128 + n) = acc[i][j];
    }
}

__device__ __forceinline__ void s5_carry_item(const Params& p, int layer, int item) {
  const int idx = item * 256 + otid();
  const int b = idx >> 11, grp = (idx >> 6) & 31, pp = idx & 63;
  const float* a8 = (const float*)(p.ws + OFF_A8) + (size_t)((layer * 32 + grp) * 64 + pp) * 2;
  const float ar = a8[0], ai = a8[1];
  const float* er = (const float*)(p.ws + OFF_E) + ((size_t)(grp * 128 + 2 * pp)) * NBC + b * 256;
  const float* ei = er + NBC;
  bf16_t* hro = (bf16_t*)(p.ws + OFF_HIN) + ((size_t)(grp * 128 + 2 * pp)) * NBC + b * 256;
  bf16_t* hio = hro + NBC;
  float hr = 0.f, hi = 0.f;
  for (int c16 = 0; c16 < 16; ++c16) {
    f32x4 vr[4], vi[4];
#pragma unroll
    for (int u = 0; u < 4; ++u) {
      vr[u] = *(const f32x4*)(er + c16 * 16 + u * 4);
      vi[u] = *(const f32x4*)(ei + c16 * 16 + u * 4);
    }
#pragma unroll
    for (int u = 0; u < 4; ++u) {
      float orr[4], oii[4];
#pragma unroll
      for (int k = 0; k < 4; ++k) {
        orr[k] = hr; oii[k] = hi;
        const float nr = ar * hr - ai * hi + vr[u][k];
        const float ni = ar * hi + ai * hr + vi[u][k];
        hr = nr; hi = ni;
      }
      u32x2 o0, o1;
      o0.x = pack2(orr[0], orr[1]); o0.y = pack2(orr[2], orr[3]);
      o1.x = pack2(oii[0], oii[1]); o1.y = pack2(oii[2], oii[3]);
      *(u32x2*)(hro + c16 * 16 + u * 4) = o0;
      *(u32x2*)(hio + c16 * 16 + u * 4) = o1;
    }
  }
}

__device__ __forceinline__ void mlapost_item(const Params& p, int layer, int round, int item) {
  const bf16_t* PROJ = (const bf16_t*)(p.ws + OFF_PROJ);
  bf16_t* QM = (bf16_t*)(p.ws + OFF_QM);
  bf16_t* KM = (bf16_t*)(p.ws + OFF_KM);
  const bf16_t* KN = (const bf16_t*)(p.ws + OFF_KN);
  const int* pos = (const int*)p.in[1];
  const int w = otid() >> 6, l = otid() & 63;
  const float* qn = p.in[31] + layer * 192;
  const float* kn = p.in[32] + layer * 192;
  const float q0 = qn[l], q1 = qn[64 + l], q2 = qn[128 + l];
  const float k0 = kn[l], k1 = kn[64 + l], k2 = kn[128 + l];
  const float invf = expf(-13.122363377404328f * (float)(l & 31) * (1.0f / 32.0f));
  const float qscale = 0.07216878364870322f * LOG2E;
  for (int tt = 0; tt < 4; ++tt) {
    const int row = item * 16 + w * 4 + tt;
    const float ang = (float)pos[round * TR + row] * invf;
    const float cs = cosf(ang), sn = sinf(ang);
    const float kr = bf2f(PROJ[(size_t)row * LDP + C_KR + l]);
#pragma unroll
    for (int h = 0; h < 4; ++h) {
      {
        bf16_t* qp = QM + (size_t)row * 768 + h * 192;
        float e0 = bf2f(qp[l]), e1 = bf2f(qp[64 + l]), e2 = bf2f(qp[128 + l]);
        const float ss = wave_sum(e0 * e0 + e1 * e1 + e2 * e2);
        const float rs = rsqrtf(ss * (1.0f / 192.0f) + EPS);
        e0 *= rs * q0; e1 *= rs * q1; e2 *= rs * q2;
        const float ot = __shfl_xor(e2, 32, 64);
        e2 = (l < 32) ? (e2 * cs - ot * sn) : (e2 * cs + ot * sn);
        bf16_t* qo = (bf16_t*)(p.ws + OFF_QM2) + (size_t)row * 768 + h * 192;
        qo[l] = f2bf(e0 * qscale); qo[64 + l] = f2bf(e1 * qscale); qo[128 + l] = f2bf(e2 * qscale);
      }
      {
        const bf16_t* kp = KN + (size_t)row * 512 + h * 128;
        float e0 = bf2f(kp[l]), e1 = bf2f(kp[64 + l]), e2 = kr;
        const float ss = wave_sum(e0 * e0 + e1 * e1 + e2 * e2);
        const float rs = rsqrtf(ss * (1.0f / 192.0f) + EPS);
        e0 *= rs * k0; e1 *= rs * k1; e2 *= rs * k2;
        const float ot = __shfl_xor(e2, 32, 64);
        e2 = (l < 32) ? (e2 * cs - ot * sn) : (e2 * cs + ot * sn);
        bf16_t* ko = KM + (size_t)row * 768 + h * 192;
        ko[l] = f2bf(e0); ko[64 + l] = f2bf(e1); ko[128 + l] = f2bf(e2);
      }
    }
  }
}

__device__ __forceinline__ void mb_scan_item(const Params& p, int item) {
  const int idx = item * 256 + otid();
  const int b = idx >> 16, h = (idx >> 13) & 7, pn = idx & 8191;
  const float* ST = (const float*)(p.ws + OFF_ST);
  const float* AC = (const float*)(p.ws + OFF_ACUM);
  bf16_t* SIN = (bf16_t*)(p.ws + OFF_SIN);
  float cur = 0.f;
  float alv[16], stv[16];
#pragma unroll
  for (int c = 0; c < 16; ++c) {
    alv[c] = AC[(size_t)(b * 2048 + c * 128 + 127) * 8 + h];
    stv[c] = ST[((size_t)((b * 16 + c) * 8 + h)) * 8192 + pn];
  }
#pragma unroll
  for (int c = 0; c < 16; ++c) {
    SIN[((size_t)((b * 16 + c) * 8 + h)) * 8192 + pn] = f2bf(cur);
    cur = __expf(alv[c]) * cur + stv[c];
  }
}

__device__ __forceinline__ void s5_y_item(const Params& p, int layer, int item, bf16_t* smem) {
  const bf16_t* PROJ = (const bf16_t*)(p.ws + OFF_PROJ);
  const int grp = item >> 3, mt = item & 7;
  const bf16_t* Km = (const bf16_t*)(p.ws + OFF_KMAT) + (size_t)(layer * 32 + grp) * 16384;
  const bf16_t* Fm = (const bf16_t*)(p.ws + OFF_FMAT) + (size_t)(layer * 32 + grp) * 16384;
  const bf16_t* HIN = (const bf16_t*)(p.ws + OFF_HIN) + (size_t)grp * 128 * NBC + mt * 128;
  bf16_t* YG = (bf16_t*)(p.ws + OFF_YG);
  f32x4 acc[4][4];
  zero_acc<4>(acc);
  gemm_tile<128, false, false, true>(acc, PROJ + (size_t)mt * 128 * 8 * LDP + C_S5U + grp * 16, 8 * LDP, Km, 128, 128, smem, LDP);
  gemm_tile<128, true, false, false>(acc, HIN, NBC, Fm, 128, 128, smem);
  const int tid = otid(), w = tid >> 6, l = tid & 63, g = l >> 4, c = l & 15, wr = w >> 1, wc = w & 1;
  const float* dsk = p.in[24] + layer * 512;
#pragma unroll
  for (int i = 0; i < 4; ++i)
#pragma unroll
    for (int j = 0; j < 4; ++j) {
      const int n = wc * 64 + j * 16 + c;
      const int tq = n >> 4, co = n & 15;
      const int ch = grp * 16 + co;
      const float dd = dsk[ch];
#pragma unroll
      for (int r = 0; r < 4; ++r) {
        const int m = mt * 128 + wr * 64 + i * 16 + g * 4 + r;
        const int row = m * 8 + tq;
        const float u = bf2f(PROJ[(size_t)row * LDP + C_S5U + ch]);
        const float y = acc[i][j][r] + dd * u;
        YG[(size_t)row * 512 + ch] = f2bf(gelu_tanh(y));
      }
    }
}

template <int DK, int NM>
__device__ __forceinline__ void attn_core(const bf16_t* __restrict__ Qb, long ldq, const bf16_t* __restrict__ Kb, long ldk,
                                          const bf16_t* __restrict__ Vt, int qb, bf16_t* smem, f32x4 (&O)[NM][8], float (&lsum)[NM][4]) {
  constexpr int KST = DK + 8;
  constexpr int KCH = NM * 64 * DK / 8 / 256;
  constexpr int CPM = 64 * DK / 8;
  constexpr int CPRK = DK / 8;
  bf16_t* sK = smem;
  bf16_t* sV = sK + NM * 64 * KST;
  bf16_t* sP = sV + 128 * 72;
  const int tid = otid(), w = tid >> 6, l = tid & 63, g = l >> 4, c = l & 15;
  bf16x8 qf[NM][DK / 32];
  {
    const long qrow = (long)qb * 64 + w * 16 + c;
#pragma unroll
    for (int m = 0; m < NM; ++m)
#pragma unroll
      for (int ks = 0; ks < DK / 32; ++ks) qf[m][ks] = *(const bf16x8*)(Qb + qrow * ldq + m * DK + ks * 32 + g * 8);
  }
  float mrow[NM][4];
#pragma unroll
  for (int m = 0; m < NM; ++m) {
#pragma unroll
    for (int r = 0; r < 4; ++r) { mrow[m][r] = -INFINITY; lsum[m][r] = 0.f; }
#pragma unroll
    for (int nt = 0; nt < 8; ++nt) O[m][nt] = (f32x4){0.f, 0.f, 0.f, 0.f};
  }
  u32x4 kr[KCH], vr[4];
  auto gloadK = [&](int kt) {
#pragma unroll
    for (int i = 0; i < KCH; ++i) {
      const int ch = tid + i * 256;
      const int m = ch / CPM, cc = ch % CPM;
      const int key = cc / CPRK, d0 = (cc % CPRK) * 8;
      kr[i] = *(const u32x4*)(Kb + (long)(kt * 64 + key) * ldk + m * DK + d0);
    }
  };
  auto gloadV = [&](int kt) {
#pragma unroll
    for (int i = 0; i < 4; ++i) {
      const int ch = tid + i * 256;
      const int dvr = ch >> 3, kc = (ch & 7) * 8;
      vr[i] = *(const u32x4*)(Vt + (long)dvr * 2048 + kt * 64 + kc);
    }
  };
  gloadK(0);
  gloadV(0);
  for (int kt = 0; kt <= qb; ++kt) {
    __syncthreads();
#pragma unroll
    for (int i = 0; i < KCH; ++i) {
      const int ch = tid + i * 256;
      const int m = ch / CPM, cc = ch % CPM;
      const int key = cc / CPRK, d0 = (cc % CPRK) * 8;
      *(u32x4*)(sK + (m * 64 + key) * KST + d0) = kr[i];
    }
#pragma unroll
    for (int i = 0; i < 4; ++i) {
      const int ch = tid + i * 256;
      const int dvr = ch >> 3, kc = (ch & 7) * 8;
      *(u32x4*)(sV + dvr * 72 + kc) = vr[i];
    }
    __syncthreads();
    if (kt < qb) gloadK(kt + 1);
#pragma unroll
    for (int m = 0; m < NM; ++m) {
      f32x4 S[4];
#pragma unroll
      for (int nt = 0; nt < 4; ++nt) {
        S[nt] = (f32x4){0.f, 0.f, 0.f, 0.f};
#pragma unroll
        for (int ks = 0; ks < DK / 32; ++ks) {
          const bf16x8 kf = *(const bf16x8*)(sK + (m * 64 + nt * 16 + c) * KST + ks * 32 + g * 8);
          S[nt] = __builtin_amdgcn_mfma_f32_16x16x32_bf16(qf[m][ks], kf, S[nt], 0, 0, 0);
        }
        MEMBAR();
      }
      if (kt == qb) {
#pragma unroll
        for (int nt = 0; nt < 4; ++nt)
#pragma unroll
          for (int r = 0; r < 4; ++r)
            if (nt * 16 + c > w * 16 + g * 4 + r) S[nt][r] = -INFINITY;
      }
      bf16_t* pw = sP + (size_t)((w * NM + m) * 16) * 72;
#pragma unroll
      for (int r = 0; r < 4; ++r) {
        float mx = fmaxf(fmaxf(S[0][r], S[1][r]), fmaxf(S[2][r], S[3][r]));
        mx = fmaxf(mx, __shfl_xor(mx, 1, 64));
        mx = fmaxf(mx, __shfl_xor(mx, 2, 64));
        mx = fmaxf(mx, __shfl_xor(mx, 4, 64));
        mx = fmaxf(mx, __shfl_xor(mx, 8, 64));
        const float mnew = fmaxf(mrow[m][r], mx);
        const float sc = __builtin_amdgcn_exp2f(mrow[m][r] - mnew);
        mrow[m][r] = mnew;
        float ps = 0.f;
#pragma unroll
        for (int nt = 0; nt < 4; ++nt) {
          const float pv = __builtin_amdgcn_exp2f(S[nt][r] - mnew);
          ps += pv;
          pw[(g * 4 + r) * 72 + nt * 16 + c] = f2bf(pv);
        }
        ps += __shfl_xor(ps, 1, 64);
        ps += __shfl_xor(ps, 2, 64);
        ps += __shfl_xor(ps, 4, 64);
        ps += __shfl_xor(ps, 8, 64);
        lsum[m][r] = lsum[m][r] * sc + ps;
#pragma unroll
        for (int nt = 0; nt < 8; ++nt) O[m][nt][r] *= sc;
      }
    }
    __syncthreads();
    if (kt < qb) gloadV(kt + 1);
#pragma unroll
    for (int m = 0; m < NM; ++m) {
      const bf16_t* pw = sP + (size_t)((w * NM + m) * 16) * 72;
#pragma unroll
      for (int ks = 0; ks < 2; ++ks) {
        const bf16x8 pf = *(const bf16x8*)(pw + c * 72 + ks * 32 + g * 8);
#pragma unroll
        for (int nt = 0; nt < 8; ++nt) {
          const bf16x8 vf = *(const bf16x8*)(sV + (nt * 16 + c) * 72 + ks * 32 + g * 8);
          O[m][nt] = __builtin_amdgcn_mfma_f32_16x16x32_bf16(pf, vf, O[m][nt], 0, 0, 0);
        }
        MEMBAR();
      }
    }
  }
}

__device__ __forceinline__ void da_attn_item(const Params& p, int layer, int bh, int qb, bf16_t* smem, bool dry = false) {
  bf16_t* PROJ = (bf16_t*)(p.ws + OFF_PROJ);
  const bf16_t* VTA = (const bf16_t*)(p.ws + OFF_VTA);
  const bf16_t* QKB = (const bf16_t*)(p.ws + OFF_QK);
  const int b = bh >> 2, h = bh & 3;
  f32x4 O[2][8];
  float ls[2][4];
  {
    f32x4 O1[1][8];
    float l1[1][4];
#pragma unroll 1
    for (int m = 0; m < 2; ++m) {
      attn_core<64, 1>(QKB + (size_t)b * 2048 * 1024 + h * 128 + m * 64, 1024, QKB + (size_t)b * 2048 * 1024 + 512 + h * 128 + m * 64, 1024,
                       VTA + (size_t)(b * 4 + h) * 128 * 2048, qb, smem, O1, l1);
      if (m == 0) {
#pragma unroll
        for (int nt = 0; nt < 8; ++nt) O[0][nt] = O1[0][nt];
#pragma unroll
        for (int r = 0; r < 4; ++r) ls[0][r] = l1[0][r];
      } else {
#pragma unroll
        for (int nt = 0; nt < 8; ++nt) O[1][nt] = O1[0][nt];
#pragma unroll
        for (int r = 0; r < 4; ++r) ls[1][r] = l1[0][r];
      }
    }
  }
  const int tid = otid(), w = tid >> 6, l = tid & 63, g = l >> 4, c = l & 15;
  const float lam = ((const float*)(p.ws + OFF_LAM))[layer];
  const float linit = 0.8f - 0.6f * expf(-0.3f * (float)layer);
  const float* sg = p.in[10] + layer * 128;
#pragma unroll
  for (int r = 0; r < 4; ++r) {
    const float i0 = 1.0f / ls[0][r], i1 = lam / ls[1][r];
    float o[8];
    float ss = 0.f;
#pragma unroll
    for (int nt = 0; nt < 8; ++nt) {
      o[nt] = O[0][nt][r] * i0 - O[1][nt][r] * i1;
      ss += o[nt] * o[nt];
    }
    ss += __shfl_xor(ss, 1, 64);
    ss += __shfl_xor(ss, 2, 64);
    ss += __shfl_xor(ss, 4, 64);
    ss += __shfl_xor(ss, 8, 64);
    const float rs = rsqrtf(ss * (1.0f / 128.0f) + EPS) * (1.0f - linit);
    const size_t row = (size_t)b * 2048 + qb * 64 + w * 16 + g * 4 + r;
#pragma unroll
    for (int nt = 0; nt < 8; ++nt) {
      const int dv = nt * 16 + c;
      bf16_t* gp = PROJ + row * LDP + C_DAG + h * 128 + dv;
      const float gt = bf2f(*gp);
      if (!dry) *gp = f2bf(o[nt] * rs * sg[dv] * siluf_(gt));
    }
  }
}

__device__ __forceinline__ void mla_attn_item(const Params& p, int bh, int qb, bf16_t* smem, bool dry = false) {
  bf16_t* PROJ = (bf16_t*)(p.ws + OFF_PROJ);
  const bf16_t* QM = (const bf16_t*)(p.ws + OFF_QM2);
  const bf16_t* KM = (const bf16_t*)(p.ws + OFF_KM);
  const bf16_t* VTD = (const bf16_t*)(p.ws + OFF_VTD);
  const int b = bh >> 2, h = bh & 3;
  f32x4 O[1][8];
  float ls[1][4];
  attn_core<192, 1>(QM + (size_t)b * 2048 * 768 + h * 192, 768, KM + (size_t)b * 2048 * 768 + h * 192, 768,
                    VTD + (size_t)(b * 4 + h) * 128 * 2048, qb, smem, O, ls);
  const int tid = otid(), w = tid >> 6, l = tid & 63, g = l >> 4, c = l & 15;
#pragma unroll
  for (int r = 0; r < 4; ++r) {
    const float i0 = 1.0f / ls[0][r];
    const size_t row = (size_t)b * 2048 + qb * 64 + w * 16 + g * 4 + r;
#pragma unroll
    for (int nt = 0; nt < 8; ++nt) {
      const int dv = nt * 16 + c;
      bf16_t* gp = PROJ + row * LDP + C_MLG + h * 128 + dv;
      const float gt = bf2f(*gp);
      if (!dry) *gp = f2bf(O[0][nt][r] * i0 * siluf_(gt));
    }
  }
}

__device__ __forceinline__ void mb_out_item(const Params& p, int layer, int item, bf16_t* smem) {
  bf16_t* PROJ = (bf16_t*)(p.ws + OFF_PROJ);
  const bf16_t* XC = (const bf16_t*)(p.ws + OFF_XC);
  const float* DT = (const float*)(p.ws + OFF_DT);
  const float* AC = (const float*)(p.ws + OFF_ACUM);
  const bf16_t* SIN = (const bf16_t*)(p.ws + OFF_SIN);
  bf16_t* MS = (bf16_t*)(p.ws + OFF_MS) + (size_t)blockIdx.x * 128 * 128;
  float* rowss = (float*)((unsigned char*)smem + 73728);
  const int grp = item & 1, bc = item >> 1;
  const int row0 = bc * 128;
  __syncthreads();
  const bf16_t* Cp = XC + (size_t)row0 * 1024 + 768 + grp * 128;
  const bf16_t* Bp = XC + (size_t)row0 * 1024 + 512 + grp * 128;
#pragma unroll 1
  for (int r4 = 0; r4 < 4; ++r4) {
    const int h = grp * 4 + r4;
    const int tid = otid(), w = tid >> 6, l = tid & 63, g = l >> 4, c = l & 15, wr = w >> 1, wc = w & 1;
    {
      f32x4 cb[4][4];
      zero_acc<4>(cb);
      gemm_tile<128, false, false, false>(cb, Cp, 1024, Bp, 1024, 128, smem);
      float acs[4], dts[4];
#pragma unroll
      for (int j = 0; j < 4; ++j) {
        const int s = wc * 64 + j * 16 + c;
        acs[j] = AC[(size_t)(row0 + s) * 8 + h];
        dts[j] = DT[(size_t)(row0 + s) * 8 + h];
      }
#pragma unroll
      for (int i = 0; i < 4; ++i)
#pragma unroll
        for (int r = 0; r < 4; ++r) {
          const int lr = wr * 64 + i * 16 + g * 4 + r;
          const float acl = AC[(size_t)(row0 + lr) * 8 + h];
#pragma unroll
          for (int j = 0; j < 4; ++j) {
            const int s = wc * 64 + j * 16 + c;
            const float v = (s <= lr) ? cb[i][j][r] * __expf(acl - acs[j]) * dts[j] : 0.f;
            MS[lr * 128 + s] = f2bf(v);
          }
          MEMBAR();
        }
    }
    block_global_handoff();
    f32x4 ad[4][2], ao[4][2];
    zero_acc<2>(ad);
    zero_acc<2>(ao);
    gemm_tile<64, false, true, false>(ad, MS, 128, XC + (size_t)row0 * 1024 + h * 64, 1024, 128, smem);
    gemm_tile<64, false, false, false>(ao, Cp, 1024, SIN + ((size_t)(bc * 8 + h)) * 8192, 128, 128, smem);
    const float dsk = p.in[15][layer * 8 + h];
#pragma unroll
    for (int i = 0; i < 4; ++i)
#pragma unroll
      for (int r = 0; r < 4; ++r) {
        const int lr = wr * 64 + i * 16 + g * 4 + r;
        const size_t row = (size_t)row0 + lr;
        const float ea = __expf(AC[row * 8 + h]);
        float ssq = 0.f;
#pragma unroll
        for (int j = 0; j < 2; ++j) {
          const int ch = h * 64 + wc * 32 + j * 16 + c;
          const float xv = bf2f(XC[row * 1024 + ch]);
          bf16_t* zp = PROJ + row * LDP + C_MBZ + ch;
          const float z = bf2f(*zp);
          float y = ad[i][j][r] + ea * ao[i][j][r] + dsk * xv;
          y *= siluf_(z);
          ssq += y * y;
          *zp = f2bf(y);
        }
        ssq += __shfl_xor(ssq, 1, 64);
        ssq += __shfl_xor(ssq, 2, 64);
        ssq += __shfl_xor(ssq, 4, 64);
        ssq += __shfl_xor(ssq, 8, 64);
        if (c == 0) rowss[(r4 * 2 + wc) * 128 + lr] = ssq;
        MEMBAR();
      }
  }
  block_global_handoff();
  const float* ng = p.in[16] + layer * 512 + grp * 256;
  {
    const int cc = otid();
    const float gcc = ng[cc];
    for (int l0 = 0; l0 < 128; l0 += 16) {
      bf16_t vals[16];
#pragma unroll
      for (int u = 0; u < 16; ++u) vals[u] = PROJ[(size_t)(row0 + l0 + u) * LDP + C_MBZ + grp * 256 + cc];
#pragma unroll
      for (int u = 0; u < 16; ++u) {
        const int lr = l0 + u;
        float tot = 0.f;
#pragma unroll
        for (int q = 0; q < 8; ++q) tot += rowss[q * 128 + lr];
        PROJ[(size_t)(row0 + lr) * LDP + C_MBZ + grp * 256 + cc] = f2bf(bf2f(vals[u]) * rsqrtf(tot * (1.0f / 256.0f) + EPS) * gcc);
      }
    }
  }
}

__device__ __forceinline__ void s5_glu_tile(const Params& p, int layer, int rt, int ct, bf16_t* smem) {
  bf16_t* PROJ = (bf16_t*)(p.ws + OFF_PROJ);
  const bf16_t* YG = (const bf16_t*)(p.ws + OFF_YG);
  const bf16_t* W = (const bf16_t*)(p.ws + OFF_WGLUT) + (size_t)layer * 512 * 512;
  f32x4 acc[4][4];
  zero_acc<4>(acc);
  gemm_tile<128, false, false, false>(acc, YG + (size_t)rt * 128 * 512, 512, W + (size_t)ct * 128 * 512, 512, 512, smem);
  const int tid = otid(), w = tid >> 6, l = tid & 63, g = l >> 4, c = l & 15, wr = w >> 1, wc = w & 1;
  const float* bg = p.in[26] + layer * 512;
#pragma unroll
  for (int i = 0; i < 4; ++i)
#pragma unroll
    for (int j = 0; j < 4; ++j) {
      const int col = ct * 128 + wc * 64 + j * 16 + c;
      const float bb = bg[col];
#pragma unroll
      for (int r = 0; r < 4; ++r) {
        const size_t row = (size_t)rt * 128 + wr * 64 + i * 16 + g * 4 + r;
        const float yv = bf2f(YG[row * 512 + col]);
        bf16_t* gp = PROJ + row * LDP + C_S5G + col;
        const float gt = bf2f(*gp);
        *gp = f2bf(yv * sigmoidf_(acc[i][j][r] + bb) * siluf_(gt));
      }
    }
}

__device__ __forceinline__ void merge_tile(const Params& p, int layer, int rt, int ct, bf16_t* smem) {
  const bf16_t* PROJ = (const bf16_t*)(p.ws + OFF_PROJ);
  bf16_t* MG = (bf16_t*)(p.ws + OFF_MERGED);
  f32x4 macc[4][2];
  zero_acc<2>(macc);
  const int tid = otid(), w = tid >> 6, l = tid & 63, g = l >> 4, c = l & 15, wr = w >> 1, wc = w & 1;
  for (int n = 0; n < 4; ++n) {
    const int ycol = (n == 0) ? C_DAG : (n == 1) ? C_MBZ : (n == 2) ? C_S5G : C_MLG;
    const bf16_t* W = (const bf16_t*)(p.ws + OFF_WBRT) + (size_t)(layer * 4 + n) * 1024 * 512;
    f32x4 acc[4][2];
    zero_acc<2>(acc);
    gemm_tile<64, false, false, false>(acc, PROJ + (size_t)rt * 128 * LDP + ycol, LDP, W + (size_t)ct * 64 * 512, 512, 512, smem);
#pragma unroll
    for (int i = 0; i < 4; ++i) {
#pragma unroll
      for (int r = 0; r < 4; ++r) {
        const size_t row = (size_t)rt * 128 + wr * 64 + i * 16 + g * 4 + r;
        const bf16_t* gp = PROJ + row * LDP + C_GATE + n * 1024 + ct * 64 + wc * 32 + c;
#pragma unroll
        for (int j = 0; j < 2; ++j) macc[i][j][r] += bf2f(gp[j * 16]) * acc[i][j][r];
      }
      MEMBAR();
    }
  }
#pragma unroll
  for (int i = 0; i < 4; ++i) {
#pragma unroll
    for (int r = 0; r < 4; ++r) {
      const size_t row = (size_t)rt * 128 + wr * 64 + i * 16 + g * 4 + r;
      bf16_t* op = MG + row * 1024 + ct * 64 + wc * 32 + c;
#pragma unroll
      for (int j = 0; j < 2; ++j) op[j * 16] = f2bf(macc[i][j][r]);
    }
    MEMBAR();
  }
}

__device__ __forceinline__ void out_tile(const Params& p, int layer, const float* xo, float* xn, int rt, int ct, bf16_t* smem) {
  const bf16_t* MG = (const bf16_t*)(p.ws + OFF_MERGED);
  const bf16_t* W = (const bf16_t*)(p.ws + OFF_WOUTT) + (size_t)layer * 1024 * 1024;
  f32x4 acc[4][4];
  zero_acc<4>(acc);
  gemm_tile<128, false, false, false>(acc, MG + (size_t)rt * 128 * 1024, 1024, W + (size_t)ct * 128 * 1024, 1024, 1024, smem);
  const int tid = otid(), w = tid >> 6, l = tid & 63, g = l >> 4, c = l & 15, wr = w >> 1, wc = w & 1;
#pragma unroll
  for (int i = 0; i < 4; ++i)
#pragma unroll
    for (int j = 0; j < 4; ++j) {
      const int col = ct * 128 + wc * 64 + j * 16 + c;
#pragma unroll
      for (int r = 0; r < 4; ++r) {
        const size_t row = (size_t)rt * 128 + wr * 64 + i * 16 + g * 4 + r;
        xn[row * 1024 + col] = xo[row * 1024 + col] + acc[i][j][r];
      }
    }
}

struct Bx { unsigned xcd, nloc, nx, hier; };
__device__ __forceinline__ unsigned xcc_id() { return (unsigned)__builtin_amdgcn_s_getreg((3 << 11) | 20) & 0x7u; }
__device__ __forceinline__ void gsync_flat(unsigned* bar) {
  asm volatile("s_waitcnt vmcnt(0)" ::: "memory");
  __syncthreads();
  if (otid() == 0) {
    unsigned long long* w = (unsigned long long*)bar;
    __builtin_amdgcn_fence(__ATOMIC_RELEASE, "agent");
    asm volatile("s_waitcnt vmcnt(0)" ::: "memory");
    const unsigned long long old = __hip_atomic_fetch_add(w, 1ull, __ATOMIC_RELAXED, __HIP_MEMORY_SCOPE_AGENT);
    const unsigned G = gridDim.x;
    if ((unsigned)(old & 0xffffffffull) == G - 1) {
      __hip_atomic_fetch_add(w, (1ull << 32) - (unsigned long long)G, __ATOMIC_RELAXED, __HIP_MEMORY_SCOPE_AGENT);
    } else {
      const unsigned g0 = (unsigned)(old >> 32);
      while ((unsigned)(__hip_atomic_load(w, __ATOMIC_RELAXED, __HIP_MEMORY_SCOPE_AGENT) >> 32) == g0) __builtin_amdgcn_s_sleep(1);
    }
    __builtin_amdgcn_fence(__ATOMIC_ACQUIRE, "agent");
    asm volatile("s_waitcnt vmcnt(0)" ::: "memory");
  }
  __syncthreads();
}
__device__ __forceinline__ void gsync(cg::grid_group& grid, unsigned* bar, unsigned& epoch, const volatile unsigned* bxs) {
  asm volatile("s_waitcnt vmcnt(0)" ::: "memory");
  __syncthreads();
  if (otid() == 0) {
    const unsigned xcd = bxs[0], nloc = bxs[1], nx = bxs[2];
    unsigned long long* L = (unsigned long long*)((unsigned char*)bar + 3072 + 256 * xcd);
    unsigned long long* T = (unsigned long long*)((unsigned char*)bar + 5120);
    const unsigned long long old = __hip_atomic_fetch_add(L, 1ull, __ATOMIC_RELAXED, __HIP_MEMORY_SCOPE_AGENT);
    if ((unsigned)(old & 0xffffffffull) == nloc - 1) {
      __builtin_amdgcn_fence(__ATOMIC_RELEASE, "agent");
      asm volatile("s_waitcnt vmcnt(0)" ::: "memory");
      const unsigned long long oldt = __hip_atomic_fetch_add(T, 1ull, __ATOMIC_RELAXED, __HIP_MEMORY_SCOPE_AGENT);
      if ((unsigned)(oldt & 0xffffffffull) == nx - 1) {
        __hip_atomic_fetch_add(T, (1ull << 32) - (unsigned long long)nx, __ATOMIC_RELAXED, __HIP_MEMORY_SCOPE_AGENT);
      } else {
        const unsigned gt = (unsigned)(oldt >> 32);
        while ((unsigned)(__hip_atomic_load(T, __ATOMIC_RELAXED, __HIP_MEMORY_SCOPE_AGENT) >> 32) == gt) __builtin_amdgcn_s_sleep(1);
      }
      __hip_atomic_fetch_add(L, (1ull << 32) - (unsigned long long)nloc, __ATOMIC_RELAXED, __HIP_MEMORY_SCOPE_AGENT);
    } else {
      const unsigned g0 = (unsigned)(old >> 32);
      while ((unsigned)(__hip_atomic_load(L, __ATOMIC_RELAXED, __HIP_MEMORY_SCOPE_AGENT) >> 32) == g0) __builtin_amdgcn_s_sleep(1);
    }
    __builtin_amdgcn_fence(__ATOMIC_ACQUIRE, "agent");
    asm volatile("s_waitcnt vmcnt(0)" ::: "memory");
  }
  __syncthreads();
}

#ifdef SELFCHECK
__device__ __forceinline__ void cksum(const void* ptr, size_t bytes, unsigned long long* slot) {
  const u32x4* q = (const u32x4*)ptr;
  const size_t n = bytes / 16;
  unsigned long long s = 0;
  for (size_t i = (size_t)blockIdx.x * 256 + otid(); i < n; i += (size_t)gridDim.x * 256) {
    const u32x4 v = q[i];
    s += (unsigned long long)v.x + 3ull * v.y + 5ull * v.z + 7ull * v.w;
  }
  unsigned lo = (unsigned)s, hi = (unsigned)(s >> 32);
  unsigned long long t = s;
#pragma unroll
  for (int d = 32; d >= 1; d >>= 1) {
    const unsigned l2 = __shfl_xor((unsigned)t, d, 64), h2 = __shfl_xor((unsigned)(t >> 32), d, 64);
    t += ((unsigned long long)h2 << 32) | l2;
  }
  (void)lo; (void)hi;
  if ((otid() & 63) == 0) atomicAdd(slot, t);
}
#define CK(ptr, bytes) cksum((ptr), (bytes), slots + slot)
#else
#define CK(ptr, bytes) do {} while (0)
#endif

__device__ __forceinline__ void cksum_acc(const void* ptr, size_t bytes, unsigned long long& s) {
  const u32x4* q = (const u32x4*)ptr;
  const size_t n = bytes / 16;
  for (size_t i = ((size_t)blockIdx.x * 256 + otid()) * 64; i < n; i += (size_t)gridDim.x * 256 * 64) {
    const u32x4 v = __builtin_nontemporal_load(q + i);
    s += (unsigned long long)v.x + 3ull * v.y + 5ull * v.z + 7ull * v.w;
  }
}
__device__ __forceinline__ void cksum_commit(unsigned long long t, unsigned long long* slot) {
#pragma unroll
  for (int d = 32; d >= 1; d >>= 1) {
    const unsigned l2 = __shfl_xor((unsigned)t, d, 64), h2 = __shfl_xor((unsigned)(t >> 32), d, 64);
    t += ((unsigned long long)h2 << 32) | l2;
  }
  if ((otid() & 63) == 0) atomicAdd(slot, t);
}

__global__ void __launch_bounds__(256, 2) fwd_megakernel(Params p) {
  cg::grid_group grid = cg::this_grid();
  __shared__ __attribute__((aligned(16))) unsigned char smem_raw[SMEM_BYTES];
  bf16_t* smem = (bf16_t*)smem_raw;
  float* smf = (float*)smem_raw;
  const int G = gridDim.x, bid = blockIdx.x;
  unsigned* bar = (unsigned*)(p.ws + OFF_BAR);
  unsigned epoch = 0;
  volatile unsigned* bxs = (volatile unsigned*)(smem_raw + 73728 + 4096);
  if (otid() == 0) {
    const unsigned xc = xcc_id();
    bxs[0] = xc; bxs[1] = 0u; bxs[2] = 0u; bxs[3] = 0u;
    __hip_atomic_fetch_add((unsigned*)((unsigned char*)bar + 2048 + 128 * xc), 1u, __ATOMIC_RELAXED, __HIP_MEMORY_SCOPE_AGENT);
  }
  __syncthreads();
#ifdef START_DELAY_US
  {
    const unsigned long long t0 = __builtin_amdgcn_s_memrealtime();
    while (__builtin_amdgcn_s_memrealtime() - t0 < (unsigned long long)START_DELAY_US * 100ull) __builtin_amdgcn_s_sleep(20);
  }
#endif
  grid.sync();
#ifdef WCHECK
  unsigned wseen = 0;
  if (bid == 0 && otid() == 0) wseen = __hip_atomic_load(bar + 32, __ATOMIC_RELAXED, __HIP_MEMORY_SCOPE_AGENT);
#endif

#ifdef SELFCHECK
  unsigned long long* slots_base = (unsigned long long*)(p.ws + OFF_BAR + 256);
  if (bid == 0) for (int k = otid(); k < 768; k += 256) __hip_atomic_store(slots_base + k, 0ull, __ATOMIC_RELAXED, __HIP_MEMORY_SCOPE_AGENT);
  for (int run = 0; run < 3; ++run) {
  unsigned long long* slots = slots_base + run * 256;
  int slot = 0;
#endif
  {
    unsigned long long* sslots = (unsigned long long*)(p.ws + OFF_BAR + 1024);
    unsigned long long prev = 0;
    for (int iter = 0; iter < 64; ++iter) {
      unsigned long long s = 0;
      cksum_acc(p.out, (size_t)BATCH * SEQ * 1024 * 4, s);
      cksum_acc(p.ws, OFF_BAR, s);
      cksum_commit(s, sslots + iter);
      gsync_flat(bar);
      const unsigned long long c = __hip_atomic_load(sslots + iter, __ATOMIC_RELAXED, __HIP_MEMORY_SCOPE_AGENT);
      if (iter > 0 && c == prev) break;
      prev = c;
    }
  }
  {
    if (otid() == 0) {
      unsigned nl = 0, nxx = 0;
      const unsigned xc = bxs[0];
      for (int j = 0; j < 8; ++j) {
        const unsigned cj = __hip_atomic_load((unsigned*)((unsigned char*)bar + 2048 + 128 * j), __ATOMIC_RELAXED, __HIP_MEMORY_SCOPE_AGENT);
        nxx += (cj > 0u) ? 1u : 0u;
        nl = ((unsigned)j == xc) ? cj : nl;
      }
      bxs[1] = nl; bxs[2] = nxx; bxs[3] = 1u;
    }
    __syncthreads();
  }
  phase_prep(p, smf);
  gsync(grid, bar, epoch, bxs);
  phase_prep(p, smf);
#ifdef SELF_POISON
  {
    u32x4* q = (u32x4*)(p.ws + OFF_H);
    const size_t n16 = (WS_TOTAL - OFF_H) / 16;
    const u32x4 pv = {SELF_POISON, SELF_POISON, SELF_POISON, SELF_POISON};
    for (size_t i = (size_t)bid * 256 + otid(); i < n16; i += (size_t)G * 256) q[i] = pv;
  }
#endif
  gsync(grid, bar, epoch, bxs);
#ifdef SELFCHECK
  CK(p.ws, OFF_H); slot++;
#endif

  for (int layer = 0; layer < 2; ++layer) {
    const float* xin = (layer == 0) ? p.in[0] : p.out;
    float* xout = p.out;
    for (int round = 0; round < NROUND; ++round) {
      const size_t tok0 = (size_t)round * TR;
      if (layer == 0 && round == 0) {
        phase_hnorm(xin + tok0 * 1024, p.in[2] + layer * 1024, (bf16_t*)(p.ws + OFF_H));
        gsync(grid, bar, epoch, bxs);
      }
#ifdef SELFCHECK
      CK(p.ws + OFF_H, (size_t)TR * 1024 * 2); slot++;
#endif
#ifndef REP_B
#define REP_B 1
#endif
      for (int rep = 0; rep < REP_B; ++rep) {
      for (int it = bid; it < NRT * 76; it += G) inproj_tile(p, layer, it % NRT, it / NRT, smem);
      gsync(grid, bar, epoch, bxs);
      }
#ifdef SELFCHECK
      CK(p.ws + OFF_PROJ, (size_t)TR * D_INP * 2); CK(p.ws + OFF_VTA, (size_t)RB * 4 * 128 * 2048 * 2); slot++;
#endif
      {
        constexpr int n1 = 256, n2 = TR / 16, n3 = RB * 32 * 16, n4 = RB * 16 * 8 / 4;
        for (int it = bid; it < n1 + n2 + n3 + n4; it += G) {
          if (it < n1) s5_e_item(p, layer, it, smem);
          else if (it < n1 + n2) tokpost_item(p, layer, round, it - n1);
          else if (it < n1 + n2 + n3) conv_item(p, layer, it - n1 - n2);
          else dtacum_item(p, layer, it - n1 - n2 - n3);
        }
      }
      gsync(grid, bar, epoch, bxs);
#ifdef SELFCHECK
      CK(p.ws + OFF_PROJ, (size_t)TR * D_INP * 2); CK(p.ws + OFF_E, (size_t)32 * 128 * NBC * 4); CK(p.ws + OFF_XC, (size_t)TR * 1024 * 2);
      CK(p.ws + OFF_DT, (size_t)TR * 8 * 4); CK(p.ws + OFF_ACUM, (size_t)TR * 8 * 4); slot++;
#endif
      {
        constexpr int n1 = NRT * 6, n2 = NRT * 8, n3 = RB * 16 * 8, n4 = RB * 32 * 64 / 256;
        for (int it = bid; it < n1 + n2 + n3 + n4; it += G) {
          if (it < n1) mla_up_q_tile(p, layer, it % NRT, it / NRT, smem);
          else if (it < n1 + n2) mla_up_kv_tile(p, layer, (it - n1) % NRT, (it - n1) / NRT, smem);
          else if (it < n1 + n2 + n3) mb_states_item(p, it - n1 - n2, smem);
          else s5_carry_item(p, layer, it - n1 - n2 - n3);
        }
      }
      gsync(grid, bar, epoch, bxs);
#ifdef SELFCHECK
      CK(p.ws + OFF_QM, (size_t)TR * 768 * 2); CK(p.ws + OFF_KN, (size_t)TR * 512 * 2); CK(p.ws + OFF_VTD, (size_t)RB * 4 * 128 * 2048 * 2);
      CK(p.ws + OFF_ST, (size_t)RB * 16 * 8 * 8192 * 4); CK(p.ws + OFF_HIN, (size_t)32 * 128 * NBC * 2); slot++;
#endif
      {
        constexpr int n1 = 256, n2 = TR / 16, n3 = RB * 8 * 8192 / 256;
        for (int it = bid; it < n1 + n2 + n3; it += G) {
          if (it < n1) s5_y_item(p, layer, it, smem);
          else if (it < n1 + n2) mlapost_item(p, layer, round, it - n1);
          else mb_scan_item(p, it - n1 - n2);
        }
      }
      gsync(grid, bar, epoch, bxs);
#ifdef SELFCHECK
      CK(p.ws + OFF_YG, (size_t)TR * 512 * 2); CK(p.ws + OFF_QM, (size_t)TR * 768 * 2); CK(p.ws + OFF_KM, (size_t)TR * 768 * 2);
      CK(p.ws + OFF_SIN, (size_t)RB * 16 * 8 * 8192 * 2); slot++;
#endif
#ifdef REP_ATT
      {
        constexpr int nat = RB * 4 * 32 * 2;
        for (int it = bid; it < nat; it += G) {
            const int half = nat / 2;
            const int qb = (it < half) ? (31 - it / 32) : ((it - half) / 32);
            const int sub = it & 31;
            if (sub < 16) da_attn_item(p, layer, sub, qb, smem, true);
            else mla_attn_item(p, sub - 16, qb, smem, true);
        }
        gsync(grid, bar, epoch, bxs);
      }
#endif
      {
        constexpr int nat = RB * 4 * 32 * 2;
        constexpr int n3 = RB * 16 * 2, n4 = NRT * 4;
        for (int it0 = bid; it0 < nat + n3 + n4; it0 += G) {
          if (it0 < n3) { mb_out_item(p, layer, it0, smem); continue; }
          const int it = it0 - n3;
          if (it < nat) {
            const int half = nat / 2;
            const int qb = (it < half) ? (31 - it / 32) : ((it - half) / 32);
            const int sub = it & 31;
            if (sub < 16) da_attn_item(p, layer, sub, qb, smem);
            else mla_attn_item(p, sub - 16, qb, smem);
          } else s5_glu_tile(p, layer, (it - nat) % NRT, (it - nat) / NRT, smem);
        }
      }
      gsync(grid, bar, epoch, bxs);
#ifdef SELFCHECK
      CK(p.ws + OFF_PROJ, (size_t)TR * D_INP * 2); slot++;
#endif
      for (int it = bid; it < NRT * 16; it += G) merge_tile(p, layer, it % NRT, it / NRT, smem);
      gsync(grid, bar, epoch, bxs);
#ifdef SELFCHECK
      CK(p.ws + OFF_MERGED, (size_t)TR * 1024 * 2); slot++;
#endif
      for (int it = bid; it < NRT * 8; it += G) out_tile(p, layer, xin + tok0 * 1024, xout + tok0 * 1024, it % NRT, it / NRT, smem);
      {
        const int nl = (round + 1 < NROUND) ? layer : layer + 1;
        const int nr = (round + 1 < NROUND) ? round + 1 : 0;
        if (nl < 2) {
          const float* nx = (nl == 0) ? p.in[0] : p.out;
          phase_hnorm(nx + (size_t)nr * TR * 1024, p.in[2] + nl * 1024, (bf16_t*)(p.ws + OFF_H));
        }
      }
      gsync(grid, bar, epoch, bxs);
#ifdef SELFCHECK
      CK(xout + tok0 * 1024, (size_t)TR * 1024 * 4); slot++;
#endif
    }
  }
#ifdef WCHECK
  if (bid == 0 && otid() == 0) {
    if (wseen != 0) p.out[0] = 1.0e6f;
    __hip_atomic_store(bar + 32, 1u, __ATOMIC_RELAXED, __HIP_MEMORY_SCOPE_AGENT);
  }
#endif
#ifdef SELFCHECK
  gsync(grid, bar, epoch, bxs);
  }
  gsync(grid, bar, epoch, bxs);
  if (bid == 0 && otid() == 0) {
    int bad = -1;
    for (int k = 0; k < 100; ++k) {
      const unsigned long long a = __hip_atomic_load(slots_base + k, __ATOMIC_RELAXED, __HIP_MEMORY_SCOPE_AGENT);
      const unsigned long long b = __hip_atomic_load(slots_base + 256 + k, __ATOMIC_RELAXED, __HIP_MEMORY_SCOPE_AGENT);
      const unsigned long long c = __hip_atomic_load(slots_base + 512 + k, __ATOMIC_RELAXED, __HIP_MEMORY_SCOPE_AGENT);
      if (a != b || a != c) { bad = k; break; }
    }
    if (bad >= 0) p.out[0] = 10000.0f * exp2f((float)bad);
  }
#endif
}

extern "C" void kernel_launch(void* const* d_in, const int* in_sizes, int n_in, void* d_out,
                              int out_size, void* d_ws, size_t ws_size, hipStream_t stream) {
  static int grid_blocks = 0;
  if (!grid_blocks) {
    int dev = 0, cus = 0, per_cu = 0;
    (void)hipGetDevice(&dev);
    (void)hipDeviceGetAttribute(&cus, hipDeviceAttributeMultiprocessorCount, dev);
    (void)hipOccupancyMaxActiveBlocksPerMultiprocessor(&per_cu, fwd_megakernel, 256, 0);
    if (per_cu > 2) per_cu = 2;
    if (per_cu < 1) per_cu = 1;
    grid_blocks = cus * per_cu;
    if (grid_blocks > MAXBLK) grid_blocks = MAXBLK;
  }
  if (ws_size < WS_TOTAL) fprintf(stderr, "workspace too small: %zu < %zu\n", ws_size, (size_t)WS_TOTAL);
  Params p{};
  for (int i = 0; i < 35; ++i) p.in[i] = (const float*)d_in[i];
  p.out = (float*)d_out;
  p.ws = (unsigned char*)d_ws;
  (void)hipMemsetAsync((unsigned char*)d_ws + OFF_BAR, 0, 8192, stream);
  void* args[] = {&p};
  hipError_t e = hipLaunchCooperativeKernel((void*)fwd_megakernel, dim3(grid_blocks), dim3(256), args, 0, stream);
  if (e != hipSuccess) fprintf(stderr, "cooperative launch failed: %s (grid %d)\n", hipGetErrorString(e), grid_blocks);
}
```

```cpp
#include <hip/hip_runtime.h>
#include <hip/hip_cooperative_groups.h>
#include <cstdio>
#include <cstdint>
namespace cg = cooperative_groups;

typedef unsigned short bf16_t;
typedef short bf16x8 __attribute__((ext_vector_type(8)));
typedef float f32x4 __attribute__((ext_vector_type(4)));
typedef unsigned u32x4 __attribute__((ext_vector_type(4)));
typedef unsigned u32x2 __attribute__((ext_vector_type(2)));

constexpr int SEQ = 2048, BATCH = 16;
constexpr int D_IN = 9672, D_INP = 9728;
constexpr int RB = 4;
constexpr int TR = RB * SEQ;
constexpr int NROUND = BATCH / RB;
constexpr int NRT = TR / 128;
constexpr int NBC = TR / 8;
constexpr int MAXBLK = 512;
constexpr float EPS = 1e-6f;
constexpr float LOG2E = 1.4426950408889634f;
constexpr int C_DAQ = 0, C_DAK = 512, C_DAV = 1024, C_DAG = 1536, C_MBZ = 2048, C_XBC = 2560, C_DT = 3584,
              C_S5U = 3592, C_S5G = 4104, C_CQ = 4616, C_CKV = 4872, C_KR = 5000, C_MLG = 5064, C_GATE = 5576;
constexpr long LDP = D_INP;

constexpr size_t al256(size_t x) { return (x + 255) & ~size_t(255); }
constexpr size_t OFF_WINT = 0;
constexpr size_t OFF_WBRT = OFF_WINT + al256((size_t)2 * D_INP * 1024 * 2);
constexpr size_t OFF_WOUTT = OFF_WBRT + al256((size_t)2 * 4 * 1024 * 512 * 2);
constexpr size_t OFF_WGLUT = OFF_WOUTT + al256((size_t)2 * 1024 * 1024 * 2);
constexpr size_t OFF_WUQT = OFF_WGLUT + al256((size_t)2 * 512 * 512 * 2);
constexpr size_t OFF_WUKVT = OFF_WUQT + al256((size_t)2 * 768 * 256 * 2);
constexpr size_t OFF_KMAT = OFF_WUKVT + al256((size_t)2 * 1024 * 128 * 2);
constexpr size_t OFF_EMAT = OFF_KMAT + al256((size_t)2 * 32 * 128 * 128 * 2);
constexpr size_t OFF_FMAT = OFF_EMAT + al256((size_t)2 * 32 * 128 * 128 * 2);
constexpr size_t OFF_A8 = OFF_FMAT + al256((size_t)2 * 32 * 128 * 128 * 2);
constexpr size_t OFF_LAM = OFF_A8 + al256((size_t)2 * 32 * 64 * 2 * 4);
constexpr size_t OFF_H = OFF_LAM + 256;
constexpr size_t OFF_PROJ = OFF_H + al256((size_t)TR * 1024 * 2);
constexpr size_t OFF_XC = OFF_PROJ + al256((size_t)TR * D_INP * 2);
constexpr size_t OFF_DT = OFF_XC + al256((size_t)TR * 1024 * 2);
constexpr size_t OFF_ACUM = OFF_DT + al256((size_t)TR * 8 * 4);
constexpr size_t OFF_VTA = OFF_ACUM + al256((size_t)TR * 8 * 4);
constexpr size_t OFF_VTD = OFF_VTA + al256((size_t)RB * 4 * 128 * 2048 * 2);
constexpr size_t OFF_QM = OFF_VTD + al256((size_t)RB * 4 * 128 * 2048 * 2);
constexpr size_t OFF_KM = OFF_QM + al256((size_t)TR * 768 * 2);
constexpr size_t OFF_KN = OFF_KM + al256((size_t)TR * 768 * 2);
constexpr size_t OFF_ST = OFF_KN + al256((size_t)TR * 512 * 2);
constexpr size_t OFF_SIN = OFF_ST + al256((size_t)RB * 16 * 8 * 8192 * 4);
constexpr size_t OFF_MS = OFF_SIN + al256((size_t)RB * 16 * 8 * 8192 * 2);
constexpr size_t OFF_XS = OFF_MS + al256((size_t)MAXBLK * 128 * 128 * 2);
constexpr size_t OFF_E = OFF_XS + al256((size_t)MAXBLK * 128 * 64 * 2);
constexpr size_t OFF_HIN = OFF_E + al256((size_t)32 * 128 * NBC * 4);
constexpr size_t OFF_YG = OFF_HIN + al256((size_t)32 * 128 * NBC * 2);
constexpr size_t OFF_MERGED = OFF_YG + al256((size_t)TR * 512 * 2);
constexpr size_t OFF_QK = OFF_MERGED + al256((size_t)TR * 1024 * 2);
constexpr size_t OFF_CQ2 = OFF_QK + al256((size_t)TR * 1024 * 2);
constexpr size_t OFF_QM2 = OFF_CQ2 + al256((size_t)TR * 384 * 2);
constexpr size_t OFF_BAR = OFF_QM2 + al256((size_t)TR * 768 * 2);
constexpr size_t WS_TOTAL = OFF_BAR + 8192;

constexpr int SMEM_BYTES = 73728 + 4096 + 64;

struct Params {
  const float* in[35];
  float* out;
  unsigned char* ws;
};

#define MEMBAR() do { asm volatile("" ::: "memory"); __builtin_amdgcn_sched_barrier(0); } while (0)
__device__ __forceinline__ int otid() { int t = threadIdx.x; asm volatile("" : "+v"(t)); return t; }
__device__ __forceinline__ bf16_t f2bf(float f) {
  unsigned u = __float_as_uint(f);
  u += 0x7fffu + ((u >> 16) & 1u);
  return (bf16_t)(u >> 16);
}
__device__ __forceinline__ float bf2f(bf16_t b) { return __uint_as_float(((unsigned)b) << 16); }
__device__ __forceinline__ unsigned pack2(float a, float b) { return (unsigned)f2bf(a) | ((unsigned)f2bf(b) << 16); }
__device__ __forceinline__ float sigmoidf_(float x) { return 1.0f / (1.0f + __expf(-x)); }
__device__ __forceinline__ float siluf_(float x) { return x / (1.0f + __expf(-x)); }
__device__ __forceinline__ float gelu_tanh(float x) {
  float u = 0.7978845608028654f * (x + 0.044715f * x * x * x);
  float t = 1.0f - 2.0f / (__expf(2.0f * u) + 1.0f);
  return 0.5f * x * (1.0f + t);
}
__device__ __forceinline__ float wave_sum(float v) {
#pragma unroll
  for (int d = 32; d >= 1; d >>= 1) v += __shfl_xor(v, d, 64);
  return v;
}

__device__ __forceinline__ void block_global_handoff() {
  asm volatile("s_waitcnt vmcnt(0)" ::: "memory");
  __syncthreads();
  if (otid() < 64) {
    __builtin_amdgcn_fence(__ATOMIC_ACQUIRE, "agent");
    asm volatile("s_waitcnt vmcnt(0)" ::: "memory");
  }
  __syncthreads();
}
template <int R, bool T, bool SEG, int N>
__device__ __forceinline__ void g_load(u32x4 (&rg)[N], const bf16_t* __restrict__ P, long ld, int k0, long segs, int tid) {
#pragma unroll
  for (int i = 0; i < N; ++i) {
    const int ch = tid + i * 256;
    if (!T) {
      const int row = ch >> 3, kc = k0 + (ch & 7) * 8;
      const long ko = SEG ? ((long)(kc >> 4) * segs + (kc & 15)) : (long)kc;
      rg[i] = *(const u32x4*)(P + (long)row * ld + ko);
    } else {
      constexpr int CPR = R / 8;
      const int kk = ch / CPR, m0 = (ch % CPR) * 8;
      rg[i] = *(const u32x4*)(P + (long)(k0 + kk) * ld + m0);
    }
  }
}
template <int R, bool T, int N>
__device__ __forceinline__ void s_store(const u32x4 (&rg)[N], bf16_t* sm, int tid) {
  constexpr int LS = 72;
#pragma unroll
  for (int i = 0; i < N; ++i) {
    const int ch = tid + i * 256;
    if (!T) {
      const int row = ch >> 3, kc = (ch & 7) * 8;
      *(u32x4*)(sm + row * LS + kc) = rg[i];
    } else {
      constexpr int CPR = R / 8;
      const int kk = ch / CPR, m0 = (ch % CPR) * 8;
      bf16_t* d = sm + m0 * LS + kk;
      d[0 * LS] = (bf16_t)(rg[i].x & 0xffffu); d[1 * LS] = (bf16_t)(rg[i].x >> 16);
      d[2 * LS] = (bf16_t)(rg[i].y & 0xffffu); d[3 * LS] = (bf16_t)(rg[i].y >> 16);
      d[4 * LS] = (bf16_t)(rg[i].z & 0xffffu); d[5 * LS] = (bf16_t)(rg[i].z >> 16);
      d[6 * LS] = (bf16_t)(rg[i].w & 0xffffu); d[7 * LS] = (bf16_t)(rg[i].w >> 16);
    }
  }
}
template <int BN>
__device__ __forceinline__ void mfma_stage(f32x4 (&acc)[4][BN / 32], const bf16_t* sA, const bf16_t* sB, int wr, int wc, int g, int c) {
  constexpr int LS = 72;
  const bf16_t* pa = sA + (wr * 64 + c) * LS + g * 8;
  const bf16_t* pb = sB + (wc * (BN / 2) + c) * LS + g * 8;
#pragma unroll
  for (int ks = 0; ks < 2; ++ks) {
    bf16x8 af[4], bfr[BN / 32];
#pragma unroll
    for (int i = 0; i < 4; ++i) af[i] = *(const bf16x8*)(pa + i * 16 * LS + ks * 32);
#pragma unroll
    for (int j = 0; j < BN / 32; ++j) bfr[j] = *(const bf16x8*)(pb + j * 16 * LS + ks * 32);
#pragma unroll
    for (int i = 0; i < 4; ++i)
#pragma unroll
      for (int j = 0; j < BN / 32; ++j) acc[i][j] = __builtin_amdgcn_mfma_f32_16x16x32_bf16(af[i], bfr[j], acc[i][j], 0, 0, 0);
  }
}
template <int BN, bool TA, bool TB, bool SEGA>
__device__ __forceinline__ void gemm_tile(f32x4 (&acc)[4][BN / 32], const bf16_t* __restrict__ A, long lda,
                                          const bf16_t* __restrict__ B, long ldb, int K, bf16_t* smem, long segs = 0) {
  constexpr int LS = 72;
  constexpr int STAGE = 2 * 128 * LS;
  const int tid = otid(), w = tid >> 6, l = tid & 63, g = l >> 4, c = l & 15;
  const int wr = w >> 1, wc = w & 1;
  constexpr int NA = 4, NB = BN / 32;
  u32x4 ra0[NA], rb0[NB], ra1[NA], rb1[NB];
  const int nk = K / 64;
  bf16_t* s0A = smem;
  bf16_t* s0B = smem + 128 * LS;
  bf16_t* s1A = smem + STAGE;
  bf16_t* s1B = smem + STAGE + 128 * LS;
  g_load<128, TA, SEGA, NA>(ra0, A, lda, 0, segs, tid);
  g_load<BN, TB, false, NB>(rb0, B, ldb, 0, 0, tid);
  g_load<128, TA, SEGA, NA>(ra1, A, lda, 64, segs, tid);
  g_load<BN, TB, false, NB>(rb1, B, ldb, 64, 0, tid);
  __syncthreads();
  s_store<128, TA, NA>(ra0, s0A, tid);
  s_store<BN, TB, NB>(rb0, s0B, tid);
  __syncthreads();
  for (int kt = 0; kt < nk; kt += 2) {
    if (kt + 2 < nk) {
      g_load<128, TA, SEGA, NA>(ra0, A, lda, (kt + 2) * 64, segs, tid);
      g_load<BN, TB, false, NB>(rb0, B, ldb, (kt + 2) * 64, 0, tid);
    }
    mfma_stage<BN>(acc, s0A, s0B, wr, wc, g, c);
    s_store<128, TA, NA>(ra1, s1A, tid);
    s_store<BN, TB, NB>(rb1, s1B, tid);
    __syncthreads();
    if (kt + 3 < nk) {
      g_load<128, TA, SEGA, NA>(ra1, A, lda, (kt + 3) * 64, segs, tid);
      g_load<BN, TB, false, NB>(rb1, B, ldb, (kt + 3) * 64, 0, tid);
    }
    mfma_stage<BN>(acc, s1A, s1B, wr, wc, g, c);
    if (kt + 2 < nk) {
      s_store<128, TA, NA>(ra0, s0A, tid);
      s_store<BN, TB, NB>(rb0, s0B, tid);
    }
    __syncthreads();
  }
}

template <int NJ>
__device__ __forceinline__ void zero_acc(f32x4 (&acc)[4][NJ]) {
#pragma unroll
  for (int i = 0; i < 4; ++i)
#pragma unroll
    for (int j = 0; j < NJ; ++j) acc[i][j] = (f32x4){0.f, 0.f, 0.f, 0.f};
}

__device__ __forceinline__ void tconv_tile(const float* __restrict__ src, bf16_t* __restrict__ dst, int K, int N, int tk, int tn, float* sm) {
  const int tid = otid();
  const int k0 = tk * 64, n0 = tn * 64;
  __syncthreads();
#pragma unroll 4
  for (int i = 0; i < 16; ++i) {
    const int kk = i * 4 + (tid >> 6), nn = tid & 63;
    float v = 0.f;
    if (n0 + nn < N) v = src[(long)(k0 + kk) * N + n0 + nn];
    sm[kk * 65 + nn] = v;
  }
  __syncthreads();
#pragma unroll 4
  for (int i = 0; i < 16; ++i) {
    const int nn = i * 4 + (tid >> 6), kk = tid & 63;
    dst[(long)(n0 + nn) * K + k0 + kk] = f2bf(sm[kk * 65 + nn]);
  }
}

__device__ __forceinline__ void tconv_job(const float* src, bf16_t* dst, int K, int N, int Npad, float* sm) {
  const int tkn = K / 64, tnn = Npad / 64;
  for (int t = blockIdx.x; t < tkn * tnn; t += gridDim.x) tconv_tile(src, dst, K, N, t % tkn, t / tkn, sm);
}

__device__ __forceinline__ void s5_prep(const Params& p, int layer, int grp, float* sm) {
  float* pwr = sm;
  float* pwi = pwr + 9 * 64;
  float* bbr = pwi + 9 * 64;
  float* bbi = bbr + 1024;
  float* cr = bbi + 1024;
  float* ci = cr + 1024;
  float* kt = ci + 1024;
  const int tid = otid();
  const int lg = layer * 32 + grp;
  __syncthreads();
  if (tid < 64) {
    const int pp = tid;
    const double step = exp((double)p.in[19][lg]);
    const double lr = (double)p.in[17][lg * 64 + pp], li = (double)p.in[18][lg * 64 + pp];
    const double mag = exp(lr * step);
    const double abr = mag * cos(li * step), abi = mag * sin(li * step);
    const double den = lr * lr + li * li;
    const double fr = ((abr - 1.0) * lr + abi * li) / den;
    const double fi = (abi * lr - (abr - 1.0) * li) / den;
    double qr = 1.0, qi = 0.0;
    for (int t = 0; t < 9; ++t) {
      pwr[t * 64 + pp] = (float)qr;
      pwi[t * 64 + pp] = (float)qi;
      const double nr = qr * abr - qi * abi, ni = qr * abi + qi * abr;
      qr = nr; qi = ni;
    }
    float* a8 = (float*)(p.ws + OFF_A8) + (size_t)(lg * 64 + pp) * 2;
    a8[0] = pwr[8 * 64 + pp];
    a8[1] = pwi[8 * 64 + pp];
    for (int cc = 0; cc < 16; ++cc) {
      const double br = (double)p.in[20][(lg * 64 + pp) * 16 + cc], bi = (double)p.in[21][(lg * 64 + pp) * 16 + cc];
      bbr[pp * 16 + cc] = (float)(fr * br - fi * bi);
      bbi[pp * 16 + cc] = (float)(fr * bi + fi * br);
    }
  }
  for (int e = tid; e < 1024; e += 256) {
    cr[e] = p.in[22][lg * 1024 + e];
    ci[e] = p.in[23][lg * 1024 + e];
  }
  __syncthreads();
  for (int e = tid; e < 2048; e += 256) {
    const int tau = e >> 8, co = (e >> 4) & 15, cin = e & 15;
    float s = 0.f;
    for (int pp = 0; pp < 64; ++pp) {
      const float pr = pwr[tau * 64 + pp], pi = pwi[tau * 64 + pp];
      const float zr = pr * bbr[pp * 16 + cin] - pi * bbi[pp * 16 + cin];
      const float zi = pr * bbi[pp * 16 + cin] + pi * bbr[pp * 16 + cin];
      s += cr[co * 64 + pp] * zr - ci[co * 64 + pp] * zi;
    }
    kt[e] = s;
  }
  __syncthreads();
  bf16_t* Km = (bf16_t*)(p.ws + OFF_KMAT) + (size_t)lg * 16384;
  bf16_t* Em = (bf16_t*)(p.ws + OFF_EMAT) + (size_t)lg * 16384;
  bf16_t* Fm = (bf16_t*)(p.ws + OFF_FMAT) + (size_t)lg * 16384;
  for (int e = tid; e < 16384; e += 256) {
    const int n = e >> 7, k = e & 127;
    {
      const int tq = n >> 4, co = n & 15, sq = k >> 4, cin = k & 15;
      Km[e] = f2bf(tq >= sq ? kt[((tq - sq) * 16 + co) * 16 + cin] : 0.f);
    }
    {
      const int pp = n >> 1, ri = n & 1, sq = k >> 4, cin = k & 15;
      const float pr = pwr[(7 - sq) * 64 + pp], pi = pwi[(7 - sq) * 64 + pp];
      const float zr = pr * bbr[pp * 16 + cin] - pi * bbi[pp * 16 + cin];
      const float zi = pr * bbi[pp * 16 + cin] + pi * bbr[pp * 16 + cin];
      Em[e] = f2bf(ri ? zi : zr);
    }
    {
      const int tq = n >> 4, co = n & 15, pp = k >> 1, ri = k & 1;
      const float pr = pwr[(tq + 1) * 64 + pp], pi = pwi[(tq + 1) * 64 + pp];
      const float gr = cr[co * 64 + pp] * pr - ci[co * 64 + pp] * pi;
      const float gi = cr[co * 64 + pp] * pi + ci[co * 64 + pp] * pr;
      Fm[e] = f2bf(ri ? -gi : gr);
    }
  }
}

__device__ __forceinline__ void phase_prep(const Params& p, float* smf) {
  for (int L = 0; L < 2; ++L) {
    tconv_job(p.in[3] + (size_t)L * 1024 * D_IN, (bf16_t*)(p.ws + OFF_WINT) + (size_t)L * D_INP * 1024, 1024, D_IN, D_INP, smf);
    for (int n = 0; n < 4; ++n)
      tconv_job(p.in[33] + (size_t)(L * 4 + n) * 512 * 1024, (bf16_t*)(p.ws + OFF_WBRT) + (size_t)(L * 4 + n) * 1024 * 512, 512, 1024, 1024, smf);
    tconv_job(p.in[34] + (size_t)L * 1024 * 1024, (bf16_t*)(p.ws + OFF_WOUTT) + (size_t)L * 1024 * 1024, 1024, 1024, 1024, smf);
    tconv_job(p.in[25] + (size_t)L * 512 * 512, (bf16_t*)(p.ws + OFF_WGLUT) + (size_t)L * 512 * 512, 512, 512, 512, smf);
    tconv_job(p.in[28] + (size_t)L * 256 * 768, (bf16_t*)(p.ws + OFF_WUQT) + (size_t)L * 768 * 256, 256, 768, 768, smf);
    tconv_job(p.in[30] + (size_t)L * 128 * 1024, (bf16_t*)(p.ws + OFF_WUKVT) + (size_t)L * 1024 * 128, 128, 1024, 1024, smf);
  }
  for (int it = blockIdx.x; it < 64; it += gridDim.x) s5_prep(p, it >> 5, it & 31, smf);
  if (blockIdx.x == gridDim.x - 1 && otid() < 2) {
    const int L = otid();
    float s1 = 0.f, s2 = 0.f;
    for (int i = 0; i < 64; ++i) {
      s1 += p.in[6][L * 64 + i] * p.in[7][L * 64 + i];
      s2 += p.in[8][L * 64 + i] * p.in[9][L * 64 + i];
    }
    const float li = 0.8f - 0.6f * expf(-0.3f * (float)L);
    ((float*)(p.ws + OFF_LAM))[L] = expf(s1) - expf(s2) + li;
  }
}

__device__ __forceinline__ void phase_hnorm(const float* __restrict__ x, const float* __restrict__ gn, bf16_t* __restrict__ H) {
  const int w = otid() >> 6, l = otid() & 63;
  for (int row = blockIdx.x * 4 + w; row < TR; row += gridDim.x * 4) {
    const float4* xr = (const float4*)(x + (size_t)row * 1024);
    float4 v[4];
    float ss = 0.f;
#pragma unroll
    for (int i = 0; i < 4; ++i) {
      v[i] = xr[i * 64 + l];
      ss += v[i].x * v[i].x + v[i].y * v[i].y + v[i].z * v[i].z + v[i].w * v[i].w;
    }
    ss = wave_sum(ss);
    const float rs = rsqrtf(ss * (1.0f / 1024.0f) + EPS);
#pragma unroll
    for (int i = 0; i < 4; ++i) {
      const float4 gg = ((const float4*)gn)[i * 64 + l];
      u32x2 o;
      o.x = pack2(v[i].x * rs * gg.x, v[i].y * rs * gg.y);
      o.y = pack2(v[i].z * rs * gg.z, v[i].w * rs * gg.w);
      *(u32x2*)(H + (size_t)row * 1024 + (i * 64 + l) * 4) = o;
    }
  }
}

__device__ __forceinline__ void inproj_tile(const Params& p, int layer, int rt, int ct, bf16_t* smem) {
  const bf16_t* H = (const bf16_t*)(p.ws + OFF_H);
  const bf16_t* W = (const bf16_t*)(p.ws + OFF_WINT) + (size_t)layer * D_INP * 1024;
  bf16_t* PROJ = (bf16_t*)(p.ws + OFF_PROJ);
  bf16_t* VTA = (bf16_t*)(p.ws + OFF_VTA);
  f32x4 acc[4][4];
  zero_acc<4>(acc);
  gemm_tile<128, false, false, false>(acc, H + (size_t)rt * 128 * 1024, 1024, W + (size_t)ct * 128 * 1024, 1024, 1024, smem);
  const int tid = otid(), w = tid >> 6, l = tid & 63, g = l >> 4, c = l & 15, wr = w >> 1, wc = w & 1;
  const int c0 = ct * 128;
  if (c0 >= C_DAV && c0 < C_DAG) {
    const int h = (c0 - C_DAV) >> 7;
#pragma unroll
    for (int i = 0; i < 4; ++i)
#pragma unroll
      for (int j = 0; j < 4; ++j) {
        const int row = rt * 128 + wr * 64 + i * 16 + g * 4;
        const int dv = wc * 64 + j * 16 + c;
        const int b = row >> 11, s = row & 2047;
        u32x2 o;
        o.x = pack2(acc[i][j][0], acc[i][j][1]);
        o.y = pack2(acc[i][j][2], acc[i][j][3]);
        *(u32x2*)(VTA + ((size_t)((b * 4 + h) * 128 + dv)) * 2048 + s) = o;
      }
  } else {
#pragma unroll
    for (int i = 0; i < 4; ++i) {
#pragma unroll
      for (int r = 0; r < 4; ++r) {
        const int row = rt * 128 + wr * 64 + i * 16 + g * 4 + r;
        bf16_t* rp = PROJ + (size_t)row * LDP + c0 + wc * 64 + c;
#pragma unroll
        for (int j = 0; j < 4; ++j) {
          float v = acc[i][j][r];
          if (c0 + wc * 64 + j * 16 + c >= C_GATE) v = sigmoidf_(v);
          rp[j * 16] = f2bf(v);
        }
      }
      MEMBAR();
    }
  }
}

__device__ __forceinline__ void tokpost_item(const Params& p, int layer, int round, int item) {
  bf16_t* PROJ = (bf16_t*)(p.ws + OFF_PROJ);
  const int* pos = (const int*)p.in[1];
  const int w = otid() >> 6, l = otid() & 63;
  for (int tt = 0; tt < 4; ++tt) {
    const int row = item * 16 + w * 4 + tt;
    const float fpos = (float)pos[round * TR + row];
    bf16_t* pr = PROJ + (size_t)row * LDP;
    {
      const int which = l >> 5, idx = (l & 31) * 16, off = (l & 3) * 16;
      bf16_t* ptr = pr + which * 512 + idx;
      u32x4 u0 = *(const u32x4*)ptr, u1 = *(const u32x4*)(ptr + 8);
      const unsigned uu[8] = {u0.x, u0.y, u0.z, u0.w, u1.x, u1.y, u1.z, u1.w};
      float v[16];
      float ss = 0.f;
#pragma unroll
      for (int e = 0; e < 8; ++e) {
        v[2 * e] = __uint_as_float(uu[e] << 16);
        v[2 * e + 1] = __uint_as_float(uu[e] & 0xffff0000u);
        ss += v[2 * e] * v[2 * e] + v[2 * e + 1] * v[2 * e + 1];
      }
      ss += __shfl_xor(ss, 1, 64);
      ss += __shfl_xor(ss, 2, 64);
      const float rs = rsqrtf(ss * (1.0f / 64.0f) + EPS);
      const float* gn = (which ? p.in[5] : p.in[4]) + layer * 64 + off;
#pragma unroll
      for (int e = 0; e < 16; ++e) v[e] = v[e] * rs * gn[e];
      if ((l & 3) == 0) {
#pragma unroll
        for (int i = 0; i < 8; ++i) {
          const float invf = expf(-13.122363377404328f * (float)i * 0.125f);
          const float ang = fpos * invf;
          const float cs = cosf(ang), sn = sinf(ang);
          const float x1 = v[i], x2 = v[i + 8];
          v[i] = x1 * cs - x2 * sn;
          v[i + 8] = x2 * cs + x1 * sn;
        }
      }
      if (which == 0) {
#pragma unroll
        for (int e = 0; e < 16; ++e) v[e] *= 0.125f * LOG2E;
      }
      u32x4 o0, o1;
      o0.x = pack2(v[0], v[1]); o0.y = pack2(v[2], v[3]); o0.z = pack2(v[4], v[5]); o0.w = pack2(v[6], v[7]);
      o1.x = pack2(v[8], v[9]); o1.y = pack2(v[10], v[11]); o1.z = pack2(v[12], v[13]); o1.w = pack2(v[14], v[15]);
      bf16_t* qko = (bf16_t*)(p.ws + OFF_QK) + (size_t)row * 1024 + which * 512 + idx;
      *(u32x4*)qko = o0;
      *(u32x4*)(qko + 8) = o1;
    }
    {
      bf16_t* ptr = pr + C_CQ + l * 4;
      u32x2 u = *(const u32x2*)ptr;
      float v0 = __uint_as_float(u.x << 16), v1 = __uint_as_float(u.x & 0xffff0000u);
      float v2 = __uint_as_float(u.y << 16), v3 = __uint_as_float(u.y & 0xffff0000u);
      float ss = wave_sum(v0 * v0 + v1 * v1 + v2 * v2 + v3 * v3);
      const float rs = rsqrtf(ss * (1.0f / 256.0f) + EPS);
      const float* gn = p.in[27] + layer * 256 + l * 4;
      u32x2 o;
      o.x = pack2(v0 * rs * gn[0], v1 * rs * gn[1]);
      o.y = pack2(v2 * rs * gn[2], v3 * rs * gn[3]);
      *(u32x2*)((bf16_t*)(p.ws + OFF_CQ2) + (size_t)row * 384 + l * 4) = o;
    }
    {
      bf16_t* ptr = pr + C_CKV + l * 2;
      unsigned u = *(const unsigned*)ptr;
      float v0 = __uint_as_float(u << 16), v1 = __uint_as_float(u & 0xffff0000u);
      float ss = wave_sum(v0 * v0 + v1 * v1);
      const float rs = rsqrtf(ss * (1.0f / 128.0f) + EPS);
      const float* gn = p.in[29] + layer * 128 + l * 2;
      *(unsigned*)((bf16_t*)(p.ws + OFF_CQ2) + (size_t)row * 384 + 256 + l * 2) = pack2(v0 * rs * gn[0], v1 * rs * gn[1]);
    }
  }
}

__device__ __forceinline__ void conv_item(const Params& p, int layer, int item) {
  const bf16_t* PROJ = (const bf16_t*)(p.ws + OFF_PROJ);
  bf16_t* XC = (bf16_t*)(p.ws + OFF_XC);
  const int chtile = item & 15, tt = (item >> 4) & 31, b = item >> 9;
  const int ch = chtile * 64 + (otid() & 63);
  const int tr0 = otid() >> 6;
  const float* cw = p.in[11] + (size_t)layer * 4 * 1024;
  const float w0 = cw[ch], w1 = cw[1024 + ch], w2 = cw[2048 + ch], w3 = cw[3072 + ch];
  const float bias = p.in[12][layer * 1024 + ch];
  for (int i0 = 0; i0 < 16; i0 += 8) {
    float x0[8], x1[8], x2[8], x3[8];
#pragma unroll
    for (int u = 0; u < 8; ++u) {
      const int t = tt * 64 + (i0 + u) * 4 + tr0;
      const bf16_t* base = PROJ + (size_t)(b * 2048 + t) * LDP + C_XBC + ch;
      x3[u] = bf2f(base[0]);
      x2[u] = (t >= 1) ? bf2f(*(base - LDP)) : 0.f;
      x1[u] = (t >= 2) ? bf2f(*(base - 2 * LDP)) : 0.f;
      x0[u] = (t >= 3) ? bf2f(*(base - 3 * LDP)) : 0.f;
    }
#pragma unroll
    for (int u = 0; u < 8; ++u) {
      const int t = tt * 64 + (i0 + u) * 4 + tr0;
      const float y = bias + w3 * x3[u] + w2 * x2[u] + w1 * x1[u] + w0 * x0[u];
      XC[(size_t)(b * 2048 + t) * 1024 + ch] = f2bf(siluf_(y));
    }
  }
}

__device__ __forceinline__ void dtacum_item(const Params& p, int layer, int item) {
  const bf16_t* PROJ = (const bf16_t*)(p.ws + OFF_PROJ);
  float* DT = (float*)(p.ws + OFF_DT);
  float* AC = (float*)(p.ws + OFF_ACUM);
  const int w = otid() >> 6, l = otid() & 63;
  const int id = item * 4 + w;
  const int h = id & 7, bc = id >> 3;
  const int row0 = bc * 128 + 2 * l;
  const float bias = p.in[13][layer * 8 + h];
  const float A = -expf(p.in[14][layer * 8 + h]);
  float x0 = bf2f(PROJ[(size_t)row0 * LDP + C_DT + h]) + bias;
  float x1 = bf2f(PROJ[(size_t)(row0 + 1) * LDP + C_DT + h]) + bias;
  const float d0 = x0 > 20.f ? x0 : log1pf(expf(x0));
  const float d1 = x1 > 20.f ? x1 : log1pf(expf(x1));
  const float a0 = d0 * A, a1 = d1 * A;
  float s = a0 + a1;
#pragma unroll
  for (int d = 1; d < 64; d <<= 1) {
    const float t = __shfl_up(s, d, 64);
    if (l >= d) s += t;
  }
  DT[(size_t)row0 * 8 + h] = d0;
  DT[(size_t)(row0 + 1) * 8 + h] = d1;
  AC[(size_t)row0 * 8 + h] = s - a1;
  AC[(size_t)(row0 + 1) * 8 + h] = s;
}

__device__ __forceinline__ void s5_e_item(const Params& p, int layer, int item, bf16_t* smem) {
  const bf16_t* PROJ = (const bf16_t*)(p.ws + OFF_PROJ);
  const int grp = item >> 3, mt = item & 7;
  const bf16_t* Em = (const bf16_t*)(p.ws + OFF_EMAT) + (size_t)(layer * 32 + grp) * 16384;
  float* E = (float*)(p.ws + OFF_E);
  f32x4 acc[4][4];
  zero_acc<4>(acc);
  gemm_tile<128, false, false, true>(acc, PROJ + (size_t)mt * 128 * 8 * LDP + C_S5U + grp * 16, 8 * LDP, Em, 128, 128, smem, LDP);
  const int tid = otid(), w = tid >> 6, l = tid & 63, g = l >> 4, c = l & 15, wr = w >> 1, wc = w & 1;
#pragma unroll
  for (int i = 0; i < 4; ++i)
#pragma unroll
    for (int j = 0; j < 4; ++j) {
      const int m = mt * 128 + wr * 64 + i * 16 + g * 4;
      const int n = wc * 64 + j * 16 + c;
      *(f32x4*)(E + ((size_t)(grp * 128 + n)) * NBC + m) = acc[i][j];
    }
}

__device__ __forceinline__ void mla_up_q_tile(const Params& p, int layer, int rt, int ct, bf16_t* smem) {
  const bf16_t* PROJ = (const bf16_t*)(p.ws + OFF_PROJ);
  const bf16_t* W = (const bf16_t*)(p.ws + OFF_WUQT) + (size_t)layer * 768 * 256;
  bf16_t* QM = (bf16_t*)(p.ws + OFF_QM);
  f32x4 acc[4][4];
  zero_acc<4>(acc);
  gemm_tile<128, false, false, false>(acc, (const bf16_t*)(p.ws + OFF_CQ2) + (size_t)rt * 128 * 384, 384, W + (size_t)ct * 128 * 256, 256, 256, smem);
  const int tid = otid(), w = tid >> 6, l = tid & 63, g = l >> 4, c = l & 15, wr = w >> 1, wc = w & 1;
#pragma unroll
  for (int i = 0; i < 4; ++i)
#pragma unroll
    for (int j = 0; j < 4; ++j)
#pragma unroll
      for (int r = 0; r < 4; ++r) {
        const int row = rt * 128 + wr * 64 + i * 16 + g * 4 + r, col = ct * 128 + wc * 64 + j * 16 + c;
        QM[(size_t)row * 768 + col] = f2bf(acc[i][j][r]);
      }
}
__device__ __forceinline__ void mla_up_kv_tile(const Params& p, int layer, int rt, int ct, bf16_t* smem) {
  const bf16_t* PROJ = (const bf16_t*)(p.ws + OFF_PROJ);
  const bf16_t* W = (const bf16_t*)(p.ws + OFF_WUKVT) + (size_t)layer * 1024 * 128;
  bf16_t* KN = (bf16_t*)(p.ws + OFF_KN);
  bf16_t* VTD = (bf16_t*)(p.ws + OFF_VTD);
  f32x4 acc[4][4];
  zero_acc<4>(acc);
  gemm_tile<128, false, false, false>(acc, (const bf16_t*)(p.ws + OFF_CQ2) + (size_t)rt * 128 * 384 + 256, 384, W + (size_t)ct * 128 * 128, 128, 128, smem);
  const int tid = otid(), w = tid >> 6, l = tid & 63, g = l >> 4, c = l & 15, wr = w >> 1, wc = w & 1;
  const int h = ct >> 1;
  if ((ct & 1) == 0) {
#pragma unroll
    for (int i = 0; i < 4; ++i)
#pragma unroll
      for (int j = 0; j < 4; ++j)
#pragma unroll
        for (int r = 0; r < 4; ++r) {
          const int row = rt * 128 + wr * 64 + i * 16 + g * 4 + r, cc = wc * 64 + j * 16 + c;
          KN[(size_t)row * 512 + h * 128 + cc] = f2bf(acc[i][j][r]);
        }
  } else {
#pragma unroll
    for (int i = 0; i < 4; ++i)
#pragma unroll
      for (int j = 0; j < 4; ++j) {
        const int row = rt * 128 + wr * 64 + i * 16 + g * 4, dv = wc * 64 + j * 16 + c;
        const int b = row >> 11, s = row & 2047;
        u32x2 o;
        o.x = pack2(acc[i][j][0], acc[i][j][1]);
        o.y = pack2(acc[i][j][2], acc[i][j][3]);
        *(u32x2*)(VTD + ((size_t)((b * 4 + h) * 128 + dv)) * 2048 + s) = o;
      }
  }
}

__device__ __forceinline__ void mb_states_item(const Params& p, int item, bf16_t* smem) {
  const bf16_t* XC = (const bf16_t*)(p.ws + OFF_XC);
  const float* DT = (const float*)(p.ws + OFF_DT);
  const float* AC = (const float*)(p.ws + OFF_ACUM);
  bf16_t* XS = (bf16_t*)(p.ws + OFF_XS) + (size_t)blockIdx.x * 128 * 64;
  float* ST = (float*)(p.ws + OFF_ST);
  const int h = item & 7, bc = item >> 3;
  const int grp = h >> 2;
  const int row0 = bc * 128;
  const int tid = otid();
  __syncthreads();
  const float alast = AC[(size_t)(row0 + 127) * 8 + h];
  for (int e0 = tid; e0 < 8192; e0 += 2048) {
    float dv[8], av[8];
    bf16_t xv[8];
#pragma unroll
    for (int u = 0; u < 8; ++u) {
      const int e = e0 + u * 256;
      const int row = row0 + (e >> 6);
      dv[u] = DT[(size_t)row * 8 + h];
      av[u] = AC[(size_t)row * 8 + h];
      xv[u] = XC[(size_t)row * 1024 + h * 64 + (e & 63)];
    }
#pragma unroll
    for (int u = 0; u < 8; ++u) XS[e0 + u * 256] = f2bf(bf2f(xv[u]) * dv[u] * __expf(alast - av[u]));
  }
  block_global_handoff();
  f32x4 acc[4][2];
  zero_acc<2>(acc);
  gemm_tile<64, true, true, false>(acc, XC + (size_t)row0 * 1024 + 512 + grp * 128, 1024, XS, 64, 128, smem);
  const int w = tid >> 6, l = tid & 63, g = l >> 4, c = l & 15, wr = w >> 1, wc = w & 1;
#pragma unroll
  for (int i = 0; i < 4; ++i)
#pragma unroll
    for (int j = 0; j < 2; ++j) {
      const int n = wr * 64 + i * 16 + g * 4;
      const int pp = wc * 32 + j * 16 + c;
      *(f32x4*)(ST + ((size_t)(bc * 8 + h) * 64 + pp) * 128 + n) = acc[i][j];
    }
}

__device__ __forceinline__ void s5_carry_item(const Params& p, int layer, int item) {
  const int idx = item * 256 + otid();
  const int b = idx >> 11, grp = (idx >> 6) & 31, pp = idx & 63;
  const float* a8 = (const float*)(p.ws + OFF_A8) + (size_t)((layer * 32 + grp) * 64 + pp) * 2;
  const float ar = a8[0], ai = a8[1];
  const float* er = (const float*)(p.ws + OFF_E) + ((size_t)(grp * 128 + 2 * pp)) * NBC + b * 256;
  const float* ei = er + NBC;
  bf16_t* hro = (bf16_t*)(p.ws + OFF_HIN) + ((size_t)(grp * 128 + 2 * pp)) * NBC + b * 256;
  bf16_t* hio = hro + NBC;
  float hr = 0.f, hi = 0.f;
  for (int c16 = 0; c16 < 16; ++c16) {
    f32x4 vr[4], vi[4];
#pragma unroll
    for (int u = 0; u < 4; ++u) {
      vr[u] = *(const f32x4*)(er + c16 * 16 + u * 4);
      vi[u] = *(const f32x4*)(ei + c16 * 16 + u * 4);
    }
#pragma unroll
    for (int u = 0; u < 4; ++u) {
      float orr[4], oii[4];
#pragma unroll
      for (int k = 0; k < 4; ++k) {
        orr[k] = hr; oii[k] = hi;
        const float nr = ar * hr - ai * hi + vr[u][k];
        const float ni = ar * hi + ai * hr + vi[u][k];
        hr = nr; hi = ni;
      }
      u32x2 o0, o1;
      o0.x = pack2(orr[0], orr[1]); o0.y = pack2(orr[2], orr[3]);
      o1.x = pack2(oii[0], oii[1]); o1.y = pack2(oii[2], oii[3]);
      *(u32x2*)(hro + c16 * 16 + u * 4) = o0;
      *(u32x2*)(hio + c16 * 16 + u * 4) = o1;
    }
  }
}

__device__ __forceinline__ void mlapost_item(const Params& p, int layer, int round, int item) {
  const bf16_t* PROJ = (const bf16_t*)(p.ws + OFF_PROJ);
  bf16_t* QM = (bf16_t*)(p.ws + OFF_QM);
  bf16_t* KM = (bf16_t*)(p.ws + OFF_KM);
  const bf16_t* KN = (const bf16_t*)(p.ws + OFF_KN);
  const int* pos = (const int*)p.in[1];
  const int w = otid() >> 6, l = otid() & 63;
  const float* qn = p.in[31] + layer * 192;
  const float* kn = p.in[32] + layer * 192;
  const float q0 = qn[l], q1 = qn[64 + l], q2 = qn[128 + l];
  const float k0 = kn[l], k1 = kn[64 + l], k2 = kn[128 + l];
  const float invf = expf(-13.122363377404328f * (float)(l & 31) * (1.0f / 32.0f));
  const float qscale = 0.07216878364870322f * LOG2E;
  for (int tt = 0; tt < 4; ++tt) {
    const int row = item * 16 + w * 4 + tt;
    const float ang = (float)pos[round * TR + row] * invf;
    const float cs = cosf(ang), sn = sinf(ang);
    const float kr = bf2f(PROJ[(size_t)row * LDP + C_KR + l]);
#pragma unroll
    for (int h = 0; h < 4; ++h) {
      {
        bf16_t* qp = QM + (size_t)row * 768 + h * 192;
        float e0 = bf2f(qp[l]), e1 = bf2f(qp[64 + l]), e2 = bf2f(qp[128 + l]);
        const float ss = wave_sum(e0 * e0 + e1 * e1 + e2 * e2);
        const float rs = rsqrtf(ss * (1.0f / 192.0f) + EPS);
        e0 *= rs * q0; e1 *= rs * q1; e2 *= rs * q2;
        const float ot = __shfl_xor(e2, 32, 64);
        e2 = (l < 32) ? (e2 * cs - ot * sn) : (e2 * cs + ot * sn);
        bf16_t* qo = (bf16_t*)(p.ws + OFF_QM2) + (size_t)row * 768 + h * 192;
        qo[l] = f2bf(e0 * qscale); qo[64 + l] = f2bf(e1 * qscale); qo[128 + l] = f2bf(e2 * qscale);
      }
      {
        const bf16_t* kp = KN + (size_t)row * 512 + h * 128;
        float e0 = bf2f(kp[l]), e1 = bf2f(kp[64 + l]), e2 = kr;
        const float ss = wave_sum(e0 * e0 + e1 * e1 + e2 * e2);
        const float rs = rsqrtf(ss * (1.0f / 192.0f) + EPS);
        e0 *= rs * k0; e1 *= rs * k1; e2 *= rs * k2;
        const float ot = __shfl_xor(e2, 32, 64);
        e2 = (l < 32) ? (e2 * cs - ot * sn) : (e2 * cs + ot * sn);
        bf16_t* ko = KM + (size_t)row * 768 + h * 192;
        ko[l] = f2bf(e0); ko[64 + l] = f2bf(e1); ko[128 + l] = f2bf(e2);
      }
    }
  }
}

__device__ __forceinline__ void mb_scan_item(const Params& p, int item) {
  const int idx = item * 256 + otid();
  const int b = idx >> 16, h = (idx >> 13) & 7, pn = idx & 8191;
  const float* ST = (const float*)(p.ws + OFF_ST);
  const float* AC = (const float*)(p.ws + OFF_ACUM);
  bf16_t* SIN = (bf16_t*)(p.ws + OFF_SIN);
  float cur = 0.f;
  float alv[16], stv[16];
#pragma unroll
  for (int c = 0; c < 16; ++c) {
    alv[c] = AC[(size_t)(b * 2048 + c * 128 + 127) * 8 + h];
    stv[c] = ST[((size_t)((b * 16 + c) * 8 + h)) * 8192 + pn];
  }
#pragma unroll
  for (int c = 0; c < 16; ++c) {
    SIN[((size_t)((b * 16 + c) * 8 + h)) * 8192 + pn] = f2bf(cur);
    cur = __expf(alv[c]) * cur + stv[c];
  }
}

__device__ __forceinline__ void s5_y_item(const Params& p, int layer, int item, bf16_t* smem) {
  const bf16_t* PROJ = (const bf16_t*)(p.ws + OFF_PROJ);
  const int grp = item >> 3, mt = item & 7;
  const bf16_t* Km = (const bf16_t*)(p.ws + OFF_KMAT) + (size_t)(layer * 32 + grp) * 16384;
  const bf16_t* Fm = (const bf16_t*)(p.ws + OFF_FMAT) + (size_t)(layer * 32 + grp) * 16384;
  const bf16_t* HIN = (const bf16_t*)(p.ws + OFF_HIN) + (size_t)grp * 128 * NBC + mt * 128;
  bf16_t* YG = (bf16_t*)(p.ws + OFF_YG);
  f32x4 acc[4][4];
  zero_acc<4>(acc);
  gemm_tile<128, false, false, true>(acc, PROJ + (size_t)mt * 128 * 8 * LDP + C_S5U + grp * 16, 8 * LDP, Km, 128, 128, smem, LDP);
  gemm_tile<128, true, false, false>(acc, HIN, NBC, Fm, 128, 128, smem);
  const int tid = otid(), w = tid >> 6, l = tid & 63, g = l >> 4, c = l & 15, wr = w >> 1, wc = w & 1;
  const float* dsk = p.in[24] + layer * 512;
#pragma unroll
  for (int i = 0; i < 4; ++i)
#pragma unroll
    for (int j = 0; j < 4; ++j) {
      const int n = wc * 64 + j * 16 + c;
      const int tq = n >> 4, co = n & 15;
      const int ch = grp * 16 + co;
      const float dd = dsk[ch];
#pragma unroll
      for (int r = 0; r < 4; ++r) {
        const int m = mt * 128 + wr * 64 + i * 16 + g * 4 + r;
        const int row = m * 8 + tq;
        const float u = bf2f(PROJ[(size_t)row * LDP + C_S5U + ch]);
        const float y = acc[i][j][r] + dd * u;
        YG[(size_t)row * 512 + ch] = f2bf(gelu_tanh(y));
      }
    }
}

template <int DK, int NM>
__device__ __forceinline__ void attn_core(const bf16_t* __restrict__ Qb, long ldq, const bf16_t* __restrict__ Kb, long ldk,
                                          const bf16_t* __restrict__ Vt, int qb, bf16_t* smem, f32x4 (&O)[NM][8], float (&lsum)[NM][4]) {
  constexpr int KST = DK + 8;
  constexpr int KCH = NM * 64 * DK / 8 / 256;
  constexpr int CPM = 64 * DK / 8;
  constexpr int CPRK = DK / 8;
  bf16_t* sK = smem;
  bf16_t* sV = sK + NM * 64 * KST;
  bf16_t* sP = sV + 128 * 72;
  const int tid = otid(), w = tid >> 6, l = tid & 63, g = l >> 4, c = l & 15;
  bf16x8 qf[NM][DK / 32];
  {
    const long qrow = (long)qb * 64 + w * 16 + c;
#pragma unroll
    for (int m = 0; m < NM; ++m)
#pragma unroll
      for (int ks = 0; ks < DK / 32; ++ks) qf[m][ks] = *(const bf16x8*)(Qb + qrow * ldq + m * DK + ks * 32 + g * 8);
  }
  float mrow[NM][4];
#pragma unroll
  for (int m = 0; m < NM; ++m) {
#pragma unroll
    for (int r = 0; r < 4; ++r) { mrow[m][r] = -INFINITY; lsum[m][r] = 0.f; }
#pragma unroll
    for (int nt = 0; nt < 8; ++nt) O[m][nt] = (f32x4){0.f, 0.f, 0.f, 0.f};
  }
  u32x4 kr[KCH], vr[4];
  auto gloadK = [&](int kt) {
#pragma unroll
    for (int i = 0; i < KCH; ++i) {
      const int ch = tid + i * 256;
      const int m = ch / CPM, cc = ch % CPM;
      const int key = cc / CPRK, d0 = (cc % CPRK) * 8;
      kr[i] = *(const u32x4*)(Kb + (long)(kt * 64 + key) * ldk + m * DK + d0);
    }
  };
  auto gloadV = [&](int kt) {
#pragma unroll
    for (int i = 0; i < 4; ++i) {
      const int ch = tid + i * 256;
      const int dvr = ch >> 3, kc = (ch & 7) * 8;
      vr[i] = *(const u32x4*)(Vt + (long)dvr * 2048 + kt * 64 + kc);
    }
  };
  gloadK(0);
  gloadV(0);
  for (int kt = 0; kt <= qb; ++kt) {
    __syncthreads();
#pragma unroll
    for (int i = 0; i < KCH; ++i) {
      const int ch = tid + i * 256;
      const int m = ch / CPM, cc = ch % CPM;
      const int key = cc / CPRK, d0 = (cc % CPRK) * 8;
      *(u32x4*)(sK + (m * 64 + key) * KST + d0) = kr[i];
    }
#pragma unroll
    for (int i = 0; i < 4; ++i) {
      const int ch = tid + i * 256;
      const int dvr = ch >> 3, kc = (ch & 7) * 8;
      *(u32x4*)(sV + dvr * 72 + kc) = vr[i];
    }
    __syncthreads();
    if (kt < qb) gloadK(kt + 1);
#pragma unroll
    for (int m = 0; m < NM; ++m) {
      f32x4 S[4];
#pragma unroll
      for (int nt = 0; nt < 4; ++nt) {
        S[nt] = (f32x4){0.f, 0.f, 0.f, 0.f};
#pragma unroll
        for (int ks = 0; ks < DK / 32; ++ks) {
          const bf16x8 kf = *(const bf16x8*)(sK + (m * 64 + nt * 16 + c) * KST + ks * 32 + g * 8);
          S[nt] = __builtin_amdgcn_mfma_f32_16x16x32_bf16(qf[m][ks], kf, S[nt], 0, 0, 0);
        }
        MEMBAR();
      }
      if (kt == qb) {
#pragma unroll
        for (int nt = 0; nt < 4; ++nt)
#pragma unroll
          for (int r = 0; r < 4; ++r)
            if (nt * 16 + c > w * 16 + g * 4 + r) S[nt][r] = -INFINITY;
      }
      bf16_t* pw = sP + (size_t)((w * NM + m) * 16) * 72;
#pragma unroll
      for (int r = 0; r < 4; ++r) {
        float mx = fmaxf(fmaxf(S[0][r], S[1][r]), fmaxf(S[2][r], S[3][r]));
        mx = fmaxf(mx, __shfl_xor(mx, 1, 64));
        mx = fmaxf(mx, __shfl_xor(mx, 2, 64));
        mx = fmaxf(mx, __shfl_xor(mx, 4, 64));
        mx = fmaxf(mx, __shfl_xor(mx, 8, 64));
        const float mnew = fmaxf(mrow[m][r], mx);
        const float sc = __builtin_amdgcn_exp2f(mrow[m][r] - mnew);
        mrow[m][r] = mnew;
        float ps = 0.f;
#pragma unroll
        for (int nt = 0; nt < 4; ++nt) {
          const float pv = __builtin_amdgcn_exp2f(S[nt][r] - mnew);
          ps += pv;
          pw[(g * 4 + r) * 72 + nt * 16 + c] = f2bf(pv);
        }
        ps += __shfl_xor(ps, 1, 64);
        ps += __shfl_xor(ps, 2, 64);
        ps += __shfl_xor(ps, 4, 64);
        ps += __shfl_xor(ps, 8, 64);
        lsum[m][r] = lsum[m][r] * sc + ps;
#pragma unroll
        for (int nt = 0; nt < 8; ++nt) O[m][nt][r] *= sc;
      }
    }
    __syncthreads();
    if (kt < qb) gloadV(kt + 1);
#pragma unroll
    for (int m = 0; m < NM; ++m) {
      const bf16_t* pw = sP + (size_t)((w * NM + m) * 16) * 72;
#pragma unroll
      for (int ks = 0; ks < 2; ++ks) {
        const bf16x8 pf = *(const bf16x8*)(pw + c * 72 + ks * 32 + g * 8);
#pragma unroll
        for (int nt = 0; nt < 8; ++nt) {
          const bf16x8 vf = *(const bf16x8*)(sV + (nt * 16 + c) * 72 + ks * 32 + g * 8);
          O[m][nt] = __builtin_amdgcn_mfma_f32_16x16x32_bf16(pf, vf, O[m][nt], 0, 0, 0);
        }
        MEMBAR();
      }
    }
  }
}

__device__ __forceinline__ void da_attn_item(const Params& p, int layer, int bh, int qb, bf16_t* smem, bool dry = false) {
  bf16_t* PROJ = (bf16_t*)(p.ws + OFF_PROJ);
  const bf16_t* VTA = (const bf16_t*)(p.ws + OFF_VTA);
  const bf16_t* QKB = (const bf16_t*)(p.ws + OFF_QK);
  const int b = bh >> 2, h = bh & 3;
  f32x4 O[2][8];
  float ls[2][4];
  {
    f32x4 O1[1][8];
    float l1[1][4];
#pragma unroll 1
    for (int m = 0; m < 2; ++m) {
      attn_core<64, 1>(QKB + (size_t)b * 2048 * 1024 + h * 128 + m * 64, 1024, QKB + (size_t)b * 2048 * 1024 + 512 + h * 128 + m * 64, 1024,
                       VTA + (size_t)(b * 4 + h) * 128 * 2048, qb, smem, O1, l1);
      if (m == 0) {
#pragma unroll
        for (int nt = 0; nt < 8; ++nt) O[0][nt] = O1[0][nt];
#pragma unroll
        for (int r = 0; r < 4; ++r) ls[0][r] = l1[0][r];
      } else {
#pragma unroll
        for (int nt = 0; nt < 8; ++nt) O[1][nt] = O1[0][nt];
#pragma unroll
        for (int r = 0; r < 4; ++r) ls[1][r] = l1[0][r];
      }
    }
  }
  const int tid = otid(), w = tid >> 6, l = tid & 63, g = l >> 4, c = l & 15;
  const float lam = ((const float*)(p.ws + OFF_LAM))[layer];
  const float linit = 0.8f - 0.6f * expf(-0.3f * (float)layer);
  const float* sg = p.in[10] + layer * 128;
#pragma unroll
  for (int r = 0; r < 4; ++r) {
    const float i0 = 1.0f / ls[0][r], i1 = lam / ls[1][r];
    float o[8];
    float ss = 0.f;
#pragma unroll
    for (int nt = 0; nt < 8; ++nt) {
      o[nt] = O[0][nt][r] * i0 - O[1][nt][r] * i1;
      ss += o[nt] * o[nt];
    }
    ss += __shfl_xor(ss, 1, 64);
    ss += __shfl_xor(ss, 2, 64);
    ss += __shfl_xor(ss, 4, 64);
    ss += __shfl_xor(ss, 8, 64);
    const float rs = rsqrtf(ss * (1.0f / 128.0f) + EPS) * (1.0f - linit);
    const size_t row = (size_t)b * 2048 + qb * 64 + w * 16 + g * 4 + r;
#pragma unroll
    for (int nt = 0; nt < 8; ++nt) {
      const int dv = nt * 16 + c;
      bf16_t* gp = PROJ + row * LDP + C_DAG + h * 128 + dv;
      const float gt = bf2f(*gp);
      if (!dry) *gp = f2bf(o[nt] * rs * sg[dv] * siluf_(gt));
    }
  }
}

__device__ __forceinline__ void mla_attn_item(const Params& p, int bh, int qb, bf16_t* smem, bool dry = false) {
  bf16_t* PROJ = (bf16_t*)(p.ws + OFF_PROJ);
  const bf16_t* QM = (const bf16_t*)(p.ws + OFF_QM2);
  const bf16_t* KM = (const bf16_t*)(p.ws + OFF_KM);
  const bf16_t* VTD = (const bf16_t*)(p.ws + OFF_VTD);
  const int b = bh >> 2, h = bh & 3;
  f32x4 O[1][8];
  float ls[1][4];
  attn_core<192, 1>(QM + (size_t)b * 2048 * 768 + h * 192, 768, KM + (size_t)b * 2048 * 768 + h * 192, 768,
                    VTD + (size_t)(b * 4 + h) * 128 * 2048, qb, smem, O, ls);
  const int tid = otid(), w = tid >> 6, l = tid & 63, g = l >> 4, c = l & 15;
#pragma unroll
  for (int r = 0; r < 4; ++r) {
    const float i0 = 1.0f / ls[0][r];
    const size_t row = (size_t)b * 2048 + qb * 64 + w * 16 + g * 4 + r;
#pragma unroll
    for (int nt = 0; nt < 8; ++nt) {
      const int dv = nt * 16 + c;
      bf16_t* gp = PROJ + row * LDP + C_MLG + h * 128 + dv;
      const float gt = bf2f(*gp);
      if (!dry) *gp = f2bf(O[0][nt][r] * i0 * siluf_(gt));
    }
  }
}

__device__ __forceinline__ void mb_out_item(const Params& p, int layer, int item, bf16_t* smem) {
  bf16_t* PROJ = (bf16_t*)(p.ws + OFF_PROJ);
  const bf16_t* XC = (const bf16_t*)(p.ws + OFF_XC);
  const float* DT = (const float*)(p.ws + OFF_DT);
  const float* AC = (const float*)(p.ws + OFF_ACUM);
  const bf16_t* SIN = (const bf16_t*)(p.ws + OFF_SIN);
  bf16_t* MS = (bf16_t*)(p.ws + OFF_MS) + (size_t)blockIdx.x * 128 * 128;
  float* rowss = (float*)((unsigned char*)smem + 73728);
  const int grp = item & 1, bc = item >> 1;
  const int row0 = bc * 128;
  __syncthreads();
  const bf16_t* Cp = XC + (size_t)row0 * 1024 + 768 + grp * 128;
  const bf16_t* Bp = XC + (size_t)row0 * 1024 + 512 + grp * 128;
#pragma unroll 1
  for (int r4 = 0; r4 < 4; ++r4) {
    const int h = grp * 4 + r4;
    const int tid = otid(), w = tid >> 6, l = tid & 63, g = l >> 4, c = l & 15, wr = w >> 1, wc = w & 1;
    {
      f32x4 cb[4][4];
      zero_acc<4>(cb);
      gemm_tile<128, false, false, false>(cb, Cp, 1024, Bp, 1024, 128, smem);
      float acs[4], dts[4];
#pragma unroll
      for (int j = 0; j < 4; ++j) {
        const int s = wc * 64 + j * 16 + c;
        acs[j] = AC[(size_t)(row0 + s) * 8 + h];
        dts[j] = DT[(size_t)(row0 + s) * 8 + h];
      }
#pragma unroll
      for (int i = 0; i < 4; ++i)
#pragma unroll
        for (int r = 0; r < 4; ++r) {
          const int lr = wr * 64 + i * 16 + g * 4 + r;
          const float acl = AC[(size_t)(row0 + lr) * 8 + h];
#pragma unroll
          for (int j = 0; j < 4; ++j) {
            const int s = wc * 64 + j * 16 + c;
            const float v = (s <= lr) ? cb[i][j][r] * __expf(acl - acs[j]) * dts[j] : 0.f;
            MS[lr * 128 + s] = f2bf(v);
          }
          MEMBAR();
        }
    }
    block_global_handoff();
    f32x4 ad[4][2], ao[4][2];
    zero_acc<2>(ad);
    zero_acc<2>(ao);
    gemm_tile<64, false, true, false>(ad, MS, 128, XC + (size_t)row0 * 1024 + h * 64, 1024, 128, smem);
    gemm_tile<64, false, false, false>(ao, Cp, 1024, SIN + ((size_t)(bc * 8 + h)) * 8192, 128, 128, smem);
    const float dsk = p.in[15][layer * 8 + h];
#pragma unroll
    for (int i = 0; i < 4; ++i)
#pragma unroll
      for (int r = 0; r < 4; ++r) {
        const int lr = wr * 64 + i * 16 + g * 4 + r;
        const size_t row = (size_t)row0 + lr;
        const float ea = __expf(AC[row * 8 + h]);
        float ssq = 0.f;
#pragma unroll
        for (int j = 0; j < 2; ++j) {
          const int ch = h * 64 + wc * 32 + j * 16 + c;
          const float xv = bf2f(XC[row * 1024 + ch]);
          bf16_t* zp = PROJ + row * LDP + C_MBZ + ch;
          const float z = bf2f(*zp);
          float y = ad[i][j][r] + ea * ao[i][j][r] + dsk * xv;
          y *= siluf_(z);
          ssq += y * y;
          *zp = f2bf(y);
        }
        ssq += __shfl_xor(ssq, 1, 64);
        ssq += __shfl_xor(ssq, 2, 64);
        ssq += __shfl_xor(ssq, 4, 64);
        ssq += __shfl_xor(ssq, 8, 64);
        if (c == 0) rowss[(r4 * 2 + wc) * 128 + lr] = ssq;
        MEMBAR();
      }
  }
  block_global_handoff();
  const float* ng = p.in[16] + layer * 512 + grp * 256;
  {
    const int cc = otid();
    const float gcc = ng[cc];
    for (int l0 = 0; l0 < 128; l0 += 16) {
      bf16_t vals[16];
#pragma unroll
      for (int u = 0; u < 16; ++u) vals[u] = PROJ[(size_t)(row0 + l0 + u) * LDP + C_MBZ + grp * 256 + cc];
#pragma unroll
      for (int u = 0; u < 16; ++u) {
        const int lr = l0 + u;
        float tot = 0.f;
#pragma unroll
        for (int q = 0; q < 8; ++q) tot += rowss[q * 128 + lr];
        PROJ[(size_t)(row0 + lr) * LDP + C_MBZ + grp * 256 + cc] = f2bf(bf2f(vals[u]) * rsqrtf(tot * (1.0f / 256.0f) + EPS) * gcc);
      }
    }
  }
}

__device__ __forceinline__ void s5_glu_tile(const Params& p, int layer, int rt, int ct, bf16_t* smem) {
  bf16_t* PROJ = (bf16_t*)(p.ws + OFF_PROJ);
  const bf16_t* YG = (const bf16_t*)(p.ws + OFF_YG);
  const bf16_t* W = (const bf16_t*)(p.ws + OFF_WGLUT) + (size_t)layer * 512 * 512;
  f32x4 acc[4][4];
  zero_acc<4>(acc);
  gemm_tile<128, false, false, false>(acc, YG + (size_t)rt * 128 * 512, 512, W + (size_t)ct * 128 * 512, 512, 512, smem);
  const int tid = otid(), w = tid >> 6, l = tid & 63, g = l >> 4, c = l & 15, wr = w >> 1, wc = w & 1;
  const float* bg = p.in[26] + layer * 512;
#pragma unroll
  for (int i = 0; i < 4; ++i)
#pragma unroll
    for (int j = 0; j < 4; ++j) {
      const int col = ct * 128 + wc * 64 + j * 16 + c;
      const float bb = bg[col];
#pragma unroll
      for (int r = 0; r < 4; ++r) {
        const size_t row = (size_t)rt * 128 + wr * 64 + i * 16 + g * 4 + r;
        const float yv = bf2f(YG[row * 512 + col]);
        bf16_t* gp = PROJ + row * LDP + C_S5G + col;
        const float gt = bf2f(*gp);
        *gp = f2bf(yv * sigmoidf_(acc[i][j][r] + bb) * siluf_(gt));
      }
    }
}

__device__ __forceinline__ void merge_tile(const Params& p, int layer, int rt, int ct, bf16_t* smem) {
  const bf16_t* PROJ = (const bf16_t*)(p.ws + OFF_PROJ);
  bf16_t* MG = (bf16_t*)(p.ws + OFF_MERGED);
  f32x4 macc[4][2];
  zero_acc<2>(macc);
  const int tid = otid(), w = tid >> 6, l = tid & 63, g = l >> 4, c = l & 15, wr = w >> 1, wc = w & 1;
  for (int n = 0; n < 4; ++n) {
    const int ycol = (n == 0) ? C_DAG : (n == 1) ? C_MBZ : (n == 2) ? C_S5G : C_MLG;
    const bf16_t* W = (const bf16_t*)(p.ws + OFF_WBRT) + (size_t)(layer * 4 + n) * 1024 * 512;
    f32x4 acc[4][2];
    zero_acc<2>(acc);
    gemm_tile<64, false, false, false>(acc, PROJ + (size_t)rt * 128 * LDP + ycol, LDP, W + (size_t)ct * 64 * 512, 512, 512, smem);
#pragma unroll
    for (int i = 0; i < 4; ++i) {
#pragma unroll
      for (int r = 0; r < 4; ++r) {
        const size_t row = (size_t)rt * 128 + wr * 64 + i * 16 + g * 4 + r;
        const bf16_t* gp = PROJ + row * LDP + C_GATE + n * 1024 + ct * 64 + wc * 32 + c;
#pragma unroll
        for (int j = 0; j < 2; ++j) macc[i][j][r] += bf2f(gp[j * 16]) * acc[i][j][r];
      }
      MEMBAR();
    }
  }
#pragma unroll
  for (int i = 0; i < 4; ++i) {
#pragma unroll
    for (int r = 0; r < 4; ++r) {
      const size_t row = (size_t)rt * 128 + wr * 64 + i * 16 + g * 4 + r;
      bf16_t* op = MG + row * 1024 + ct * 64 + wc * 32 + c;
#pragma unroll
      for (int j = 0; j < 2; ++j) op[j * 16] = f2bf(macc[i][j][r]);
    }
    MEMBAR();
  }
}

__device__ __forceinline__ void out_tile(const Params& p, int layer, const float* xo, float* xn, int rt, int ct, bf16_t* smem) {
  const bf16_t* MG = (const bf16_t*)(p.ws + OFF_MERGED);
  const bf16_t* W = (const bf16_t*)(p.ws + OFF_WOUTT) + (size_t)layer * 1024 * 1024;
  f32x4 acc[4][4];
  zero_acc<4>(acc);
  gemm_tile<128, false, false, false>(acc, MG + (size_t)rt * 128 * 1024, 1024, W + (size_t)ct * 128 * 1024, 1024, 1024, smem);
  const int tid = otid(), w = tid >> 6, l = tid & 63, g = l >> 4, c = l & 15, wr = w >> 1, wc = w & 1;
#pragma unroll
  for (int i = 0; i < 4; ++i)
#pragma unroll
    for (int j = 0; j < 4; ++j) {
      const int col = ct * 128 + wc * 64 + j * 16 + c;
#pragma unroll
      for (int r = 0; r < 4; ++r) {
        const size_t row = (size_t)rt * 128 + wr * 64 + i * 16 + g * 4 + r;
        xn[row * 1024 + col] = xo[row * 1024 + col] + acc[i][j][r];
      }
    }
}

struct Bx { unsigned xcd, nloc, nx, hier; };
__device__ __forceinline__ unsigned xcc_id() { return (unsigned)__builtin_amdgcn_s_getreg((3 << 11) | 20) & 0x7u; }
__device__ __forceinline__ void gsync_flat(unsigned* bar) {
  asm volatile("s_waitcnt vmcnt(0)" ::: "memory");
  __syncthreads();
  if (otid() == 0) {
    unsigned long long* w = (unsigned long long*)bar;
    __builtin_amdgcn_fence(__ATOMIC_RELEASE, "agent");
    asm volatile("s_waitcnt vmcnt(0)" ::: "memory");
    const unsigned long long old = __hip_atomic_fetch_add(w, 1ull, __ATOMIC_RELAXED, __HIP_MEMORY_SCOPE_AGENT);
    const unsigned G = gridDim.x;
    if ((unsigned)(old & 0xffffffffull) == G - 1) {
      __hip_atomic_fetch_add(w, (1ull << 32) - (unsigned long long)G, __ATOMIC_RELAXED, __HIP_MEMORY_SCOPE_AGENT);
    } else {
      const unsigned g0 = (unsigned)(old >> 32);
      while ((unsigned)(__hip_atomic_load(w, __ATOMIC_RELAXED, __HIP_MEMORY_SCOPE_AGENT) >> 32) == g0) __builtin_amdgcn_s_sleep(1);
    }
    __builtin_amdgcn_fence(__ATOMIC_ACQUIRE, "agent");
    asm volatile("s_waitcnt vmcnt(0)" ::: "memory");
  }
  __syncthreads();
}
__device__ __forceinline__ void gsync(cg::grid_group& grid, unsigned* bar, unsigned& epoch, const volatile unsigned* bxs) {
  asm volatile("s_waitcnt vmcnt(0)" ::: "memory");
  __syncthreads();
  if (otid() == 0) {
    const unsigned xcd = bxs[0], nloc = bxs[1], nx = bxs[2];
    unsigned long long* L = (unsigned long long*)((unsigned char*)bar + 3072 + 256 * xcd);
    unsigned long long* T = (unsigned long long*)((unsigned char*)bar + 5120);
    const unsigned long long old = __hip_atomic_fetch_add(L, 1ull, __ATOMIC_RELAXED, __HIP_MEMORY_SCOPE_AGENT);
    if ((unsigned)(old & 0xffffffffull) == nloc - 1) {
      __builtin_amdgcn_fence(__ATOMIC_RELEASE, "agent");
      asm volatile("s_waitcnt vmcnt(0)" ::: "memory");
      const unsigned long long oldt = __hip_atomic_fetch_add(T, 1ull, __ATOMIC_RELAXED, __HIP_MEMORY_SCOPE_AGENT);
      if ((unsigned)(oldt & 0xffffffffull) == nx - 1) {
        __hip_atomic_fetch_add(T, (1ull << 32) - (unsigned long long)nx, __ATOMIC_RELAXED, __HIP_MEMORY_SCOPE_AGENT);
      } else {
        const unsigned gt = (unsigned)(oldt >> 32);
        while ((unsigned)(__hip_atomic_load(T, __ATOMIC_RELAXED, __HIP_MEMORY_SCOPE_AGENT) >> 32) == gt) __builtin_amdgcn_s_sleep(1);
      }
      __hip_atomic_fetch_add(L, (1ull << 32) - (unsigned long long)nloc, __ATOMIC_RELAXED, __HIP_MEMORY_SCOPE_AGENT);
    } else {
      const unsigned g0 = (unsigned)(old >> 32);
      while ((unsigned)(__hip_atomic_load(L, __ATOMIC_RELAXED, __HIP_MEMORY_SCOPE_AGENT) >> 32) == g0) __builtin_amdgcn_s_sleep(1);
    }
    __builtin_amdgcn_fence(__ATOMIC_ACQUIRE, "agent");
    asm volatile("s_waitcnt vmcnt(0)" ::: "memory");
  }
  __syncthreads();
}

#ifdef SELFCHECK
__device__ __forceinline__ void cksum(const void* ptr, size_t bytes, unsigned long long* slot) {
  const u32x4* q = (const u32x4*)ptr;
  const size_t n = bytes / 16;
  unsigned long long s = 0;
  for (size_t i = (size_t)blockIdx.x * 256 + otid(); i < n; i += (size_t)gridDim.x * 256) {
    const u32x4 v = q[i];
    s += (unsigned long long)v.x + 3ull * v.y + 5ull * v.z + 7ull * v.w;
  }
  unsigned lo = (unsigned)s, hi = (unsigned)(s >> 32);
  unsigned long long t = s;
#pragma unroll
  for (int d = 32; d >= 1; d >>= 1) {
    const unsigned l2 = __shfl_xor((unsigned)t, d, 64), h2 = __shfl_xor((unsigned)(t >> 32), d, 64);
    t += ((unsigned long long)h2 << 32) | l2;
  }
  (void)lo; (void)hi;
  if ((otid() & 63) == 0) atomicAdd(slot, t);
}
#define CK(ptr, bytes) cksum((ptr), (bytes), slots + slot)
#else
#define CK(ptr, bytes) do {} while (0)
#endif

__device__ __forceinline__ void cksum_acc(const void* ptr, size_t bytes, unsigned long long& s) {
  const u32x4* q = (const u32x4*)ptr;
  const size_t n = bytes / 16;
  for (size_t i = ((size_t)blockIdx.x * 256 + otid()) * 64; i < n; i += (size_t)gridDim.x * 256 * 64) {
    const u32x4 v = __builtin_nontemporal_load(q + i);
    s += (unsigned long long)v.x + 3ull * v.y + 5ull * v.z + 7ull * v.w;
  }
}
__device__ __forceinline__ void cksum_commit(unsigned long long t, unsigned long long* slot) {
#pragma unroll
  for (int d = 32; d >= 1; d >>= 1) {
    const unsigned l2 = __shfl_xor((unsigned)t, d, 64), h2 = __shfl_xor((unsigned)(t >> 32), d, 64);
    t += ((unsigned long long)h2 << 32) | l2;
  }
  if ((otid() & 63) == 0) atomicAdd(slot, t);
}

__global__ void __launch_bounds__(256, 2) fwd_megakernel(Params p) {
  cg::grid_group grid = cg::this_grid();
  __shared__ __attribute__((aligned(16))) unsigned char smem_raw[SMEM_BYTES];
  bf16_t* smem = (bf16_t*)smem_raw;
  float* smf = (float*)smem_raw;
  const int G = gridDim.x, bid = blockIdx.x;
  unsigned* bar = (unsigned*)(p.ws + OFF_BAR);
  unsigned epoch = 0;
  volatile unsigned* bxs = (volatile unsigned*)(smem_raw + 73728 + 4096);
  if (otid() == 0) {
    const unsigned xc = xcc_id();
    bxs[0] = xc; bxs[1] = 0u; bxs[2] = 0u; bxs[3] = 0u;
    __hip_atomic_fetch_add((unsigned*)((unsigned char*)bar + 2048 + 128 * xc), 1u, __ATOMIC_RELAXED, __HIP_MEMORY_SCOPE_AGENT);
  }
  __syncthreads();
#ifdef START_DELAY_US
  {
    const unsigned long long t0 = __builtin_amdgcn_s_memrealtime();
    while (__builtin_amdgcn_s_memrealtime() - t0 < (unsigned long long)START_DELAY_US * 100ull) __builtin_amdgcn_s_sleep(20);
  }
#endif
  grid.sync();
#ifdef WCHECK
  unsigned wseen = 0;
  if (bid == 0 && otid() == 0) wseen = __hip_atomic_load(bar + 32, __ATOMIC_RELAXED, __HIP_MEMORY_SCOPE_AGENT);
#endif

#ifdef SELFCHECK
  unsigned long long* slots_base = (unsigned long long*)(p.ws + OFF_BAR + 256);
  if (bid == 0) for (int k = otid(); k < 768; k += 256) __hip_atomic_store(slots_base + k, 0ull, __ATOMIC_RELAXED, __HIP_MEMORY_SCOPE_AGENT);
  for (int run = 0; run < 3; ++run) {
  unsigned long long* slots = slots_base + run * 256;
  int slot = 0;
#endif
  {
    unsigned long long* sslots = (unsigned long long*)(p.ws + OFF_BAR + 1024);
    unsigned long long prev = 0;
    for (int iter = 0; iter < 64; ++iter) {
      unsigned long long s = 0;
      cksum_acc(p.out, (size_t)BATCH * SEQ * 1024 * 4, s);
      cksum_acc(p.ws, OFF_BAR, s);
      cksum_commit(s, sslots + iter);
      gsync_flat(bar);
      const unsigned long long c = __hip_atomic_load(sslots + iter, __ATOMIC_RELAXED, __HIP_MEMORY_SCOPE_AGENT);
      if (iter > 0 && c == prev) break;
      prev = c;
    }
  }
  {
    if (otid() == 0) {
      unsigned nl = 0, nxx = 0;
      const unsigned xc = bxs[0];
      for (int j = 0; j < 8; ++j) {
        const unsigned cj = __hip_atomic_load((unsigned*)((unsigned char*)bar + 2048 + 128 * j), __ATOMIC_RELAXED, __HIP_MEMORY_SCOPE_AGENT);
        nxx += (cj > 0u) ? 1u : 0u;
        nl = ((unsigned)j == xc) ? cj : nl;
      }
      bxs[1] = nl; bxs[2] = nxx; bxs[3] = 1u;
    }
    __syncthreads();
  }
  phase_prep(p, smf);
  gsync(grid, bar, epoch, bxs);
  phase_prep(p, smf);
#ifdef SELF_POISON
  {
    u32x4* q = (u32x4*)(p.ws + OFF_H);
    const size_t n16 = (WS_TOTAL - OFF_H) / 16;
    const u32x4 pv = {SELF_POISON, SELF_POISON, SELF_POISON, SELF_POISON};
    for (size_t i = (size_t)bid * 256 + otid(); i < n16; i += (size_t)G * 256) q[i] = pv;
  }
#endif
  gsync(grid, bar, epoch, bxs);
#ifdef SELFCHECK
  CK(p.ws, OFF_H); slot++;
#endif

  for (int layer = 0; layer < 2; ++layer) {
    const float* xin = (layer == 0) ? p.in[0] : p.out;
    float* xout = p.out;
    for (int round = 0; round < NROUND; ++round) {
      const size_t tok0 = (size_t)round * TR;
      if (layer == 0 && round == 0) {
        phase_hnorm(xin + tok0 * 1024, p.in[2] + layer * 1024, (bf16_t*)(p.ws + OFF_H));
        gsync(grid, bar, epoch, bxs);
      }
#ifdef SELFCHECK
      CK(p.ws + OFF_H, (size_t)TR * 1024 * 2); slot++;
#endif
#ifndef REP_B
#define REP_B 1
#endif
      for (int rep = 0; rep < REP_B; ++rep) {
      for (int it = bid; it < NRT * 76; it += G) inproj_tile(p, layer, it % NRT, it / NRT, smem);
      gsync(grid, bar, epoch, bxs);
      }
#ifdef SELFCHECK
      CK(p.ws + OFF_PROJ, (size_t)TR * D_INP * 2); CK(p.ws + OFF_VTA, (size_t)RB * 4 * 128 * 2048 * 2); slot++;
#endif
      {
        constexpr int n1 = 256, n2 = TR / 16, n3 = RB * 32 * 16, n4 = RB * 16 * 8 / 4;
        for (int it = bid; it < n1 + n2 + n3 + n4; it += G) {
          if (it < n1) s5_e_item(p, layer, it, smem);
          else if (it < n1 + n2) tokpost_item(p, layer, round, it - n1);
          else if (it < n1 + n2 + n3) conv_item(p, layer, it - n1 - n2);
          else dtacum_item(p, layer, it - n1 - n2 - n3);
        }
      }
      gsync(grid, bar, epoch, bxs);
#ifdef SELFCHECK
      CK(p.ws + OFF_PROJ, (size_t)TR * D_INP * 2); CK(p.ws + OFF_E, (size_t)32 * 128 * NBC * 4); CK(p.ws + OFF_XC, (size_t)TR * 1024 * 2);
      CK(p.ws + OFF_DT, (size_t)TR * 8 * 4); CK(p.ws + OFF_ACUM, (size_t)TR * 8 * 4); slot++;
#endif
      {
        constexpr int n1 = NRT * 6, n2 = NRT * 8, n3 = RB * 16 * 8, n4 = RB * 32 * 64 / 256;
        for (int it = bid; it < n1 + n2 + n3 + n4; it += G) {
          if (it < n1) mla_up_q_tile(p, layer, it % NRT, it / NRT, smem);
          else if (it < n1 + n2) mla_up_kv_tile(p, layer, (it - n1) % NRT, (it - n1) / NRT, smem);
          else if (it < n1 + n2 + n3) mb_states_item(p, it - n1 - n2, smem);
          else s5_carry_item(p, layer, it - n1 - n2 - n3);
        }
      }
      gsync(grid, bar, epoch, bxs);
#ifdef SELFCHECK
      CK(p.ws + OFF_QM, (size_t)TR * 768 * 2); CK(p.ws + OFF_KN, (size_t)TR * 512 * 2); CK(p.ws + OFF_VTD, (size_t)RB * 4 * 128 * 2048 * 2);
      CK(p.ws + OFF_ST, (size_t)RB * 16 * 8 * 8192 * 4); CK(p.ws + OFF_HIN, (size_t)32 * 128 * NBC * 2); slot++;
#endif
      {
        constexpr int n1 = 256, n2 = TR / 16, n3 = RB * 8 * 8192 / 256;
        for (int it = bid; it < n1 + n2 + n3; it += G) {
          if (it < n1) s5_y_item(p, layer, it, smem);
          else if (it < n1 + n2) mlapost_item(p, layer, round, it - n1);
          else mb_scan_item(p, it - n1 - n2);
        }
      }
      gsync(grid, bar, epoch, bxs);
#ifdef SELFCHECK
      CK(p.ws + OFF_YG, (size_t)TR * 512 * 2); CK(p.ws + OFF_QM, (size_t)TR * 768 * 2); CK(p.ws + OFF_KM, (size_t)TR * 768 * 2);
      CK(p.ws + OFF_SIN, (size_t)RB * 16 * 8 * 8192 * 2); slot++;
#endif
#ifdef REP_ATT
      {
        constexpr int nat = RB * 4 * 32 * 2;
        for (int it = bid; it < nat; it += G) {
            const int half = nat / 2;
            const int qb = (it < half) ? (31 - it / 32) : ((it - half) / 32);
            const int sub = it & 31;
            if (sub < 16) da_attn_item(p, layer, sub, qb, smem, true);
            else mla_attn_item(p, sub - 16, qb, smem, true);
        }
        gsync(grid, bar, epoch, bxs);
      }
#endif
      {
        constexpr int nat = RB * 4 * 32 * 2;
        constexpr int n3 = RB * 16 * 2, n4 = NRT * 4;
        const int nmb = (G > n3 + 64) ? n3 : 0;
        if (bid < nmb) {
          mb_out_item(p, layer, bid, smem);
        } else {
          const int j = bid - nmb, W = G - nmb;
          if (nmb == 0) for (int it = bid; it < n3; it += G) mb_out_item(p, layer, it, smem);
          for (int r = 0; r * W < nat; ++r) {
            const int k = (r & 1) ? ((r + 1) * W - 1 - j) : (r * W + j);
            if (k < nat) {
              const int qb = 31 - (k >> 5), sub = k & 31;
              if (sub < 16) da_attn_item(p, layer, sub, qb, smem);
              else mla_attn_item(p, sub - 16, qb, smem);
            }
          }
          for (int t = W - 1 - j; t < n4; t += W) s5_glu_tile(p, layer, t % NRT, t / NRT, smem);
        }
      }
      gsync(grid, bar, epoch, bxs);
#ifdef SELFCHECK
      CK(p.ws + OFF_PROJ, (size_t)TR * D_INP * 2); slot++;
#endif
      for (int it = bid; it < NRT * 16; it += G) merge_tile(p, layer, it % NRT, it / NRT, smem);
      gsync(grid, bar, epoch, bxs);
#ifdef SELFCHECK
      CK(p.ws + OFF_MERGED, (size_t)TR * 1024 * 2); slot++;
#endif
      for (int it = bid; it < NRT * 8; it += G) out_tile(p, layer, xin + tok0 * 1024, xout + tok0 * 1024, it % NRT, it / NRT, smem);
      {
        const int nl = (round + 1 < NROUND) ? layer : layer + 1;
        const int nr = (round + 1 < NROUND) ? round + 1 : 0;
        if (nl < 2) {
          const float* nx = (nl == 0) ? p.in[0] : p.out;
          phase_hnorm(nx + (size_t)nr * TR * 1024, p.in[2] + nl * 1024, (bf16_t*)(p.ws + OFF_H));
        }
      }
      gsync(grid, bar, epoch, bxs);
#ifdef SELFCHECK
      CK(xout + tok0 * 1024, (size_t)TR * 1024 * 4); slot++;
#endif
    }
  }
#ifdef WCHECK
  if (bid == 0 && otid() == 0) {
    if (wseen != 0) p.out[0] = 1.0e6f;
    __hip_atomic_store(bar + 32, 1u, __ATOMIC_RELAXED, __HIP_MEMORY_SCOPE_AGENT);
  }
#endif
#ifdef SELFCHECK
  gsync(grid, bar, epoch, bxs);
  }
  gsync(grid, bar, epoch, bxs);
  if (bid == 0 && otid() == 0) {
    int bad = -1;
    for (int k = 0; k < 100; ++k) {
      const unsigned long long a = __hip_atomic_load(slots_base + k, __ATOMIC_RELAXED, __HIP_MEMORY_SCOPE_AGENT);
      const unsigned long long b = __hip_atomic_load(slots_base + 256 + k, __ATOMIC_RELAXED, __HIP_MEMORY_SCOPE_AGENT);
      const unsigned long long c = __hip_atomic_load(slots_base + 512 + k, __ATOMIC_RELAXED, __HIP_MEMORY_SCOPE_AGENT);
      if (a != b || a != c) { bad = k; break; }
    }
    if (bad >= 0) p.out[0] = 10000.0f * exp2f((float)bad);
  }
#endif
}

extern "C" void kernel_launch(void* const* d_in, const int* in_sizes, int n_in, void* d_out,
                              int out_size, void* d_ws, size_t ws_size, hipStream_t stream) {
  static int grid_blocks = 0;
  if (!grid_blocks) {
    int dev = 0, cus = 0, per_cu = 0;
    (void)hipGetDevice(&dev);
    (void)hipDeviceGetAttribute(&cus, hipDeviceAttributeMultiprocessorCount, dev);
    (void)hipOccupancyMaxActiveBlocksPerMultiprocessor(&per_cu, fwd_megakernel, 256, 0);
    if (per_cu > 2) per_cu = 2;
    if (per_cu < 1) per_cu = 1;
    grid_blocks = cus * per_cu;
    if (grid_blocks > MAXBLK) grid_blocks = MAXBLK;
  }
  if (ws_size < WS_TOTAL) fprintf(stderr, "workspace too small: %zu < %zu\n", ws_size, (size_t)WS_TOTAL);
  Params p{};
  for (int i = 0; i < 35; ++i) p.in[i] = (const float*)d_in[i];
  p.out = (float*)d_out;
  p.ws = (unsigned char*)d_ws;
  (void)hipMemsetAsync((unsigned char*)d_ws + OFF_BAR, 0, 8192, stream);
  void* args[] = {&p};
  hipError_t e = hipLaunchCooperativeKernel((void*)fwd_megakernel, dim3(grid_blocks), dim3(256), args, 0, stream);
  if (e != hipSuccess) fprintf(stderr, "cooperative launch failed: %s (grid %d)\n", hipGetErrorString(e), grid_blocks);
}
```

```cpp
#include <hip/hip_runtime.h>
#include <hip/hip_cooperative_groups.h>
#include <cstdio>
#include <cstdint>
namespace cg = cooperative_groups;

typedef unsigned short bf16_t;
typedef short bf16x8 __attribute__((ext_vector_type(8)));
typedef float f32x4 __attribute__((ext_vector_type(4)));
typedef unsigned u32x4 __attribute__((ext_vector_type(4)));
typedef unsigned u32x2 __attribute__((ext_vector_type(2)));

constexpr int SEQ = 2048, BATCH = 16;
constexpr int D_IN = 9672, D_INP = 9728;
constexpr int RB = 4;
constexpr int TR = RB * SEQ;
constexpr int NROUND = BATCH / RB;
constexpr int NRT = TR / 128;
constexpr int NBC = TR / 8;
constexpr int MAXBLK = 512;
constexpr float EPS = 1e-6f;
constexpr float LOG2E = 1.4426950408889634f;
constexpr int C_DAQ = 0, C_DAK = 512, C_DAV = 1024, C_DAG = 1536, C_MBZ = 2048, C_XBC = 2560, C_DT = 3584,
              C_S5U = 3592, C_S5G = 4104, C_CQ = 4616, C_CKV = 4872, C_KR = 5000, C_MLG = 5064, C_GATE = 5576;
constexpr long LDP = D_INP;

constexpr size_t al256(size_t x) { return (x + 255) & ~size_t(255); }
constexpr size_t OFF_WINT = 0;
constexpr size_t OFF_WBRT = OFF_WINT + al256((size_t)2 * D_INP * 1024 * 2);
constexpr size_t OFF_WOUTT = OFF_WBRT + al256((size_t)2 * 4 * 1024 * 512 * 2);
constexpr size_t OFF_WGLUT = OFF_WOUTT + al256((size_t)2 * 1024 * 1024 * 2);
constexpr size_t OFF_WUQT = OFF_WGLUT + al256((size_t)2 * 512 * 512 * 2);
constexpr size_t OFF_WUKVT = OFF_WUQT + al256((size_t)2 * 768 * 256 * 2);
constexpr size_t OFF_KMAT = OFF_WUKVT + al256((size_t)2 * 1024 * 128 * 2);
constexpr size_t OFF_EMAT = OFF_KMAT + al256((size_t)2 * 32 * 128 * 128 * 2);
constexpr size_t OFF_FMAT = OFF_EMAT + al256((size_t)2 * 32 * 128 * 128 * 2);
constexpr size_t OFF_A8 = OFF_FMAT + al256((size_t)2 * 32 * 128 * 128 * 2);
constexpr size_t OFF_LAM = OFF_A8 + al256((size_t)2 * 32 * 64 * 2 * 4);
constexpr size_t OFF_H = OFF_LAM + 256;
constexpr size_t OFF_PROJ = OFF_H + al256((size_t)TR * 1024 * 2);
constexpr size_t OFF_XC = OFF_PROJ + al256((size_t)TR * D_INP * 2);
constexpr size_t OFF_DT = OFF_XC + al256((size_t)TR * 1024 * 2);
constexpr size_t OFF_ACUM = OFF_DT + al256((size_t)TR * 8 * 4);
constexpr size_t OFF_VTA = OFF_ACUM + al256((size_t)TR * 8 * 4);
constexpr size_t OFF_VTD = OFF_VTA + al256((size_t)RB * 4 * 128 * 2048 * 2);
constexpr size_t OFF_QM = OFF_VTD + al256((size_t)RB * 4 * 128 * 2048 * 2);
constexpr size_t OFF_KM = OFF_QM + al256((size_t)TR * 768 * 2);
constexpr size_t OFF_KN = OFF_KM + al256((size_t)TR * 768 * 2);
constexpr size_t OFF_ST = OFF_KN + al256((size_t)TR * 512 * 2);
constexpr size_t OFF_SIN = OFF_ST + al256((size_t)RB * 16 * 8 * 8192 * 4);
constexpr size_t OFF_MS = OFF_SIN + al256((size_t)RB * 16 * 8 * 8192 * 2);
constexpr size_t OFF_XS = OFF_MS + al256((size_t)MAXBLK * 4 * 128 * 128 * 2);
constexpr size_t OFF_E = OFF_XS + al256((size_t)MAXBLK * 128 * 64 * 2);
constexpr size_t OFF_HIN = OFF_E + al256((size_t)32 * 128 * NBC * 4);
constexpr size_t OFF_YG = OFF_HIN + al256((size_t)32 * 128 * NBC * 2);
constexpr size_t OFF_MERGED = OFF_YG + al256((size_t)TR * 512 * 2);
constexpr size_t OFF_QK = OFF_MERGED + al256((size_t)TR * 1024 * 2);
constexpr size_t OFF_CQ2 = OFF_QK + al256((size_t)TR * 1024 * 2);
constexpr size_t OFF_QM2 = OFF_CQ2 + al256((size_t)TR * 384 * 2);
constexpr size_t OFF_BAR = OFF_QM2 + al256((size_t)TR * 768 * 2);
constexpr size_t WS_TOTAL = OFF_BAR + 8192;

constexpr int SMEM_BYTES = 73728 + 4096 + 64;

struct Params {
  const float* in[35];
  float* out;
  unsigned char* ws;
};

#define MEMBAR() do { asm volatile("" ::: "memory"); __builtin_amdgcn_sched_barrier(0); } while (0)
__device__ __forceinline__ int otid() { int t = threadIdx.x; asm volatile("" : "+v"(t)); return t; }
__device__ __forceinline__ bf16_t f2bf(float f) {
  unsigned u = __float_as_uint(f);
  u += 0x7fffu + ((u >> 16) & 1u);
  return (bf16_t)(u >> 16);
}
__device__ __forceinline__ float bf2f(bf16_t b) { return __uint_as_float(((unsigned)b) << 16); }
__device__ __forceinline__ unsigned pack2(float a, float b) { return (unsigned)f2bf(a) | ((unsigned)f2bf(b) << 16); }
__device__ __forceinline__ float sigmoidf_(float x) { return 1.0f / (1.0f + __expf(-x)); }
__device__ __forceinline__ float siluf_(float x) { return x / (1.0f + __expf(-x)); }
__device__ __forceinline__ float gelu_tanh(float x) {
  float u = 0.7978845608028654f * (x + 0.044715f * x * x * x);
  float t = 1.0f - 2.0f / (__expf(2.0f * u) + 1.0f);
  return 0.5f * x * (1.0f + t);
}
__device__ __forceinline__ float wave_sum(float v) {
#pragma unroll
  for (int d = 32; d >= 1; d >>= 1) v += __shfl_xor(v, d, 64);
  return v;
}

__device__ __forceinline__ void block_global_handoff() {
  asm volatile("s_waitcnt vmcnt(0)" ::: "memory");
  __syncthreads();
  if (otid() < 64) {
    __builtin_amdgcn_fence(__ATOMIC_ACQUIRE, "agent");
    asm volatile("s_waitcnt vmcnt(0)" ::: "memory");
  }
  __syncthreads();
}
template <int R, bool T, bool SEG, int N>
__device__ __forceinline__ void g_load(u32x4 (&rg)[N], const bf16_t* __restrict__ P, long ld, int k0, long segs, int tid) {
#pragma unroll
  for (int i = 0; i < N; ++i) {
    const int ch = tid + i * 256;
    if (!T) {
      const int row = ch >> 3, kc = k0 + (ch & 7) * 8;
      const long ko = SEG ? ((long)(kc >> 4) * segs + (kc & 15)) : (long)kc;
      rg[i] = *(const u32x4*)(P + (long)row * ld + ko);
    } else {
      constexpr int CPR = R / 8;
      const int kk = ch / CPR, m0 = (ch % CPR) * 8;
      rg[i] = *(const u32x4*)(P + (long)(k0 + kk) * ld + m0);
    }
  }
}
template <int R, bool T, int N>
__device__ __forceinline__ void s_store(const u32x4 (&rg)[N], bf16_t* sm, int tid) {
  constexpr int LS = 72;
#pragma unroll
  for (int i = 0; i < N; ++i) {
    const int ch = tid + i * 256;
    if (!T) {
      const int row = ch >> 3, kc = (ch & 7) * 8;
      *(u32x4*)(sm + row * LS + kc) = rg[i];
    } else {
      constexpr int CPR = R / 8;
      const int kk = ch / CPR, m0 = (ch % CPR) * 8;
      bf16_t* d = sm + m0 * LS + kk;
      d[0 * LS] = (bf16_t)(rg[i].x & 0xffffu); d[1 * LS] = (bf16_t)(rg[i].x >> 16);
      d[2 * LS] = (bf16_t)(rg[i].y & 0xffffu); d[3 * LS] = (bf16_t)(rg[i].y >> 16);
      d[4 * LS] = (bf16_t)(rg[i].z & 0xffffu); d[5 * LS] = (bf16_t)(rg[i].z >> 16);
      d[6 * LS] = (bf16_t)(rg[i].w & 0xffffu); d[7 * LS] = (bf16_t)(rg[i].w >> 16);
    }
  }
}
template <int BN>
__device__ __forceinline__ void mfma_stage(f32x4 (&acc)[4][BN / 32], const bf16_t* sA, const bf16_t* sB, int wr, int wc, int g, int c) {
  constexpr int LS = 72;
  const bf16_t* pa = sA + (wr * 64 + c) * LS + g * 8;
  const bf16_t* pb = sB + (wc * (BN / 2) + c) * LS + g * 8;
#pragma unroll
  for (int ks = 0; ks < 2; ++ks) {
    bf16x8 af[4], bfr[BN / 32];
#pragma unroll
    for (int i = 0; i < 4; ++i) af[i] = *(const bf16x8*)(pa + i * 16 * LS + ks * 32);
#pragma unroll
    for (int j = 0; j < BN / 32; ++j) bfr[j] = *(const bf16x8*)(pb + j * 16 * LS + ks * 32);
#pragma unroll
    for (int i = 0; i < 4; ++i)
#pragma unroll
      for (int j = 0; j < BN / 32; ++j) acc[i][j] = __builtin_amdgcn_mfma_f32_16x16x32_bf16(af[i], bfr[j], acc[i][j], 0, 0, 0);
  }
}
template <int BN, bool TA, bool TB, bool SEGA>
__device__ __forceinline__ void gemm_tile(f32x4 (&acc)[4][BN / 32], const bf16_t* __restrict__ A, long lda,
                                          const bf16_t* __restrict__ B, long ldb, int K, bf16_t* smem, long segs = 0) {
  constexpr int LS = 72;
  constexpr int STAGE = 2 * 128 * LS;
  const int tid = otid(), w = tid >> 6, l = tid & 63, g = l >> 4, c = l & 15;
  const int wr = w >> 1, wc = w & 1;
  constexpr int NA = 4, NB = BN / 32;
  u32x4 ra0[NA], rb0[NB], ra1[NA], rb1[NB];
  const int nk = K / 64;
  bf16_t* s0A = smem;
  bf16_t* s0B = smem + 128 * LS;
  bf16_t* s1A = smem + STAGE;
  bf16_t* s1B = smem + STAGE + 128 * LS;
  g_load<128, TA, SEGA, NA>(ra0, A, lda, 0, segs, tid);
  g_load<BN, TB, false, NB>(rb0, B, ldb, 0, 0, tid);
  g_load<128, TA, SEGA, NA>(ra1, A, lda, 64, segs, tid);
  g_load<BN, TB, false, NB>(rb1, B, ldb, 64, 0, tid);
  __syncthreads();
  s_store<128, TA, NA>(ra0, s0A, tid);
  s_store<BN, TB, NB>(rb0, s0B, tid);
  __syncthreads();
  for (int kt = 0; kt < nk; kt += 2) {
    if (kt + 2 < nk) {
      g_load<128, TA, SEGA, NA>(ra0, A, lda, (kt + 2) * 64, segs, tid);
      g_load<BN, TB, false, NB>(rb0, B, ldb, (kt + 2) * 64, 0, tid);
    }
    mfma_stage<BN>(acc, s0A, s0B, wr, wc, g, c);
    s_store<128, TA, NA>(ra1, s1A, tid);
    s_store<BN, TB, NB>(rb1, s1B, tid);
    __syncthreads();
    if (kt + 3 < nk) {
      g_load<128, TA, SEGA, NA>(ra1, A, lda, (kt + 3) * 64, segs, tid);
      g_load<BN, TB, false, NB>(rb1, B, ldb, (kt + 3) * 64, 0, tid);
    }
    mfma_stage<BN>(acc, s1A, s1B, wr, wc, g, c);
    if (kt + 2 < nk) {
      s_store<128, TA, NA>(ra0, s0A, tid);
      s_store<BN, TB, NB>(rb0, s0B, tid);
    }
    __syncthreads();
  }
}

template <int NJ>
__device__ __forceinline__ void zero_acc(f32x4 (&acc)[4][NJ]) {
#pragma unroll
  for (int i = 0; i < 4; ++i)
#pragma unroll
    for (int j = 0; j < NJ; ++j) acc[i][j] = (f32x4){0.f, 0.f, 0.f, 0.f};
}

__device__ __forceinline__ void tconv_tile(const float* __restrict__ src, bf16_t* __restrict__ dst, int K, int N, int tk, int tn, float* sm) {
  const int tid = otid();
  const int k0 = tk * 64, n0 = tn * 64;
  __syncthreads();
#pragma unroll 4
  for (int i = 0; i < 16; ++i) {
    const int kk = i * 4 + (tid >> 6), nn = tid & 63;
    float v = 0.f;
    if (n0 + nn < N) v = src[(long)(k0 + kk) * N + n0 + nn];
    sm[kk * 65 + nn] = v;
  }
  __syncthreads();
#pragma unroll 4
  for (int i = 0; i < 16; ++i) {
    const int nn = i * 4 + (tid >> 6), kk = tid & 63;
    dst[(long)(n0 + nn) * K + k0 + kk] = f2bf(sm[kk * 65 + nn]);
  }
}

__device__ __forceinline__ void tconv_job(const float* src, bf16_t* dst, int K, int N, int Npad, float* sm) {
  const int tkn = K / 64, tnn = Npad / 64;
  for (int t = blockIdx.x; t < tkn * tnn; t += gridDim.x) tconv_tile(src, dst, K, N, t % tkn, t / tkn, sm);
}

__device__ __forceinline__ void s5_prep(const Params& p, int layer, int grp, float* sm) {
  float* pwr = sm;
  float* pwi = pwr + 9 * 64;
  float* bbr = pwi + 9 * 64;
  float* bbi = bbr + 1024;
  float* cr = bbi + 1024;
  float* ci = cr + 1024;
  float* kt = ci + 1024;
  const int tid = otid();
  const int lg = layer * 32 + grp;
  __syncthreads();
  if (tid < 64) {
    const int pp = tid;
    const double step = exp((double)p.in[19][lg]);
    const double lr = (double)p.in[17][lg * 64 + pp], li = (double)p.in[18][lg * 64 + pp];
    const double mag = exp(lr * step);
    const double abr = mag * cos(li * step), abi = mag * sin(li * step);
    const double den = lr * lr + li * li;
    const double fr = ((abr - 1.0) * lr + abi * li) / den;
    const double fi = (abi * lr - (abr - 1.0) * li) / den;
    double qr = 1.0, qi = 0.0;
    for (int t = 0; t < 9; ++t) {
      pwr[t * 64 + pp] = (float)qr;
      pwi[t * 64 + pp] = (float)qi;
      const double nr = qr * abr - qi * abi, ni = qr * abi + qi * abr;
      qr = nr; qi = ni;
    }
    float* a8 = (float*)(p.ws + OFF_A8) + (size_t)(lg * 64 + pp) * 2;
    a8[0] = pwr[8 * 64 + pp];
    a8[1] = pwi[8 * 64 + pp];
    for (int cc = 0; cc < 16; ++cc) {
      const double br = (double)p.in[20][(lg * 64 + pp) * 16 + cc], bi = (double)p.in[21][(lg * 64 + pp) * 16 + cc];
      bbr[pp * 16 + cc] = (float)(fr * br - fi * bi);
      bbi[pp * 16 + cc] = (float)(fr * bi + fi * br);
    }
  }
  for (int e = tid; e < 1024; e += 256) {
    cr[e] = p.in[22][lg * 1024 + e];
    ci[e] = p.in[23][lg * 1024 + e];
  }
  __syncthreads();
  for (int e = tid; e < 2048; e += 256) {
    const int tau = e >> 8, co = (e >> 4) & 15, cin = e & 15;
    float s = 0.f;
    for (int pp = 0; pp < 64; ++pp) {
      const float pr = pwr[tau * 64 + pp], pi = pwi[tau * 64 + pp];
      const float zr = pr * bbr[pp * 16 + cin] - pi * bbi[pp * 16 + cin];
      const float zi = pr * bbi[pp * 16 + cin] + pi * bbr[pp * 16 + cin];
      s += cr[co * 64 + pp] * zr - ci[co * 64 + pp] * zi;
    }
    kt[e] = s;
  }
  __syncthreads();
  bf16_t* Km = (bf16_t*)(p.ws + OFF_KMAT) + (size_t)lg * 16384;
  bf16_t* Em = (bf16_t*)(p.ws + OFF_EMAT) + (size_t)lg * 16384;
  bf16_t* Fm = (bf16_t*)(p.ws + OFF_FMAT) + (size_t)lg * 16384;
  for (int e = tid; e < 16384; e += 256) {
    const int n = e >> 7, k = e & 127;
    {
      const int tq = n >> 4, co = n & 15, sq = k >> 4, cin = k & 15;
      Km[e] = f2bf(tq >= sq ? kt[((tq - sq) * 16 + co) * 16 + cin] : 0.f);
    }
    {
      const int pp = n >> 1, ri = n & 1, sq = k >> 4, cin = k & 15;
      const float pr = pwr[(7 - sq) * 64 + pp], pi = pwi[(7 - sq) * 64 + pp];
      const float zr = pr * bbr[pp * 16 + cin] - pi * bbi[pp * 16 + cin];
      const float zi = pr * bbi[pp * 16 + cin] + pi * bbr[pp * 16 + cin];
      Em[e] = f2bf(ri ? zi : zr);
    }
    {
      const int tq = n >> 4, co = n & 15, pp = k >> 1, ri = k & 1;
      const float pr = pwr[(tq + 1) * 64 + pp], pi = pwi[(tq + 1) * 64 + pp];
      const float gr = cr[co * 64 + pp] * pr - ci[co * 64 + pp] * pi;
      const float gi = cr[co * 64 + pp] * pi + ci[co * 64 + pp] * pr;
      Fm[e] = f2bf(ri ? -gi : gr);
    }
  }
}

__device__ __forceinline__ void phase_prep(const Params& p, float* smf) {
  for (int L = 0; L < 2; ++L) {
    tconv_job(p.in[3] + (size_t)L * 1024 * D_IN, (bf16_t*)(p.ws + OFF_WINT) + (size_t)L * D_INP * 1024, 1024, D_IN, D_INP, smf);
    for (int n = 0; n < 4; ++n)
      tconv_job(p.in[33] + (size_t)(L * 4 + n) * 512 * 1024, (bf16_t*)(p.ws + OFF_WBRT) + (size_t)(L * 4 + n) * 1024 * 512, 512, 1024, 1024, smf);
    tconv_job(p.in[34] + (size_t)L * 1024 * 1024, (bf16_t*)(p.ws + OFF_WOUTT) + (size_t)L * 1024 * 1024, 1024, 1024, 1024, smf);
    tconv_job(p.in[25] + (size_t)L * 512 * 512, (bf16_t*)(p.ws + OFF_WGLUT) + (size_t)L * 512 * 512, 512, 512, 512, smf);
    tconv_job(p.in[28] + (size_t)L * 256 * 768, (bf16_t*)(p.ws + OFF_WUQT) + (size_t)L * 768 * 256, 256, 768, 768, smf);
    tconv_job(p.in[30] + (size_t)L * 128 * 1024, (bf16_t*)(p.ws + OFF_WUKVT) + (size_t)L * 1024 * 128, 128, 1024, 1024, smf);
  }
  for (int it = blockIdx.x; it < 64; it += gridDim.x) s5_prep(p, it >> 5, it & 31, smf);
  if (blockIdx.x == gridDim.x - 1 && otid() < 2) {
    const int L = otid();
    float s1 = 0.f, s2 = 0.f;
    for (int i = 0; i < 64; ++i) {
      s1 += p.in[6][L * 64 + i] * p.in[7][L * 64 + i];
      s2 += p.in[8][L * 64 + i] * p.in[9][L * 64 + i];
    }
    const float li = 0.8f - 0.6f * expf(-0.3f * (float)L);
    ((float*)(p.ws + OFF_LAM))[L] = expf(s1) - expf(s2) + li;
  }
}

__device__ __forceinline__ void phase_hnorm(const float* __restrict__ x, const float* __restrict__ gn, bf16_t* __restrict__ H) {
  const int w = otid() >> 6, l = otid() & 63;
  for (int row = blockIdx.x * 4 + w; row < TR; row += gridDim.x * 4) {
    const float4* xr = (const float4*)(x + (size_t)row * 1024);
    float4 v[4];
    float ss = 0.f;
#pragma unroll
    for (int i = 0; i < 4; ++i) {
      v[i] = xr[i * 64 + l];
      ss += v[i].x * v[i].x + v[i].y * v[i].y + v[i].z * v[i].z + v[i].w * v[i].w;
    }
    ss = wave_sum(ss);
    const float rs = rsqrtf(ss * (1.0f / 1024.0f) + EPS);
#pragma unroll
    for (int i = 0; i < 4; ++i) {
      const float4 gg = ((const float4*)gn)[i * 64 + l];
      u32x2 o;
      o.x = pack2(v[i].x * rs * gg.x, v[i].y * rs * gg.y);
      o.y = pack2(v[i].z * rs * gg.z, v[i].w * rs * gg.w);
      *(u32x2*)(H + (size_t)row * 1024 + (i * 64 + l) * 4) = o;
    }
  }
}

__device__ __forceinline__ void inproj_tile(const Params& p, int layer, int rt, int ct, bf16_t* smem) {
  const bf16_t* H = (const bf16_t*)(p.ws + OFF_H);
  const bf16_t* W = (const bf16_t*)(p.ws + OFF_WINT) + (size_t)layer * D_INP * 1024;
  bf16_t* PROJ = (bf16_t*)(p.ws + OFF_PROJ);
  bf16_t* VTA = (bf16_t*)(p.ws + OFF_VTA);
  f32x4 acc[4][4];
  zero_acc<4>(acc);
  gemm_tile<128, false, false, false>(acc, H + (size_t)rt * 128 * 1024, 1024, W + (size_t)ct * 128 * 1024, 1024, 1024, smem);
  const int tid = otid(), w = tid >> 6, l = tid & 63, g = l >> 4, c = l & 15, wr = w >> 1, wc = w & 1;
  const int c0 = ct * 128;
  if (c0 >= C_DAV && c0 < C_DAG) {
    const int h = (c0 - C_DAV) >> 7;
#pragma unroll
    for (int i = 0; i < 4; ++i)
#pragma unroll
      for (int j = 0; j < 4; ++j) {
        const int row = rt * 128 + wr * 64 + i * 16 + g * 4;
        const int dv = wc * 64 + j * 16 + c;
        const int b = row >> 11, s = row & 2047;
        u32x2 o;
        o.x = pack2(acc[i][j][0], acc[i][j][1]);
        o.y = pack2(acc[i][j][2], acc[i][j][3]);
        *(u32x2*)(VTA + ((size_t)((b * 4 + h) * 128 + dv)) * 2048 + s) = o;
      }
  } else {
#pragma unroll
    for (int i = 0; i < 4; ++i) {
#pragma unroll
      for (int r = 0; r < 4; ++r) {
        const int row = rt * 128 + wr * 64 + i * 16 + g * 4 + r;
        bf16_t* rp = PROJ + (size_t)row * LDP + c0 + wc * 64 + c;
#pragma unroll
        for (int j = 0; j < 4; ++j) {
          float v = acc[i][j][r];
          if (c0 + wc * 64 + j * 16 + c >= C_GATE) v = sigmoidf_(v);
          rp[j * 16] = f2bf(v);
        }
      }
      MEMBAR();
    }
  }
}

__device__ __forceinline__ void tokpost_item(const Params& p, int layer, int round, int item) {
  bf16_t* PROJ = (bf16_t*)(p.ws + OFF_PROJ);
  const int* pos = (const int*)p.in[1];
  const int w = otid() >> 6, l = otid() & 63;
  for (int tt = 0; tt < 4; ++tt) {
    const int row = item * 16 + w * 4 + tt;
    const float fpos = (float)pos[round * TR + row];
    bf16_t* pr = PROJ + (size_t)row * LDP;
    {
      const int which = l >> 5, idx = (l & 31) * 16, off = (l & 3) * 16;
      bf16_t* ptr = pr + which * 512 + idx;
      u32x4 u0 = *(const u32x4*)ptr, u1 = *(const u32x4*)(ptr + 8);
      const unsigned uu[8] = {u0.x, u0.y, u0.z, u0.w, u1.x, u1.y, u1.z, u1.w};
      float v[16];
      float ss = 0.f;
#pragma unroll
      for (int e = 0; e < 8; ++e) {
        v[2 * e] = __uint_as_float(uu[e] << 16);
        v[2 * e + 1] = __uint_as_float(uu[e] & 0xffff0000u);
        ss += v[2 * e] * v[2 * e] + v[2 * e + 1] * v[2 * e + 1];
      }
      ss += __shfl_xor(ss, 1, 64);
      ss += __shfl_xor(ss, 2, 64);
      const float rs = rsqrtf(ss * (1.0f / 64.0f) + EPS);
      const float* gn = (which ? p.in[5] : p.in[4]) + layer * 64 + off;
#pragma unroll
      for (int e = 0; e < 16; ++e) v[e] = v[e] * rs * gn[e];
      if ((l & 3) == 0) {
#pragma unroll
        for (int i = 0; i < 8; ++i) {
          const float invf = expf(-13.122363377404328f * (float)i * 0.125f);
          const float ang = fpos * invf;
          const float cs = cosf(ang), sn = sinf(ang);
          const float x1 = v[i], x2 = v[i + 8];
          v[i] = x1 * cs - x2 * sn;
          v[i + 8] = x2 * cs + x1 * sn;
        }
      }
      if (which == 0) {
#pragma unroll
        for (int e = 0; e < 16; ++e) v[e] *= 0.125f * LOG2E;
      }
      u32x4 o0, o1;
      o0.x = pack2(v[0], v[1]); o0.y = pack2(v[2], v[3]); o0.z = pack2(v[4], v[5]); o0.w = pack2(v[6], v[7]);
      o1.x = pack2(v[8], v[9]); o1.y = pack2(v[10], v[11]); o1.z = pack2(v[12], v[13]); o1.w = pack2(v[14], v[15]);
      bf16_t* qko = (bf16_t*)(p.ws + OFF_QK) + (size_t)row * 1024 + which * 512 + idx;
      *(u32x4*)qko = o0;
      *(u32x4*)(qko + 8) = o1;
    }
    {
      bf16_t* ptr = pr + C_CQ + l * 4;
      u32x2 u = *(const u32x2*)ptr;
      float v0 = __uint_as_float(u.x << 16), v1 = __uint_as_float(u.x & 0xffff0000u);
      float v2 = __uint_as_float(u.y << 16), v3 = __uint_as_float(u.y & 0xffff0000u);
      float ss = wave_sum(v0 * v0 + v1 * v1 + v2 * v2 + v3 * v3);
      const float rs = rsqrtf(ss * (1.0f / 256.0f) + EPS);
      const float* gn = p.in[27] + layer * 256 + l * 4;
      u32x2 o;
      o.x = pack2(v0 * rs * gn[0], v1 * rs * gn[1]);
      o.y = pack2(v2 * rs * gn[2], v3 * rs * gn[3]);
      *(u32x2*)((bf16_t*)(p.ws + OFF_CQ2) + (size_t)row * 384 + l * 4) = o;
    }
    {
      bf16_t* ptr = pr + C_CKV + l * 2;
      unsigned u = *(const unsigned*)ptr;
      float v0 = __uint_as_float(u << 16), v1 = __uint_as_float(u & 0xffff0000u);
      float ss = wave_sum(v0 * v0 + v1 * v1);
      const float rs = rsqrtf(ss * (1.0f / 128.0f) + EPS);
      const float* gn = p.in[29] + layer * 128 + l * 2;
      *(unsigned*)((bf16_t*)(p.ws + OFF_CQ2) + (size_t)row * 384 + 256 + l * 2) = pack2(v0 * rs * gn[0], v1 * rs * gn[1]);
    }
  }
}

__device__ __forceinline__ void conv_item(const Params& p, int layer, int item) {
  const bf16_t* PROJ = (const bf16_t*)(p.ws + OFF_PROJ);
  bf16_t* XC = (bf16_t*)(p.ws + OFF_XC);
  const int chtile = item & 15, tt = (item >> 4) & 31, b = item >> 9;
  const int ch = chtile * 64 + (otid() & 63);
  const int tr0 = otid() >> 6;
  const float* cw = p.in[11] + (size_t)layer * 4 * 1024;
  const float w0 = cw[ch], w1 = cw[1024 + ch], w2 = cw[2048 + ch], w3 = cw[3072 + ch];
  const float bias = p.in[12][layer * 1024 + ch];
  for (int i0 = 0; i0 < 16; i0 += 8) {
    float x0[8], x1[8], x2[8], x3[8];
#pragma unroll
    for (int u = 0; u < 8; ++u) {
      const int t = tt * 64 + (i0 + u) * 4 + tr0;
      const bf16_t* base = PROJ + (size_t)(b * 2048 + t) * LDP + C_XBC + ch;
      x3[u] = bf2f(base[0]);
      x2[u] = (t >= 1) ? bf2f(*(base - LDP)) : 0.f;
      x1[u] = (t >= 2) ? bf2f(*(base - 2 * LDP)) : 0.f;
      x0[u] = (t >= 3) ? bf2f(*(base - 3 * LDP)) : 0.f;
    }
#pragma unroll
    for (int u = 0; u < 8; ++u) {
      const int t = tt * 64 + (i0 + u) * 4 + tr0;
      const float y = bias + w3 * x3[u] + w2 * x2[u] + w1 * x1[u] + w0 * x0[u];
      XC[(size_t)(b * 2048 + t) * 1024 + ch] = f2bf(siluf_(y));
    }
  }
}

__device__ __forceinline__ void dtacum_item(const Params& p, int layer, int item) {
  const bf16_t* PROJ = (const bf16_t*)(p.ws + OFF_PROJ);
  float* DT = (float*)(p.ws + OFF_DT);
  float* AC = (float*)(p.ws + OFF_ACUM);
  const int w = otid() >> 6, l = otid() & 63;
  const int id = item * 4 + w;
  const int h = id & 7, bc = id >> 3;
  const int row0 = bc * 128 + 2 * l;
  const float bias = p.in[13][layer * 8 + h];
  const float A = -expf(p.in[14][layer * 8 + h]);
  float x0 = bf2f(PROJ[(size_t)row0 * LDP + C_DT + h]) + bias;
  float x1 = bf2f(PROJ[(size_t)(row0 + 1) * LDP + C_DT + h]) + bias;
  const float d0 = x0 > 20.f ? x0 : log1pf(expf(x0));
  const float d1 = x1 > 20.f ? x1 : log1pf(expf(x1));
  const float a0 = d0 * A, a1 = d1 * A;
  float s = a0 + a1;
#pragma unroll
  for (int d = 1; d < 64; d <<= 1) {
    const float t = __shfl_up(s, d, 64);
    if (l >= d) s += t;
  }
  DT[(size_t)row0 * 8 + h] = d0;
  DT[(size_t)(row0 + 1) * 8 + h] = d1;
  AC[(size_t)row0 * 8 + h] = s - a1;
  AC[(size_t)(row0 + 1) * 8 + h] = s;
}

__device__ __forceinline__ void s5_e_item(const Params& p, int layer, int item, bf16_t* smem) {
  const bf16_t* PROJ = (const bf16_t*)(p.ws + OFF_PROJ);
  const int grp = item >> 3, mt = item & 7;
  const bf16_t* Em = (const bf16_t*)(p.ws + OFF_EMAT) + (size_t)(layer * 32 + grp) * 16384;
  float* E = (float*)(p.ws + OFF_E);
  f32x4 acc[4][4];
  zero_acc<4>(acc);
  gemm_tile<128, false, false, true>(acc, PROJ + (size_t)mt * 128 * 8 * LDP + C_S5U + grp * 16, 8 * LDP, Em, 128, 128, smem, LDP);
  const int tid = otid(), w = tid >> 6, l = tid & 63, g = l >> 4, c = l & 15, wr = w >> 1, wc = w & 1;
#pragma unroll
  for (int i = 0; i < 4; ++i)
#pragma unroll
    for (int j = 0; j < 4; ++j) {
      const int m = mt * 128 + wr * 64 + i * 16 + g * 4;
      const int n = wc * 64 + j * 16 + c;
      *(f32x4*)(E + ((size_t)(grp * 128 + n)) * NBC + m) = acc[i][j];
    }
}

__device__ __forceinline__ void mla_up_q_tile(const Params& p, int layer, int rt, int ct, bf16_t* smem) {
  const bf16_t* PROJ = (const bf16_t*)(p.ws + OFF_PROJ);
  const bf16_t* W = (const bf16_t*)(p.ws + OFF_WUQT) + (size_t)layer * 768 * 256;
  bf16_t* QM = (bf16_t*)(p.ws + OFF_QM);
  f32x4 acc[4][4];
  zero_acc<4>(acc);
  gemm_tile<128, false, false, false>(acc, (const bf16_t*)(p.ws + OFF_CQ2) + (size_t)rt * 128 * 384, 384, W + (size_t)ct * 128 * 256, 256, 256, smem);
  const int tid = otid(), w = tid >> 6, l = tid & 63, g = l >> 4, c = l & 15, wr = w >> 1, wc = w & 1;
#pragma unroll
  for (int i = 0; i < 4; ++i)
#pragma unroll
    for (int j = 0; j < 4; ++j)
#pragma unroll
      for (int r = 0; r < 4; ++r) {
        const int row = rt * 128 + wr * 64 + i * 16 + g * 4 + r, col = ct * 128 + wc * 64 + j * 16 + c;
        QM[(size_t)row * 768 + col] = f2bf(acc[i][j][r]);
      }
}
__device__ __forceinline__ void mla_up_kv_tile(const Params& p, int layer, int rt, int ct, bf16_t* smem) {
  const bf16_t* PROJ = (const bf16_t*)(p.ws + OFF_PROJ);
  const bf16_t* W = (const bf16_t*)(p.ws + OFF_WUKVT) + (size_t)layer * 1024 * 128;
  bf16_t* KN = (bf16_t*)(p.ws + OFF_KN);
  bf16_t* VTD = (bf16_t*)(p.ws + OFF_VTD);
  f32x4 acc[4][4];
  zero_acc<4>(acc);
  gemm_tile<128, false, false, false>(acc, (const bf16_t*)(p.ws + OFF_CQ2) + (size_t)rt * 128 * 384 + 256, 384, W + (size_t)ct * 128 * 128, 128, 128, smem);
  const int tid = otid(), w = tid >> 6, l = tid & 63, g = l >> 4, c = l & 15, wr = w >> 1, wc = w & 1;
  const int h = ct >> 1;
  if ((ct & 1) == 0) {
#pragma unroll
    for (int i = 0; i < 4; ++i)
#pragma unroll
      for (int j = 0; j < 4; ++j)
#pragma unroll
        for (int r = 0; r < 4; ++r) {
          const int row = rt * 128 + wr * 64 + i * 16 + g * 4 + r, cc = wc * 64 + j * 16 + c;
          KN[(size_t)row * 512 + h * 128 + cc] = f2bf(acc[i][j][r]);
        }
  } else {
#pragma unroll
    for (int i = 0; i < 4; ++i)
#pragma unroll
      for (int j = 0; j < 4; ++j) {
        const int row = rt * 128 + wr * 64 + i * 16 + g * 4, dv = wc * 64 + j * 16 + c;
        const int b = row >> 11, s = row & 2047;
        u32x2 o;
        o.x = pack2(acc[i][j][0], acc[i][j][1]);
        o.y = pack2(acc[i][j][2], acc[i][j][3]);
        *(u32x2*)(VTD + ((size_t)((b * 4 + h) * 128 + dv)) * 2048 + s) = o;
      }
  }
}

__device__ __forceinline__ void mb_states_item(const Params& p, int item, bf16_t* smem) {
  const bf16_t* XC = (const bf16_t*)(p.ws + OFF_XC);
  const float* DT = (const float*)(p.ws + OFF_DT);
  const float* AC = (const float*)(p.ws + OFF_ACUM);
  bf16_t* XS = (bf16_t*)(p.ws + OFF_XS) + (size_t)blockIdx.x * 128 * 64;
  float* ST = (float*)(p.ws + OFF_ST);
  const int h = item & 7, bc = item >> 3;
  const int grp = h >> 2;
  const int row0 = bc * 128;
  const int tid = otid();
  __syncthreads();
  const float alast = AC[(size_t)(row0 + 127) * 8 + h];
  for (int e0 = tid; e0 < 8192; e0 += 2048) {
    float dv[8], av[8];
    bf16_t xv[8];
#pragma unroll
    for (int u = 0; u < 8; ++u) {
      const int e = e0 + u * 256;
      const int row = row0 + (e >> 6);
      dv[u] = DT[(size_t)row * 8 + h];
      av[u] = AC[(size_t)row * 8 + h];
      xv[u] = XC[(size_t)row * 1024 + h * 64 + (e & 63)];
    }
#pragma unroll
    for (int u = 0; u < 8; ++u) XS[e0 + u * 256] = f2bf(bf2f(xv[u]) * dv[u] * __expf(alast - av[u]));
  }
  block_global_handoff();
  f32x4 acc[4][2];
  zero_acc<2>(acc);
  gemm_tile<64, true, true, false>(acc, XC + (size_t)row0 * 1024 + 512 + grp * 128, 1024, XS, 64, 128, smem);
  const int w = tid >> 6, l = tid & 63, g = l >> 4, c = l & 15, wr = w >> 1, wc = w & 1;
#pragma unroll
  for (int i = 0; i < 4; ++i)
#pragma unroll
    for (int j = 0; j < 2; ++j) {
      const int n = wr * 64 + i * 16 + g * 4;
      const int pp = wc * 32 + j * 16 + c;
      *(f32x4*)(ST + ((size_t)(bc * 8 + h) * 64 + pp) * 128 + n) = acc[i][j];
    }
}

__device__ __forceinline__ void s5_carry_item(const Params& p, int layer, int item) {
  const int idx = item * 256 + otid();
  const int b = idx >> 11, grp = (idx >> 6) & 31, pp = idx & 63;
  const float* a8 = (const float*)(p.ws + OFF_A8) + (size_t)((layer * 32 + grp) * 64 + pp) * 2;
  const float ar = a8[0], ai = a8[1];
  const float* er = (const float*)(p.ws + OFF_E) + ((size_t)(grp * 128 + 2 * pp)) * NBC + b * 256;
  const float* ei = er + NBC;
  bf16_t* hro = (bf16_t*)(p.ws + OFF_HIN) + ((size_t)(grp * 128 + 2 * pp)) * NBC + b * 256;
  bf16_t* hio = hro + NBC;
  float hr = 0.f, hi = 0.f;
  for (int c16 = 0; c16 < 16; ++c16) {
    f32x4 vr[4], vi[4];
#pragma unroll
    for (int u = 0; u < 4; ++u) {
      vr[u] = *(const f32x4*)(er + c16 * 16 + u * 4);
      vi[u] = *(const f32x4*)(ei + c16 * 16 + u * 4);
    }
#pragma unroll
    for (int u = 0; u < 4; ++u) {
      float orr[4], oii[4];
#pragma unroll
      for (int k = 0; k < 4; ++k) {
        orr[k] = hr; oii[k] = hi;
        const float nr = ar * hr - ai * hi + vr[u][k];
        const float ni = ar * hi + ai * hr + vi[u][k];
        hr = nr; hi = ni;
      }
      u32x2 o0, o1;
      o0.x = pack2(orr[0], orr[1]); o0.y = pack2(orr[2], orr[3]);
      o1.x = pack2(oii[0], oii[1]); o1.y = pack2(oii[2], oii[3]);
      *(u32x2*)(hro + c16 * 16 + u * 4) = o0;
      *(u32x2*)(hio + c16 * 16 + u * 4) = o1;
    }
  }
}

__device__ __forceinline__ void mlapost_item(const Params& p, int layer, int round, int item) {
  const bf16_t* PROJ = (const bf16_t*)(p.ws + OFF_PROJ);
  bf16_t* QM = (bf16_t*)(p.ws + OFF_QM);
  bf16_t* KM = (bf16_t*)(p.ws + OFF_KM);
  const bf16_t* KN = (const bf16_t*)(p.ws + OFF_KN);
  const int* pos = (const int*)p.in[1];
  const int w = otid() >> 6, l = otid() & 63;
  const float* qn = p.in[31] + layer * 192;
  const float* kn = p.in[32] + layer * 192;
  const float q0 = qn[l], q1 = qn[64 + l], q2 = qn[128 + l];
  const float k0 = kn[l], k1 = kn[64 + l], k2 = kn[128 + l];
  const float invf = expf(-13.122363377404328f * (float)(l & 31) * (1.0f / 32.0f));
  const float qscale = 0.07216878364870322f * LOG2E;
  for (int tt = 0; tt < 4; ++tt) {
    const int row = item * 16 + w * 4 + tt;
    const float ang = (float)pos[round * TR + row] * invf;
    const float cs = cosf(ang), sn = sinf(ang);
    const float kr = bf2f(PROJ[(size_t)row * LDP + C_KR + l]);
#pragma unroll
    for (int h = 0; h < 4; ++h) {
      {
        bf16_t* qp = QM + (size_t)row * 768 + h * 192;
        float e0 = bf2f(qp[l]), e1 = bf2f(qp[64 + l]), e2 = bf2f(qp[128 + l]);
        const float ss = wave_sum(e0 * e0 + e1 * e1 + e2 * e2);
        const float rs = rsqrtf(ss * (1.0f / 192.0f) + EPS);
        e0 *= rs * q0; e1 *= rs * q1; e2 *= rs * q2;
        const float ot = __shfl_xor(e2, 32, 64);
        e2 = (l < 32) ? (e2 * cs - ot * sn) : (e2 * cs + ot * sn);
        bf16_t* qo = (bf16_t*)(p.ws + OFF_QM2) + (size_t)row * 768 + h * 192;
        qo[l] = f2bf(e0 * qscale); qo[64 + l] = f2bf(e1 * qscale); qo[128 + l] = f2bf(e2 * qscale);
      }
      {
        const bf16_t* kp = KN + (size_t)row * 512 + h * 128;
        float e0 = bf2f(kp[l]), e1 = bf2f(kp[64 + l]), e2 = kr;
        const float ss = wave_sum(e0 * e0 + e1 * e1 + e2 * e2);
        const float rs = rsqrtf(ss * (1.0f / 192.0f) + EPS);
        e0 *= rs * k0; e1 *= rs * k1; e2 *= rs * k2;
        const float ot = __shfl_xor(e2, 32, 64);
        e2 = (l < 32) ? (e2 * cs - ot * sn) : (e2 * cs + ot * sn);
        bf16_t* ko = KM + (size_t)row * 768 + h * 192;
        ko[l] = f2bf(e0); ko[64 + l] = f2bf(e1); ko[128 + l] = f2bf(e2);
      }
    }
  }
}

__device__ __forceinline__ void mb_scan_item(const Params& p, int item) {
  const int idx = item * 256 + otid();
  const int b = idx >> 16, h = (idx >> 13) & 7, pn = idx & 8191;
  const float* ST = (const float*)(p.ws + OFF_ST);
  const float* AC = (const float*)(p.ws + OFF_ACUM);
  bf16_t* SIN = (bf16_t*)(p.ws + OFF_SIN);
  float cur = 0.f;
  float alv[16], stv[16];
#pragma unroll
  for (int c = 0; c < 16; ++c) {
    alv[c] = AC[(size_t)(b * 2048 + c * 128 + 127) * 8 + h];
    stv[c] = ST[((size_t)((b * 16 + c) * 8 + h)) * 8192 + pn];
  }
#pragma unroll
  for (int c = 0; c < 16; ++c) {
    SIN[((size_t)((b * 16 + c) * 8 + h)) * 8192 + pn] = f2bf(cur);
    cur = __expf(alv[c]) * cur + stv[c];
  }
}

__device__ __forceinline__ void s5_y_item(const Params& p, int layer, int item, bf16_t* smem) {
  const bf16_t* PROJ = (const bf16_t*)(p.ws + OFF_PROJ);
  const int grp = item >> 3, mt = item & 7;
  const bf16_t* Km = (const bf16_t*)(p.ws + OFF_KMAT) + (size_t)(layer * 32 + grp) * 16384;
  const bf16_t* Fm = (const bf16_t*)(p.ws + OFF_FMAT) + (size_t)(layer * 32 + grp) * 16384;
  const bf16_t* HIN = (const bf16_t*)(p.ws + OFF_HIN) + (size_t)grp * 128 * NBC + mt * 128;
  bf16_t* YG = (bf16_t*)(p.ws + OFF_YG);
  f32x4 acc[4][4];
  zero_acc<4>(acc);
  gemm_tile<128, false, false, true>(acc, PROJ + (size_t)mt * 128 * 8 * LDP + C_S5U + grp * 16, 8 * LDP, Km, 128, 128, smem, LDP);
  gemm_tile<128, true, false, false>(acc, HIN, NBC, Fm, 128, 128, smem);
  const int tid = otid(), w = tid >> 6, l = tid & 63, g = l >> 4, c = l & 15, wr = w >> 1, wc = w & 1;
  const float* dsk = p.in[24] + layer * 512;
#pragma unroll
  for (int i = 0; i < 4; ++i)
#pragma unroll
    for (int j = 0; j < 4; ++j) {
      const int n = wc * 64 + j * 16 + c;
      const int tq = n >> 4, co = n & 15;
      const int ch = grp * 16 + co;
      const float dd = dsk[ch];
#pragma unroll
      for (int r = 0; r < 4; ++r) {
        const int m = mt * 128 + wr * 64 + i * 16 + g * 4 + r;
        const int row = m * 8 + tq;
        const float u = bf2f(PROJ[(size_t)row * LDP + C_S5U + ch]);
        const float y = acc[i][j][r] + dd * u;
        YG[(size_t)row * 512 + ch] = f2bf(gelu_tanh(y));
      }
    }
}

template <int DK, int NM>
__device__ __forceinline__ void attn_core(const bf16_t* __restrict__ Qb, long ldq, const bf16_t* __restrict__ Kb, long ldk,
                                          const bf16_t* __restrict__ Vt, int qb, bf16_t* smem, f32x4 (&O)[NM][8], float (&lsum)[NM][4]) {
  constexpr int KST = DK + 8;
  constexpr int KCH = NM * 64 * DK / 8 / 256;
  constexpr int CPM = 64 * DK / 8;
  constexpr int CPRK = DK / 8;
  bf16_t* sK = smem;
  bf16_t* sV = sK + NM * 64 * KST;
  bf16_t* sP = sV + 128 * 72;
  const int tid = otid(), w = tid >> 6, l = tid & 63, g = l >> 4, c = l & 15;
  bf16x8 qf[NM][DK / 32];
  {
    const long qrow = (long)qb * 64 + w * 16 + c;
#pragma unroll
    for (int m = 0; m < NM; ++m)
#pragma unroll
      for (int ks = 0; ks < DK / 32; ++ks) qf[m][ks] = *(const bf16x8*)(Qb + qrow * ldq + m * DK + ks * 32 + g * 8);
  }
  float mrow[NM][4];
#pragma unroll
  for (int m = 0; m < NM; ++m) {
#pragma unroll
    for (int r = 0; r < 4; ++r) { mrow[m][r] = -INFINITY; lsum[m][r] = 0.f; }
#pragma unroll
    for (int nt = 0; nt < 8; ++nt) O[m][nt] = (f32x4){0.f, 0.f, 0.f, 0.f};
  }
  u32x4 kr[KCH], vr[4];
  auto gloadK = [&](int kt) {
#pragma unroll
    for (int i = 0; i < KCH; ++i) {
      const int ch = tid + i * 256;
      const int m = ch / CPM, cc = ch % CPM;
      const int key = cc / CPRK, d0 = (cc % CPRK) * 8;
      kr[i] = *(const u32x4*)(Kb + (long)(kt * 64 + key) * ldk + m * DK + d0);
    }
  };
  auto gloadV = [&](int kt) {
#pragma unroll
    for (int i = 0; i < 4; ++i) {
      const int ch = tid + i * 256;
      const int dvr = ch >> 3, kc = (ch & 7) * 8;
      vr[i] = *(const u32x4*)(Vt + (long)dvr * 2048 + kt * 64 + kc);
    }
  };
  gloadK(0);
  gloadV(0);
  for (int kt = 0; kt <= qb; ++kt) {
    __syncthreads();
#pragma unroll
    for (int i = 0; i < KCH; ++i) {
      const int ch = tid + i * 256;
      const int m = ch / CPM, cc = ch % CPM;
      const int key = cc / CPRK, d0 = (cc % CPRK) * 8;
      *(u32x4*)(sK + (m * 64 + key) * KST + d0) = kr[i];
    }
#pragma unroll
    for (int i = 0; i < 4; ++i) {
      const int ch = tid + i * 256;
      const int dvr = ch >> 3, kc = (ch & 7) * 8;
      *(u32x4*)(sV + dvr * 72 + kc) = vr[i];
    }
    __syncthreads();
    if (kt < qb) gloadK(kt + 1);
#pragma unroll
    for (int m = 0; m < NM; ++m) {
      f32x4 S[4];
#pragma unroll
      for (int nt = 0; nt < 4; ++nt) {
        S[nt] = (f32x4){0.f, 0.f, 0.f, 0.f};
#pragma unroll
        for (int ks = 0; ks < DK / 32; ++ks) {
          const bf16x8 kf = *(const bf16x8*)(sK + (m * 64 + nt * 16 + c) * KST + ks * 32 + g * 8);
          S[nt] = __builtin_amdgcn_mfma_f32_16x16x32_bf16(qf[m][ks], kf, S[nt], 0, 0, 0);
        }
        MEMBAR();
      }
      if (kt == qb) {
#pragma unroll
        for (int nt = 0; nt < 4; ++nt)
#pragma unroll
          for (int r = 0; r < 4; ++r)
            if (nt * 16 + c > w * 16 + g * 4 + r) S[nt][r] = -INFINITY;
      }
      bf16_t* pw = sP + (size_t)((w * NM + m) * 16) * 72;
#pragma unroll
      for (int r = 0; r < 4; ++r) {
        float mx = fmaxf(fmaxf(S[0][r], S[1][r]), fmaxf(S[2][r], S[3][r]));
        mx = fmaxf(mx, __shfl_xor(mx, 1, 64));
        mx = fmaxf(mx, __shfl_xor(mx, 2, 64));
        mx = fmaxf(mx, __shfl_xor(mx, 4, 64));
        mx = fmaxf(mx, __shfl_xor(mx, 8, 64));
        const float mnew = fmaxf(mrow[m][r], mx);
        const float sc = __builtin_amdgcn_exp2f(mrow[m][r] - mnew);
        mrow[m][r] = mnew;
        float ps = 0.f;
#pragma unroll
        for (int nt = 0; nt < 4; ++nt) {
          const float pv = __builtin_amdgcn_exp2f(S[nt][r] - mnew);
          ps += pv;
          pw[(g * 4 + r) * 72 + nt * 16 + c] = f2bf(pv);
        }
        ps += __shfl_xor(ps, 1, 64);
        ps += __shfl_xor(ps, 2, 64);
        ps += __shfl_xor(ps, 4, 64);
        ps += __shfl_xor(ps, 8, 64);
        lsum[m][r] = lsum[m][r] * sc + ps;
#pragma unroll
        for (int nt = 0; nt < 8; ++nt) O[m][nt][r] *= sc;
      }
    }
    __syncthreads();
    if (kt < qb) gloadV(kt + 1);
#pragma unroll
    for (int m = 0; m < NM; ++m) {
      const bf16_t* pw = sP + (size_t)((w * NM + m) * 16) * 72;
#pragma unroll
      for (int ks = 0; ks < 2; ++ks) {
        const bf16x8 pf = *(const bf16x8*)(pw + c * 72 + ks * 32 + g * 8);
#pragma unroll
        for (int nt = 0; nt < 8; ++nt) {
          const bf16x8 vf = *(const bf16x8*)(sV + (nt * 16 + c) * 72 + ks * 32 + g * 8);
          O[m][nt] = __builtin_amdgcn_mfma_f32_16x16x32_bf16(pf, vf, O[m][nt], 0, 0, 0);
        }
        MEMBAR();
      }
    }
  }
}

__device__ __forceinline__ void da_attn_item(const Params& p, int layer, int bh, int qb, bf16_t* smem, bool dry = false) {
  bf16_t* PROJ = (bf16_t*)(p.ws + OFF_PROJ);
  const bf16_t* VTA = (const bf16_t*)(p.ws + OFF_VTA);
  const bf16_t* QKB = (const bf16_t*)(p.ws + OFF_QK);
  const int b = bh >> 2, h = bh & 3;
  f32x4 O[2][8];
  float ls[2][4];
  {
    f32x4 O1[1][8];
    float l1[1][4];
#pragma unroll 1
    for (int m = 0; m < 2; ++m) {
      attn_core<64, 1>(QKB + (size_t)b * 2048 * 1024 + h * 128 + m * 64, 1024, QKB + (size_t)b * 2048 * 1024 + 512 + h * 128 + m * 64, 1024,
                       VTA + (size_t)(b * 4 + h) * 128 * 2048, qb, smem, O1, l1);
      if (m == 0) {
#pragma unroll
        for (int nt = 0; nt < 8; ++nt) O[0][nt] = O1[0][nt];
#pragma unroll
        for (int r = 0; r < 4; ++r) ls[0][r] = l1[0][r];
      } else {
#pragma unroll
        for (int nt = 0; nt < 8; ++nt) O[1][nt] = O1[0][nt];
#pragma unroll
        for (int r = 0; r < 4; ++r) ls[1][r] = l1[0][r];
      }
    }
  }
  const int tid = otid(), w = tid >> 6, l = tid & 63, g = l >> 4, c = l & 15;
  const float lam = ((const float*)(p.ws + OFF_LAM))[layer];
  const float linit = 0.8f - 0.6f * expf(-0.3f * (float)layer);
  const float* sg = p.in[10] + layer * 128;
#pragma unroll
  for (int r = 0; r < 4; ++r) {
    const float i0 = 1.0f / ls[0][r], i1 = lam / ls[1][r];
    float o[8];
    float ss = 0.f;
#pragma unroll
    for (int nt = 0; nt < 8; ++nt) {
      o[nt] = O[0][nt][r] * i0 - O[1][nt][r] * i1;
      ss += o[nt] * o[nt];
    }
    ss += __shfl_xor(ss, 1, 64);
    ss += __shfl_xor(ss, 2, 64);
    ss += __shfl_xor(ss, 4, 64);
    ss += __shfl_xor(ss, 8, 64);
    const float rs = rsqrtf(ss * (1.0f / 128.0f) + EPS) * (1.0f - linit);
    const size_t row = (size_t)b * 2048 + qb * 64 + w * 16 + g * 4 + r;
#pragma unroll
    for (int nt = 0; nt < 8; ++nt) {
      const int dv = nt * 16 + c;
      bf16_t* gp = PROJ + row * LDP + C_DAG + h * 128 + dv;
      const float gt = bf2f(*gp);
      if (!dry) *gp = f2bf(o[nt] * rs * sg[dv] * siluf_(gt));
    }
  }
}

__device__ __forceinline__ void mla_attn_item(const Params& p, int bh, int qb, bf16_t* smem, bool dry = false) {
  bf16_t* PROJ = (bf16_t*)(p.ws + OFF_PROJ);
  const bf16_t* QM = (const bf16_t*)(p.ws + OFF_QM2);
  const bf16_t* KM = (const bf16_t*)(p.ws + OFF_KM);
  const bf16_t* VTD = (const bf16_t*)(p.ws + OFF_VTD);
  const int b = bh >> 2, h = bh & 3;
  f32x4 O[1][8];
  float ls[1][4];
  attn_core<192, 1>(QM + (size_t)b * 2048 * 768 + h * 192, 768, KM + (size_t)b * 2048 * 768 + h * 192, 768,
                    VTD + (size_t)(b * 4 + h) * 128 * 2048, qb, smem, O, ls);
  const int tid = otid(), w = tid >> 6, l = tid & 63, g = l >> 4, c = l & 15;
#pragma unroll
  for (int r = 0; r < 4; ++r) {
    const float i0 = 1.0f / ls[0][r];
    const size_t row = (size_t)b * 2048 + qb * 64 + w * 16 + g * 4 + r;
#pragma unroll
    for (int nt = 0; nt < 8; ++nt) {
      const int dv = nt * 16 + c;
      bf16_t* gp = PROJ + row * LDP + C_MLG + h * 128 + dv;
      const float gt = bf2f(*gp);
      if (!dry) *gp = f2bf(O[0][nt][r] * i0 * siluf_(gt));
    }
  }
}

__device__ __forceinline__ void mb_out_item(const Params& p, int layer, int item, bf16_t* smem) {
  bf16_t* PROJ = (bf16_t*)(p.ws + OFF_PROJ);
  const bf16_t* XC = (const bf16_t*)(p.ws + OFF_XC);
  const float* DT = (const float*)(p.ws + OFF_DT);
  const float* AC = (const float*)(p.ws + OFF_ACUM);
  const bf16_t* SIN = (const bf16_t*)(p.ws + OFF_SIN);
  bf16_t* MS0 = (bf16_t*)(p.ws + OFF_MS) + (size_t)blockIdx.x * 4 * 128 * 128;
  float* rowss = (float*)((unsigned char*)smem + 73728);
  const int grp = item & 1, bc = item >> 1;
  const int row0 = bc * 128;
  __syncthreads();
  const bf16_t* Cp = XC + (size_t)row0 * 1024 + 768 + grp * 128;
  const bf16_t* Bp = XC + (size_t)row0 * 1024 + 512 + grp * 128;
  {
    const int tid = otid(), w = tid >> 6, l = tid & 63, g = l >> 4, c = l & 15, wr = w >> 1, wc = w & 1;
    f32x4 cb[4][4];
    zero_acc<4>(cb);
    gemm_tile<128, false, false, false>(cb, Cp, 1024, Bp, 1024, 128, smem);
#pragma unroll 1
    for (int r4 = 0; r4 < 4; ++r4) {
      const int h = grp * 4 + r4;
      bf16_t* MS = MS0 + (size_t)r4 * 128 * 128;
      float acs[4], dts[4];
#pragma unroll
      for (int j = 0; j < 4; ++j) {
        const int s = wc * 64 + j * 16 + c;
        acs[j] = AC[(size_t)(row0 + s) * 8 + h];
        dts[j] = DT[(size_t)(row0 + s) * 8 + h];
      }
#pragma unroll
      for (int i = 0; i < 4; ++i)
#pragma unroll
        for (int r = 0; r < 4; ++r) {
          const int lr = wr * 64 + i * 16 + g * 4 + r;
          const float acl = AC[(size_t)(row0 + lr) * 8 + h];
#pragma unroll
          for (int j = 0; j < 4; ++j) {
            const int s = wc * 64 + j * 16 + c;
            const float v = (s <= lr) ? cb[i][j][r] * __expf(acl - acs[j]) * dts[j] : 0.f;
            MS[lr * 128 + s] = f2bf(v);
          }
          MEMBAR();
        }
    }
  }
  block_global_handoff();
#pragma unroll 1
  for (int r4 = 0; r4 < 4; ++r4) {
    const int h = grp * 4 + r4;
    const bf16_t* MS = MS0 + (size_t)r4 * 128 * 128;
    const int tid = otid(), w = tid >> 6, l = tid & 63, g = l >> 4, c = l & 15, wr = w >> 1, wc = w & 1;
    f32x4 ad[4][2], ao[4][2];
    zero_acc<2>(ad);
    zero_acc<2>(ao);
    gemm_tile<64, false, true, false>(ad, MS, 128, XC + (size_t)row0 * 1024 + h * 64, 1024, 128, smem);
    gemm_tile<64, false, false, false>(ao, Cp, 1024, SIN + ((size_t)(bc * 8 + h)) * 8192, 128, 128, smem);
    const float dsk = p.in[15][layer * 8 + h];
#pragma unroll
    for (int i = 0; i < 4; ++i)
#pragma unroll
      for (int r = 0; r < 4; ++r) {
        const int lr = wr * 64 + i * 16 + g * 4 + r;
        const size_t row = (size_t)row0 + lr;
        const float ea = __expf(AC[row * 8 + h]);
        float ssq = 0.f;
#pragma unroll
        for (int j = 0; j < 2; ++j) {
          const int ch = h * 64 + wc * 32 + j * 16 + c;
          const float xv = bf2f(XC[row * 1024 + ch]);
          bf16_t* zp = PROJ + row * LDP + C_MBZ + ch;
          const float z = bf2f(*zp);
          float y = ad[i][j][r] + ea * ao[i][j][r] + dsk * xv;
          y *= siluf_(z);
          ssq += y * y;
          *zp = f2bf(y);
        }
        ssq += __shfl_xor(ssq, 1, 64);
        ssq += __shfl_xor(ssq, 2, 64);
        ssq += __shfl_xor(ssq, 4, 64);
        ssq += __shfl_xor(ssq, 8, 64);
        if (c == 0) rowss[(r4 * 2 + wc) * 128 + lr] = ssq;
        MEMBAR();
      }
  }
  block_global_handoff();
  const float* ng = p.in[16] + layer * 512 + grp * 256;
  {
    const int cc = otid();
    const float gcc = ng[cc];
    for (int l0 = 0; l0 < 128; l0 += 16) {
      bf16_t vals[16];
#pragma unroll
      for (int u = 0; u < 16; ++u) vals[u] = PROJ[(size_t)(row0 + l0 + u) * LDP + C_MBZ + grp * 256 + cc];
#pragma unroll
      for (int u = 0; u < 16; ++u) {
        const int lr = l0 + u;
        float tot = 0.f;
#pragma unroll
        for (int q = 0; q < 8; ++q) tot += rowss[q * 128 + lr];
        PROJ[(size_t)(row0 + lr) * LDP + C_MBZ + grp * 256 + cc] = f2bf(bf2f(vals[u]) * rsqrtf(tot * (1.0f / 256.0f) + EPS) * gcc);
      }
    }
  }
}

__device__ __forceinline__ void s5_glu_tile(const Params& p, int layer, int rt, int ct, bf16_t* smem) {
  bf16_t* PROJ = (bf16_t*)(p.ws + OFF_PROJ);
  const bf16_t* YG = (const bf16_t*)(p.ws + OFF_YG);
  const bf16_t* W = (const bf16_t*)(p.ws + OFF_WGLUT) + (size_t)layer * 512 * 512;
  f32x4 acc[4][4];
  zero_acc<4>(acc);
  gemm_tile<128, false, false, false>(acc, YG + (size_t)rt * 128 * 512, 512, W + (size_t)ct * 128 * 512, 512, 512, smem);
  const int tid = otid(), w = tid >> 6, l = tid & 63, g = l >> 4, c = l & 15, wr = w >> 1, wc = w & 1;
  const float* bg = p.in[26] + layer * 512;
#pragma unroll
  for (int i = 0; i < 4; ++i)
#pragma unroll
    for (int j = 0; j < 4; ++j) {
      const int col = ct * 128 + wc * 64 + j * 16 + c;
      const float bb = bg[col];
#pragma unroll
      for (int r = 0; r < 4; ++r) {
        const size_t row = (size_t)rt * 128 + wr * 64 + i * 16 + g * 4 + r;
        const float yv = bf2f(YG[row * 512 + col]);
        bf16_t* gp = PROJ + row * LDP + C_S5G + col;
        const float gt = bf2f(*gp);
        *gp = f2bf(yv * sigmoidf_(acc[i][j][r] + bb) * siluf_(gt));
      }
    }
}

__device__ __forceinline__ void merge_tile(const Params& p, int layer, int rt, int ct, bf16_t* smem) {
  const bf16_t* PROJ = (const bf16_t*)(p.ws + OFF_PROJ);
  bf16_t* MG = (bf16_t*)(p.ws + OFF_MERGED);
  f32x4 macc[4][2];
  zero_acc<2>(macc);
  const int tid = otid(), w = tid >> 6, l = tid & 63, g = l >> 4, c = l & 15, wr = w >> 1, wc = w & 1;
  for (int n = 0; n < 4; ++n) {
    const int ycol = (n == 0) ? C_DAG : (n == 1) ? C_MBZ : (n == 2) ? C_S5G : C_MLG;
    const bf16_t* W = (const bf16_t*)(p.ws + OFF_WBRT) + (size_t)(layer * 4 + n) * 1024 * 512;
    f32x4 acc[4][2];
    zero_acc<2>(acc);
    gemm_tile<64, false, false, false>(acc, PROJ + (size_t)rt * 128 * LDP + ycol, LDP, W + (size_t)ct * 64 * 512, 512, 512, smem);
#pragma unroll
    for (int i = 0; i < 4; ++i) {
#pragma unroll
      for (int r = 0; r < 4; ++r) {
        const size_t row = (size_t)rt * 128 + wr * 64 + i * 16 + g * 4 + r;
        const bf16_t* gp = PROJ + row * LDP + C_GATE + n * 1024 + ct * 64 + wc * 32 + c;
#pragma unroll
        for (int j = 0; j < 2; ++j) macc[i][j][r] += bf2f(gp[j * 16]) * acc[i][j][r];
      }
      MEMBAR();
    }
  }
#pragma unroll
  for (int i = 0; i < 4; ++i) {
#pragma unroll
    for (int r = 0; r < 4; ++r) {
      const size_t row = (size_t)rt * 128 + wr * 64 + i * 16 + g * 4 + r;
      bf16_t* op = MG + row * 1024 + ct * 64 + wc * 32 + c;
#pragma unroll
      for (int j = 0; j < 2; ++j) op[j * 16] = f2bf(macc[i][j][r]);
    }
    MEMBAR();
  }
}

__device__ __forceinline__ void out_tile(const Params& p, int layer, const float* xo, float* xn, int rt, int ct, bf16_t* smem) {
  const bf16_t* MG = (const bf16_t*)(p.ws + OFF_MERGED);
  const bf16_t* W = (const bf16_t*)(p.ws + OFF_WOUTT) + (size_t)layer * 1024 * 1024;
  f32x4 acc[4][4];
  zero_acc<4>(acc);
  gemm_tile<128, false, false, false>(acc, MG + (size_t)rt * 128 * 1024, 1024, W + (size_t)ct * 128 * 1024, 1024, 1024, smem);
  const int tid = otid(), w = tid >> 6, l = tid & 63, g = l >> 4, c = l & 15, wr = w >> 1, wc = w & 1;
#pragma unroll
  for (int i = 0; i < 4; ++i)
#pragma unroll
    for (int j = 0; j < 4; ++j) {
      const int col = ct * 128 + wc * 64 + j * 16 + c;
#pragma unroll
      for (int r = 0; r < 4; ++r) {
        const size_t row = (size_t)rt * 128 + wr * 64 + i * 16 + g * 4 + r;
        xn[row * 1024 + col] = xo[row * 1024 + col] + acc[i][j][r];
      }
    }
}

struct Bx { unsigned xcd, nloc, nx, hier; };
__device__ __forceinline__ unsigned xcc_id() { return (unsigned)__builtin_amdgcn_s_getreg((3 << 11) | 20) & 0x7u; }
__device__ __forceinline__ void gsync_flat(unsigned* bar) {
  asm volatile("s_waitcnt vmcnt(0)" ::: "memory");
  __syncthreads();
  if (otid() == 0) {
    unsigned long long* w = (unsigned long long*)bar;
    __builtin_amdgcn_fence(__ATOMIC_RELEASE, "agent");
    asm volatile("s_waitcnt vmcnt(0)" ::: "memory");
    const unsigned long long old = __hip_atomic_fetch_add(w, 1ull, __ATOMIC_RELAXED, __HIP_MEMORY_SCOPE_AGENT);
    const unsigned G = gridDim.x;
    if ((unsigned)(old & 0xffffffffull) == G - 1) {
      __hip_atomic_fetch_add(w, (1ull << 32) - (unsigned long long)G, __ATOMIC_RELAXED, __HIP_MEMORY_SCOPE_AGENT);
    } else {
      const unsigned g0 = (unsigned)(old >> 32);
      while ((unsigned)(__hip_atomic_load(w, __ATOMIC_RELAXED, __HIP_MEMORY_SCOPE_AGENT) >> 32) == g0) __builtin_amdgcn_s_sleep(1);
    }
    __builtin_amdgcn_fence(__ATOMIC_ACQUIRE, "agent");
    asm volatile("s_waitcnt vmcnt(0)" ::: "memory");
  }
  __syncthreads();
}
__device__ __forceinline__ void gsync(cg::grid_group& grid, unsigned* bar, unsigned& epoch, const volatile unsigned* bxs) {
  asm volatile("s_waitcnt vmcnt(0)" ::: "memory");
  __syncthreads();
  if (otid() == 0) {
    const unsigned xcd = bxs[0], nloc = bxs[1], nx = bxs[2];
    unsigned long long* L = (unsigned long long*)((unsigned char*)bar + 3072 + 256 * xcd);
    unsigned long long* T = (unsigned long long*)((unsigned char*)bar + 5120);
    const unsigned long long old = __hip_atomic_fetch_add(L, 1ull, __ATOMIC_RELAXED, __HIP_MEMORY_SCOPE_AGENT);
    if ((unsigned)(old & 0xffffffffull) == nloc - 1) {
      __builtin_amdgcn_fence(__ATOMIC_RELEASE, "agent");
      asm volatile("s_waitcnt vmcnt(0)" ::: "memory");
      const unsigned long long oldt = __hip_atomic_fetch_add(T, 1ull, __ATOMIC_RELAXED, __HIP_MEMORY_SCOPE_AGENT);
      if ((unsigned)(oldt & 0xffffffffull) == nx - 1) {
        __hip_atomic_fetch_add(T, (1ull << 32) - (unsigned long long)nx, __ATOMIC_RELAXED, __HIP_MEMORY_SCOPE_AGENT);
      } else {
        const unsigned gt = (unsigned)(oldt >> 32);
        while ((unsigned)(__hip_atomic_load(T, __ATOMIC_RELAXED, __HIP_MEMORY_SCOPE_AGENT) >> 32) == gt) __builtin_amdgcn_s_sleep(1);
      }
      __hip_atomic_fetch_add(L, (1ull << 32) - (unsigned long long)nloc, __ATOMIC_RELAXED, __HIP_MEMORY_SCOPE_AGENT);
    } else {
      const unsigned g0 = (unsigned)(old >> 32);
      while ((unsigned)(__hip_atomic_load(L, __ATOMIC_RELAXED, __HIP_MEMORY_SCOPE_AGENT) >> 32) == g0) __builtin_amdgcn_s_sleep(1);
    }
    __builtin_amdgcn_fence(__ATOMIC_ACQUIRE, "agent");
    asm volatile("s_waitcnt vmcnt(0)" ::: "memory");
  }
  __syncthreads();
}

#ifdef SELFCHECK
__device__ __forceinline__ void cksum(const void* ptr, size_t bytes, unsigned long long* slot) {
  const u32x4* q = (const u32x4*)ptr;
  const size_t n = bytes / 16;
  unsigned long long s = 0;
  for (size_t i = (size_t)blockIdx.x * 256 + otid(); i < n; i += (size_t)gridDim.x * 256) {
    const u32x4 v = q[i];
    s += (unsigned long long)v.x + 3ull * v.y + 5ull * v.z + 7ull * v.w;
  }
  unsigned lo = (unsigned)s, hi = (unsigned)(s >> 32);
  unsigned long long t = s;
#pragma unroll
  for (int d = 32; d >= 1; d >>= 1) {
    const unsigned l2 = __shfl_xor((unsigned)t, d, 64), h2 = __shfl_xor((unsigned)(t >> 32), d, 64);
    t += ((unsigned long long)h2 << 32) | l2;
  }
  (void)lo; (void)hi;
  if ((otid() & 63) == 0) atomicAdd(slot, t);
}
#define CK(ptr, bytes) cksum((ptr), (bytes), slots + slot)
#else
#define CK(ptr, bytes) do {} while (0)
#endif

__device__ __forceinline__ void cksum_acc(const void* ptr, size_t bytes, unsigned long long& s) {
  const u32x4* q = (const u32x4*)ptr;
  const size_t n = bytes / 16;
  for (size_t i = ((size_t)blockIdx.x * 256 + otid()) * 64; i < n; i += (size_t)gridDim.x * 256 * 64) {
    const u32x4 v = __builtin_nontemporal_load(q + i);
    s += (unsigned long long)v.x + 3ull * v.y + 5ull * v.z + 7ull * v.w;
  }
}
__device__ __forceinline__ void cksum_commit(unsigned long long t, unsigned long long* slot) {
#pragma unroll
  for (int d = 32; d >= 1; d >>= 1) {
    const unsigned l2 = __shfl_xor((unsigned)t, d, 64), h2 = __shfl_xor((unsigned)(t >> 32), d, 64);
    t += ((unsigned long long)h2 << 32) | l2;
  }
  if ((otid() & 63) == 0) atomicAdd(slot, t);
}

__global__ void __launch_bounds__(256, 2) fwd_megakernel(Params p) {
  cg::grid_group grid = cg::this_grid();
  __shared__ __attribute__((aligned(16))) unsigned char smem_raw[SMEM_BYTES];
  bf16_t* smem = (bf16_t*)smem_raw;
  float* smf = (float*)smem_raw;
  const int G = gridDim.x, bid = blockIdx.x;
  unsigned* bar = (unsigned*)(p.ws + OFF_BAR);
  unsigned epoch = 0;
  volatile unsigned* bxs = (volatile unsigned*)(smem_raw + 73728 + 4096);
  if (otid() == 0) {
    const unsigned xc = xcc_id();
    bxs[0] = xc; bxs[1] = 0u; bxs[2] = 0u; bxs[3] = 0u;
    __hip_atomic_fetch_add((unsigned*)((unsigned char*)bar + 2048 + 128 * xc), 1u, __ATOMIC_RELAXED, __HIP_MEMORY_SCOPE_AGENT);
  }
  __syncthreads();
#ifdef START_DELAY_US
  {
    const unsigned long long t0 = __builtin_amdgcn_s_memrealtime();
    while (__builtin_amdgcn_s_memrealtime() - t0 < (unsigned long long)START_DELAY_US * 100ull) __builtin_amdgcn_s_sleep(20);
  }
#endif
  grid.sync();
#ifdef WCHECK
  unsigned wseen = 0;
  if (bid == 0 && otid() == 0) wseen = __hip_atomic_load(bar + 32, __ATOMIC_RELAXED, __HIP_MEMORY_SCOPE_AGENT);
#endif

#ifdef SELFCHECK
  unsigned long long* slots_base = (unsigned long long*)(p.ws + OFF_BAR + 256);
  if (bid == 0) for (int k = otid(); k < 768; k += 256) __hip_atomic_store(slots_base + k, 0ull, __ATOMIC_RELAXED, __HIP_MEMORY_SCOPE_AGENT);
  for (int run = 0; run < 3; ++run) {
  unsigned long long* slots = slots_base + run * 256;
  int slot = 0;
#endif
  {
    unsigned long long* sslots = (unsigned long long*)(p.ws + OFF_BAR + 1024);
    unsigned long long prev = 0;
    for (int iter = 0; iter < 64; ++iter) {
      unsigned long long s = 0;
      cksum_acc(p.out, (size_t)BATCH * SEQ * 1024 * 4, s);
      cksum_acc(p.ws, OFF_BAR, s);
      cksum_commit(s, sslots + iter);
      gsync_flat(bar);
      const unsigned long long c = __hip_atomic_load(sslots + iter, __ATOMIC_RELAXED, __HIP_MEMORY_SCOPE_AGENT);
      if (iter > 0 && c == prev) break;
      prev = c;
    }
  }
  {
    if (otid() == 0) {
      unsigned nl = 0, nxx = 0;
      const unsigned xc = bxs[0];
      for (int j = 0; j < 8; ++j) {
        const unsigned cj = __hip_atomic_load((unsigned*)((unsigned char*)bar + 2048 + 128 * j), __ATOMIC_RELAXED, __HIP_MEMORY_SCOPE_AGENT);
        nxx += (cj > 0u) ? 1u : 0u;
        nl = ((unsigned)j == xc) ? cj : nl;
      }
      bxs[1] = nl; bxs[2] = nxx; bxs[3] = 1u;
    }
    __syncthreads();
  }
  phase_prep(p, smf);
  gsync(grid, bar, epoch, bxs);
  phase_prep(p, smf);
#ifdef SELF_POISON
  {
    u32x4* q = (u32x4*)(p.ws + OFF_H);
    const size_t n16 = (WS_TOTAL - OFF_H) / 16;
    const u32x4 pv = {SELF_POISON, SELF_POISON, SELF_POISON, SELF_POISON};
    for (size_t i = (size_t)bid * 256 + otid(); i < n16; i += (size_t)G * 256) q[i] = pv;
  }
#endif
  gsync(grid, bar, epoch, bxs);
#ifdef SELFCHECK
  CK(p.ws, OFF_H); slot++;
#endif

  for (int layer = 0; layer < 2; ++layer) {
    const float* xin = (layer == 0) ? p.in[0] : p.out;
    float* xout = p.out;
    for (int round = 0; round < NROUND; ++round) {
      const size_t tok0 = (size_t)round * TR;
      if (layer == 0 && round == 0) {
        phase_hnorm(xin + tok0 * 1024, p.in[2] + layer * 1024, (bf16_t*)(p.ws + OFF_H));
        gsync(grid, bar, epoch, bxs);
      }
#ifdef SELFCHECK
      CK(p.ws + OFF_H, (size_t)TR * 1024 * 2); slot++;
#endif
#ifndef REP_B
#define REP_B 1
#endif
      for (int rep = 0; rep < REP_B; ++rep) {
      for (int it = bid; it < NRT * 76; it += G) inproj_tile(p, layer, it % NRT, it / NRT, smem);
      gsync(grid, bar, epoch, bxs);
      }
#ifdef SELFCHECK
      CK(p.ws + OFF_PROJ, (size_t)TR * D_INP * 2); CK(p.ws + OFF_VTA, (size_t)RB * 4 * 128 * 2048 * 2); slot++;
#endif
      {
        constexpr int n1 = 256, n2 = TR / 16, n3 = RB * 32 * 16, n4 = RB * 16 * 8 / 4;
        for (int it = bid; it < n1 + n2 + n3 + n4; it += G) {
          if (it < n1) s5_e_item(p, layer, it, smem);
          else if (it < n1 + n2) tokpost_item(p, layer, round, it - n1);
          else if (it < n1 + n2 + n3) conv_item(p, layer, it - n1 - n2);
          else dtacum_item(p, layer, it - n1 - n2 - n3);
        }
      }
      gsync(grid, bar, epoch, bxs);
#ifdef SELFCHECK
      CK(p.ws + OFF_PROJ, (size_t)TR * D_INP * 2); CK(p.ws + OFF_E, (size_t)32 * 128 * NBC * 4); CK(p.ws + OFF_XC, (size_t)TR * 1024 * 2);
      CK(p.ws + OFF_DT, (size_t)TR * 8 * 4); CK(p.ws + OFF_ACUM, (size_t)TR * 8 * 4); slot++;
#endif
      {
        constexpr int n1 = NRT * 6, n2 = NRT * 8, n3 = RB * 16 * 8, n4 = RB * 32 * 64 / 256;
        for (int it = bid; it < n1 + n2 + n3 + n4; it += G) {
          if (it < n1) mla_up_q_tile(p, layer, it % NRT, it / NRT, smem);
          else if (it < n1 + n2) mla_up_kv_tile(p, layer, (it - n1) % NRT, (it - n1) / NRT, smem);
          else if (it < n1 + n2 + n3) mb_states_item(p, it - n1 - n2, smem);
          else s5_carry_item(p, layer, it - n1 - n2 - n3);
        }
      }
      gsync(grid, bar, epoch, bxs);
#ifdef SELFCHECK
      CK(p.ws + OFF_QM, (size_t)TR * 768 * 2); CK(p.ws + OFF_KN, (size_t)TR * 512 * 2); CK(p.ws + OFF_VTD, (size_t)RB * 4 * 128 * 2048 * 2);
      CK(p.ws + OFF_ST, (size_t)RB * 16 * 8 * 8192 * 4); CK(p.ws + OFF_HIN, (size_t)32 * 128 * NBC * 2); slot++;
#endif
      {
        constexpr int n1 = 256, n2 = TR / 16, n3 = RB * 8 * 8192 / 256;
        for (int it = bid; it < n1 + n2 + n3; it += G) {
          if (it < n1) s5_y_item(p, layer, it, smem);
          else if (it < n1 + n2) mlapost_item(p, layer, round, it - n1);
          else mb_scan_item(p, it - n1 - n2);
        }
      }
      gsync(grid, bar, epoch, bxs);
#ifdef SELFCHECK
      CK(p.ws + OFF_YG, (size_t)TR * 512 * 2); CK(p.ws + OFF_QM, (size_t)TR * 768 * 2); CK(p.ws + OFF_KM, (size_t)TR * 768 * 2);
      CK(p.ws + OFF_SIN, (size_t)RB * 16 * 8 * 8192 * 2); slot++;
#endif
#ifdef REP_ATT
      {
        constexpr int nat = RB * 4 * 32 * 2;
        for (int it = bid; it < nat; it += G) {
            const int half = nat / 2;
            const int qb = (it < half) ? (31 - it / 32) : ((it - half) / 32);
            const int sub = it & 31;
            if (sub < 16) da_attn_item(p, layer, sub, qb, smem, true);
            else mla_attn_item(p, sub - 16, qb, smem, true);
        }
        gsync(grid, bar, epoch, bxs);
      }
#endif
      {
        constexpr int nat = RB * 4 * 32 * 2;
        constexpr int n3 = RB * 16 * 2, n4 = NRT * 4;
        const int nmb = (G > n3 + 64) ? n3 : 0;
        if (bid < nmb) {
          mb_out_item(p, layer, bid, smem);
        } else {
          const int j = bid - nmb, W = G - nmb;
          if (nmb == 0) for (int it = bid; it < n3; it += G) mb_out_item(p, layer, it, smem);
          for (int r = 0; r * W < nat; ++r) {
            const int k = (r & 1) ? ((r + 1) * W - 1 - j) : (r * W + j);
            if (k < nat) {
              const int qb = 31 - (k >> 5), sub = k & 31;
              if (sub < 16) da_attn_item(p, layer, sub, qb, smem);
              else mla_attn_item(p, sub - 16, qb, smem);
            }
          }
          for (int t = W - 1 - j; t < n4; t += W) s5_glu_tile(p, layer, t % NRT, t / NRT, smem);
        }
      }
      gsync(grid, bar, epoch, bxs);
#ifdef SELFCHECK
      CK(p.ws + OFF_PROJ, (size_t)TR * D_INP * 2); slot++;
#endif
      for (int it = bid; it < NRT * 16; it += G) merge_tile(p, layer, it % NRT, it / NRT, smem);
      gsync(grid, bar, epoch, bxs);
#ifdef SELFCHECK
      CK(p.ws + OFF_MERGED, (size_t)TR * 1024 * 2); slot++;
#endif
      for (int it = bid; it < NRT * 8; it += G) out_tile(p, layer, xin + tok0 * 1024, xout + tok0 * 1024, it % NRT, it / NRT, smem);
      {
        const int nl = (round + 1 < NROUND) ? layer : layer + 1;
        const int nr = (round + 1 < NROUND) ? round + 1 : 0;
        if (nl < 2) {
          const float* nx = (nl == 0) ? p.in[0] : p.out;
          phase_hnorm(nx + (size_t)nr * TR * 1024, p.in[2] + nl * 1024, (bf16_t*)(p.ws + OFF_H));
        }
      }
      gsync(grid, bar, epoch, bxs);
#ifdef SELFCHECK
      CK(xout + tok0 * 1024, (size_t)TR * 1024 * 4); slot++;
#endif
    }
  }
#ifdef WCHECK
  if (bid == 0 && otid() == 0) {
    if (wseen != 0) p.out[0] = 1.0e6f;
    __hip_atomic_store(bar + 32, 1u, __ATOMIC_RELAXED, __HIP_MEMORY_SCOPE_AGENT);
  }
#endif
#ifdef SELFCHECK
  gsync(grid, bar, epoch, bxs);
  }
  gsync(grid, bar, epoch, bxs);
  if (bid == 0 && otid() == 0) {
    int bad = -1;
    for (int k = 0; k < 100; ++k) {
      const unsigned long long a = __hip_atomic_load(slots_base + k, __ATOMIC_RELAXED, __HIP_MEMORY_SCOPE_AGENT);
      const unsigned long long b = __hip_atomic_load(slots_base + 256 + k, __ATOMIC_RELAXED, __HIP_MEMORY_SCOPE_AGENT);
      const unsigned long long c = __hip_atomic_load(slots_base + 512 + k, __ATOMIC_RELAXED, __HIP_MEMORY_SCOPE_AGENT);
      if (a != b || a != c) { bad = k; break; }
    }
    if (bad >= 0) p.out[0] = 10000.0f * exp2f((float)bad);
  }
#endif
}

extern "C" void kernel_launch(void* const* d_in, const int* in_sizes, int n_in, void* d_out,
                              int out_size, void* d_ws, size_t ws_size, hipStream_t stream) {
  static int grid_blocks = 0;
  if (!grid_blocks) {
    int dev = 0, cus = 0, per_cu = 0;
    (void)hipGetDevice(&dev);
    (void)hipDeviceGetAttribute(&cus, hipDeviceAttributeMultiprocessorCount, dev);
    (void)hipOccupancyMaxActiveBlocksPerMultiprocessor(&per_cu, fwd_megakernel, 256, 0);
    if (per_cu > 2) per_cu = 2;
    if (per_cu < 1) per_cu = 1;
    grid_blocks = cus * per_cu;
    if (grid_blocks > MAXBLK) grid_blocks = MAXBLK;
  }
  if (ws_size < WS_TOTAL) fprintf(stderr, "workspace too small: %zu < %zu\n", ws_size, (size_t)WS_TOTAL);
  Params p{};
  for (int i = 0; i < 35; ++i) p.in[i] = (const float*)d_in[i];
  p.out = (float*)d_out;
  p.ws = (unsigned char*)d_ws;
  (void)hipMemsetAsync((unsigned char*)d_ws + OFF_BAR, 0, 8192, stream);
  void* args[] = {&p};
  hipError_t e = hipLaunchCooperativeKernel((void*)fwd_megakernel, dim3(grid_blocks), dim3(256), args, 0, stream);
  if (e != hipSuccess) fprintf(stderr, "cooperative launch failed: %s (grid %d)\n", hipGetErrorString(e), grid_blocks);
}
```

```cpp
#include <hip/hip_runtime.h>
#include <hip/hip_cooperative_groups.h>
#include <cstdio>
#include <cstdint>
namespace cg = cooperative_groups;

typedef unsigned short bf16_t;
typedef short bf16x8 __attribute__((ext_vector_type(8)));
typedef float f32x4 __attribute__((ext_vector_type(4)));
typedef unsigned u32x4 __attribute__((ext_vector_type(4)));
typedef unsigned u32x2 __attribute__((ext_vector_type(2)));

constexpr int SEQ = 2048, BATCH = 16;
constexpr int D_IN = 9672, D_INP = 9728;
constexpr int RB = 4;
constexpr int TR = RB * SEQ;
constexpr int NROUND = BATCH / RB;
constexpr int NRT = TR / 128;
constexpr int NBC = TR / 8;
constexpr int MAXBLK = 512;
constexpr float EPS = 1e-6f;
constexpr float LOG2E = 1.4426950408889634f;
constexpr int C_DAQ = 0, C_DAK = 512, C_DAV = 1024, C_DAG = 1536, C_MBZ = 2048, C_XBC = 2560, C_DT = 3584,
              C_S5U = 3592, C_S5G = 4104, C_CQ = 4616, C_CKV = 4872, C_KR = 5000, C_MLG = 5064, C_GATE = 5576;
constexpr long LDP = D_INP;

constexpr size_t al256(size_t x) { return (x + 255) & ~size_t(255); }
constexpr size_t OFF_WINT = 0;
constexpr size_t OFF_WBRT = OFF_WINT + al256((size_t)2 * D_INP * 1024 * 2);
constexpr size_t OFF_WOUTT = OFF_WBRT + al256((size_t)2 * 4 * 1024 * 512 * 2);
constexpr size_t OFF_WGLUT = OFF_WOUTT + al256((size_t)2 * 1024 * 1024 * 2);
constexpr size_t OFF_WUQT = OFF_WGLUT + al256((size_t)2 * 512 * 512 * 2);
constexpr size_t OFF_WUKVT = OFF_WUQT + al256((size_t)2 * 768 * 256 * 2);
constexpr size_t OFF_KMAT = OFF_WUKVT + al256((size_t)2 * 1024 * 128 * 2);
constexpr size_t OFF_EMAT = OFF_KMAT + al256((size_t)2 * 32 * 128 * 128 * 2);
constexpr size_t OFF_FMAT = OFF_EMAT + al256((size_t)2 * 32 * 128 * 128 * 2);
constexpr size_t OFF_A8 = OFF_FMAT + al256((size_t)2 * 32 * 128 * 128 * 2);
constexpr size_t OFF_LAM = OFF_A8 + al256((size_t)2 * 32 * 64 * 2 * 4);
constexpr size_t OFF_H = OFF_LAM + 256;
constexpr size_t OFF_PROJ = OFF_H + al256((size_t)TR * 1024 * 2);
constexpr size_t OFF_XC = OFF_PROJ + al256((size_t)TR * D_INP * 2);
constexpr size_t OFF_DT = OFF_XC + al256((size_t)TR * 1024 * 2);
constexpr size_t OFF_ACUM = OFF_DT + al256((size_t)TR * 8 * 4);
constexpr size_t OFF_VTA = OFF_ACUM + al256((size_t)TR * 8 * 4);
constexpr size_t OFF_VTD = OFF_VTA + al256((size_t)RB * 4 * 128 * 2048 * 2);
constexpr size_t OFF_QM = OFF_VTD + al256((size_t)RB * 4 * 128 * 2048 * 2);
constexpr size_t OFF_KM = OFF_QM + al256((size_t)TR * 768 * 2);
constexpr size_t OFF_KN = OFF_KM + al256((size_t)TR * 768 * 2);
constexpr size_t OFF_ST = OFF_KN + al256((size_t)TR * 512 * 2);
constexpr size_t OFF_SIN = OFF_ST + al256((size_t)RB * 16 * 8 * 8192 * 4);
constexpr size_t OFF_MS = OFF_SIN + al256((size_t)RB * 16 * 8 * 8192 * 2);
constexpr size_t OFF_XS = OFF_MS + al256((size_t)MAXBLK * 4 * 128 * 128 * 2);
constexpr size_t OFF_E = OFF_XS + al256((size_t)MAXBLK * 128 * 64 * 2);
constexpr size_t OFF_HIN = OFF_E + al256((size_t)32 * 128 * NBC * 4);
constexpr size_t OFF_YG = OFF_HIN + al256((size_t)32 * 128 * NBC * 2);
constexpr size_t OFF_MERGED = OFF_YG + al256((size_t)TR * 512 * 2);
constexpr size_t OFF_QK = OFF_MERGED + al256((size_t)TR * 1024 * 2);
constexpr size_t OFF_CQ2 = OFF_QK + al256((size_t)TR * 1024 * 2);
constexpr size_t OFF_QM2 = OFF_CQ2 + al256((size_t)TR * 384 * 2);
constexpr size_t OFF_BAR = OFF_QM2 + al256((size_t)TR * 768 * 2);
constexpr size_t WS_TOTAL = OFF_BAR + 8192;

constexpr int SMEM_BYTES = 73728 + 4096 + 64;

struct Params {
  const float* in[35];
  float* out;
  unsigned char* ws;
};

#define MEMBAR() do { asm volatile("" ::: "memory"); __builtin_amdgcn_sched_barrier(0); } while (0)
__device__ __forceinline__ int otid() { int t = threadIdx.x; asm volatile("" : "+v"(t)); return t; }
__device__ __forceinline__ bf16_t f2bf(float f) {
  unsigned u = __float_as_uint(f);
  u += 0x7fffu + ((u >> 16) & 1u);
  return (bf16_t)(u >> 16);
}
__device__ __forceinline__ float bf2f(bf16_t b) { return __uint_as_float(((unsigned)b) << 16); }
__device__ __forceinline__ unsigned pack2(float a, float b) { return (unsigned)f2bf(a) | ((unsigned)f2bf(b) << 16); }
__device__ __forceinline__ float sigmoidf_(float x) { return 1.0f / (1.0f + __expf(-x)); }
__device__ __forceinline__ float siluf_(float x) { return x / (1.0f + __expf(-x)); }
__device__ __forceinline__ float gelu_tanh(float x) {
  float u = 0.7978845608028654f * (x + 0.044715f * x * x * x);
  float t = 1.0f - 2.0f / (__expf(2.0f * u) + 1.0f);
  return 0.5f * x * (1.0f + t);
}
__device__ __forceinline__ float wave_sum(float v) {
#pragma unroll
  for (int d = 32; d >= 1; d >>= 1) v += __shfl_xor(v, d, 64);
  return v;
}

__device__ __forceinline__ void block_global_handoff() {
  asm volatile("s_waitcnt vmcnt(0)" ::: "memory");
  __syncthreads();
  if (otid() < 64) {
    __builtin_amdgcn_fence(__ATOMIC_ACQUIRE, "agent");
    asm volatile("s_waitcnt vmcnt(0)" ::: "memory");
  }
  __syncthreads();
}
template <int R, bool T, bool SEG, int N>
__device__ __forceinline__ void g_load(u32x4 (&rg)[N], const bf16_t* __restrict__ P, long ld, int k0, long segs, int tid) {
#pragma unroll
  for (int i = 0; i < N; ++i) {
    const int ch = tid + i * 256;
    if (!T) {
      const int row = ch >> 3, kc = k0 + (ch & 7) * 8;
      const long ko = SEG ? ((long)(kc >> 4) * segs + (kc & 15)) : (long)kc;
      rg[i] = *(const u32x4*)(P + (long)row * ld + ko);
    } else {
      constexpr int CPR = R / 8;
      const int kk = ch / CPR, m0 = (ch % CPR) * 8;
      rg[i] = *(const u32x4*)(P + (long)(k0 + kk) * ld + m0);
    }
  }
}
template <int R, bool T, int N>
__device__ __forceinline__ void s_store(const u32x4 (&rg)[N], bf16_t* sm, int tid) {
  constexpr int LS = 72;
#pragma unroll
  for (int i = 0; i < N; ++i) {
    const int ch = tid + i * 256;
    if (!T) {
      const int row = ch >> 3, kc = (ch & 7) * 8;
      *(u32x4*)(sm + row * LS + kc) = rg[i];
    } else {
      constexpr int CPR = R / 8;
      const int kk = ch / CPR, m0 = (ch % CPR) * 8;
      bf16_t* d = sm + m0 * LS + kk;
      d[0 * LS] = (bf16_t)(rg[i].x & 0xffffu); d[1 * LS] = (bf16_t)(rg[i].x >> 16);
      d[2 * LS] = (bf16_t)(rg[i].y & 0xffffu); d[3 * LS] = (bf16_t)(rg[i].y >> 16);
      d[4 * LS] = (bf16_t)(rg[i].z & 0xffffu); d[5 * LS] = (bf16_t)(rg[i].z >> 16);
      d[6 * LS] = (bf16_t)(rg[i].w & 0xffffu); d[7 * LS] = (bf16_t)(rg[i].w >> 16);
    }
  }
}
template <int BN>
__device__ __forceinline__ void mfma_stage(f32x4 (&acc)[4][BN / 32], const bf16_t* sA, const bf16_t* sB, int wr, int wc, int g, int c) {
  constexpr int LS = 72;
  const bf16_t* pa = sA + (wr * 64 + c) * LS + g * 8;
  const bf16_t* pb = sB + (wc * (BN / 2) + c) * LS + g * 8;
#pragma unroll
  for (int ks = 0; ks < 2; ++ks) {
    bf16x8 af[4], bfr[BN / 32];
#pragma unroll
    for (int i = 0; i < 4; ++i) af[i] = *(const bf16x8*)(pa + i * 16 * LS + ks * 32);
#pragma unroll
    for (int j = 0; j < BN / 32; ++j) bfr[j] = *(const bf16x8*)(pb + j * 16 * LS + ks * 32);
#pragma unroll
    for (int i = 0; i < 4; ++i)
#pragma unroll
      for (int j = 0; j < BN / 32; ++j) acc[i][j] = __builtin_amdgcn_mfma_f32_16x16x32_bf16(af[i], bfr[j], acc[i][j], 0, 0, 0);
  }
}
template <int BN, bool TA, bool TB, bool SEGA>
__device__ __forceinline__ void gemm_tile(f32x4 (&acc)[4][BN / 32], const bf16_t* __restrict__ A, long lda,
                                          const bf16_t* __restrict__ B, long ldb, int K, bf16_t* smem, long segs = 0) {
  constexpr int LS = 72;
  constexpr int STAGE = 2 * 128 * LS;
  const int tid = otid(), w = tid >> 6, l = tid & 63, g = l >> 4, c = l & 15;
  const int wr = w >> 1, wc = w & 1;
  constexpr int NA = 4, NB = BN / 32;
  u32x4 ra0[NA], rb0[NB], ra1[NA], rb1[NB];
  const int nk = K / 64;
  bf16_t* s0A = smem;
  bf16_t* s0B = smem + 128 * LS;
  bf16_t* s1A = smem + STAGE;
  bf16_t* s1B = smem + STAGE + 128 * LS;
  g_load<128, TA, SEGA, NA>(ra0, A, lda, 0, segs, tid);
  g_load<BN, TB, false, NB>(rb0, B, ldb, 0, 0, tid);
  g_load<128, TA, SEGA, NA>(ra1, A, lda, 64, segs, tid);
  g_load<BN, TB, false, NB>(rb1, B, ldb, 64, 0, tid);
  __syncthreads();
  s_store<128, TA, NA>(ra0, s0A, tid);
  s_store<BN, TB, NB>(rb0, s0B, tid);
  __syncthreads();
  for (int kt = 0; kt < nk; kt += 2) {
    if (kt + 2 < nk) {
      g_load<128, TA, SEGA, NA>(ra0, A, lda, (kt + 2) * 64, segs, tid);
      g_load<BN, TB, false, NB>(rb0, B, ldb, (kt + 2) * 64, 0, tid);
    }
    mfma_stage<BN>(acc, s0A, s0B, wr, wc, g, c);
    s_store<128, TA, NA>(ra1, s1A, tid);
    s_store<BN, TB, NB>(rb1, s1B, tid);
    __syncthreads();
    if (kt + 3 < nk) {
      g_load<128, TA, SEGA, NA>(ra1, A, lda, (kt + 3) * 64, segs, tid);
      g_load<BN, TB, false, NB>(rb1, B, ldb, (kt + 3) * 64, 0, tid);
    }
    mfma_stage<BN>(acc, s1A, s1B, wr, wc, g, c);
    if (kt + 2 < nk) {
      s_store<128, TA, NA>(ra0, s0A, tid);
      s_store<BN, TB, NB>(rb0, s0B, tid);
    }
    __syncthreads();
  }
}

template <int NJ>
__device__ __forceinline__ void zero_acc(f32x4 (&acc)[4][NJ]) {
#pragma unroll
  for (int i = 0; i < 4; ++i)
#pragma unroll
    for (int j = 0; j < NJ; ++j) acc[i][j] = (f32x4){0.f, 0.f, 0.f, 0.f};
}

__device__ __forceinline__ void tconv_tile(const float* __restrict__ src, bf16_t* __restrict__ dst, int K, int N, int tk, int tn, float* sm) {
  const int tid = otid();
  const int k0 = tk * 64, n0 = tn * 64;
  __syncthreads();
#pragma unroll 4
  for (int i = 0; i < 16; ++i) {
    const int kk = i * 4 + (tid >> 6), nn = tid & 63;
    float v = 0.f;
    if (n0 + nn < N) v = src[(long)(k0 + kk) * N + n0 + nn];
    sm[kk * 65 + nn] = v;
  }
  __syncthreads();
#pragma unroll 4
  for (int i = 0; i < 16; ++i) {
    const int nn = i * 4 + (tid >> 6), kk = tid & 63;
    dst[(long)(n0 + nn) * K + k0 + kk] = f2bf(sm[kk * 65 + nn]);
  }
}

__device__ __forceinline__ void tconv_job(const float* src, bf16_t* dst, int K, int N, int Npad, float* sm) {
  const int tkn = K / 64, tnn = Npad / 64;
  for (int t = blockIdx.x; t < tkn * tnn; t += gridDim.x) tconv_tile(src, dst, K, N, t % tkn, t / tkn, sm);
}

__device__ __forceinline__ void s5_prep(const Params& p, int layer, int grp, float* sm) {
  float* pwr = sm;
  float* pwi = pwr + 9 * 64;
  float* bbr = pwi + 9 * 64;
  float* bbi = bbr + 1024;
  float* cr = bbi + 1024;
  float* ci = cr + 1024;
  float* kt = ci + 1024;
  const int tid = otid();
  const int lg = layer * 32 + grp;
  __syncthreads();
  if (tid < 64) {
    const int pp = tid;
    const double step = exp((double)p.in[19][lg]);
    const double lr = (double)p.in[17][lg * 64 + pp], li = (double)p.in[18][lg * 64 + pp];
    const double mag = exp(lr * step);
    const double abr = mag * cos(li * step), abi = mag * sin(li * step);
    const double den = lr * lr + li * li;
    const double fr = ((abr - 1.0) * lr + abi * li) / den;
    const double fi = (abi * lr - (abr - 1.0) * li) / den;
    double qr = 1.0, qi = 0.0;
    for (int t = 0; t < 9; ++t) {
      pwr[t * 64 + pp] = (float)qr;
      pwi[t * 64 + pp] = (float)qi;
      const double nr = qr * abr - qi * abi, ni = qr * abi + qi * abr;
      qr = nr; qi = ni;
    }
    float* a8 = (float*)(p.ws + OFF_A8) + (size_t)(lg * 64 + pp) * 2;
    a8[0] = pwr[8 * 64 + pp];
    a8[1] = pwi[8 * 64 + pp];
    for (int cc = 0; cc < 16; ++cc) {
      const double br = (double)p.in[20][(lg * 64 + pp) * 16 + cc], bi = (double)p.in[21][(lg * 64 + pp) * 16 + cc];
      bbr[pp * 16 + cc] = (float)(fr * br - fi * bi);
      bbi[pp * 16 + cc] = (float)(fr * bi + fi * br);
    }
  }
  for (int e = tid; e < 1024; e += 256) {
    cr[e] = p.in[22][lg * 1024 + e];
    ci[e] = p.in[23][lg * 1024 + e];
  }
  __syncthreads();
  for (int e = tid; e < 2048; e += 256) {
    const int tau = e >> 8, co = (e >> 4) & 15, cin = e & 15;
    float s = 0.f;
    for (int pp = 0; pp < 64; ++pp) {
      const float pr = pwr[tau * 64 + pp], pi = pwi[tau * 64 + pp];
      const float zr = pr * bbr[pp * 16 + cin] - pi * bbi[pp * 16 + cin];
      const float zi = pr * bbi[pp * 16 + cin] + pi * bbr[pp * 16 + cin];
      s += cr[co * 64 + pp] * zr - ci[co * 64 + pp] * zi;
    }
    kt[e] = s;
  }
  __syncthreads();
  bf16_t* Km = (bf16_t*)(p.ws + OFF_KMAT) + (size_t)lg * 16384;
  bf16_t* Em = (bf16_t*)(p.ws + OFF_EMAT) + (size_t)lg * 16384;
  bf16_t* Fm = (bf16_t*)(p.ws + OFF_FMAT) + (size_t)lg * 16384;
  for (int e = tid; e < 16384; e += 256) {
    const int n = e >> 7, k = e & 127;
    {
      const int tq = n >> 4, co = n & 15, sq = k >> 4, cin = k & 15;
      Km[e] = f2bf(tq >= sq ? kt[((tq - sq) * 16 + co) * 16 + cin] : 0.f);
    }
    {
      const int pp = n >> 1, ri = n & 1, sq = k >> 4, cin = k & 15;
      const float pr = pwr[(7 - sq) * 64 + pp], pi = pwi[(7 - sq) * 64 + pp];
      const float zr = pr * bbr[pp * 16 + cin] - pi * bbi[pp * 16 + cin];
      const float zi = pr * bbi[pp * 16 + cin] + pi * bbr[pp * 16 + cin];
      Em[e] = f2bf(ri ? zi : zr);
    }
    {
      const int tq = n >> 4, co = n & 15, pp = k >> 1, ri = k & 1;
      const float pr = pwr[(tq + 1) * 64 + pp], pi = pwi[(tq + 1) * 64 + pp];
      const float gr = cr[co * 64 + pp] * pr - ci[co * 64 + pp] * pi;
      const float gi = cr[co * 64 + pp] * pi + ci[co * 64 + pp] * pr;
      Fm[e] = f2bf(ri ? -gi : gr);
    }
  }
}

__device__ __forceinline__ void phase_prep(const Params& p, float* smf) {
  for (int L = 0; L < 2; ++L) {
    tconv_job(p.in[3] + (size_t)L * 1024 * D_IN, (bf16_t*)(p.ws + OFF_WINT) + (size_t)L * D_INP * 1024, 1024, D_IN, D_INP, smf);
    for (int n = 0; n < 4; ++n)
      tconv_job(p.in[33] + (size_t)(L * 4 + n) * 512 * 1024, (bf16_t*)(p.ws + OFF_WBRT) + (size_t)(L * 4 + n) * 1024 * 512, 512, 1024, 1024, smf);
    tconv_job(p.in[34] + (size_t)L * 1024 * 1024, (bf16_t*)(p.ws + OFF_WOUTT) + (size_t)L * 1024 * 1024, 1024, 1024, 1024, smf);
    tconv_job(p.in[25] + (size_t)L * 512 * 512, (bf16_t*)(p.ws + OFF_WGLUT) + (size_t)L * 512 * 512, 512, 512, 512, smf);
    tconv_job(p.in[28] + (size_t)L * 256 * 768, (bf16_t*)(p.ws + OFF_WUQT) + (size_t)L * 768 * 256, 256, 768, 768, smf);
    tconv_job(p.in[30] + (size_t)L * 128 * 1024, (bf16_t*)(p.ws + OFF_WUKVT) + (size_t)L * 1024 * 128, 128, 1024, 1024, smf);
  }
  for (int it = blockIdx.x; it < 64; it += gridDim.x) s5_prep(p, it >> 5, it & 31, smf);
  if (blockIdx.x == gridDim.x - 1 && otid() < 2) {
    const int L = otid();
    float s1 = 0.f, s2 = 0.f;
    for (int i = 0; i < 64; ++i) {
      s1 += p.in[6][L * 64 + i] * p.in[7][L * 64 + i];
      s2 += p.in[8][L * 64 + i] * p.in[9][L * 64 + i];
    }
    const float li = 0.8f - 0.6f * expf(-0.3f * (float)L);
    ((float*)(p.ws + OFF_LAM))[L] = expf(s1) - expf(s2) + li;
  }
}

__device__ __forceinline__ void phase_hnorm(const float* __restrict__ x, const float* __restrict__ gn, bf16_t* __restrict__ H) {
  const int w = otid() >> 6, l = otid() & 63;
  for (int row = blockIdx.x * 4 + w; row < TR; row += gridDim.x * 4) {
    const float4* xr = (const float4*)(x + (size_t)row * 1024);
    float4 v[4];
    float ss = 0.f;
#pragma unroll
    for (int i = 0; i < 4; ++i) {
      v[i] = xr[i * 64 + l];
      ss += v[i].x * v[i].x + v[i].y * v[i].y + v[i].z * v[i].z + v[i].w * v[i].w;
    }
    ss = wave_sum(ss);
    const float rs = rsqrtf(ss * (1.0f / 1024.0f) + EPS);
#pragma unroll
    for (int i = 0; i < 4; ++i) {
      const float4 gg = ((const float4*)gn)[i * 64 + l];
      u32x2 o;
      o.x = pack2(v[i].x * rs * gg.x, v[i].y * rs * gg.y);
      o.y = pack2(v[i].z * rs * gg.z, v[i].w * rs * gg.w);
      *(u32x2*)(H + (size_t)row * 1024 + (i * 64 + l) * 4) = o;
    }
  }
}

__device__ __forceinline__ void inproj_tile(const Params& p, int layer, int rt, int ct, bf16_t* smem) {
  const bf16_t* H = (const bf16_t*)(p.ws + OFF_H);
  const bf16_t* W = (const bf16_t*)(p.ws + OFF_WINT) + (size_t)layer * D_INP * 1024;
  bf16_t* PROJ = (bf16_t*)(p.ws + OFF_PROJ);
  bf16_t* VTA = (bf16_t*)(p.ws + OFF_VTA);
  f32x4 acc[4][4];
  zero_acc<4>(acc);
  gemm_tile<128, false, false, false>(acc, H + (size_t)rt * 128 * 1024, 1024, W + (size_t)ct * 128 * 1024, 1024, 1024, smem);
  const int tid = otid(), w = tid >> 6, l = tid & 63, g = l >> 4, c = l & 15, wr = w >> 1, wc = w & 1;
  const int c0 = ct * 128;
  if (c0 >= C_DAV && c0 < C_DAG) {
    const int h = (c0 - C_DAV) >> 7;
#pragma unroll
    for (int i = 0; i < 4; ++i)
#pragma unroll
      for (int j = 0; j < 4; ++j) {
        const int row = rt * 128 + wr * 64 + i * 16 + g * 4;
        const int dv = wc * 64 + j * 16 + c;
        const int b = row >> 11, s = row & 2047;
        u32x2 o;
        o.x = pack2(acc[i][j][0], acc[i][j][1]);
        o.y = pack2(acc[i][j][2], acc[i][j][3]);
        *(u32x2*)(VTA + ((size_t)((b * 4 + h) * 128 + dv)) * 2048 + s) = o;
      }
  } else {
#pragma unroll
    for (int i = 0; i < 4; ++i) {
#pragma unroll
      for (int r = 0; r < 4; ++r) {
        const int row = rt * 128 + wr * 64 + i * 16 + g * 4 + r;
        bf16_t* rp = PROJ + (size_t)row * LDP + c0 + wc * 64 + c;
#pragma unroll
        for (int j = 0; j < 4; ++j) {
          float v = acc[i][j][r];
          if (c0 + wc * 64 + j * 16 + c >= C_GATE) v = sigmoidf_(v);
          rp[j * 16] = f2bf(v);
        }
      }
      MEMBAR();
    }
  }
}

__device__ __forceinline__ void tokpost_item(const Params& p, int layer, int round, int item) {
  bf16_t* PROJ = (bf16_t*)(p.ws + OFF_PROJ);
  const int* pos = (const int*)p.in[1];
  const int w = otid() >> 6, l = otid() & 63;
  for (int tt = 0; tt < 4; ++tt) {
    const int row = item * 16 + w * 4 + tt;
    const float fpos = (float)pos[round * TR + row];
    bf16_t* pr = PROJ + (size_t)row * LDP;
    {
      const int which = l >> 5, idx = (l & 31) * 16, off = (l & 3) * 16;
      bf16_t* ptr = pr + which * 512 + idx;
      u32x4 u0 = *(const u32x4*)ptr, u1 = *(const u32x4*)(ptr + 8);
      const unsigned uu[8] = {u0.x, u0.y, u0.z, u0.w, u1.x, u1.y, u1.z, u1.w};
      float v[16];
      float ss = 0.f;
#pragma unroll
      for (int e = 0; e < 8; ++e) {
        v[2 * e] = __uint_as_float(uu[e] << 16);
        v[2 * e + 1] = __uint_as_float(uu[e] & 0xffff0000u);
        ss += v[2 * e] * v[2 * e] + v[2 * e + 1] * v[2 * e + 1];
      }
      ss += __shfl_xor(ss, 1, 64);
      ss += __shfl_xor(ss, 2, 64);
      const float rs = rsqrtf(ss * (1.0f / 64.0f) + EPS);
      const float* gn = (which ? p.in[5] : p.in[4]) + layer * 64 + off;
#pragma unroll
      for (int e = 0; e < 16; ++e) v[e] = v[e] * rs * gn[e];
      if ((l & 3) == 0) {
#pragma unroll
        for (int i = 0; i < 8; ++i) {
          const float invf = expf(-13.122363377404328f * (float)i * 0.125f);
          const float ang = fpos * invf;
          const float cs = cosf(ang), sn = sinf(ang);
          const float x1 = v[i], x2 = v[i + 8];
          v[i] = x1 * cs - x2 * sn;
          v[i + 8] = x2 * cs + x1 * sn;
        }
      }
      if (which == 0) {
#pragma unroll
        for (int e = 0; e < 16; ++e) v[e] *= 0.125f * LOG2E;
      }
      u32x4 o0, o1;
      o0.x = pack2(v[0], v[1]); o0.y = pack2(v[2], v[3]); o0.z = pack2(v[4], v[5]); o0.w = pack2(v[6], v[7]);
      o1.x = pack2(v[8], v[9]); o1.y = pack2(v[10], v[11]); o1.z = pack2(v[12], v[13]); o1.w = pack2(v[14], v[15]);
      bf16_t* qko = (bf16_t*)(p.ws + OFF_QK) + (size_t)row * 1024 + which * 512 + idx;
      *(u32x4*)qko = o0;
      *(u32x4*)(qko + 8) = o1;
    }
    {
      bf16_t* ptr = pr + C_CQ + l * 4;
      u32x2 u = *(const u32x2*)ptr;
      float v0 = __uint_as_float(u.x << 16), v1 = __uint_as_float(u.x & 0xffff0000u);
      float v2 = __uint_as_float(u.y << 16), v3 = __uint_as_float(u.y & 0xffff0000u);
      float ss = wave_sum(v0 * v0 + v1 * v1 + v2 * v2 + v3 * v3);
      const float rs = rsqrtf(ss * (1.0f / 256.0f) + EPS);
      const float* gn = p.in[27] + layer * 256 + l * 4;
      u32x2 o;
      o.x = pack2(v0 * rs * gn[0], v1 * rs * gn[1]);
      o.y = pack2(v2 * rs * gn[2], v3 * rs * gn[3]);
      *(u32x2*)((bf16_t*)(p.ws + OFF_CQ2) + (size_t)row * 384 + l * 4) = o;
    }
    {
      bf16_t* ptr = pr + C_CKV + l * 2;
      unsigned u = *(const unsigned*)ptr;
      float v0 = __uint_as_float(u << 16), v1 = __uint_as_float(u & 0xffff0000u);
      float ss = wave_sum(v0 * v0 + v1 * v1);
      const float rs = rsqrtf(ss * (1.0f / 128.0f) + EPS);
      const float* gn = p.in[29] + layer * 128 + l * 2;
      *(unsigned*)((bf16_t*)(p.ws + OFF_CQ2) + (size_t)row * 384 + 256 + l * 2) = pack2(v0 * rs * gn[0], v1 * rs * gn[1]);
    }
  }
}

__device__ __forceinline__ void conv_item(const Params& p, int layer, int item) {
  const bf16_t* PROJ = (const bf16_t*)(p.ws + OFF_PROJ);
  bf16_t* XC = (bf16_t*)(p.ws + OFF_XC);
  const int chtile = item & 15, tt = (item >> 4) & 31, b = item >> 9;
  const int ch = chtile * 64 + (otid() & 63);
  const int tr0 = otid() >> 6;
  const float* cw = p.in[11] + (size_t)layer * 4 * 1024;
  const float w0 = cw[ch], w1 = cw[1024 + ch], w2 = cw[2048 + ch], w3 = cw[3072 + ch];
  const float bias = p.in[12][layer * 1024 + ch];
  for (int i0 = 0; i0 < 16; i0 += 8) {
    float x0[8], x1[8], x2[8], x3[8];
#pragma unroll
    for (int u = 0; u < 8; ++u) {
      const int t = tt * 64 + (i0 + u) * 4 + tr0;
      const bf16_t* base = PROJ + (size_t)(b * 2048 + t) * LDP + C_XBC + ch;
      x3[u] = bf2f(base[0]);
      x2[u] = (t >= 1) ? bf2f(*(base - LDP)) : 0.f;
      x1[u] = (t >= 2) ? bf2f(*(base - 2 * LDP)) : 0.f;
      x0[u] = (t >= 3) ? bf2f(*(base - 3 * LDP)) : 0.f;
    }
#pragma unroll
    for (int u = 0; u < 8; ++u) {
      const int t = tt * 64 + (i0 + u) * 4 + tr0;
      const float y = bias + w3 * x3[u] + w2 * x2[u] + w1 * x1[u] + w0 * x0[u];
      XC[(size_t)(b * 2048 + t) * 1024 + ch] = f2bf(siluf_(y));
    }
  }
}

__device__ __forceinline__ void dtacum_item(const Params& p, int layer, int item) {
  const bf16_t* PROJ = (const bf16_t*)(p.ws + OFF_PROJ);
  float* DT = (float*)(p.ws + OFF_DT);
  float* AC = (float*)(p.ws + OFF_ACUM);
  const int w = otid() >> 6, l = otid() & 63;
  const int id = item * 4 + w;
  const int h = id & 7, bc = id >> 3;
  const int row0 = bc * 128 + 2 * l;
  const float bias = p.in[13][layer * 8 + h];
  const float A = -expf(p.in[14][layer * 8 + h]);
  float x0 = bf2f(PROJ[(size_t)row0 * LDP + C_DT + h]) + bias;
  float x1 = bf2f(PROJ[(size_t)(row0 + 1) * LDP + C_DT + h]) + bias;
  const float d0 = x0 > 20.f ? x0 : log1pf(expf(x0));
  const float d1 = x1 > 20.f ? x1 : log1pf(expf(x1));
  const float a0 = d0 * A, a1 = d1 * A;
  float s = a0 + a1;
#pragma unroll
  for (int d = 1; d < 64; d <<= 1) {
    const float t = __shfl_up(s, d, 64);
    if (l >= d) s += t;
  }
  DT[(size_t)row0 * 8 + h] = d0;
  DT[(size_t)(row0 + 1) * 8 + h] = d1;
  AC[(size_t)row0 * 8 + h] = s - a1;
  AC[(size_t)(row0 + 1) * 8 + h] = s;
}

__device__ __forceinline__ void s5_e_item(const Params& p, int layer, int item, bf16_t* smem) {
  const bf16_t* PROJ = (const bf16_t*)(p.ws + OFF_PROJ);
  const int grp = item >> 3, mt = item & 7;
  const bf16_t* Em = (const bf16_t*)(p.ws + OFF_EMAT) + (size_t)(layer * 32 + grp) * 16384;
  float* E = (float*)(p.ws + OFF_E);
  f32x4 acc[4][4];
  zero_acc<4>(acc);
  gemm_tile<128, false, false, true>(acc, PROJ + (size_t)mt * 128 * 8 * LDP + C_S5U + grp * 16, 8 * LDP, Em, 128, 128, smem, LDP);
  const int tid = otid(), w = tid >> 6, l = tid & 63, g = l >> 4, c = l & 15, wr = w >> 1, wc = w & 1;
#pragma unroll
  for (int i = 0; i < 4; ++i)
#pragma unroll
    for (int j = 0; j < 4; ++j) {
      const int m = mt * 128 + wr * 64 + i * 16 + g * 4;
      const int n = wc * 64 + j * 16 + c;
      *(f32x4*)(E + ((size_t)(grp * 128 + n)) * NBC + m) = acc[i][j];
    }
}

__device__ __forceinline__ void mla_up_q_tile(const Params& p, int layer, int rt, int ct, bf16_t* smem) {
  const bf16_t* PROJ = (const bf16_t*)(p.ws + OFF_PROJ);
  const bf16_t* W = (const bf16_t*)(p.ws + OFF_WUQT) + (size_t)layer * 768 * 256;
  bf16_t* QM = (bf16_t*)(p.ws + OFF_QM);
  f32x4 acc[4][4];
  zero_acc<4>(acc);
  gemm_tile<128, false, false, false>(acc, (const bf16_t*)(p.ws + OFF_CQ2) + (size_t)rt * 128 * 384, 384, W + (size_t)ct * 128 * 256, 256, 256, smem);
  const int tid = otid(), w = tid >> 6, l = tid & 63, g = l >> 4, c = l & 15, wr = w >> 1, wc = w & 1;
#pragma unroll
  for (int i = 0; i < 4; ++i)
#pragma unroll
    for (int j = 0; j < 4; ++j)
#pragma unroll
      for (int r = 0; r < 4; ++r) {
        const int row = rt * 128 + wr * 64 + i * 16 + g * 4 + r, col = ct * 128 + wc * 64 + j * 16 + c;
        QM[(size_t)row * 768 + col] = f2bf(acc[i][j][r]);
      }
}
__device__ __forceinline__ void mla_up_kv_tile(const Params& p, int layer, int rt, int ct, bf16_t* smem) {
  const bf16_t* PROJ = (const bf16_t*)(p.ws + OFF_PROJ);
  const bf16_t* W = (const bf16_t*)(p.ws + OFF_WUKVT) + (size_t)layer * 1024 * 128;
  bf16_t* KN = (bf16_t*)(p.ws + OFF_KN);
  bf16_t* VTD = (bf16_t*)(p.ws + OFF_VTD);
  f32x4 acc[4][4];
  zero_acc<4>(acc);
  gemm_tile<128, false, false, false>(acc, (const bf16_t*)(p.ws + OFF_CQ2) + (size_t)rt * 128 * 384 + 256, 384, W + (size_t)ct * 128 * 128, 128, 128, smem);
  const int tid = otid(), w = tid >> 6, l = tid & 63, g = l >> 4, c = l & 15, wr = w >> 1, wc = w & 1;
  const int h = ct >> 1;
  if ((ct & 1) == 0) {
#pragma unroll
    for (int i = 0; i < 4; ++i)
#pragma unroll
      for (int j = 0; j < 4; ++j)
#pragma unroll
        for (int r = 0; r < 4; ++r) {
          const int row = rt * 128 + wr * 64 + i * 16 + g * 4 + r, cc = wc * 64 + j * 16 + c;
          KN[(size_t)row * 512 + h * 128 + cc] = f2bf(acc[i][j][r]);
        }
  } else {
#pragma unroll
    for (int i = 0; i < 4; ++i)
#pragma unroll
      for (int j = 0; j < 4; ++j) {
        const int row = rt * 128 + wr * 64 + i * 16 + g * 4, dv = wc * 64 + j * 16 + c;
        const int b = row >> 11, s = row & 2047;
        u32x2 o;
        o.x = pack2(acc[i][j][0], acc[i][j][1]);
        o.y = pack2(acc[i][j][2], acc[i][j][3]);
        *(u32x2*)(VTD + ((size_t)((b * 4 + h) * 128 + dv)) * 2048 + s) = o;
      }
  }
}

__device__ __forceinline__ void mb_states_item(const Params& p, int item, bf16_t* smem) {
  const bf16_t* XC = (const bf16_t*)(p.ws + OFF_XC);
  const float* DT = (const float*)(p.ws + OFF_DT);
  const float* AC = (const float*)(p.ws + OFF_ACUM);
  bf16_t* XS = (bf16_t*)(p.ws + OFF_XS) + (size_t)blockIdx.x * 128 * 64;
  float* ST = (float*)(p.ws + OFF_ST);
  const int h = item & 7, bc = item >> 3;
  const int grp = h >> 2;
  const int row0 = bc * 128;
  const int tid = otid();
  __syncthreads();
  const float alast = AC[(size_t)(row0 + 127) * 8 + h];
  for (int e0 = tid; e0 < 8192; e0 += 2048) {
    float dv[8], av[8];
    bf16_t xv[8];
#pragma unroll
    for (int u = 0; u < 8; ++u) {
      const int e = e0 + u * 256;
      const int row = row0 + (e >> 6);
      dv[u] = DT[(size_t)row * 8 + h];
      av[u] = AC[(size_t)row * 8 + h];
      xv[u] = XC[(size_t)row * 1024 + h * 64 + (e & 63)];
    }
#pragma unroll
    for (int u = 0; u < 8; ++u) XS[e0 + u * 256] = f2bf(bf2f(xv[u]) * dv[u] * __expf(alast - av[u]));
  }
  block_global_handoff();
  f32x4 acc[4][2];
  zero_acc<2>(acc);
  gemm_tile<64, true, true, false>(acc, XC + (size_t)row0 * 1024 + 512 + grp * 128, 1024, XS, 64, 128, smem);
  const int w = tid >> 6, l = tid & 63, g = l >> 4, c = l & 15, wr = w >> 1, wc = w & 1;
#pragma unroll
  for (int i = 0; i < 4; ++i)
#pragma unroll
    for (int j = 0; j < 2; ++j) {
      const int n = wr * 64 + i * 16 + g * 4;
      const int pp = wc * 32 + j * 16 + c;
      *(f32x4*)(ST + ((size_t)(bc * 8 + h) * 64 + pp) * 128 + n) = acc[i][j];
    }
}

__device__ __forceinline__ void s5_carry_item(const Params& p, int layer, int item) {
  const int idx = item * 256 + otid();
  const int b = idx >> 11, grp = (idx >> 6) & 31, pp = idx & 63;
  const float* a8 = (const float*)(p.ws + OFF_A8) + (size_t)((layer * 32 + grp) * 64 + pp) * 2;
  const float ar = a8[0], ai = a8[1];
  const float* er = (const float*)(p.ws + OFF_E) + ((size_t)(grp * 128 + 2 * pp)) * NBC + b * 256;
  const float* ei = er + NBC;
  bf16_t* hro = (bf16_t*)(p.ws + OFF_HIN) + ((size_t)(grp * 128 + 2 * pp)) * NBC + b * 256;
  bf16_t* hio = hro + NBC;
  float hr = 0.f, hi = 0.f;
  for (int c16 = 0; c16 < 16; ++c16) {
    f32x4 vr[4], vi[4];
#pragma unroll
    for (int u = 0; u < 4; ++u) {
      vr[u] = *(const f32x4*)(er + c16 * 16 + u * 4);
      vi[u] = *(const f32x4*)(ei + c16 * 16 + u * 4);
    }
#pragma unroll
    for (int u = 0; u < 4; ++u) {
      float orr[4], oii[4];
#pragma unroll
      for (int k = 0; k < 4; ++k) {
        orr[k] = hr; oii[k] = hi;
        const float nr = ar * hr - ai * hi + vr[u][k];
        const float ni = ar * hi + ai * hr + vi[u][k];
        hr = nr; hi = ni;
      }
      u32x2 o0, o1;
      o0.x = pack2(orr[0], orr[1]); o0.y = pack2(orr[2], orr[3]);
      o1.x = pack2(oii[0], oii[1]); o1.y = pack2(oii[2], oii[3]);
      *(u32x2*)(hro + c16 * 16 + u * 4) = o0;
      *(u32x2*)(hio + c16 * 16 + u * 4) = o1;
    }
  }
}

__device__ __forceinline__ void mlapost_item(const Params& p, int layer, int round, int item) {
  const bf16_t* PROJ = (const bf16_t*)(p.ws + OFF_PROJ);
  bf16_t* QM = (bf16_t*)(p.ws + OFF_QM);
  bf16_t* KM = (bf16_t*)(p.ws + OFF_KM);
  const bf16_t* KN = (const bf16_t*)(p.ws + OFF_KN);
  const int* pos = (const int*)p.in[1];
  const int w = otid() >> 6, l = otid() & 63;
  const float* qn = p.in[31] + layer * 192;
  const float* kn = p.in[32] + layer * 192;
  const float q0 = qn[l], q1 = qn[64 + l], q2 = qn[128 + l];
  const float k0 = kn[l], k1 = kn[64 + l], k2 = kn[128 + l];
  const float invf = expf(-13.122363377404328f * (float)(l & 31) * (1.0f / 32.0f));
  const float qscale = 0.07216878364870322f * LOG2E;
  for (int tt = 0; tt < 4; ++tt) {
    const int row = item * 16 + w * 4 + tt;
    const float ang = (float)pos[round * TR + row] * invf;
    const float cs = cosf(ang), sn = sinf(ang);
    const float kr = bf2f(PROJ[(size_t)row * LDP + C_KR + l]);
#pragma unroll
    for (int h = 0; h < 4; ++h) {
      {
        bf16_t* qp = QM + (size_t)row * 768 + h * 192;
        float e0 = bf2f(qp[l]), e1 = bf2f(qp[64 + l]), e2 = bf2f(qp[128 + l]);
        const float ss = wave_sum(e0 * e0 + e1 * e1 + e2 * e2);
        const float rs = rsqrtf(ss * (1.0f / 192.0f) + EPS);
        e0 *= rs * q0; e1 *= rs * q1; e2 *= rs * q2;
        const float ot = __shfl_xor(e2, 32, 64);
        e2 = (l < 32) ? (e2 * cs - ot * sn) : (e2 * cs + ot * sn);
        bf16_t* qo = (bf16_t*)(p.ws + OFF_QM2) + (size_t)row * 768 + h * 192;
        qo[l] = f2bf(e0 * qscale); qo[64 + l] = f2bf(e1 * qscale); qo[128 + l] = f2bf(e2 * qscale);
      }
      {
        const bf16_t* kp = KN + (size_t)row * 512 + h * 128;
        float e0 = bf2f(kp[l]), e1 = bf2f(kp[64 + l]), e2 = kr;
        const float ss = wave_sum(e0 * e0 + e1 * e1 + e2 * e2);
        const float rs = rsqrtf(ss * (1.0f / 192.0f) + EPS);
        e0 *= rs * k0; e1 *= rs * k1; e2 *= rs * k2;
        const float ot = __shfl_xor(e2, 32, 64);
        e2 = (l < 32) ? (e2 * cs - ot * sn) : (e2 * cs + ot * sn);
        bf16_t* ko = KM + (size_t)row * 768 + h * 192;
        ko[l] = f2bf(e0); ko[64 + l] = f2bf(e1); ko[128 + l] = f2bf(e2);
      }
    }
  }
}

__device__ __forceinline__ void mb_scan_item(const Params& p, int item) {
  const int idx = item * 256 + otid();
  const int b = idx >> 16, h = (idx >> 13) & 7, pn = idx & 8191;
  const float* ST = (const float*)(p.ws + OFF_ST);
  const float* AC = (const float*)(p.ws + OFF_ACUM);
  bf16_t* SIN = (bf16_t*)(p.ws + OFF_SIN);
  float cur = 0.f;
  float alv[16], stv[16];
#pragma unroll
  for (int c = 0; c < 16; ++c) {
    alv[c] = AC[(size_t)(b * 2048 + c * 128 + 127) * 8 + h];
    stv[c] = ST[((size_t)((b * 16 + c) * 8 + h)) * 8192 + pn];
  }
#pragma unroll
  for (int c = 0; c < 16; ++c) {
    SIN[((size_t)((b * 16 + c) * 8 + h)) * 8192 + pn] = f2bf(cur);
    cur = __expf(alv[c]) * cur + stv[c];
  }
}

__device__ __forceinline__ void s5_y_item(const Params& p, int layer, int item, bf16_t* smem) {
  const bf16_t* PROJ = (const bf16_t*)(p.ws + OFF_PROJ);
  const int grp = item >> 3, mt = item & 7;
  const bf16_t* Km = (const bf16_t*)(p.ws + OFF_KMAT) + (size_t)(layer * 32 + grp) * 16384;
  const bf16_t* Fm = (const bf16_t*)(p.ws + OFF_FMAT) + (size_t)(layer * 32 + grp) * 16384;
  const bf16_t* HIN = (const bf16_t*)(p.ws + OFF_HIN) + (size_t)grp * 128 * NBC + mt * 128;
  bf16_t* YG = (bf16_t*)(p.ws + OFF_YG);
  f32x4 acc[4][4];
  zero_acc<4>(acc);
  gemm_tile<128, false, false, true>(acc, PROJ + (size_t)mt * 128 * 8 * LDP + C_S5U + grp * 16, 8 * LDP, Km, 128, 128, smem, LDP);
  gemm_tile<128, true, false, false>(acc, HIN, NBC, Fm, 128, 128, smem);
  const int tid = otid(), w = tid >> 6, l = tid & 63, g = l >> 4, c = l & 15, wr = w >> 1, wc = w & 1;
  const float* dsk = p.in[24] + layer * 512;
#pragma unroll
  for (int i = 0; i < 4; ++i)
#pragma unroll
    for (int j = 0; j < 4; ++j) {
      const int n = wc * 64 + j * 16 + c;
      const int tq = n >> 4, co = n & 15;
      const int ch = grp * 16 + co;
      const float dd = dsk[ch];
#pragma unroll
      for (int r = 0; r < 4; ++r) {
        const int m = mt * 128 + wr * 64 + i * 16 + g * 4 + r;
        const int row = m * 8 + tq;
        const float u = bf2f(PROJ[(size_t)row * LDP + C_S5U + ch]);
        const float y = acc[i][j][r] + dd * u;
        YG[(size_t)row * 512 + ch] = f2bf(gelu_tanh(y));
      }
    }
}

template <int DK, int NM>
__device__ __forceinline__ void attn_core(const bf16_t* __restrict__ Qb, long ldq, const bf16_t* __restrict__ Kb, long ldk,
                                          const bf16_t* __restrict__ Vt, int qb, bf16_t* smem, f32x4 (&O)[NM][8], float (&lsum)[NM][4]) {
  constexpr int KST = DK + 8;
  constexpr int KCH = NM * 64 * DK / 8 / 256;
  constexpr int CPM = 64 * DK / 8;
  constexpr int CPRK = DK / 8;
  bf16_t* sK = smem;
  bf16_t* sV = sK + NM * 64 * KST;
  bf16_t* sP = sV + 128 * 72;
  const int tid = otid(), w = tid >> 6, l = tid & 63, g = l >> 4, c = l & 15;
  bf16x8 qf[NM][DK / 32];
  {
    const long qrow = (long)qb * 64 + w * 16 + c;
#pragma unroll
    for (int m = 0; m < NM; ++m)
#pragma unroll
      for (int ks = 0; ks < DK / 32; ++ks) qf[m][ks] = *(const bf16x8*)(Qb + qrow * ldq + m * DK + ks * 32 + g * 8);
  }
  float mrow[NM][4];
#pragma unroll
  for (int m = 0; m < NM; ++m) {
#pragma unroll
    for (int r = 0; r < 4; ++r) { mrow[m][r] = -INFINITY; lsum[m][r] = 0.f; }
#pragma unroll
    for (int nt = 0; nt < 8; ++nt) O[m][nt] = (f32x4){0.f, 0.f, 0.f, 0.f};
  }
  u32x4 kr[KCH], vr[4];
  auto gloadK = [&](int kt) {
#pragma unroll
    for (int i = 0; i < KCH; ++i) {
      const int ch = tid + i * 256;
      const int m = ch / CPM, cc = ch % CPM;
      const int key = cc / CPRK, d0 = (cc % CPRK) * 8;
      kr[i] = *(const u32x4*)(Kb + (long)(kt * 64 + key) * ldk + m * DK + d0);
    }
  };
  auto gloadV = [&](int kt) {
#pragma unroll
    for (int i = 0; i < 4; ++i) {
      const int ch = tid + i * 256;
      const int dvr = ch >> 3, kc = (ch & 7) * 8;
      vr[i] = *(const u32x4*)(Vt + (long)dvr * 2048 + kt * 64 + kc);
    }
  };
  gloadK(0);
  gloadV(0);
  for (int kt = 0; kt <= qb; ++kt) {
    __syncthreads();
#pragma unroll
    for (int i = 0; i < KCH; ++i) {
      const int ch = tid + i * 256;
      const int m = ch / CPM, cc = ch % CPM;
      const int key = cc / CPRK, d0 = (cc % CPRK) * 8;
      *(u32x4*)(sK + (m * 64 + key) * KST + d0) = kr[i];
    }
#pragma unroll
    for (int i = 0; i < 4; ++i) {
      const int ch = tid + i * 256;
      const int dvr = ch >> 3, kc = (ch & 7) * 8;
      *(u32x4*)(sV + dvr * 72 + kc) = vr[i];
    }
    __syncthreads();
    if (kt < qb) gloadK(kt + 1);
#pragma unroll
    for (int m = 0; m < NM; ++m) {
      f32x4 S[4];
#pragma unroll
      for (int nt = 0; nt < 4; ++nt) {
        S[nt] = (f32x4){0.f, 0.f, 0.f, 0.f};
#pragma unroll
        for (int ks = 0; ks < DK / 32; ++ks) {
          const bf16x8 kf = *(const bf16x8*)(sK + (m * 64 + nt * 16 + c) * KST + ks * 32 + g * 8);
          S[nt] = __builtin_amdgcn_mfma_f32_16x16x32_bf16(qf[m][ks], kf, S[nt], 0, 0, 0);
        }
        MEMBAR();
      }
      if (kt == qb) {
#pragma unroll
        for (int nt = 0; nt < 4; ++nt)
#pragma unroll
          for (int r = 0; r < 4; ++r)
            if (nt * 16 + c > w * 16 + g * 4 + r) S[nt][r] = -INFINITY;
      }
      bf16_t* pw = sP + (size_t)((w * NM + m) * 16) * 72;
#pragma unroll
      for (int r = 0; r < 4; ++r) {
        float mx = fmaxf(fmaxf(S[0][r], S[1][r]), fmaxf(S[2][r], S[3][r]));
        mx = fmaxf(mx, __shfl_xor(mx, 1, 64));
        mx = fmaxf(mx, __shfl_xor(mx, 2, 64));
        mx = fmaxf(mx, __shfl_xor(mx, 4, 64));
        mx = fmaxf(mx, __shfl_xor(mx, 8, 64));
        const float mnew = fmaxf(mrow[m][r], mx);
        const float sc = __builtin_amdgcn_exp2f(mrow[m][r] - mnew);
        mrow[m][r] = mnew;
        float ps = 0.f;
#pragma unroll
        for (int nt = 0; nt < 4; ++nt) {
          const float pv = __builtin_amdgcn_exp2f(S[nt][r] - mnew);
          ps += pv;
          pw[(g * 4 + r) * 72 + nt * 16 + c] = f2bf(pv);
        }
        ps += __shfl_xor(ps, 1, 64);
        ps += __shfl_xor(ps, 2, 64);
        ps += __shfl_xor(ps, 4, 64);
        ps += __shfl_xor(ps, 8, 64);
        lsum[m][r] = lsum[m][r] * sc + ps;
#pragma unroll
        for (int nt = 0; nt < 8; ++nt) O[m][nt][r] *= sc;
      }
    }
    __syncthreads();
    if (kt < qb) gloadV(kt + 1);
#pragma unroll
    for (int m = 0; m < NM; ++m) {
      const bf16_t* pw = sP + (size_t)((w * NM + m) * 16) * 72;
#pragma unroll
      for (int ks = 0; ks < 2; ++ks) {
        const bf16x8 pf = *(const bf16x8*)(pw + c * 72 + ks * 32 + g * 8);
#pragma unroll
        for (int nt = 0; nt < 8; ++nt) {
          const bf16x8 vf = *(const bf16x8*)(sV + (nt * 16 + c) * 72 + ks * 32 + g * 8);
          O[m][nt] = __builtin_amdgcn_mfma_f32_16x16x32_bf16(pf, vf, O[m][nt], 0, 0, 0);
        }
        MEMBAR();
      }
    }
  }
}

__device__ __forceinline__ void da_attn_item(const Params& p, int layer, int bh, int qb, bf16_t* smem, bool dry = false) {
  bf16_t* PROJ = (bf16_t*)(p.ws + OFF_PROJ);
  const bf16_t* VTA = (const bf16_t*)(p.ws + OFF_VTA);
  const bf16_t* QKB = (const bf16_t*)(p.ws + OFF_QK);
  const int b = bh >> 2, h = bh & 3;
  f32x4 O[2][8];
  float ls[2][4];
  {
    f32x4 O1[1][8];
    float l1[1][4];
#pragma unroll 1
    for (int m = 0; m < 2; ++m) {
      attn_core<64, 1>(QKB + (size_t)b * 2048 * 1024 + h * 128 + m * 64, 1024, QKB + (size_t)b * 2048 * 1024 + 512 + h * 128 + m * 64, 1024,
                       VTA + (size_t)(b * 4 + h) * 128 * 2048, qb, smem, O1, l1);
      if (m == 0) {
#pragma unroll
        for (int nt = 0; nt < 8; ++nt) O[0][nt] = O1[0][nt];
#pragma unroll
        for (int r = 0; r < 4; ++r) ls[0][r] = l1[0][r];
      } else {
#pragma unroll
        for (int nt = 0; nt < 8; ++nt) O[1][nt] = O1[0][nt];
#pragma unroll
        for (int r = 0; r < 4; ++r) ls[1][r] = l1[0][r];
      }
    }
  }
  const int tid = otid(), w = tid >> 6, l = tid & 63, g = l >> 4, c = l & 15;
  const float lam = ((const float*)(p.ws + OFF_LAM))[layer];
  const float linit = 0.8f - 0.6f * expf(-0.3f * (float)layer);
  const float* sg = p.in[10] + layer * 128;
#pragma unroll
  for (int r = 0; r < 4; ++r) {
    const float i0 = 1.0f / ls[0][r], i1 = lam / ls[1][r];
    float o[8];
    float ss = 0.f;
#pragma unroll
    for (int nt = 0; nt < 8; ++nt) {
      o[nt] = O[0][nt][r] * i0 - O[1][nt][r] * i1;
      ss += o[nt] * o[nt];
    }
    ss += __shfl_xor(ss, 1, 64);
    ss += __shfl_xor(ss, 2, 64);
    ss += __shfl_xor(ss, 4, 64);
    ss += __shfl_xor(ss, 8, 64);
    const float rs = rsqrtf(ss * (1.0f / 128.0f) + EPS) * (1.0f - linit);
    const size_t row = (size_t)b * 2048 + qb * 64 + w * 16 + g * 4 + r;
#pragma unroll
    for (int nt = 0; nt < 8; ++nt) {
      const int dv = nt * 16 + c;
      bf16_t* gp = PROJ + row * LDP + C_DAG + h * 128 + dv;
      const float gt = bf2f(*gp);
      if (!dry) *gp = f2bf(o[nt] * rs * sg[dv] * siluf_(gt));
    }
  }
}

__device__ __forceinline__ void mla_attn_item(const Params& p, int bh, int qb, bf16_t* smem, bool dry = false) {
  bf16_t* PROJ = (bf16_t*)(p.ws + OFF_PROJ);
  const bf16_t* QM = (const bf16_t*)(p.ws + OFF_QM2);
  const bf16_t* KM = (const bf16_t*)(p.ws + OFF_KM);
  const bf16_t* VTD = (const bf16_t*)(p.ws + OFF_VTD);
  const int b = bh >> 2, h = bh & 3;
  f32x4 O[1][8];
  float ls[1][4];
  attn_core<192, 1>(QM + (size_t)b * 2048 * 768 + h * 192, 768, KM + (size_t)b * 2048 * 768 + h * 192, 768,
                    VTD + (size_t)(b * 4 + h) * 128 * 2048, qb, smem, O, ls);
  const int tid = otid(), w = tid >> 6, l = tid & 63, g = l >> 4, c = l & 15;
#pragma unroll
  for (int r = 0; r < 4; ++r) {
    const float i0 = 1.0f / ls[0][r];
    const size_t row = (size_t)b * 2048 + qb * 64 + w * 16 + g * 4 + r;
#pragma unroll
    for (int nt = 0; nt < 8; ++nt) {
      const int dv = nt * 16 + c;
      bf16_t* gp = PROJ + row * LDP + C_MLG + h * 128 + dv;
      const float gt = bf2f(*gp);
      if (!dry) *gp = f2bf(O[0][nt][r] * i0 * siluf_(gt));
    }
  }
}

__device__ __forceinline__ void mb_out_item(const Params& p, int layer, int item, bf16_t* smem) {
  bf16_t* PROJ = (bf16_t*)(p.ws + OFF_PROJ);
  const bf16_t* XC = (const bf16_t*)(p.ws + OFF_XC);
  const float* DT = (const float*)(p.ws + OFF_DT);
  const float* AC = (const float*)(p.ws + OFF_ACUM);
  const bf16_t* SIN = (const bf16_t*)(p.ws + OFF_SIN);
  bf16_t* MS0 = (bf16_t*)(p.ws + OFF_MS) + (size_t)blockIdx.x * 4 * 128 * 128;
  float* rowss = (float*)((unsigned char*)smem + 73728);
  const int grp = item & 1, bc = item >> 1;
  const int row0 = bc * 128;
  __syncthreads();
  const bf16_t* Cp = XC + (size_t)row0 * 1024 + 768 + grp * 128;
  const bf16_t* Bp = XC + (size_t)row0 * 1024 + 512 + grp * 128;
  {
    const int tid = otid(), w = tid >> 6, l = tid & 63, g = l >> 4, c = l & 15, wr = w >> 1, wc = w & 1;
    f32x4 cb[4][4];
    zero_acc<4>(cb);
    gemm_tile<128, false, false, false>(cb, Cp, 1024, Bp, 1024, 128, smem);
#pragma unroll 1
    for (int r4 = 0; r4 < 4; ++r4) {
      const int h = grp * 4 + r4;
      bf16_t* MS = MS0 + (size_t)r4 * 128 * 128;
      float acs[4], dts[4];
#pragma unroll
      for (int j = 0; j < 4; ++j) {
        const int s = wc * 64 + j * 16 + c;
        acs[j] = AC[(size_t)(row0 + s) * 8 + h];
        dts[j] = DT[(size_t)(row0 + s) * 8 + h];
      }
#pragma unroll
      for (int i = 0; i < 4; ++i)
#pragma unroll
        for (int r = 0; r < 4; ++r) {
          const int lr = wr * 64 + i * 16 + g * 4 + r;
          const float acl = AC[(size_t)(row0 + lr) * 8 + h];
#pragma unroll
          for (int j = 0; j < 4; ++j) {
            const int s = wc * 64 + j * 16 + c;
            const float v = (s <= lr) ? cb[i][j][r] * __expf(acl - acs[j]) * dts[j] : 0.f;
            MS[lr * 128 + s] = f2bf(v);
          }
          MEMBAR();
        }
    }
  }
  block_global_handoff();
#pragma unroll 1
  for (int r4 = 0; r4 < 4; ++r4) {
    const int h = grp * 4 + r4;
    const bf16_t* MS = MS0 + (size_t)r4 * 128 * 128;
    const int tid = otid(), w = tid >> 6, l = tid & 63, g = l >> 4, c = l & 15, wr = w >> 1, wc = w & 1;
    f32x4 ad[4][2], ao[4][2];
    zero_acc<2>(ad);
    zero_acc<2>(ao);
    gemm_tile<64, false, true, false>(ad, MS, 128, XC + (size_t)row0 * 1024 + h * 64, 1024, 128, smem);
    gemm_tile<64, false, false, false>(ao, Cp, 1024, SIN + ((size_t)(bc * 8 + h)) * 8192, 128, 128, smem);
    const float dsk = p.in[15][layer * 8 + h];
#pragma unroll
    for (int i = 0; i < 4; ++i)
#pragma unroll
      for (int r = 0; r < 4; ++r) {
        const int lr = wr * 64 + i * 16 + g * 4 + r;
        const size_t row = (size_t)row0 + lr;
        const float ea = __expf(AC[row * 8 + h]);
        float ssq = 0.f;
#pragma unroll
        for (int j = 0; j < 2; ++j) {
          const int ch = h * 64 + wc * 32 + j * 16 + c;
          const float xv = bf2f(XC[row * 1024 + ch]);
          bf16_t* zp = PROJ + row * LDP + C_MBZ + ch;
          const float z = bf2f(*zp);
          float y = ad[i][j][r] + ea * ao[i][j][r] + dsk * xv;
          y *= siluf_(z);
          ssq += y * y;
          *zp = f2bf(y);
        }
        ssq += __shfl_xor(ssq, 1, 64);
        ssq += __shfl_xor(ssq, 2, 64);
        ssq += __shfl_xor(ssq, 4, 64);
        ssq += __shfl_xor(ssq, 8, 64);
        if (c == 0) rowss[(r4 * 2 + wc) * 128 + lr] = ssq;
        MEMBAR();
      }
  }
  block_global_handoff();
  const float* ng = p.in[16] + layer * 512 + grp * 256;
  {
    const int cc = otid();
    const float gcc = ng[cc];
    for (int l0 = 0; l0 < 128; l0 += 16) {
      bf16_t vals[16];
#pragma unroll
      for (int u = 0; u < 16; ++u) vals[u] = PROJ[(size_t)(row0 + l0 + u) * LDP + C_MBZ + grp * 256 + cc];
#pragma unroll
      for (int u = 0; u < 16; ++u) {
        const int lr = l0 + u;
        float tot = 0.f;
#pragma unroll
        for (int q = 0; q < 8; ++q) tot += rowss[q * 128 + lr];
        PROJ[(size_t)(row0 + lr) * LDP + C_MBZ + grp * 256 + cc] = f2bf(bf2f(vals[u]) * rsqrtf(tot * (1.0f / 256.0f) + EPS) * gcc);
      }
    }
  }
}

__device__ __forceinline__ void s5_glu_tile(const Params& p, int layer, int rt, int ct, bf16_t* smem) {
  bf16_t* PROJ = (bf16_t*)(p.ws + OFF_PROJ);
  const bf16_t* YG = (const bf16_t*)(p.ws + OFF_YG);
  const bf16_t* W = (const bf16_t*)(p.ws + OFF_WGLUT) + (size_t)layer * 512 * 512;
  f32x4 acc[4][4];
  zero_acc<4>(acc);
  gemm_tile<128, false, false, false>(acc, YG + (size_t)rt * 128 * 512, 512, W + (size_t)ct * 128 * 512, 512, 512, smem);
  const int tid = otid(), w = tid >> 6, l = tid & 63, g = l >> 4, c = l & 15, wr = w >> 1, wc = w & 1;
  const float* bg = p.in[26] + layer * 512;
#pragma unroll
  for (int i = 0; i < 4; ++i)
#pragma unroll
    for (int j = 0; j < 4; ++j) {
      const int col = ct * 128 + wc * 64 + j * 16 + c;
      const float bb = bg[col];
#pragma unroll
      for (int r = 0; r < 4; ++r) {
        const size_t row = (size_t)rt * 128 + wr * 64 + i * 16 + g * 4 + r;
        const float yv = bf2f(YG[row * 512 + col]);
        bf16_t* gp = PROJ + row * LDP + C_S5G + col;
        const float gt = bf2f(*gp);
        *gp = f2bf(yv * sigmoidf_(acc[i][j][r] + bb) * siluf_(gt));
      }
    }
}

__device__ __forceinline__ void merge_tile(const Params& p, int layer, int rt, int ct, bf16_t* smem) {
  const bf16_t* PROJ = (const bf16_t*)(p.ws + OFF_PROJ);
  bf16_t* MG = (bf16_t*)(p.ws + OFF_MERGED);
  f32x4 macc[4][2];
  zero_acc<2>(macc);
  const int tid = otid(), w = tid >> 6, l = tid & 63, g = l >> 4, c = l & 15, wr = w >> 1, wc = w & 1;
  for (int n = 0; n < 4; ++n) {
    const int ycol = (n == 0) ? C_DAG : (n == 1) ? C_MBZ : (n == 2) ? C_S5G : C_MLG;
    const bf16_t* W = (const bf16_t*)(p.ws + OFF_WBRT) + (size_t)(layer * 4 + n) * 1024 * 512;
    f32x4 acc[4][2];
    zero_acc<2>(acc);
    gemm_tile<64, false, false, false>(acc, PROJ + (size_t)rt * 128 * LDP + ycol, LDP, W + (size_t)ct * 64 * 512, 512, 512, smem);
#pragma unroll
    for (int i = 0; i < 4; ++i) {
#pragma unroll
      for (int r = 0; r < 4; ++r) {
        const size_t row = (size_t)rt * 128 + wr * 64 + i * 16 + g * 4 + r;
        const bf16_t* gp = PROJ + row * LDP + C_GATE + n * 1024 + ct * 64 + wc * 32 + c;
#pragma unroll
        for (int j = 0; j < 2; ++j) macc[i][j][r] += bf2f(gp[j * 16]) * acc[i][j][r];
      }
      MEMBAR();
    }
  }
#pragma unroll
  for (int i = 0; i < 4; ++i) {
#pragma unroll
    for (int r = 0; r < 4; ++r) {
      const size_t row = (size_t)rt * 128 + wr * 64 + i * 16 + g * 4 + r;
      bf16_t* op = MG + row * 1024 + ct * 64 + wc * 32 + c;
#pragma unroll
      for (int j = 0; j < 2; ++j) op[j * 16] = f2bf(macc[i][j][r]);
    }
    MEMBAR();
  }
}

__device__ __forceinline__ void out_tile(const Params& p, int layer, const float* xo, float* xn, int rt, int ct, bf16_t* smem) {
  const bf16_t* MG = (const bf16_t*)(p.ws + OFF_MERGED);
  const bf16_t* W = (const bf16_t*)(p.ws + OFF_WOUTT) + (size_t)layer * 1024 * 1024;
  f32x4 acc[4][4];
  zero_acc<4>(acc);
  gemm_tile<128, false, false, false>(acc, MG + (size_t)rt * 128 * 1024, 1024, W + (size_t)ct * 128 * 1024, 1024, 1024, smem);
  const int tid = otid(), w = tid >> 6, l = tid & 63, g = l >> 4, c = l & 15, wr = w >> 1, wc = w & 1;
#pragma unroll
  for (int i = 0; i < 4; ++i)
#pragma unroll
    for (int j = 0; j < 4; ++j) {
      const int col = ct * 128 + wc * 64 + j * 16 + c;
#pragma unroll
      for (int r = 0; r < 4; ++r) {
        const size_t row = (size_t)rt * 128 + wr * 64 + i * 16 + g * 4 + r;
        xn[row * 1024 + col] = xo[row * 1024 + col] + acc[i][j][r];
      }
    }
}

struct Bx { unsigned xcd, nloc, nx, hier; };
__device__ __forceinline__ unsigned xcc_id() { return (unsigned)__builtin_amdgcn_s_getreg((3 << 11) | 20) & 0x7u; }
__device__ __forceinline__ void gsync_flat(unsigned* bar) {
  asm volatile("s_waitcnt vmcnt(0)" ::: "memory");
  __syncthreads();
  if (otid() == 0) {
    unsigned long long* w = (unsigned long long*)bar;
    __builtin_amdgcn_fence(__ATOMIC_RELEASE, "agent");
    asm volatile("s_waitcnt vmcnt(0)" ::: "memory");
    const unsigned long long old = __hip_atomic_fetch_add(w, 1ull, __ATOMIC_RELAXED, __HIP_MEMORY_SCOPE_AGENT);
    const unsigned G = gridDim.x;
    if ((unsigned)(old & 0xffffffffull) == G - 1) {
      __hip_atomic_fetch_add(w, (1ull << 32) - (unsigned long long)G, __ATOMIC_RELAXED, __HIP_MEMORY_SCOPE_AGENT);
    } else {
      const unsigned g0 = (unsigned)(old >> 32);
      while ((unsigned)(__hip_atomic_load(w, __ATOMIC_RELAXED, __HIP_MEMORY_SCOPE_AGENT) >> 32) == g0) __builtin_amdgcn_s_sleep(1);
    }
    __builtin_amdgcn_fence(__ATOMIC_ACQUIRE, "agent");
    asm volatile("s_waitcnt vmcnt(0)" ::: "memory");
  }
  __syncthreads();
}
__device__ __forceinline__ void gsync(cg::grid_group& grid, unsigned* bar, unsigned& epoch, const volatile unsigned* bxs) {
  asm volatile("s_waitcnt vmcnt(0)" ::: "memory");
  __syncthreads();
  if (otid() == 0) {
    const unsigned xcd = bxs[0], nloc = bxs[1], nx = bxs[2];
    unsigned long long* L = (unsigned long long*)((unsigned char*)bar + 3072 + 256 * xcd);
    unsigned long long* T = (unsigned long long*)((unsigned char*)bar + 5120);
    const unsigned long long old = __hip_atomic_fetch_add(L, 1ull, __ATOMIC_RELAXED, __HIP_MEMORY_SCOPE_AGENT);
    if ((unsigned)(old & 0xffffffffull) == nloc - 1) {
      __builtin_amdgcn_fence(__ATOMIC_RELEASE, "agent");
      asm volatile("s_waitcnt vmcnt(0)" ::: "memory");
      const unsigned long long oldt = __hip_atomic_fetch_add(T, 1ull, __ATOMIC_RELAXED, __HIP_MEMORY_SCOPE_AGENT);
      if ((unsigned)(oldt & 0xffffffffull) == nx - 1) {
        __hip_atomic_fetch_add(T, (1ull << 32) - (unsigned long long)nx, __ATOMIC_RELAXED, __HIP_MEMORY_SCOPE_AGENT);
      } else {
        const unsigned gt = (unsigned)(oldt >> 32);
        while ((unsigned)(__hip_atomic_load(T, __ATOMIC_RELAXED, __HIP_MEMORY_SCOPE_AGENT) >> 32) == gt) __builtin_amdgcn_s_sleep(1);
      }
      __hip_atomic_fetch_add(L, (1ull << 32) - (unsigned long long)nloc, __ATOMIC_RELAXED, __HIP_MEMORY_SCOPE_AGENT);
    } else {
      const unsigned g0 = (unsigned)(old >> 32);
      while ((unsigned)(__hip_atomic_load(L, __ATOMIC_RELAXED, __HIP_MEMORY_SCOPE_AGENT) >> 32) == g0) __builtin_amdgcn_s_sleep(1);
    }
    __builtin_amdgcn_fence(__ATOMIC_ACQUIRE, "agent");
    asm volatile("s_waitcnt vmcnt(0)" ::: "memory");
  }
  __syncthreads();
}

#ifdef SELFCHECK
__device__ __forceinline__ void cksum(const void* ptr, size_t bytes, unsigned long long* slot) {
  const u32x4* q = (const u32x4*)ptr;
  const size_t n = bytes / 16;
  unsigned long long s = 0;
  for (size_t i = (size_t)blockIdx.x * 256 + otid(); i < n; i += (size_t)gridDim.x * 256) {
    const u32x4 v = q[i];
    s += (unsigned long long)v.x + 3ull * v.y + 5ull * v.z + 7ull * v.w;
  }
  unsigned lo = (unsigned)s, hi = (unsigned)(s >> 32);
  unsigned long long t = s;
#pragma unroll
  for (int d = 32; d >= 1; d >>= 1) {
    const unsigned l2 = __shfl_xor((unsigned)t, d, 64), h2 = __shfl_xor((unsigned)(t >> 32), d, 64);
    t += ((unsigned long long)h2 << 32) | l2;
  }
  (void)lo; (void)hi;
  if ((otid() & 63) == 0) atomicAdd(slot, t);
}
#define CK(ptr, bytes) cksum((ptr), (bytes), slots + slot)
#else
#define CK(ptr, bytes) do {} while (0)
#endif

__device__ __forceinline__ void cksum_acc(const void* ptr, size_t bytes, unsigned long long& s) {
  const u32x4* q = (const u32x4*)ptr;
  const size_t n = bytes / 16;
  for (size_t i = ((size_t)blockIdx.x * 256 + otid()) * 64; i < n; i += (size_t)gridDim.x * 256 * 64) {
    const u32x4 v = __builtin_nontemporal_load(q + i);
    s += (unsigned long long)v.x + 3ull * v.y + 5ull * v.z + 7ull * v.w;
  }
}
__device__ __forceinline__ void cksum_commit(unsigned long long t, unsigned long long* slot) {
#pragma unroll
  for (int d = 32; d >= 1; d >>= 1) {
    const unsigned l2 = __shfl_xor((unsigned)t, d, 64), h2 = __shfl_xor((unsigned)(t >> 32), d, 64);
    t += ((unsigned long long)h2 << 32) | l2;
  }
  if ((otid() & 63) == 0) atomicAdd(slot, t);
}

__global__ void __launch_bounds__(256, 2) fwd_megakernel(Params p) {
  cg::grid_group grid = cg::this_grid();
  __shared__ __attribute__((aligned(16))) unsigned char smem_raw[SMEM_BYTES];
  bf16_t* smem = (bf16_t*)smem_raw;
  float* smf = (float*)smem_raw;
  const int G = gridDim.x, bid = blockIdx.x;
  unsigned* bar = (unsigned*)(p.ws + OFF_BAR);
  unsigned epoch = 0;
  volatile unsigned* bxs = (volatile unsigned*)(smem_raw + 73728 + 4096);
  if (otid() == 0) {
    const unsigned xc = xcc_id();
    bxs[0] = xc; bxs[1] = 0u; bxs[2] = 0u; bxs[3] = 0u;
    __hip_atomic_fetch_add((unsigned*)((unsigned char*)bar + 2048 + 128 * xc), 1u, __ATOMIC_RELAXED, __HIP_MEMORY_SCOPE_AGENT);
  }
  __syncthreads();
#ifdef START_DELAY_US
  {
    const unsigned long long t0 = __builtin_amdgcn_s_memrealtime();
    while (__builtin_amdgcn_s_memrealtime() - t0 < (unsigned long long)START_DELAY_US * 100ull) __builtin_amdgcn_s_sleep(20);
  }
#endif
  grid.sync();
#ifdef WCHECK
  unsigned wseen = 0;
  if (bid == 0 && otid() == 0) wseen = __hip_atomic_load(bar + 32, __ATOMIC_RELAXED, __HIP_MEMORY_SCOPE_AGENT);
#endif

#ifdef SELFCHECK
  unsigned long long* slots_base = (unsigned long long*)(p.ws + OFF_BAR + 256);
  if (bid == 0) for (int k = otid(); k < 768; k += 256) __hip_atomic_store(slots_base + k, 0ull, __ATOMIC_RELAXED, __HIP_MEMORY_SCOPE_AGENT);
  for (int run = 0; run < 3; ++run) {
  unsigned long long* slots = slots_base + run * 256;
  int slot = 0;
#endif
  gsync_flat(bar);
  {
    if (otid() == 0) {
      unsigned nl = 0, nxx = 0;
      const unsigned xc = bxs[0];
      for (int j = 0; j < 8; ++j) {
        const unsigned cj = __hip_atomic_load((unsigned*)((unsigned char*)bar + 2048 + 128 * j), __ATOMIC_RELAXED, __HIP_MEMORY_SCOPE_AGENT);
        nxx += (cj > 0u) ? 1u : 0u;
        nl = ((unsigned)j == xc) ? cj : nl;
      }
      bxs[1] = nl; bxs[2] = nxx; bxs[3] = 1u;
    }
    __syncthreads();
  }
  phase_prep(p, smf);
#ifdef SELF_POISON
  {
    u32x4* q = (u32x4*)(p.ws + OFF_H);
    const size_t n16 = (WS_TOTAL - OFF_H) / 16;
    const u32x4 pv = {SELF_POISON, SELF_POISON, SELF_POISON, SELF_POISON};
    for (size_t i = (size_t)bid * 256 + otid(); i < n16; i += (size_t)G * 256) q[i] = pv;
  }
#endif
  gsync(grid, bar, epoch, bxs);
#ifdef SELFCHECK
  CK(p.ws, OFF_H); slot++;
#endif

  for (int layer = 0; layer < 2; ++layer) {
    const float* xin = (layer == 0) ? p.in[0] : p.out;
    float* xout = p.out;
    for (int round = 0; round < NROUND; ++round) {
      const size_t tok0 = (size_t)round * TR;
      if (layer == 0 && round == 0) {
        phase_hnorm(xin + tok0 * 1024, p.in[2] + layer * 1024, (bf16_t*)(p.ws + OFF_H));
        gsync(grid, bar, epoch, bxs);
      }
#ifdef SELFCHECK
      CK(p.ws + OFF_H, (size_t)TR * 1024 * 2); slot++;
#endif
#ifndef REP_B
#define REP_B 1
#endif
      for (int rep = 0; rep < REP_B; ++rep) {
      for (int it = bid; it < NRT * 76; it += G) inproj_tile(p, layer, it % NRT, it / NRT, smem);
      gsync(grid, bar, epoch, bxs);
      }
#ifdef SELFCHECK
      CK(p.ws + OFF_PROJ, (size_t)TR * D_INP * 2); CK(p.ws + OFF_VTA, (size_t)RB * 4 * 128 * 2048 * 2); slot++;
#endif
      {
        constexpr int n1 = 256, n2 = TR / 16, n3 = RB * 32 * 16, n4 = RB * 16 * 8 / 4;
        for (int it = bid; it < n1 + n2 + n3 + n4; it += G) {
          if (it < n1) s5_e_item(p, layer, it, smem);
          else if (it < n1 + n2) tokpost_item(p, layer, round, it - n1);
          else if (it < n1 + n2 + n3) conv_item(p, layer, it - n1 - n2);
          else dtacum_item(p, layer, it - n1 - n2 - n3);
        }
      }
      gsync(grid, bar, epoch, bxs);
#ifdef SELFCHECK
      CK(p.ws + OFF_PROJ, (size_t)TR * D_INP * 2); CK(p.ws + OFF_E, (size_t)32 * 128 * NBC * 4); CK(p.ws + OFF_XC, (size_t)TR * 1024 * 2);
      CK(p.ws + OFF_DT, (size_t)TR * 8 * 4); CK(p.ws + OFF_ACUM, (size_t)TR * 8 * 4); slot++;
#endif
      {
        constexpr int n1 = NRT * 6, n2 = NRT * 8, n3 = RB * 16 * 8, n4 = RB * 32 * 64 / 256;
        for (int it = bid; it < n1 + n2 + n3 + n4; it += G) {
          if (it < n1) mla_up_q_tile(p, layer, it % NRT, it / NRT, smem);
          else if (it < n1 + n2) mla_up_kv_tile(p, layer, (it - n1) % NRT, (it - n1) / NRT, smem);
          else if (it < n1 + n2 + n3) mb_states_item(p, it - n1 - n2, smem);
          else s5_carry_item(p, layer, it - n1 - n2 - n3);
        }
      }
      gsync(grid, bar, epoch, bxs);
#ifdef SELFCHECK
      CK(p.ws + OFF_QM, (size_t)TR * 768 * 2); CK(p.ws + OFF_KN, (size_t)TR * 512 * 2); CK(p.ws + OFF_VTD, (size_t)RB * 4 * 128 * 2048 * 2);
      CK(p.ws + OFF_ST, (size_t)RB * 16 * 8 * 8192 * 4); CK(p.ws + OFF_HIN, (size_t)32 * 128 * NBC * 2); slot++;
#endif
      {
        constexpr int n1 = 256, n2 = TR / 16, n3 = RB * 8 * 8192 / 256;
        for (int it = bid; it < n1 + n2 + n3; it += G) {
          if (it < n1) s5_y_item(p, layer, it, smem);
          else if (it < n1 + n2) mlapost_item(p, layer, round, it - n1);
          else mb_scan_item(p, it - n1 - n2);
        }
      }
      gsync(grid, bar, epoch, bxs);
#ifdef SELFCHECK
      CK(p.ws + OFF_YG, (size_t)TR * 512 * 2); CK(p.ws + OFF_QM, (size_t)TR * 768 * 2); CK(p.ws + OFF_KM, (size_t)TR * 768 * 2);
      CK(p.ws + OFF_SIN, (size_t)RB * 16 * 8 * 8192 * 2); slot++;
#endif
#ifdef REP_ATT
      {
        constexpr int nat = RB * 4 * 32 * 2;
        for (int it = bid; it < nat; it += G) {
            const int half = nat / 2;
            const int qb = (it < half) ? (31 - it / 32) : ((it - half) / 32);
            const int sub = it & 31;
            if (sub < 16) da_attn_item(p, layer, sub, qb, smem, true);
            else mla_attn_item(p, sub - 16, qb, smem, true);
        }
        gsync(grid, bar, epoch, bxs);
      }
#endif
      {
        constexpr int nat = RB * 4 * 32 * 2;
        constexpr int n3 = RB * 16 * 2, n4 = NRT * 4;
        const int nmb = (G > n3 + 64) ? n3 : 0;
        if (bid < nmb) {
          mb_out_item(p, layer, bid, smem);
        } else {
          const int j = bid - nmb, W = G - nmb;
          if (nmb == 0) for (int it = bid; it < n3; it += G) mb_out_item(p, layer, it, smem);
          for (int r = 0; r * W < nat; ++r) {
            const int k = (r & 1) ? ((r + 1) * W - 1 - j) : (r * W + j);
            if (k < nat) {
              const int qb = 31 - (k >> 5), sub = k & 31;
              if (sub < 16) da_attn_item(p, layer, sub, qb, smem);
              else mla_attn_item(p, sub - 16, qb, smem);
            }
          }
          for (int t = W - 1 - j; t < n4; t += W) s5_glu_tile(p, layer, t % NRT, t / NRT, smem);
        }
      }
      gsync(grid, bar, epoch, bxs);
#ifdef SELFCHECK
      CK(p.ws + OFF_PROJ, (size_t)TR * D_INP * 2); slot++;
#endif
      for (int it = bid; it < NRT * 16; it += G) merge_tile(p, layer, it % NRT, it / NRT, smem);
      gsync(grid, bar, epoch, bxs);
#ifdef SELFCHECK
      CK(p.ws + OFF_MERGED, (size_t)TR * 1024 * 2); slot++;
#endif
      for (int it = bid; it < NRT * 8; it += G) out_tile(p, layer, xin + tok0 * 1024, xout + tok0 * 1024, it % NRT, it / NRT, smem);
      {
        const int nl = (round + 1 < NROUND) ? layer : layer + 1;
        const int nr = (round + 1 < NROUND) ? round + 1 : 0;
        if (nl < 2) {
          const float* nx = (nl == 0) ? p.in[0] : p.out;
          phase_hnorm(nx + (size_t)nr * TR * 1024, p.in[2] + nl * 1024, (bf16_t*)(p.ws + OFF_H));
        }
      }
      gsync(grid, bar, epoch, bxs);
#ifdef SELFCHECK
      CK(xout + tok0 * 1024, (size_t)TR * 1024 * 4); slot++;
#endif
    }
  }
#ifdef WCHECK
  if (bid == 0 && otid() == 0) {
    if (wseen != 0) p.out[0] = 1.0e6f;
    __hip_atomic_store(bar + 32, 1u, __ATOMIC_RELAXED, __HIP_MEMORY_SCOPE_AGENT);
  }
#endif
#ifdef SELFCHECK
  gsync(grid, bar, epoch, bxs);
  }
  gsync(grid, bar, epoch, bxs);
  if (bid == 0 && otid() == 0) {
    int bad = -1;
    for (int k = 0; k < 100; ++k) {
      const unsigned long long a = __hip_atomic_load(slots_base + k, __ATOMIC_RELAXED, __HIP_MEMORY_SCOPE_AGENT);
      const unsigned long long b = __hip_atomic_load(slots_base + 256 + k, __ATOMIC_RELAXED, __HIP_MEMORY_SCOPE_AGENT);
      const unsigned long long c = __hip_atomic_load(slots_base + 512 + k, __ATOMIC_RELAXED, __HIP_MEMORY_SCOPE_AGENT);
      if (a != b || a != c) { bad = k; break; }
    }
    if (bad >= 0) p.out[0] = 10000.0f * exp2f((float)bad);
  }
#endif
}

extern "C" void kernel_launch(void* const* d_in, const int* in_sizes, int n_in, void* d_out,
                              int out_size, void* d_ws, size_t ws_size, hipStream_t stream) {
  static int grid_blocks = 0;
  if (!grid_blocks) {
    int dev = 0, cus = 0, per_cu = 0;
    (void)hipGetDevice(&dev);
    (void)hipDeviceGetAttribute(&cus, hipDeviceAttributeMultiprocessorCount, dev);
    (void)hipOccupancyMaxActiveBlocksPerMultiprocessor(&per_cu, fwd_megakernel, 256, 0);
    if (per_cu > 2) per_cu = 2;
    if (per_cu < 1) per_cu = 1;
    grid_blocks = cus * per_cu;
    if (grid_blocks > MAXBLK) grid_blocks = MAXBLK;
  }
  if (ws_size < WS_TOTAL) fprintf(stderr, "workspace too small: %zu < %zu\n", ws_size, (size_t)WS_TOTAL);
  Params p{};
  for (int i = 0; i < 35; ++i) p.in[i] = (const float*)d_in[i];
  p.out = (float*)d_out;
  p.ws = (unsigned char*)d_ws;
  (void)hipMemsetAsync((unsigned char*)d_ws + OFF_BAR, 0, 8192, stream);
  void* args[] = {&p};
  hipError_t e = hipLaunchCooperativeKernel((void*)fwd_megakernel, dim3(grid_blocks), dim3(256), args, 0, stream);
  if (e != hipSuccess) fprintf(stderr, "cooperative launch failed: %s (grid %d)\n", hipGetErrorString(e), grid_blocks);
}
```

```cpp
#include <hip/hip_runtime.h>
#include <hip/hip_cooperative_groups.h>
#include <cstdio>
#include <cstdint>
namespace cg = cooperative_groups;

typedef unsigned short bf16_t;
typedef short bf16x8 __attribute__((ext_vector_type(8)));
typedef float f32x4 __attribute__((ext_vector_type(4)));
typedef unsigned u32x4 __attribute__((ext_vector_type(4)));
typedef unsigned u32x2 __attribute__((ext_vector_type(2)));

constexpr int SEQ = 2048, BATCH = 16;
constexpr int D_IN = 9672, D_INP = 9728;
constexpr int RB = 4;
constexpr int TR = RB * SEQ;
constexpr int NROUND = BATCH / RB;
constexpr int NRT = TR / 128;
constexpr int NBC = TR / 8;
constexpr int MAXBLK = 512;
constexpr float EPS = 1e-6f;
constexpr float LOG2E = 1.4426950408889634f;
constexpr int C_DAQ = 0, C_DAK = 512, C_DAV = 1024, C_DAG = 1536, C_MBZ = 2048, C_XBC = 2560, C_DT = 3584,
              C_S5U = 3592, C_S5G = 4104, C_CQ = 4616, C_CKV = 4872, C_KR = 5000, C_MLG = 5064, C_GATE = 5576;
constexpr long LDP = D_INP;

constexpr size_t al256(size_t x) { return (x + 255) & ~size_t(255); }
constexpr size_t OFF_WINT = 0;
constexpr size_t OFF_WBRT = OFF_WINT + al256((size_t)2 * D_INP * 1024 * 2);
constexpr size_t OFF_WOUTT = OFF_WBRT + al256((size_t)2 * 4 * 1024 * 512 * 2);
constexpr size_t OFF_WGLUT = OFF_WOUTT + al256((size_t)2 * 1024 * 1024 * 2);
constexpr size_t OFF_WUQT = OFF_WGLUT + al256((size_t)2 * 512 * 512 * 2);
constexpr size_t OFF_WUKVT = OFF_WUQT + al256((size_t)2 * 768 * 256 * 2);
constexpr size_t OFF_KMAT = OFF_WUKVT + al256((size_t)2 * 1024 * 128 * 2);
constexpr size_t OFF_EMAT = OFF_KMAT + al256((size_t)2 * 32 * 128 * 128 * 2);
constexpr size_t OFF_FMAT = OFF_EMAT + al256((size_t)2 * 32 * 128 * 128 * 2);
constexpr size_t OFF_A8 = OFF_FMAT + al256((size_t)2 * 32 * 128 * 128 * 2);
constexpr size_t OFF_LAM = OFF_A8 + al256((size_t)2 * 32 * 64 * 2 * 4);
constexpr size_t OFF_H = OFF_LAM + 256;
constexpr size_t OFF_PROJ = OFF_H + al256((size_t)TR * 1024 * 2);
constexpr size_t OFF_XC = OFF_PROJ + al256((size_t)TR * D_INP * 2);
constexpr size_t OFF_DT = OFF_XC + al256((size_t)TR * 1024 * 2);
constexpr size_t OFF_ACUM = OFF_DT + al256((size_t)TR * 8 * 4);
constexpr size_t OFF_VTA = OFF_ACUM + al256((size_t)TR * 8 * 4);
constexpr size_t OFF_VTD = OFF_VTA + al256((size_t)RB * 4 * 128 * 2048 * 2);
constexpr size_t OFF_QM = OFF_VTD + al256((size_t)RB * 4 * 128 * 2048 * 2);
constexpr size_t OFF_KM = OFF_QM + al256((size_t)TR * 768 * 2);
constexpr size_t OFF_KN = OFF_KM + al256((size_t)TR * 768 * 2);
constexpr size_t OFF_ST = OFF_KN + al256((size_t)TR * 512 * 2);
constexpr size_t OFF_SIN = OFF_ST + al256((size_t)RB * 16 * 8 * 8192 * 4);
constexpr size_t OFF_MS = OFF_SIN + al256((size_t)RB * 16 * 8 * 8192 * 2);
constexpr size_t OFF_XS = OFF_MS + al256((size_t)MAXBLK * 4 * 128 * 128 * 2);
constexpr size_t OFF_E = OFF_XS + al256((size_t)MAXBLK * 128 * 64 * 2);
constexpr size_t OFF_HIN = OFF_E + al256((size_t)32 * 128 * NBC * 4);
constexpr size_t OFF_YG = OFF_HIN + al256((size_t)32 * 128 * NBC * 2);
constexpr size_t OFF_MERGED = OFF_YG + al256((size_t)TR * 512 * 2);
constexpr size_t OFF_QK = OFF_MERGED + al256((size_t)TR * 1024 * 2);
constexpr size_t OFF_CQ2 = OFF_QK + al256((size_t)TR * 1024 * 2);
constexpr size_t OFF_QM2 = OFF_CQ2 + al256((size_t)TR * 384 * 2);
constexpr size_t OFF_BAR = OFF_QM2 + al256((size_t)TR * 768 * 2);
constexpr size_t WS_TOTAL = OFF_BAR + 8192;

constexpr int SMEM_BYTES = 73728 + 4096 + 64;

struct Params {
  const float* in[35];
  float* out;
  unsigned char* ws;
};

#define MEMBAR() do { asm volatile("" ::: "memory"); __builtin_amdgcn_sched_barrier(0); } while (0)
__device__ __forceinline__ int otid() { int t = threadIdx.x; asm volatile("" : "+v"(t)); return t; }
__device__ __forceinline__ bf16_t f2bf(float f) {
  unsigned u = __float_as_uint(f);
  u += 0x7fffu + ((u >> 16) & 1u);
  return (bf16_t)(u >> 16);
}
__device__ __forceinline__ float bf2f(bf16_t b) { return __uint_as_float(((unsigned)b) << 16); }
__device__ __forceinline__ unsigned pack2(float a, float b) { return (unsigned)f2bf(a) | ((unsigned)f2bf(b) << 16); }
__device__ __forceinline__ float sigmoidf_(float x) { return 1.0f / (1.0f + __expf(-x)); }
__device__ __forceinline__ float siluf_(float x) { return x / (1.0f + __expf(-x)); }
__device__ __forceinline__ float gelu_tanh(float x) {
  float u = 0.7978845608028654f * (x + 0.044715f * x * x * x);
  float t = 1.0f - 2.0f / (__expf(2.0f * u) + 1.0f);
  return 0.5f * x * (1.0f + t);
}
__device__ __forceinline__ float wave_sum(float v) {
#pragma unroll
  for (int d = 32; d >= 1; d >>= 1) v += __shfl_xor(v, d, 64);
  return v;
}

__device__ __forceinline__ void block_global_handoff() {
  asm volatile("s_waitcnt vmcnt(0)" ::: "memory");
  __syncthreads();
  if (otid() < 64) {
    __builtin_amdgcn_fence(__ATOMIC_ACQUIRE, "agent");
    asm volatile("s_waitcnt vmcnt(0)" ::: "memory");
  }
  __syncthreads();
}
template <int R, bool T, bool SEG, int N>
__device__ __forceinline__ void g_load(u32x4 (&rg)[N], const bf16_t* __restrict__ P, long ld, int k0, long segs, int tid) {
#pragma unroll
  for (int i = 0; i < N; ++i) {
    const int ch = tid + i * 256;
    if (!T) {
      const int row = ch >> 3, kc = k0 + (ch & 7) * 8;
      const long ko = SEG ? ((long)(kc >> 4) * segs + (kc & 15)) : (long)kc;
      rg[i] = *(const u32x4*)(P + (long)row * ld + ko);
    } else {
      constexpr int CPR = R / 8;
      const int kk = ch / CPR, m0 = (ch % CPR) * 8;
      rg[i] = *(const u32x4*)(P + (long)(k0 + kk) * ld + m0);
    }
  }
}
template <int R, bool T, int N>
__device__ __forceinline__ void s_store(const u32x4 (&rg)[N], bf16_t* sm, int tid) {
  constexpr int LS = 72;
#pragma unroll
  for (int i = 0; i < N; ++i) {
    const int ch = tid + i * 256;
    if (!T) {
      const int row = ch >> 3, kc = (ch & 7) * 8;
      *(u32x4*)(sm + row * LS + kc) = rg[i];
    } else {
      constexpr int CPR = R / 8;
      const int kk = ch / CPR, m0 = (ch % CPR) * 8;
      bf16_t* d = sm + m0 * LS + kk;
      d[0 * LS] = (bf16_t)(rg[i].x & 0xffffu); d[1 * LS] = (bf16_t)(rg[i].x >> 16);
      d[2 * LS] = (bf16_t)(rg[i].y & 0xffffu); d[3 * LS] = (bf16_t)(rg[i].y >> 16);
      d[4 * LS] = (bf16_t)(rg[i].z & 0xffffu); d[5 * LS] = (bf16_t)(rg[i].z >> 16);
      d[6 * LS] = (bf16_t)(rg[i].w & 0xffffu); d[7 * LS] = (bf16_t)(rg[i].w >> 16);
    }
  }
}
template <int BN>
__device__ __forceinline__ void mfma_stage(f32x4 (&acc)[4][BN / 32], const bf16_t* sA, const bf16_t* sB, int wr, int wc, int g, int c) {
  constexpr int LS = 72;
  const bf16_t* pa = sA + (wr * 64 + c) * LS + g * 8;
  const bf16_t* pb = sB + (wc * (BN / 2) + c) * LS + g * 8;
#pragma unroll
  for (int ks = 0; ks < 2; ++ks) {
    bf16x8 af[4], bfr[BN / 32];
#pragma unroll
    for (int i = 0; i < 4; ++i) af[i] = *(const bf16x8*)(pa + i * 16 * LS + ks * 32);
#pragma unroll
    for (int j = 0; j < BN / 32; ++j) bfr[j] = *(const bf16x8*)(pb + j * 16 * LS + ks * 32);
#pragma unroll
    for (int i = 0; i < 4; ++i)
#pragma unroll
      for (int j = 0; j < BN / 32; ++j) acc[i][j] = __builtin_amdgcn_mfma_f32_16x16x32_bf16(af[i], bfr[j], acc[i][j], 0, 0, 0);
  }
}
template <int BN, bool TA, bool TB, bool SEGA>
__device__ __forceinline__ void gemm_tile(f32x4 (&acc)[4][BN / 32], const bf16_t* __restrict__ A, long lda,
                                          const bf16_t* __restrict__ B, long ldb, int K, bf16_t* smem, long segs = 0) {
  constexpr int LS = 72;
  constexpr int STAGE = 2 * 128 * LS;
  const int tid = otid(), w = tid >> 6, l = tid & 63, g = l >> 4, c = l & 15;
  const int wr = w >> 1, wc = w & 1;
  constexpr int NA = 4, NB = BN / 32;
  u32x4 ra0[NA], rb0[NB], ra1[NA], rb1[NB];
  const int nk = K / 64;
  bf16_t* s0A = smem;
  bf16_t* s0B = smem + 128 * LS;
  bf16_t* s1A = smem + STAGE;
  bf16_t* s1B = smem + STAGE + 128 * LS;
  g_load<128, TA, SEGA, NA>(ra0, A, lda, 0, segs, tid);
  g_load<BN, TB, false, NB>(rb0, B, ldb, 0, 0, tid);
  g_load<128, TA, SEGA, NA>(ra1, A, lda, 64, segs, tid);
  g_load<BN, TB, false, NB>(rb1, B, ldb, 64, 0, tid);
  __syncthreads();
  s_store<128, TA, NA>(ra0, s0A, tid);
  s_store<BN, TB, NB>(rb0, s0B, tid);
  __syncthreads();
  for (int kt = 0; kt < nk; kt += 2) {
    if (kt + 2 < nk) {
      g_load<128, TA, SEGA, NA>(ra0, A, lda, (kt + 2) * 64, segs, tid);
      g_load<BN, TB, false, NB>(rb0, B, ldb, (kt + 2) * 64, 0, tid);
    }
    mfma_stage<BN>(acc, s0A, s0B, wr, wc, g, c);
    s_store<128, TA, NA>(ra1, s1A, tid);
    s_store<BN, TB, NB>(rb1, s1B, tid);
    __syncthreads();
    if (kt + 3 < nk) {
      g_load<128, TA, SEGA, NA>(ra1, A, lda, (kt + 3) * 64, segs, tid);
      g_load<BN, TB, false, NB>(rb1, B, ldb, (kt + 3) * 64, 0, tid);
    }
    mfma_stage<BN>(acc, s1A, s1B, wr, wc, g, c);
    if (kt + 2 < nk) {
      s_store<128, TA, NA>(ra0, s0A, tid);
      s_store<BN, TB, NB>(rb0, s0B, tid);
    }
    __syncthreads();
  }
}

template <int NJ>
__device__ __forceinline__ void zero_acc(f32x4 (&acc)[4][NJ]) {
#pragma unroll
  for (int i = 0; i < 4; ++i)
#pragma unroll
    for (int j = 0; j < NJ; ++j) acc[i][j] = (f32x4){0.f, 0.f, 0.f, 0.f};
}

__device__ __forceinline__ void tconv_tile(const float* __restrict__ src, bf16_t* __restrict__ dst, int K, int N, int tk, int tn, float* sm) {
  const int tid = otid();
  const int k0 = tk * 64, n0 = tn * 64;
  __syncthreads();
#pragma unroll 4
  for (int i = 0; i < 16; ++i) {
    const int kk = i * 4 + (tid >> 6), nn = tid & 63;
    float v = 0.f;
    if (n0 + nn < N) v = src[(long)(k0 + kk) * N + n0 + nn];
    sm[kk * 65 + nn] = v;
  }
  __syncthreads();
#pragma unroll 4
  for (int i = 0; i < 16; ++i) {
    const int nn = i * 4 + (tid >> 6), kk = tid & 63;
    dst[(long)(n0 + nn) * K + k0 + kk] = f2bf(sm[kk * 65 + nn]);
  }
}

__device__ __forceinline__ void tconv_job(const float* src, bf16_t* dst, int K, int N, int Npad, float* sm) {
  const int tkn = K / 64, tnn = Npad / 64;
  for (int t = blockIdx.x; t < tkn * tnn; t += gridDim.x) tconv_tile(src, dst, K, N, t % tkn, t / tkn, sm);
}

__device__ __forceinline__ void s5_prep(const Params& p, int layer, int grp, float* sm) {
  float* pwr = sm;
  float* pwi = pwr + 9 * 64;
  float* bbr = pwi + 9 * 64;
  float* bbi = bbr + 1024;
  float* cr = bbi + 1024;
  float* ci = cr + 1024;
  float* kt = ci + 1024;
  const int tid = otid();
  const int lg = layer * 32 + grp;
  __syncthreads();
  if (tid < 64) {
    const int pp = tid;
    const double step = exp((double)p.in[19][lg]);
    const double lr = (double)p.in[17][lg * 64 + pp], li = (double)p.in[18][lg * 64 + pp];
    const double mag = exp(lr * step);
    const double abr = mag * cos(li * step), abi = mag * sin(li * step);
    const double den = lr * lr + li * li;
    const double fr = ((abr - 1.0) * lr + abi * li) / den;
    const double fi = (abi * lr - (abr - 1.0) * li) / den;
    double qr = 1.0, qi = 0.0;
    for (int t = 0; t < 9; ++t) {
      pwr[t * 64 + pp] = (float)qr;
      pwi[t * 64 + pp] = (float)qi;
      const double nr = qr * abr - qi * abi, ni = qr * abi + qi * abr;
      qr = nr; qi = ni;
    }
    float* a8 = (float*)(p.ws + OFF_A8) + (size_t)(lg * 64 + pp) * 2;
    a8[0] = pwr[8 * 64 + pp];
    a8[1] = pwi[8 * 64 + pp];
    for (int cc = 0; cc < 16; ++cc) {
      const double br = (double)p.in[20][(lg * 64 + pp) * 16 + cc], bi = (double)p.in[21][(lg * 64 + pp) * 16 + cc];
      bbr[pp * 16 + cc] = (float)(fr * br - fi * bi);
      bbi[pp * 16 + cc] = (float)(fr * bi + fi * br);
    }
  }
  for (int e = tid; e < 1024; e += 256) {
    cr[e] = p.in[22][lg * 1024 + e];
    ci[e] = p.in[23][lg * 1024 + e];
  }
  __syncthreads();
  for (int e = tid; e < 2048; e += 256) {
    const int tau = e >> 8, co = (e >> 4) & 15, cin = e & 15;
    float s = 0.f;
    for (int pp = 0; pp < 64; ++pp) {
      const float pr = pwr[tau * 64 + pp], pi = pwi[tau * 64 + pp];
      const float zr = pr * bbr[pp * 16 + cin] - pi * bbi[pp * 16 + cin];
      const float zi = pr * bbi[pp * 16 + cin] + pi * bbr[pp * 16 + cin];
      s += cr[co * 64 + pp] * zr - ci[co * 64 + pp] * zi;
    }
    kt[e] = s;
  }
  __syncthreads();
  bf16_t* Km = (bf16_t*)(p.ws + OFF_KMAT) + (size_t)lg * 16384;
  bf16_t* Em = (bf16_t*)(p.ws + OFF_EMAT) + (size_t)lg * 16384;
  bf16_t* Fm = (bf16_t*)(p.ws + OFF_FMAT) + (size_t)lg * 16384;
  for (int e = tid; e < 16384; e += 256) {
    const int n = e >> 7, k = e & 127;
    {
      const int tq = n >> 4, co = n & 15, sq = k >> 4, cin = k & 15;
      Km[e] = f2bf(tq >= sq ? kt[((tq - sq) * 16 + co) * 16 + cin] : 0.f);
    }
    {
      const int pp = n >> 1, ri = n & 1, sq = k >> 4, cin = k & 15;
      const float pr = pwr[(7 - sq) * 64 + pp], pi = pwi[(7 - sq) * 64 + pp];
      const float zr = pr * bbr[pp * 16 + cin] - pi * bbi[pp * 16 + cin];
      const float zi = pr * bbi[pp * 16 + cin] + pi * bbr[pp * 16 + cin];
      Em[e] = f2bf(ri ? zi : zr);
    }
    {
      const int tq = n >> 4, co = n & 15, pp = k >> 1, ri = k & 1;
      const float pr = pwr[(tq + 1) * 64 + pp], pi = pwi[(tq + 1) * 64 + pp];
      const float gr = cr[co * 64 + pp] * pr - ci[co * 64 + pp] * pi;
      const float gi = cr[co * 64 + pp] * pi + ci[co * 64 + pp] * pr;
      Fm[e] = f2bf(ri ? -gi : gr);
    }
  }
}

__device__ __forceinline__ void phase_prep(const Params& p, float* smf) {
  for (int L = 0; L < 2; ++L) {
    tconv_job(p.in[3] + (size_t)L * 1024 * D_IN, (bf16_t*)(p.ws + OFF_WINT) + (size_t)L * D_INP * 1024, 1024, D_IN, D_INP, smf);
    for (int n = 0; n < 4; ++n)
      tconv_job(p.in[33] + (size_t)(L * 4 + n) * 512 * 1024, (bf16_t*)(p.ws + OFF_WBRT) + (size_t)(L * 4 + n) * 1024 * 512, 512, 1024, 1024, smf);
    tconv_job(p.in[34] + (size_t)L * 1024 * 1024, (bf16_t*)(p.ws + OFF_WOUTT) + (size_t)L * 1024 * 1024, 1024, 1024, 1024, smf);
    tconv_job(p.in[25] + (size_t)L * 512 * 512, (bf16_t*)(p.ws + OFF_WGLUT) + (size_t)L * 512 * 512, 512, 512, 512, smf);
    tconv_job(p.in[28] + (size_t)L * 256 * 768, (bf16_t*)(p.ws + OFF_WUQT) + (size_t)L * 768 * 256, 256, 768, 768, smf);
    tconv_job(p.in[30] + (size_t)L * 128 * 1024, (bf16_t*)(p.ws + OFF_WUKVT) + (size_t)L * 1024 * 128, 128, 1024, 1024, smf);
  }
  for (int it = blockIdx.x; it < 64; it += gridDim.x) s5_prep(p, it >> 5, it & 31, smf);
  if (blockIdx.x == gridDim.x - 1 && otid() < 2) {
    const int L = otid();
    float s1 = 0.f, s2 = 0.f;
    for (int i = 0; i < 64; ++i) {
      s1 += p.in[6][L * 64 + i] * p.in[7][L * 64 + i];
      s2 += p.in[8][L * 64 + i] * p.in[9][L * 64 + i];
    }
    const float li = 0.8f - 0.6f * expf(-0.3f * (float)L);
    ((float*)(p.ws + OFF_LAM))[L] = expf(s1) - expf(s2) + li;
  }
}

__device__ __forceinline__ void phase_hnorm(const float* __restrict__ x, const float* __restrict__ gn, bf16_t* __restrict__ H) {
  const int w = otid() >> 6, l = otid() & 63;
  for (int row = blockIdx.x * 4 + w; row < TR; row += gridDim.x * 4) {
    const float4* xr = (const float4*)(x + (size_t)row * 1024);
    float4 v[4];
    float ss = 0.f;
#pragma unroll
    for (int i = 0; i < 4; ++i) {
      v[i] = xr[i * 64 + l];
      ss += v[i].x * v[i].x + v[i].y * v[i].y + v[i].z * v[i].z + v[i].w * v[i].w;
    }
    ss = wave_sum(ss);
    const float rs = rsqrtf(ss * (1.0f / 1024.0f) + EPS);
#pragma unroll
    for (int i = 0; i < 4; ++i) {
      const float4 gg = ((const float4*)gn)[i * 64 + l];
      u32x2 o;
      o.x = pack2(v[i].x * rs * gg.x, v[i].y * rs * gg.y);
      o.y = pack2(v[i].z * rs * gg.z, v[i].w * rs * gg.w);
      *(u32x2*)(H + (size_t)row * 1024 + (i * 64 + l) * 4) = o;
    }
  }
}

__device__ __forceinline__ void inproj_tile(const Params& p, int layer, int rt, int ct, bf16_t* smem) {
  const bf16_t* H = (const bf16_t*)(p.ws + OFF_H);
  const bf16_t* W = (const bf16_t*)(p.ws + OFF_WINT) + (size_t)layer * D_INP * 1024;
  bf16_t* PROJ = (bf16_t*)(p.ws + OFF_PROJ);
  bf16_t* VTA = (bf16_t*)(p.ws + OFF_VTA);
  f32x4 acc[4][4];
  zero_acc<4>(acc);
  gemm_tile<128, false, false, false>(acc, H + (size_t)rt * 128 * 1024, 1024, W + (size_t)ct * 128 * 1024, 1024, 1024, smem);
  const int tid = otid(), w = tid >> 6, l = tid & 63, g = l >> 4, c = l & 15, wr = w >> 1, wc = w & 1;
  const int c0 = ct * 128;
  if (c0 >= C_DAV && c0 < C_DAG) {
    const int h = (c0 - C_DAV) >> 7;
#pragma unroll
    for (int i = 0; i < 4; ++i)
#pragma unroll
      for (int j = 0; j < 4; ++j) {
        const int row = rt * 128 + wr * 64 + i * 16 + g * 4;
        const int dv = wc * 64 + j * 16 + c;
        const int b = row >> 11, s = row & 2047;
        u32x2 o;
        o.x = pack2(acc[i][j][0], acc[i][j][1]);
        o.y = pack2(acc[i][j][2], acc[i][j][3]);
        *(u32x2*)(VTA + ((size_t)((b * 4 + h) * 128 + dv)) * 2048 + s) = o;
      }
  } else {
#pragma unroll
    for (int i = 0; i < 4; ++i) {
#pragma unroll
      for (int r = 0; r < 4; ++r) {
        const int row = rt * 128 + wr * 64 + i * 16 + g * 4 + r;
        bf16_t* rp = PROJ + (size_t)row * LDP + c0 + wc * 64 + c;
#pragma unroll
        for (int j = 0; j < 4; ++j) {
          float v = acc[i][j][r];
          if (c0 + wc * 64 + j * 16 + c >= C_GATE) v = sigmoidf_(v);
          rp[j * 16] = f2bf(v);
        }
      }
      MEMBAR();
    }
  }
}

__device__ __forceinline__ void tokpost_item(const Params& p, int layer, int round, int item) {
  bf16_t* PROJ = (bf16_t*)(p.ws + OFF_PROJ);
  const int* pos = (const int*)p.in[1];
  const int w = otid() >> 6, l = otid() & 63;
  for (int tt = 0; tt < 4; ++tt) {
    const int row = item * 16 + w * 4 + tt;
    const float fpos = (float)pos[round * TR + row];
    bf16_t* pr = PROJ + (size_t)row * LDP;
    {
      const int which = l >> 5, idx = (l & 31) * 16, off = (l & 3) * 16;
      bf16_t* ptr = pr + which * 512 + idx;
      u32x4 u0 = *(const u32x4*)ptr, u1 = *(const u32x4*)(ptr + 8);
      const unsigned uu[8] = {u0.x, u0.y, u0.z, u0.w, u1.x, u1.y, u1.z, u1.w};
      float v[16];
      float ss = 0.f;
#pragma unroll
      for (int e = 0; e < 8; ++e) {
        v[2 * e] = __uint_as_float(uu[e] << 16);
        v[2 * e + 1] = __uint_as_float(uu[e] & 0xffff0000u);
        ss += v[2 * e] * v[2 * e] + v[2 * e + 1] * v[2 * e + 1];
      }
      ss += __shfl_xor(ss, 1, 64);
      ss += __shfl_xor(ss, 2, 64);
      const float rs = rsqrtf(ss * (1.0f / 64.0f) + EPS);
      const float* gn = (which ? p.in[5] : p.in[4]) + layer * 64 + off;
#pragma unroll
      for (int e = 0; e < 16; ++e) v[e] = v[e] * rs * gn[e];
      if ((l & 3) == 0) {
#pragma unroll
        for (int i = 0; i < 8; ++i) {
          const float invf = expf(-13.122363377404328f * (float)i * 0.125f);
          const float ang = fpos * invf;
          const float cs = cosf(ang), sn = sinf(ang);
          const float x1 = v[i], x2 = v[i + 8];
          v[i] = x1 * cs - x2 * sn;
          v[i + 8] = x2 * cs + x1 * sn;
        }
      }
      if (which == 0) {
#pragma unroll
        for (int e = 0; e < 16; ++e) v[e] *= 0.125f * LOG2E;
      }
      u32x4 o0, o1;
      o0.x = pack2(v[0], v[1]); o0.y = pack2(v[2], v[3]); o0.z = pack2(v[4], v[5]); o0.w = pack2(v[6], v[7]);
      o1.x = pack2(v[8], v[9]); o1.y = pack2(v[10], v[11]); o1.z = pack2(v[12], v[13]); o1.w = pack2(v[14], v[15]);
      bf16_t* qko = (bf16_t*)(p.ws + OFF_QK) + (size_t)row * 1024 + which * 512 + idx;
      *(u32x4*)qko = o0;
      *(u32x4*)(qko + 8) = o1;
    }
    {
      bf16_t* ptr = pr + C_CQ + l * 4;
      u32x2 u = *(const u32x2*)ptr;
      float v0 = __uint_as_float(u.x << 16), v1 = __uint_as_float(u.x & 0xffff0000u);
      float v2 = __uint_as_float(u.y << 16), v3 = __uint_as_float(u.y & 0xffff0000u);
      float ss = wave_sum(v0 * v0 + v1 * v1 + v2 * v2 + v3 * v3);
      const float rs = rsqrtf(ss * (1.0f / 256.0f) + EPS);
      const float* gn = p.in[27] + layer * 256 + l * 4;
      u32x2 o;
      o.x = pack2(v0 * rs * gn[0], v1 * rs * gn[1]);
      o.y = pack2(v2 * rs * gn[2], v3 * rs * gn[3]);
      *(u32x2*)((bf16_t*)(p.ws + OFF_CQ2) + (size_t)row * 384 + l * 4) = o;
    }
    {
      bf16_t* ptr = pr + C_CKV + l * 2;
      unsigned u = *(const unsigned*)ptr;
      float v0 = __uint_as_float(u << 16), v1 = __uint_as_float(u & 0xffff0000u);
      float ss = wave_sum(v0 * v0 + v1 * v1);
      const float rs = rsqrtf(ss * (1.0f / 128.0f) + EPS);
      const float* gn = p.in[29] + layer * 128 + l * 2;
      *(unsigned*)((bf16_t*)(p.ws + OFF_CQ2) + (size_t)row * 384 + 256 + l * 2) = pack2(v0 * rs * gn[0], v1 * rs * gn[1]);
    }
  }
}

__device__ __forceinline__ void conv_item(const Params& p, int layer, int item) {
  const bf16_t* PROJ = (const bf16_t*)(p.ws + OFF_PROJ);
  bf16_t* XC = (bf16_t*)(p.ws + OFF_XC);
  const int chtile = item & 15, tt = (item >> 4) & 31, b = item >> 9;
  const int ch = chtile * 64 + (otid() & 63);
  const int tr0 = otid() >> 6;
  const float* cw = p.in[11] + (size_t)layer * 4 * 1024;
  const float w0 = cw[ch], w1 = cw[1024 + ch], w2 = cw[2048 + ch], w3 = cw[3072 + ch];
  const float bias = p.in[12][layer * 1024 + ch];
  for (int i0 = 0; i0 < 16; i0 += 8) {
    float x0[8], x1[8], x2[8], x3[8];
#pragma unroll
    for (int u = 0; u < 8; ++u) {
      const int t = tt * 64 + (i0 + u) * 4 + tr0;
      const bf16_t* base = PROJ + (size_t)(b * 2048 + t) * LDP + C_XBC + ch;
      x3[u] = bf2f(base[0]);
      x2[u] = (t >= 1) ? bf2f(*(base - LDP)) : 0.f;
      x1[u] = (t >= 2) ? bf2f(*(base - 2 * LDP)) : 0.f;
      x0[u] = (t >= 3) ? bf2f(*(base - 3 * LDP)) : 0.f;
    }
#pragma unroll
    for (int u = 0; u < 8; ++u) {
      const int t = tt * 64 + (i0 + u) * 4 + tr0;
      const float y = bias + w3 * x3[u] + w2 * x2[u] + w1 * x1[u] + w0 * x0[u];
      XC[(size_t)(b * 2048 + t) * 1024 + ch] = f2bf(siluf_(y));
    }
  }
}

__device__ __forceinline__ void dtacum_item(const Params& p, int layer, int item) {
  const bf16_t* PROJ = (const bf16_t*)(p.ws + OFF_PROJ);
  float* DT = (float*)(p.ws + OFF_DT);
  float* AC = (float*)(p.ws + OFF_ACUM);
  const int w = otid() >> 6, l = otid() & 63;
  const int id = item * 4 + w;
  const int h = id & 7, bc = id >> 3;
  const int row0 = bc * 128 + 2 * l;
  const float bias = p.in[13][layer * 8 + h];
  const float A = -expf(p.in[14][layer * 8 + h]);
  float x0 = bf2f(PROJ[(size_t)row0 * LDP + C_DT + h]) + bias;
  float x1 = bf2f(PROJ[(size_t)(row0 + 1) * LDP + C_DT + h]) + bias;
  const float d0 = x0 > 20.f ? x0 : log1pf(expf(x0));
  const float d1 = x1 > 20.f ? x1 : log1pf(expf(x1));
  const float a0 = d0 * A, a1 = d1 * A;
  float s = a0 + a1;
#pragma unroll
  for (int d = 1; d < 64; d <<= 1) {
    const float t = __shfl_up(s, d, 64);
    if (l >= d) s += t;
  }
  DT[(size_t)row0 * 8 + h] = d0;
  DT[(size_t)(row0 + 1) * 8 + h] = d1;
  AC[(size_t)row0 * 8 + h] = s - a1;
  AC[(size_t)(row0 + 1) * 8 + h] = s;
}

__device__ __forceinline__ void s5_e_item(const Params& p, int layer, int item, bf16_t* smem) {
  const bf16_t* PROJ = (const bf16_t*)(p.ws + OFF_PROJ);
  const int grp = item >> 3, mt = item & 7;
  const bf16_t* Em = (const bf16_t*)(p.ws + OFF_EMAT) + (size_t)(layer * 32 + grp) * 16384;
  float* E = (float*)(p.ws + OFF_E);
  f32x4 acc[4][4];
  zero_acc<4>(acc);
  gemm_tile<128, false, false, true>(acc, PROJ + (size_t)mt * 128 * 8 * LDP + C_S5U + grp * 16, 8 * LDP, Em, 128, 128, smem, LDP);
  const int tid = otid(), w = tid >> 6, l = tid & 63, g = l >> 4, c = l & 15, wr = w >> 1, wc = w & 1;
#pragma unroll
  for (int i = 0; i < 4; ++i)
#pragma unroll
    for (int j = 0; j < 4; ++j) {
      const int m = mt * 128 + wr * 64 + i * 16 + g * 4;
      const int n = wc * 64 + j * 16 + c;
      *(f32x4*)(E + ((size_t)(grp * 128 + n)) * NBC + m) = acc[i][j];
    }
}

__device__ __forceinline__ void mla_up_q_tile(const Params& p, int layer, int rt, int ct, bf16_t* smem) {
  const bf16_t* PROJ = (const bf16_t*)(p.ws + OFF_PROJ);
  const bf16_t* W = (const bf16_t*)(p.ws + OFF_WUQT) + (size_t)layer * 768 * 256;
  bf16_t* QM = (bf16_t*)(p.ws + OFF_QM);
  f32x4 acc[4][4];
  zero_acc<4>(acc);
  gemm_tile<128, false, false, false>(acc, (const bf16_t*)(p.ws + OFF_CQ2) + (size_t)rt * 128 * 384, 384, W + (size_t)ct * 128 * 256, 256, 256, smem);
  const int tid = otid(), w = tid >> 6, l = tid & 63, g = l >> 4, c = l & 15, wr = w >> 1, wc = w & 1;
#pragma unroll
  for (int i = 0; i < 4; ++i)
#pragma unroll
    for (int j = 0; j < 4; ++j)
#pragma unroll
      for (int r = 0; r < 4; ++r) {
        const int row = rt * 128 + wr * 64 + i * 16 + g * 4 + r, col = ct * 128 + wc * 64 + j * 16 + c;
        QM[(size_t)row * 768 + col] = f2bf(acc[i][j][r]);
      }
}
__device__ __forceinline__ void mla_up_kv_tile(const Params& p, int layer, int rt, int ct, bf16_t* smem) {
  const bf16_t* PROJ = (const bf16_t*)(p.ws + OFF_PROJ);
  const bf16_t* W = (const bf16_t*)(p.ws + OFF_WUKVT) + (size_t)layer * 1024 * 128;
  bf16_t* KN = (bf16_t*)(p.ws + OFF_KN);
  bf16_t* VTD = (bf16_t*)(p.ws + OFF_VTD);
  f32x4 acc[4][4];
  zero_acc<4>(acc);
  gemm_tile<128, false, false, false>(acc, (const bf16_t*)(p.ws + OFF_CQ2) + (size_t)rt * 128 * 384 + 256, 384, W + (size_t)ct * 128 * 128, 128, 128, smem);
  const int tid = otid(), w = tid >> 6, l = tid & 63, g = l >> 4, c = l & 15, wr = w >> 1, wc = w & 1;
  const int h = ct >> 1;
  if ((ct & 1) == 0) {
#pragma unroll
    for (int i = 0; i < 4; ++i)
#pragma unroll
      for (int j = 0; j < 4; ++j)
#pragma unroll
        for (int r = 0; r < 4; ++r) {
          const int row = rt * 128 + wr * 64 + i * 16 + g * 4 + r, cc = wc * 64 + j * 16 + c;
          KN[(size_t)row * 512 + h * 128 + cc] = f2bf(acc[i][j][r]);
        }
  } else {
#pragma unroll
    for (int i = 0; i < 4; ++i)
#pragma unroll
      for (int j = 0; j < 4; ++j) {
        const int row = rt * 128 + wr * 64 + i * 16 + g * 4, dv = wc * 64 + j * 16 + c;
        const int b = row >> 11, s = row & 2047;
        u32x2 o;
        o.x = pack2(acc[i][j][0], acc[i][j][1]);
        o.y = pack2(acc[i][j][2], acc[i][j][3]);
        *(u32x2*)(VTD + ((size_t)((b * 4 + h) * 128 + dv)) * 2048 + s) = o;
      }
  }
}

__device__ __forceinline__ void mb_states_item(const Params& p, int item, bf16_t* smem) {
  const bf16_t* XC = (const bf16_t*)(p.ws + OFF_XC);
  const float* DT = (const float*)(p.ws + OFF_DT);
  const float* AC = (const float*)(p.ws + OFF_ACUM);
  bf16_t* XS = (bf16_t*)(p.ws + OFF_XS) + (size_t)blockIdx.x * 128 * 64;
  float* ST = (float*)(p.ws + OFF_ST);
  const int h = item & 7, bc = item >> 3;
  const int grp = h >> 2;
  const int row0 = bc * 128;
  const int tid = otid();
  __syncthreads();
  const float alast = AC[(size_t)(row0 + 127) * 8 + h];
  for (int e0 = tid; e0 < 8192; e0 += 2048) {
    float dv[8], av[8];
    bf16_t xv[8];
#pragma unroll
    for (int u = 0; u < 8; ++u) {
      const int e = e0 + u * 256;
      const int row = row0 + (e >> 6);
      dv[u] = DT[(size_t)row * 8 + h];
      av[u] = AC[(size_t)row * 8 + h];
      xv[u] = XC[(size_t)row * 1024 + h * 64 + (e & 63)];
    }
#pragma unroll
    for (int u = 0; u < 8; ++u) XS[e0 + u * 256] = f2bf(bf2f(xv[u]) * dv[u] * __expf(alast - av[u]));
  }
  block_global_handoff();
  f32x4 acc[4][2];
  zero_acc<2>(acc);
  gemm_tile<64, true, true, false>(acc, XC + (size_t)row0 * 1024 + 512 + grp * 128, 1024, XS, 64, 128, smem);
  const int w = tid >> 6, l = tid & 63, g = l >> 4, c = l & 15, wr = w >> 1, wc = w & 1;
#pragma unroll
  for (int i = 0; i < 4; ++i)
#pragma unroll
    for (int j = 0; j < 2; ++j) {
      const int n = wr * 64 + i * 16 + g * 4;
      const int pp = wc * 32 + j * 16 + c;
      *(f32x4*)(ST + ((size_t)(bc * 8 + h) * 64 + pp) * 128 + n) = acc[i][j];
    }
}

__device__ __forceinline__ void s5_carry_item(const Params& p, int layer, int item) {
  const int idx = item * 256 + otid();
  const int b = idx >> 11, grp = (idx >> 6) & 31, pp = idx & 63;
  const float* a8 = (const float*)(p.ws + OFF_A8) + (size_t)((layer * 32 + grp) * 64 + pp) * 2;
  const float ar = a8[0], ai = a8[1];
  const float* er = (const float*)(p.ws + OFF_E) + ((size_t)(grp * 128 + 2 * pp)) * NBC + b * 256;
  const float* ei = er + NBC;
  bf16_t* hro = (bf16_t*)(p.ws + OFF_HIN) + ((size_t)(grp * 128 + 2 * pp)) * NBC + b * 256;
  bf16_t* hio = hro + NBC;
  float hr = 0.f, hi = 0.f;
  for (int c16 = 0; c16 < 16; ++c16) {
    f32x4 vr[4], vi[4];
#pragma unroll
    for (int u = 0; u < 4; ++u) {
      vr[u] = *(const f32x4*)(er + c16 * 16 + u * 4);
      vi[u] = *(const f32x4*)(ei + c16 * 16 + u * 4);
    }
#pragma unroll
    for (int u = 0; u < 4; ++u) {
      float orr[4], oii[4];
#pragma unroll
      for (int k = 0; k < 4; ++k) {
        orr[k] = hr; oii[k] = hi;
        const float nr = ar * hr - ai * hi + vr[u][k];
        const float ni = ar * hi + ai * hr + vi[u][k];
        hr = nr; hi = ni;
      }
      u32x2 o0, o1;
      o0.x = pack2(orr[0], orr[1]); o0.y = pack2(orr[2], orr[3]);
      o1.x = pack2(oii[0], oii[1]); o1.y = pack2(oii[2], oii[3]);
      *(u32x2*)(hro + c16 * 16 + u * 4) = o0;
      *(u32x2*)(hio + c16 * 16 + u * 4) = o1;
    }
  }
}

__device__ __forceinline__ void mlapost_item(const Params& p, int layer, int round, int item) {
  const bf16_t* PROJ = (const bf16_t*)(p.ws + OFF_PROJ);
  bf16_t* QM = (bf16_t*)(p.ws + OFF_QM);
  bf16_t* KM = (bf16_t*)(p.ws + OFF_KM);
  const bf16_t* KN = (const bf16_t*)(p.ws + OFF_KN);
  const int* pos = (const int*)p.in[1];
  const int w = otid() >> 6, l = otid() & 63;
  const float* qn = p.in[31] + layer * 192;
  const float* kn = p.in[32] + layer * 192;
  const float q0 = qn[l], q1 = qn[64 + l], q2 = qn[128 + l];
  const float k0 = kn[l], k1 = kn[64 + l], k2 = kn[128 + l];
  const float invf = expf(-13.122363377404328f * (float)(l & 31) * (1.0f / 32.0f));
  const float qscale = 0.07216878364870322f * LOG2E;
  for (int tt = 0; tt < 4; ++tt) {
    const int row = item * 16 + w * 4 + tt;
    const float ang = (float)pos[round * TR + row] * invf;
    const float cs = cosf(ang), sn = sinf(ang);
    const float kr = bf2f(PROJ[(size_t)row * LDP + C_KR + l]);
#pragma unroll
    for (int h = 0; h < 4; ++h) {
      {
        bf16_t* qp = QM + (size_t)row * 768 + h * 192;
        float e0 = bf2f(qp[l]), e1 = bf2f(qp[64 + l]), e2 = bf2f(qp[128 + l]);
        const float ss = wave_sum(e0 * e0 + e1 * e1 + e2 * e2);
        const float rs = rsqrtf(ss * (1.0f / 192.0f) + EPS);
        e0 *= rs * q0; e1 *= rs * q1; e2 *= rs * q2;
        const float ot = __shfl_xor(e2, 32, 64);
        e2 = (l < 32) ? (e2 * cs - ot * sn) : (e2 * cs + ot * sn);
        bf16_t* qo = (bf16_t*)(p.ws + OFF_QM2) + (size_t)row * 768 + h * 192;
        qo[l] = f2bf(e0 * qscale); qo[64 + l] = f2bf(e1 * qscale); qo[128 + l] = f2bf(e2 * qscale);
      }
      {
        const bf16_t* kp = KN + (size_t)row * 512 + h * 128;
        float e0 = bf2f(kp[l]), e1 = bf2f(kp[64 + l]), e2 = kr;
        const float ss = wave_sum(e0 * e0 + e1 * e1 + e2 * e2);
        const float rs = rsqrtf(ss * (1.0f / 192.0f) + EPS);
        e0 *= rs * k0; e1 *= rs * k1; e2 *= rs * k2;
        const float ot = __shfl_xor(e2, 32, 64);
        e2 = (l < 32) ? (e2 * cs - ot * sn) : (e2 * cs + ot * sn);
        bf16_t* ko = KM + (size_t)row * 768 + h * 192;
        ko[l] = f2bf(e0); ko[64 + l] = f2bf(e1); ko[128 + l] = f2bf(e2);
      }
    }
  }
}

__device__ __forceinline__ void mb_scan_item(const Params& p, int item) {
  const int idx = item * 256 + otid();
  const int b = idx >> 16, h = (idx >> 13) & 7, pn = idx & 8191;
  const float* ST = (const float*)(p.ws + OFF_ST);
  const float* AC = (const float*)(p.ws + OFF_ACUM);
  bf16_t* SIN = (bf16_t*)(p.ws + OFF_SIN);
  float cur = 0.f;
  float alv[16], stv[16];
#pragma unroll
  for (int c = 0; c < 16; ++c) {
    alv[c] = AC[(size_t)(b * 2048 + c * 128 + 127) * 8 + h];
    stv[c] = ST[((size_t)((b * 16 + c) * 8 + h)) * 8192 + pn];
  }
#pragma unroll
  for (int c = 0; c < 16; ++c) {
    SIN[((size_t)((b * 16 + c) * 8 + h)) * 8192 + pn] = f2bf(cur);
    cur = __expf(alv[c]) * cur + stv[c];
  }
}

__device__ __forceinline__ void s5_y_item(const Params& p, int layer, int item, bf16_t* smem) {
  const bf16_t* PROJ = (const bf16_t*)(p.ws + OFF_PROJ);
  const int grp = item >> 3, mt = item & 7;
  const bf16_t* Km = (const bf16_t*)(p.ws + OFF_KMAT) + (size_t)(layer * 32 + grp) * 16384;
  const bf16_t* Fm = (const bf16_t*)(p.ws + OFF_FMAT) + (size_t)(layer * 32 + grp) * 16384;
  const bf16_t* HIN = (const bf16_t*)(p.ws + OFF_HIN) + (size_t)grp * 128 * NBC + mt * 128;
  bf16_t* YG = (bf16_t*)(p.ws + OFF_YG);
  f32x4 acc[4][4];
  zero_acc<4>(acc);
  gemm_tile<128, false, false, true>(acc, PROJ + (size_t)mt * 128 * 8 * LDP + C_S5U + grp * 16, 8 * LDP, Km, 128, 128, smem, LDP);
  gemm_tile<128, true, false, false>(acc, HIN, NBC, Fm, 128, 128, smem);
  const int tid = otid(), w = tid >> 6, l = tid & 63, g = l >> 4, c = l & 15, wr = w >> 1, wc = w & 1;
  const float* dsk = p.in[24] + layer * 512;
#pragma unroll
  for (int i = 0; i < 4; ++i)
#pragma unroll
    for (int j = 0; j < 4; ++j) {
      const int n = wc * 64 + j * 16 + c;
      const int tq = n >> 4, co = n & 15;
      const int ch = grp * 16 + co;
      const float dd = dsk[ch];
#pragma unroll
      for (int r = 0; r < 4; ++r) {
        const int m = mt * 128 + wr * 64 + i * 16 + g * 4 + r;
        const int row = m * 8 + tq;
        const float u = bf2f(PROJ[(size_t)row * LDP + C_S5U + ch]);
        const float y = acc[i][j][r] + dd * u;
        YG[(size_t)row * 512 + ch] = f2bf(gelu_tanh(y));
      }
    }
}

template <int DK, int NM>
__device__ __forceinline__ void attn_core(const bf16_t* __restrict__ Qb, long ldq, const bf16_t* __restrict__ Kb, long ldk,
                                          const bf16_t* __restrict__ Vt, int qb, bf16_t* smem, f32x4 (&O)[NM][8], float (&lsum)[NM][4]) {
  constexpr int KST = DK + 8;
  constexpr int KCH = NM * 64 * DK / 8 / 256;
  constexpr int CPM = 64 * DK / 8;
  constexpr int CPRK = DK / 8;
  bf16_t* sK = smem;
  bf16_t* sV = sK + NM * 64 * KST;
  bf16_t* sP = sV + 128 * 72;
  const int tid = otid(), w = tid >> 6, l = tid & 63, g = l >> 4, c = l & 15;
  bf16x8 qf[NM][DK / 32];
  {
    const long qrow = (long)qb * 64 + w * 16 + c;
#pragma unroll
    for (int m = 0; m < NM; ++m)
#pragma unroll
      for (int ks = 0; ks < DK / 32; ++ks) qf[m][ks] = *(const bf16x8*)(Qb + qrow * ldq + m * DK + ks * 32 + g * 8);
  }
  float mrow[NM][4];
#pragma unroll
  for (int m = 0; m < NM; ++m) {
#pragma unroll
    for (int r = 0; r < 4; ++r) { mrow[m][r] = -INFINITY; lsum[m][r] = 0.f; }
#pragma unroll
    for (int nt = 0; nt < 8; ++nt) O[m][nt] = (f32x4){0.f, 0.f, 0.f, 0.f};
  }
  u32x4 kr[KCH], vr[4];
  auto gloadK = [&](int kt) {
#pragma unroll
    for (int i = 0; i < KCH; ++i) {
      const int ch = tid + i * 256;
      const int m = ch / CPM, cc = ch % CPM;
      const int key = cc / CPRK, d0 = (cc % CPRK) * 8;
      kr[i] = *(const u32x4*)(Kb + (long)(kt * 64 + key) * ldk + m * DK + d0);
    }
  };
  auto gloadV = [&](int kt) {
#pragma unroll
    for (int i = 0; i < 4; ++i) {
      const int ch = tid + i * 256;
      const int dvr = ch >> 3, kc = (ch & 7) * 8;
      vr[i] = *(const u32x4*)(Vt + (long)dvr * 2048 + kt * 64 + kc);
    }
  };
  gloadK(0);
  gloadV(0);
  for (int kt = 0; kt <= qb; ++kt) {
    __syncthreads();
#pragma unroll
    for (int i = 0; i < KCH; ++i) {
      const int ch = tid + i * 256;
      const int m = ch / CPM, cc = ch % CPM;
      const int key = cc / CPRK, d0 = (cc % CPRK) * 8;
      *(u32x4*)(sK + (m * 64 + key) * KST + d0) = kr[i];
    }
#pragma unroll
    for (int i = 0; i < 4; ++i) {
      const int ch = tid + i * 256;
      const int dvr = ch >> 3, kc = (ch & 7) * 8;
      *(u32x4*)(sV + dvr * 72 + kc) = vr[i];
    }
    __syncthreads();
    if (kt < qb) gloadK(kt + 1);
#pragma unroll
    for (int m = 0; m < NM; ++m) {
      f32x4 S[4];
#pragma unroll
      for (int nt = 0; nt < 4; ++nt) {
        S[nt] = (f32x4){0.f, 0.f, 0.f, 0.f};
#pragma unroll
        for (int ks = 0; ks < DK / 32; ++ks) {
          const bf16x8 kf = *(const bf16x8*)(sK + (m * 64 + nt * 16 + c) * KST + ks * 32 + g * 8);
          S[nt] = __builtin_amdgcn_mfma_f32_16x16x32_bf16(qf[m][ks], kf, S[nt], 0, 0, 0);
        }
        MEMBAR();
      }
      if (kt == qb) {
#pragma unroll
        for (int nt = 0; nt < 4; ++nt)
#pragma unroll
          for (int r = 0; r < 4; ++r)
            if (nt * 16 + c > w * 16 + g * 4 + r) S[nt][r] = -INFINITY;
      }
      bf16_t* pw = sP + (size_t)((w * NM + m) * 16) * 72;
#pragma unroll
      for (int r = 0; r < 4; ++r) {
        float mx = fmaxf(fmaxf(S[0][r], S[1][r]), fmaxf(S[2][r], S[3][r]));
        mx = fmaxf(mx, __shfl_xor(mx, 1, 64));
        mx = fmaxf(mx, __shfl_xor(mx, 2, 64));
        mx = fmaxf(mx, __shfl_xor(mx, 4, 64));
        mx = fmaxf(mx, __shfl_xor(mx, 8, 64));
        const float mnew = fmaxf(mrow[m][r], mx);
        const float sc = __builtin_amdgcn_exp2f(mrow[m][r] - mnew);
        mrow[m][r] = mnew;
        float ps = 0.f;
#pragma unroll
        for (int nt = 0; nt < 4; ++nt) {
          const float pv = __builtin_amdgcn_exp2f(S[nt][r] - mnew);
          ps += pv;
          pw[(g * 4 + r) * 72 + nt * 16 + c] = f2bf(pv);
        }
        ps += __shfl_xor(ps, 1, 64);
        ps += __shfl_xor(ps, 2, 64);
        ps += __shfl_xor(ps, 4, 64);
        ps += __shfl_xor(ps, 8, 64);
        lsum[m][r] = lsum[m][r] * sc + ps;
#pragma unroll
        for (int nt = 0; nt < 8; ++nt) O[m][nt][r] *= sc;
      }
    }
    __syncthreads();
    if (kt < qb) gloadV(kt + 1);
#pragma unroll
    for (int m = 0; m < NM; ++m) {
      const bf16_t* pw = sP + (size_t)((w * NM + m) * 16) * 72;
#pragma unroll
      for (int ks = 0; ks < 2; ++ks) {
        const bf16x8 pf = *(const bf16x8*)(pw + c * 72 + ks * 32 + g * 8);
#pragma unroll
        for (int nt = 0; nt < 8; ++nt) {
          const bf16x8 vf = *(const bf16x8*)(sV + (nt * 16 + c) * 72 + ks * 32 + g * 8);
          O[m][nt] = __builtin_amdgcn_mfma_f32_16x16x32_bf16(pf, vf, O[m][nt], 0, 0, 0);
        }
        MEMBAR();
      }
    }
  }
}

__device__ __forceinline__ void da_attn_item(const Params& p, int layer, int bh, int qb, bf16_t* smem, bool dry = false) {
  bf16_t* PROJ = (bf16_t*)(p.ws + OFF_PROJ);
  const bf16_t* VTA = (const bf16_t*)(p.ws + OFF_VTA);
  const bf16_t* QKB = (const bf16_t*)(p.ws + OFF_QK);
  const int b = bh >> 2, h = bh & 3;
  f32x4 O[2][8];
  float ls[2][4];
  {
    f32x4 O1[1][8];
    float l1[1][4];
#pragma unroll 1
    for (int m = 0; m < 2; ++m) {
      attn_core<64, 1>(QKB + (size_t)b * 2048 * 1024 + h * 128 + m * 64, 1024, QKB + (size_t)b * 2048 * 1024 + 512 + h * 128 + m * 64, 1024,
                       VTA + (size_t)(b * 4 + h) * 128 * 2048, qb, smem, O1, l1);
      if (m == 0) {
#pragma unroll
        for (int nt = 0; nt < 8; ++nt) O[0][nt] = O1[0][nt];
#pragma unroll
        for (int r = 0; r < 4; ++r) ls[0][r] = l1[0][r];
      } else {
#pragma unroll
        for (int nt = 0; nt < 8; ++nt) O[1][nt] = O1[0][nt];
#pragma unroll
        for (int r = 0; r < 4; ++r) ls[1][r] = l1[0][r];
      }
    }
  }
  const int tid = otid(), w = tid >> 6, l = tid & 63, g = l >> 4, c = l & 15;
  const float lam = ((const float*)(p.ws + OFF_LAM))[layer];
  const float linit = 0.8f - 0.6f * expf(-0.3f * (float)layer);
  const float* sg = p.in[10] + layer * 128;
#pragma unroll
  for (int r = 0; r < 4; ++r) {
    const float i0 = 1.0f / ls[0][r], i1 = lam / ls[1][r];
    float o[8];
    float ss = 0.f;
#pragma unroll
    for (int nt = 0; nt < 8; ++nt) {
      o[nt] = O[0][nt][r] * i0 - O[1][nt][r] * i1;
      ss += o[nt] * o[nt];
    }
    ss += __shfl_xor(ss, 1, 64);
    ss += __shfl_xor(ss, 2, 64);
    ss += __shfl_xor(ss, 4, 64);
    ss += __shfl_xor(ss, 8, 64);
    const float rs = rsqrtf(ss * (1.0f / 128.0f) + EPS) * (1.0f - linit);
    const size_t row = (size_t)b * 2048 + qb * 64 + w * 16 + g * 4 + r;
#pragma unroll
    for (int nt = 0; nt < 8; ++nt) {
      const int dv = nt * 16 + c;
      bf16_t* gp = PROJ + row * LDP + C_DAG + h * 128 + dv;
      const float gt = bf2f(*gp);
      if (!dry) *gp = f2bf(o[nt] * rs * sg[dv] * siluf_(gt));
    }
  }
}

__device__ __forceinline__ void mla_attn_item(const Params& p, int bh, int qb, bf16_t* smem, bool dry = false) {
  bf16_t* PROJ = (bf16_t*)(p.ws + OFF_PROJ);
  const bf16_t* QM = (const bf16_t*)(p.ws + OFF_QM2);
  const bf16_t* KM = (const bf16_t*)(p.ws + OFF_KM);
  const bf16_t* VTD = (const bf16_t*)(p.ws + OFF_VTD);
  const int b = bh >> 2, h = bh & 3;
  f32x4 O[1][8];
  float ls[1][4];
  attn_core<192, 1>(QM + (size_t)b * 2048 * 768 + h * 192, 768, KM + (size_t)b * 2048 * 768 + h * 192, 768,
                    VTD + (size_t)(b * 4 + h) * 128 * 2048, qb, smem, O, ls);
  const int tid = otid(), w = tid >> 6, l = tid & 63, g = l >> 4, c = l & 15;
#pragma unroll
  for (int r = 0; r < 4; ++r) {
    const float i0 = 1.0f / ls[0][r];
    const size_t row = (size_t)b * 2048 + qb * 64 + w * 16 + g * 4 + r;
#pragma unroll
    for (int nt = 0; nt < 8; ++nt) {
      const int dv = nt * 16 + c;
      bf16_t* gp = PROJ + row * LDP + C_MLG + h * 128 + dv;
      const float gt = bf2f(*gp);
      if (!dry) *gp = f2bf(O[0][nt][r] * i0 * siluf_(gt));
    }
  }
}

__device__ __forceinline__ void mb_out_item(const Params& p, int layer, int item, bf16_t* smem) {
  bf16_t* PROJ = (bf16_t*)(p.ws + OFF_PROJ);
  const bf16_t* XC = (const bf16_t*)(p.ws + OFF_XC);
  const float* DT = (const float*)(p.ws + OFF_DT);
  const float* AC = (const float*)(p.ws + OFF_ACUM);
  const bf16_t* SIN = (const bf16_t*)(p.ws + OFF_SIN);
  bf16_t* MS0 = (bf16_t*)(p.ws + OFF_MS) + (size_t)blockIdx.x * 4 * 128 * 128;
  float* rowss = (float*)((unsigned char*)smem + 73728);
  const int grp = item & 1, bc = item >> 1;
  const int row0 = bc * 128;
  __syncthreads();
  const bf16_t* Cp = XC + (size_t)row0 * 1024 + 768 + grp * 128;
  const bf16_t* Bp = XC + (size_t)row0 * 1024 + 512 + grp * 128;
  {
    const int tid = otid(), w = tid >> 6, l = tid & 63, g = l >> 4, c = l & 15, wr = w >> 1, wc = w & 1;
    f32x4 cb[4][4];
    zero_acc<4>(cb);
    gemm_tile<128, false, false, false>(cb, Cp, 1024, Bp, 1024, 128, smem);
#pragma unroll 1
    for (int r4 = 0; r4 < 4; ++r4) {
      const int h = grp * 4 + r4;
      bf16_t* MS = MS0 + (size_t)r4 * 128 * 128;
      float acs[4], dts[4];
#pragma unroll
      for (int j = 0; j < 4; ++j) {
        const int s = wc * 64 + j * 16 + c;
        acs[j] = AC[(size_t)(row0 + s) * 8 + h];
        dts[j] = DT[(size_t)(row0 + s) * 8 + h];
      }
#pragma unroll
      for (int i = 0; i < 4; ++i)
#pragma unroll
        for (int r = 0; r < 4; ++r) {
          const int lr = wr * 64 + i * 16 + g * 4 + r;
          const float acl = AC[(size_t)(row0 + lr) * 8 + h];
#pragma unroll
          for (int j = 0; j < 4; ++j) {
            const int s = wc * 64 + j * 16 + c;
            const float v = (s <= lr) ? cb[i][j][r] * __expf(acl - acs[j]) * dts[j] : 0.f;
            MS[lr * 128 + s] = f2bf(v);
          }
          MEMBAR();
        }
    }
  }
  block_global_handoff();
#pragma unroll 1
  for (int r4 = 0; r4 < 4; ++r4) {
    const int h = grp * 4 + r4;
    const bf16_t* MS = MS0 + (size_t)r4 * 128 * 128;
    const int tid = otid(), w = tid >> 6, l = tid & 63, g = l >> 4, c = l & 15, wr = w >> 1, wc = w & 1;
    f32x4 ad[4][2], ao[4][2];
    zero_acc<2>(ad);
    zero_acc<2>(ao);
    gemm_tile<64, false, true, false>(ad, MS, 128, XC + (size_t)row0 * 1024 + h * 64, 1024, 128, smem);
    gemm_tile<64, false, false, false>(ao, Cp, 1024, SIN + ((size_t)(bc * 8 + h)) * 8192, 128, 128, smem);
    const float dsk = p.in[15][layer * 8 + h];
#pragma unroll
    for (int i = 0; i < 4; ++i)
#pragma unroll
      for (int r = 0; r < 4; ++r) {
        const int lr = wr * 64 + i * 16 + g * 4 + r;
        const size_t row = (size_t)row0 + lr;
        const float ea = __expf(AC[row * 8 + h]);
        float ssq = 0.f;
#pragma unroll
        for (int j = 0; j < 2; ++j) {
          const int ch = h * 64 + wc * 32 + j * 16 + c;
          const float xv = bf2f(XC[row * 1024 + ch]);
          bf16_t* zp = PROJ + row * LDP + C_MBZ + ch;
          const float z = bf2f(*zp);
          float y = ad[i][j][r] + ea * ao[i][j][r] + dsk * xv;
          y *= siluf_(z);
          ssq += y * y;
          *zp = f2bf(y);
        }
        ssq += __shfl_xor(ssq, 1, 64);
        ssq += __shfl_xor(ssq, 2, 64);
        ssq += __shfl_xor(ssq, 4, 64);
        ssq += __shfl_xor(ssq, 8, 64);
        if (c == 0) rowss[(r4 * 2 + wc) * 128 + lr] = ssq;
        MEMBAR();
      }
  }
  block_global_handoff();
  const float* ng = p.in[16] + layer * 512 + grp * 256;
  {
    const int cc = otid();
    const float gcc = ng[cc];
    for (int l0 = 0; l0 < 128; l0 += 16) {
      bf16_t vals[16];
#pragma unroll
      for (int u = 0; u < 16; ++u) vals[u] = PROJ[(size_t)(row0 + l0 + u) * LDP + C_MBZ + grp * 256 + cc];
#pragma unroll
      for (int u = 0; u < 16; ++u) {
        const int lr = l0 + u;
        float tot = 0.f;
#pragma unroll
        for (int q = 0; q < 8; ++q) tot += rowss[q * 128 + lr];
        PROJ[(size_t)(row0 + lr) * LDP + C_MBZ + grp * 256 + cc] = f2bf(bf2f(vals[u]) * rsqrtf(tot * (1.0f / 256.0f) + EPS) * gcc);
      }
    }
  }
}

__device__ __forceinline__ void s5_glu_tile(const Params& p, int layer, int rt, int ct, bf16_t* smem) {
  bf16_t* PROJ = (bf16_t*)(p.ws + OFF_PROJ);
  const bf16_t* YG = (const bf16_t*)(p.ws + OFF_YG);
  const bf16_t* W = (const bf16_t*)(p.ws + OFF_WGLUT) + (size_t)layer * 512 * 512;
  f32x4 acc[4][4];
  zero_acc<4>(acc);
  gemm_tile<128, false, false, false>(acc, YG + (size_t)rt * 128 * 512, 512, W + (size_t)ct * 128 * 512, 512, 512, smem);
  const int tid = otid(), w = tid >> 6, l = tid & 63, g = l >> 4, c = l & 15, wr = w >> 1, wc = w & 1;
  const float* bg = p.in[26] + layer * 512;
#pragma unroll
  for (int i = 0; i < 4; ++i)
#pragma unroll
    for (int j = 0; j < 4; ++j) {
      const int col = ct * 128 + wc * 64 + j * 16 + c;
      const float bb = bg[col];
#pragma unroll
      for (int r = 0; r < 4; ++r) {
        const size_t row = (size_t)rt * 128 + wr * 64 + i * 16 + g * 4 + r;
        const float yv = bf2f(YG[row * 512 + col]);
        bf16_t* gp = PROJ + row * LDP + C_S5G + col;
        const float gt = bf2f(*gp);
        *gp = f2bf(yv * sigmoidf_(acc[i][j][r] + bb) * siluf_(gt));
      }
    }
}

__device__ __forceinline__ void merge_tile(const Params& p, int layer, int rt, int ct, bf16_t* smem) {
  const bf16_t* PROJ = (const bf16_t*)(p.ws + OFF_PROJ);
  bf16_t* MG = (bf16_t*)(p.ws + OFF_MERGED);
  f32x4 macc[4][2];
  zero_acc<2>(macc);
  const int tid = otid(), w = tid >> 6, l = tid & 63, g = l >> 4, c = l & 15, wr = w >> 1, wc = w & 1;
  for (int n = 0; n < 4; ++n) {
    const int ycol = (n == 0) ? C_DAG : (n == 1) ? C_MBZ : (n == 2) ? C_S5G : C_MLG;
    const bf16_t* W = (const bf16_t*)(p.ws + OFF_WBRT) + (size_t)(layer * 4 + n) * 1024 * 512;
    f32x4 acc[4][2];
    zero_acc<2>(acc);
    gemm_tile<64, false, false, false>(acc, PROJ + (size_t)rt * 128 * LDP + ycol, LDP, W + (size_t)ct * 64 * 512, 512, 512, smem);
#pragma unroll
    for (int i = 0; i < 4; ++i) {
#pragma unroll
      for (int r = 0; r < 4; ++r) {
        const size_t row = (size_t)rt * 128 + wr * 64 + i * 16 + g * 4 + r;
        const bf16_t* gp = PROJ + row * LDP + C_GATE + n * 1024 + ct * 64 + wc * 32 + c;
#pragma unroll
        for (int j = 0; j < 2; ++j) macc[i][j][r] += bf2f(gp[j * 16]) * acc[i][j][r];
      }
      MEMBAR();
    }
  }
#pragma unroll
  for (int i = 0; i < 4; ++i) {
#pragma unroll
    for (int r = 0; r < 4; ++r) {
      const size_t row = (size_t)rt * 128 + wr * 64 + i * 16 + g * 4 + r;
      bf16_t* op = MG + row * 1024 + ct * 64 + wc * 32 + c;
#pragma unroll
      for (int j = 0; j < 2; ++j) op[j * 16] = f2bf(macc[i][j][r]);
    }
    MEMBAR();
  }
}

__device__ __forceinline__ void out_tile(const Params& p, int layer, const float* xo, float* xn, int rt, int ct, bf16_t* smem) {
  const bf16_t* MG = (const bf16_t*)(p.ws + OFF_MERGED);
  const bf16_t* W = (const bf16_t*)(p.ws + OFF_WOUTT) + (size_t)layer * 1024 * 1024;
  f32x4 acc[4][4];
  zero_acc<4>(acc);
  gemm_tile<128, false, false, false>(acc, MG + (size_t)rt * 128 * 1024, 1024, W + (size_t)ct * 128 * 1024, 1024, 1024, smem);
  const int tid = otid(), w = tid >> 6, l = tid & 63, g = l >> 4, c = l & 15, wr = w >> 1, wc = w & 1;
#pragma unroll
  for (int i = 0; i < 4; ++i)
#pragma unroll
    for (int j = 0; j < 4; ++j) {
      const int col = ct * 128 + wc * 64 + j * 16 + c;
#pragma unroll
      for (int r = 0; r < 4; ++r) {
        const size_t row = (size_t)rt * 128 + wr * 64 + i * 16 + g * 4 + r;
        xn[row * 1024 + col] = xo[row * 1024 + col] + acc[i][j][r];
      }
    }
}

struct Bx { unsigned xcd, nloc, nx, hier; };
__device__ __forceinline__ unsigned xcc_id() { return (unsigned)__builtin_amdgcn_s_getreg((3 << 11) | 20) & 0x7u; }
__device__ __forceinline__ void gsync_flat(unsigned* bar) {
  asm volatile("s_waitcnt vmcnt(0)" ::: "memory");
  __syncthreads();
  if (otid() == 0) {
    unsigned long long* w = (unsigned long long*)bar;
    __builtin_amdgcn_fence(__ATOMIC_RELEASE, "agent");
    asm volatile("s_waitcnt vmcnt(0)" ::: "memory");
    const unsigned long long old = __hip_atomic_fetch_add(w, 1ull, __ATOMIC_RELAXED, __HIP_MEMORY_SCOPE_AGENT);
    const unsigned G = gridDim.x;
    if ((unsigned)(old & 0xffffffffull) == G - 1) {
      __hip_atomic_fetch_add(w, (1ull << 32) - (unsigned long long)G, __ATOMIC_RELAXED, __HIP_MEMORY_SCOPE_AGENT);
    } else {
      const unsigned g0 = (unsigned)(old >> 32);
      while ((unsigned)(__hip_atomic_load(w, __ATOMIC_RELAXED, __HIP_MEMORY_SCOPE_AGENT) >> 32) == g0) __builtin_amdgcn_s_sleep(1);
    }
    __builtin_amdgcn_fence(__ATOMIC_ACQUIRE, "agent");
    asm volatile("s_waitcnt vmcnt(0)" ::: "memory");
  }
  __syncthreads();
}
__device__ __forceinline__ void gsync(cg::grid_group& grid, unsigned* bar, unsigned& epoch, const volatile unsigned* bxs) {
  asm volatile("s_waitcnt vmcnt(0)" ::: "memory");
  __syncthreads();
  if (otid() == 0) {
    const unsigned xcd = bxs[0], nloc = bxs[1], nx = bxs[2];
    unsigned long long* L = (unsigned long long*)((unsigned char*)bar + 3072 + 256 * xcd);
    unsigned long long* T = (unsigned long long*)((unsigned char*)bar + 5120);
    const unsigned long long old = __hip_atomic_fetch_add(L, 1ull, __ATOMIC_RELAXED, __HIP_MEMORY_SCOPE_AGENT);
    if ((unsigned)(old & 0xffffffffull) == nloc - 1) {
      __builtin_amdgcn_fence(__ATOMIC_RELEASE, "agent");
      asm volatile("s_waitcnt vmcnt(0)" ::: "memory");
      const unsigned long long oldt = __hip_atomic_fetch_add(T, 1ull, __ATOMIC_RELAXED, __HIP_MEMORY_SCOPE_AGENT);
      if ((unsigned)(oldt & 0xffffffffull) == nx - 1) {
        __hip_atomic_fetch_add(T, (1ull << 32) - (unsigned long long)nx, __ATOMIC_RELAXED, __HIP_MEMORY_SCOPE_AGENT);
      } else {
        const unsigned gt = (unsigned)(oldt >> 32);
        while ((unsigned)(__hip_atomic_load(T, __ATOMIC_RELAXED, __HIP_MEMORY_SCOPE_AGENT) >> 32) == gt) __builtin_amdgcn_s_sleep(1);
      }
      __hip_atomic_fetch_add(L, (1ull << 32) - (unsigned long long)nloc, __ATOMIC_RELAXED, __HIP_MEMORY_SCOPE_AGENT);
    } else {
      const unsigned g0 = (unsigned)(old >> 32);
      while ((unsigned)(__hip_atomic_load(L, __ATOMIC_RELAXED, __HIP_MEMORY_SCOPE_AGENT) >> 32) == g0) __builtin_amdgcn_s_sleep(1);
    }
    __builtin_amdgcn_fence(__ATOMIC_ACQUIRE, "agent");
    asm volatile("s_waitcnt vmcnt(0)" ::: "memory");
  }
  __syncthreads();
}

#ifdef SELFCHECK
__device__ __forceinline__ void cksum(const void* ptr, size_t bytes, unsigned long long* slot) {
  const u32x4* q = (const u32x4*)ptr;
  const size_t n = bytes / 16;
  unsigned long long s = 0;
  for (size_t i = (size_t)blockIdx.x * 256 + otid(); i < n; i += (size_t)gridDim.x * 256) {
    const u32x4 v = q[i];
    s += (unsigned long long)v.x + 3ull * v.y + 5ull * v.z + 7ull * v.w;
  }
  unsigned lo = (unsigned)s, hi = (unsigned)(s >> 32);
  unsigned long long t = s;
#pragma unroll
  for (int d = 32; d >= 1; d >>= 1) {
    const unsigned l2 = __shfl_xor((unsigned)t, d, 64), h2 = __shfl_xor((unsigned)(t >> 32), d, 64);
    t += ((unsigned long long)h2 << 32) | l2;
  }
  (void)lo; (void)hi;
  if ((otid() & 63) == 0) atomicAdd(slot, t);
}
#define CK(ptr, bytes) cksum((ptr), (bytes), slots + slot)
#else
#define CK(ptr, bytes) do {} while (0)
#endif

__device__ __forceinline__ void cksum_acc(const void* ptr, size_t bytes, unsigned long long& s) {
  const u32x4* q = (const u32x4*)ptr;
  const size_t n = bytes / 16;
  for (size_t i = ((size_t)blockIdx.x * 256 + otid()) * 64; i < n; i += (size_t)gridDim.x * 256 * 64) {
    const u32x4 v = __builtin_nontemporal_load(q + i);
    s += (unsigned long long)v.x + 3ull * v.y + 5ull * v.z + 7ull * v.w;
  }
}
__device__ __forceinline__ void cksum_commit(unsigned long long t, unsigned long long* slot) {
#pragma unroll
  for (int d = 32; d >= 1; d >>= 1) {
    const unsigned l2 = __shfl_xor((unsigned)t, d, 64), h2 = __shfl_xor((unsigned)(t >> 32), d, 64);
    t += ((unsigned long long)h2 << 32) | l2;
  }
  if ((otid() & 63) == 0) atomicAdd(slot, t);
}

__global__ void __launch_bounds__(256, 2) fwd_megakernel(Params p) {
  cg::grid_group grid = cg::this_grid();
  __shared__ __attribute__((aligned(16))) unsigned char smem_raw[SMEM_BYTES];
  bf16_t* smem = (bf16_t*)smem_raw;
  float* smf = (float*)smem_raw;
  const int G = gridDim.x, bid = blockIdx.x;
  unsigned* bar = (unsigned*)(p.ws + OFF_BAR);
  unsigned epoch = 0;
  volatile unsigned* bxs = (volatile unsigned*)(smem_raw + 73728 + 4096);
  if (otid() == 0) {
    const unsigned xc = xcc_id();
    bxs[0] = xc; bxs[1] = 0u; bxs[2] = 0u; bxs[3] = 0u;
    __hip_atomic_fetch_add((unsigned*)((unsigned char*)bar + 2048 + 128 * xc), 1u, __ATOMIC_RELAXED, __HIP_MEMORY_SCOPE_AGENT);
  }
  __syncthreads();
#ifdef START_DELAY_US
  {
    const unsigned long long t0 = __builtin_amdgcn_s_memrealtime();
    while (__builtin_amdgcn_s_memrealtime() - t0 < (unsigned long long)START_DELAY_US * 100ull) __builtin_amdgcn_s_sleep(20);
  }
#endif
  if (p.ws == nullptr) grid.sync();
#ifdef WCHECK
  unsigned wseen = 0;
  if (bid == 0 && otid() == 0) wseen = __hip_atomic_load(bar + 32, __ATOMIC_RELAXED, __HIP_MEMORY_SCOPE_AGENT);
#endif

#ifdef SELFCHECK
  unsigned long long* slots_base = (unsigned long long*)(p.ws + OFF_BAR + 256);
  if (bid == 0) for (int k = otid(); k < 768; k += 256) __hip_atomic_store(slots_base + k, 0ull, __ATOMIC_RELAXED, __HIP_MEMORY_SCOPE_AGENT);
  for (int run = 0; run < 3; ++run) {
  unsigned long long* slots = slots_base + run * 256;
  int slot = 0;
#endif
  gsync_flat(bar);
  {
    if (otid() == 0) {
      unsigned nl = 0, nxx = 0;
      const unsigned xc = bxs[0];
      for (int j = 0; j < 8; ++j) {
        const unsigned cj = __hip_atomic_load((unsigned*)((unsigned char*)bar + 2048 + 128 * j), __ATOMIC_RELAXED, __HIP_MEMORY_SCOPE_AGENT);
        nxx += (cj > 0u) ? 1u : 0u;
        nl = ((unsigned)j == xc) ? cj : nl;
      }
      bxs[1] = nl; bxs[2] = nxx; bxs[3] = 1u;
    }
    __syncthreads();
  }
  phase_prep(p, smf);
#ifdef SELF_POISON
  {
    u32x4* q = (u32x4*)(p.ws + OFF_H);
    const size_t n16 = (WS_TOTAL - OFF_H) / 16;
    const u32x4 pv = {SELF_POISON, SELF_POISON, SELF_POISON, SELF_POISON};
    for (size_t i = (size_t)bid * 256 + otid(); i < n16; i += (size_t)G * 256) q[i] = pv;
  }
#endif
  gsync(grid, bar, epoch, bxs);
#ifdef SELFCHECK
  CK(p.ws, OFF_H); slot++;
#endif

  for (int layer = 0; layer < 2; ++layer) {
    const float* xin = (layer == 0) ? p.in[0] : p.out;
    float* xout = p.out;
    for (int round = 0; round < NROUND; ++round) {
      const size_t tok0 = (size_t)round * TR;
      if (layer == 0 && round == 0) {
        phase_hnorm(xin + tok0 * 1024, p.in[2] + layer * 1024, (bf16_t*)(p.ws + OFF_H));
        gsync(grid, bar, epoch, bxs);
      }
#ifdef SELFCHECK
      CK(p.ws + OFF_H, (size_t)TR * 1024 * 2); slot++;
#endif
#ifndef REP_B
#define REP_B 1
#endif
      for (int rep = 0; rep < REP_B; ++rep) {
      for (int it = bid; it < NRT * 76; it += G) inproj_tile(p, layer, it % NRT, it / NRT, smem);
      gsync(grid, bar, epoch, bxs);
      }
#ifdef SELFCHECK
      CK(p.ws + OFF_PROJ, (size_t)TR * D_INP * 2); CK(p.ws + OFF_VTA, (size_t)RB * 4 * 128 * 2048 * 2); slot++;
#endif
      {
        constexpr int n1 = 256, n2 = TR / 16, n3 = RB * 32 * 16, n4 = RB * 16 * 8 / 4;
        for (int it = bid; it < n1 + n2 + n3 + n4; it += G) {
          if (it < n1) s5_e_item(p, layer, it, smem);
          else if (it < n1 + n2) tokpost_item(p, layer, round, it - n1);
          else if (it < n1 + n2 + n3) conv_item(p, layer, it - n1 - n2);
          else dtacum_item(p, layer, it - n1 - n2 - n3);
        }
      }
      gsync(grid, bar, epoch, bxs);
#ifdef SELFCHECK
      CK(p.ws + OFF_PROJ, (size_t)TR * D_INP * 2); CK(p.ws + OFF_E, (size_t)32 * 128 * NBC * 4); CK(p.ws + OFF_XC, (size_t)TR * 1024 * 2);
      CK(p.ws + OFF_DT, (size_t)TR * 8 * 4); CK(p.ws + OFF_ACUM, (size_t)TR * 8 * 4); slot++;
#endif
      {
        constexpr int n1 = NRT * 6, n2 = NRT * 8, n3 = RB * 16 * 8, n4 = RB * 32 * 64 / 256;
        for (int it = bid; it < n1 + n2 + n3 + n4; it += G) {
          if (it < n1) mla_up_q_tile(p, layer, it % NRT, it / NRT, smem);
          else if (it < n1 + n2) mla_up_kv_tile(p, layer, (it - n1) % NRT, (it - n1) / NRT, smem);
          else if (it < n1 + n2 + n3) mb_states_item(p, it - n1 - n2, smem);
          else s5_carry_item(p, layer, it - n1 - n2 - n3);
        }
      }
      gsync(grid, bar, epoch, bxs);
#ifdef SELFCHECK
      CK(p.ws + OFF_QM, (size_t)TR * 768 * 2); CK(p.ws + OFF_KN, (size_t)TR * 512 * 2); CK(p.ws + OFF_VTD, (size_t)RB * 4 * 128 * 2048 * 2);
      CK(p.ws + OFF_ST, (size_t)RB * 16 * 8 * 8192 * 4); CK(p.ws + OFF_HIN, (size_t)32 * 128 * NBC * 2); slot++;
#endif
      {
        constexpr int n1 = 256, n2 = TR / 16, n3 = RB * 8 * 8192 / 256;
        for (int it = bid; it < n1 + n2 + n3; it += G) {
          if (it < n1) s5_y_item(p, layer, it, smem);
          else if (it < n1 + n2) mlapost_item(p, layer, round, it - n1);
          else mb_scan_item(p, it - n1 - n2);
        }
      }
      gsync(grid, bar, epoch, bxs);
#ifdef SELFCHECK
      CK(p.ws + OFF_YG, (size_t)TR * 512 * 2); CK(p.ws + OFF_QM, (size_t)TR * 768 * 2); CK(p.ws + OFF_KM, (size_t)TR * 768 * 2);
      CK(p.ws + OFF_SIN, (size_t)RB * 16 * 8 * 8192 * 2); slot++;
#endif
#ifdef REP_ATT
      {
        constexpr int nat = RB * 4 * 32 * 2;
        for (int it = bid; it < nat; it += G) {
            const int half = nat / 2;
            const int qb = (it < half) ? (31 - it / 32) : ((it - half) / 32);
            const int sub = it & 31;
            if (sub < 16) da_attn_item(p, layer, sub, qb, smem, true);
            else mla_attn_item(p, sub - 16, qb, smem, true);
        }
        gsync(grid, bar, epoch, bxs);
      }
#endif
      {
        constexpr int nat = RB * 4 * 32 * 2;
        constexpr int n3 = RB * 16 * 2, n4 = NRT * 4;
        const int nmb = (G > n3 + 64) ? n3 : 0;
        if (bid < nmb) {
          mb_out_item(p, layer, bid, smem);
        } else {
          const int j = bid - nmb, W = G - nmb;
          if (nmb == 0) for (int it = bid; it < n3; it += G) mb_out_item(p, layer, it, smem);
          for (int r = 0; r * W < nat; ++r) {
            const int k = (r & 1) ? ((r + 1) * W - 1 - j) : (r * W + j);
            if (k < nat) {
              const int qb = 31 - (k >> 5), sub = k & 31;
              if (sub < 16) da_attn_item(p, layer, sub, qb, smem);
              else mla_attn_item(p, sub - 16, qb, smem);
            }
          }
          for (int t = W - 1 - j; t < n4; t += W) s5_glu_tile(p, layer, t % NRT, t / NRT, smem);
        }
      }
      gsync(grid, bar, epoch, bxs);
#ifdef SELFCHECK
      CK(p.ws + OFF_PROJ, (size_t)TR * D_INP * 2); slot++;
#endif
      for (int it = bid; it < NRT * 16; it += G) merge_tile(p, layer, it % NRT, it / NRT, smem);
      gsync(grid, bar, epoch, bxs);
#ifdef SELFCHECK
      CK(p.ws + OFF_MERGED, (size_t)TR * 1024 * 2); slot++;
#endif
      for (int it = bid; it < NRT * 8; it += G) out_tile(p, layer, xin + tok0 * 1024, xout + tok0 * 1024, it % NRT, it / NRT, smem);
      {
        const int nl = (round + 1 < NROUND) ? layer : layer + 1;
        const int nr = (round + 1 < NROUND) ? round + 1 : 0;
        if (nl < 2) {
          const float* nx = (nl == 0) ? p.in[0] : p.out;
          phase_hnorm(nx + (size_t)nr * TR * 1024, p.in[2] + nl * 1024, (bf16_t*)(p.ws + OFF_H));
        }
      }
      gsync(grid, bar, epoch, bxs);
#ifdef SELFCHECK
      CK(xout + tok0 * 1024, (size_t)TR * 1024 * 4); slot++;
#endif
    }
  }
#ifdef WCHECK
  if (bid == 0 && otid() == 0) {
    if (wseen != 0) p.out[0] = 1.0e6f;
    __hip_atomic_store(bar + 32, 1u, __ATOMIC_RELAXED, __HIP_MEMORY_SCOPE_AGENT);
  }
#endif
#ifdef SELFCHECK
  gsync(grid, bar, epoch, bxs);
  }
  gsync(grid, bar, epoch, bxs);
  if (bid == 0 && otid() == 0) {
    int bad = -1;
    for (int k = 0; k < 100; ++k) {
      const unsigned long long a = __hip_atomic_load(slots_base + k, __ATOMIC_RELAXED, __HIP_MEMORY_SCOPE_AGENT);
      const unsigned long long b = __hip_atomic_load(slots_base + 256 + k, __ATOMIC_RELAXED, __HIP_MEMORY_SCOPE_AGENT);
      const unsigned long long c = __hip_atomic_load(slots_base + 512 + k, __ATOMIC_RELAXED, __HIP_MEMORY_SCOPE_AGENT);
      if (a != b || a != c) { bad = k; break; }
    }
    if (bad >= 0) p.out[0] = 10000.0f * exp2f((float)bad);
  }
#endif
}

extern "C" void kernel_launch(void* const* d_in, const int* in_sizes, int n_in, void* d_out,
                              int out_size, void* d_ws, size_t ws_size, hipStream_t stream) {
  static int grid_blocks = 0;
  if (!grid_blocks) {
    int dev = 0, cus = 0, per_cu = 0;
    (void)hipGetDevice(&dev);
    (void)hipDeviceGetAttribute(&cus, hipDeviceAttributeMultiprocessorCount, dev);
    (void)hipOccupancyMaxActiveBlocksPerMultiprocessor(&per_cu, fwd_megakernel, 256, 0);
    if (per_cu > 2) per_cu = 2;
    if (per_cu < 1) per_cu = 1;
    grid_blocks = cus * per_cu;
    if (grid_blocks > MAXBLK) grid_blocks = MAXBLK;
  }
  if (ws_size < WS_TOTAL) fprintf(stderr, "workspace too small: %zu < %zu\n", ws_size, (size_t)WS_TOTAL);
  Params p{};
  for (int i = 0; i < 35; ++i) p.in[i] = (const float*)d_in[i];
  p.out = (float*)d_out;
  p.ws = (unsigned char*)d_ws;
  (void)hipMemsetAsync((unsigned char*)d_ws + OFF_BAR, 0, 8192, stream);
  void* args[] = {&p};
  hipError_t e = hipLaunchCooperativeKernel((void*)fwd_megakernel, dim3(grid_blocks), dim3(256), args, 0, stream);
  if (e != hipSuccess) fprintf(stderr, "cooperative launch failed: %s (grid %d)\n", hipGetErrorString(e), grid_blocks);
}
```
